# Optimizing an MI355X kernel written in HIP

```python
import math
import jax
import jax.numpy as jnp
from jax import lax
import numpy as np

D_MODEL = 1024
BATCH = 4
SEQ = 8192
DEPTH = 2

CTX_LEN = 256
GRID_W = 64

DN_HEADS = 4
DN_DK = 64
DN_DV = 64
DN_CONV = 5
DN_CHUNK = 64
DT_MIN = 0.001
DT_MAX = 0.1

S5_WIDTH = 256
S5_GROUP = 16
S5_GROUPS = S5_WIDTH // S5_GROUP
S5_STATE = 64

DA_HEADS = 4
DA_DK = 32
DA_DV = 2 * DA_DK
DA_QBLOCK = 128
ROPE_BASE = 10000.0

GLA_HEADS = 4
GLA_DK = 32
GLA_DV = 64
GLA_GATE_RANK = 16
GLA_TAU = 16.0
GLA_CHUNK = 16

N_BRANCH = 4
BRANCH_WIDTH = 256

N_EXPERTS = 16
N_GROUPS = 4
EXPERTS_PER_GROUP = N_EXPERTS // N_GROUPS
TOP_K = 2
D_EXPERT = 512
MOE_BLOCK = 128

NORM_EPS = 1e-6

PROJ_LAYOUT = (
    ("dn_qkv", DN_HEADS * (2 * DN_DK + DN_DV)),
    ("dn_z", DN_HEADS * DN_DV),
    ("dn_a", 2 * DN_HEADS),
    ("dn_b", 2 * DN_HEADS),
    ("s5_u", S5_WIDTH),
    ("da_q", DA_HEADS * 2 * DA_DK),
    ("da_k", DA_HEADS * 2 * DA_DK),
    ("da_v", DA_HEADS * DA_DV),
    ("gla_q", GLA_HEADS * GLA_DK),
    ("gla_k", GLA_HEADS * GLA_DK),
    ("gla_v", GLA_HEADS * GLA_DV),
    ("gla_r", GLA_HEADS * GLA_DV),
    ("gla_gate", 2 * GLA_GATE_RANK),
)
D_IN = sum(w for _, w in PROJ_LAYOUT)

kernel_name = "hybrid_flow_deltanet_s5_diffattn_gla_moe"

F32 = jnp.float32


def rmsnorm(x, g, eps=NORM_EPS):
    xf = x.astype(F32)
    y = xf * lax.rsqrt(jnp.mean(xf * xf, axis=-1, keepdims=True) + eps)
    return (y * g.astype(F32)).astype(x.dtype)


def l2norm(x, eps=1e-6):
    xf = x.astype(F32)
    return xf * lax.rsqrt(jnp.sum(xf * xf, axis=-1, keepdims=True) + eps)


def modulate(xn, shift, scale):
    return xn * (1.0 + scale) + shift


def split_proj(z):
    out, off = {}, 0
    for name, width in PROJ_LAYOUT:
        out[name] = z[..., off:off + width]
        off += width
    return out


def joint_order(ctx_part, lat_part, reverse):
    if reverse:
        ctx_part, lat_part = jnp.flip(ctx_part, 1), jnp.flip(lat_part, 1)
    return jnp.concatenate([ctx_part, lat_part], axis=1)


def split_order(y, n_ctx, reverse):
    y_ctx, y_lat = y[:, :n_ctx], y[:, n_ctx:]
    if reverse:
        y_ctx, y_lat = jnp.flip(y_ctx, 1), jnp.flip(y_lat, 1)
    return y_ctx, y_lat


def centred_dwconv(x, w):
    k = w.shape[0]
    return lax.conv_general_dilated(
        x, w[:, None, :].astype(x.dtype), window_strides=(1,), padding=[(k // 2, k // 2)],
        dimension_numbers=("NWC", "WIO", "NWC"), feature_group_count=x.shape[-1])


def axial_rope_tables(n_rows, head_dim):
    t = jnp.arange(n_rows * GRID_W)
    row = (t // GRID_W).astype(F32)
    col = (t % GRID_W).astype(F32)
    n_freq = head_dim // 4
    inv = ROPE_BASE ** (-jnp.arange(n_freq, dtype=F32) / n_freq)
    ang = jnp.concatenate([row[:, None] * inv, col[:, None] * inv], axis=-1)
    return jnp.cos(ang), jnp.sin(ang)


def apply_rope(x, cos, sin):
    half = x.shape[-1] // 2
    cos, sin = cos[:, None, None, :], sin[:, None, None, :]
    x1, x2 = x[..., :half], x[..., half:]
    return jnp.concatenate([x1 * cos - x2 * sin, x1 * sin + x2 * cos], axis=-1).astype(x.dtype)


def gated_delta_rule_chunked(q, k, v, g, beta):
    B, T, H, dk = q.shape
    dv = v.shape[-1]
    C = DN_CHUNK
    n = T // C

    def to_chunks(t):
        return jnp.moveaxis(t.astype(F32), 1, 2).reshape((B, H, n, C) + t.shape[3:])

    q = to_chunks(q) * dk ** -0.5
    k, v, beta = to_chunks(k), to_chunks(v), to_chunks(beta)
    g = jnp.cumsum(to_chunks(g), axis=-1)
    incl = jnp.tril(jnp.ones((C, C), bool))
    strict = jnp.tril(jnp.ones((C, C), bool), -1)
    decay = jnp.where(incl, jnp.exp(jnp.where(incl, g[..., :, None] - g[..., None, :], 0.0)), 0.0)
    kb = k * beta[..., None]
    lower = jnp.where(strict, jnp.einsum("bhnid,bhnjd->bhnij", kb, k) * decay, 0.0)
    rhs = jnp.concatenate([v * beta[..., None], kb * jnp.exp(g)[..., None]], axis=-1)
    sol = lax.linalg.triangular_solve(lower + jnp.eye(C, dtype=F32), rhs,
                                      left_side=True, lower=True, unit_diagonal=True)
    u, w = sol[..., :dv], sol[..., dv:]
    a_intra = jnp.where(incl, jnp.einsum("bhnid,bhnjd->bhnij", q, k) * decay, 0.0)
    q_dec = q * jnp.exp(g)[..., None]
    k_dec = k * jnp.exp(g[..., -1:] - g)[..., None]
    g_last = jnp.exp(g[..., -1])

    def step(state, xs):
        qd, kd, u_i, w_i, a_i, gl = xs
        v_new = u_i - w_i @ state
        o = qd @ state + a_i @ v_new
        state = state * gl[..., None, None] + jnp.einsum("bhcd,bhcv->bhdv", kd, v_new)
        return state, o

    xs = tuple(jnp.moveaxis(t, 2, 0) for t in (q_dec, k_dec, u, w, a_intra, g_last))
    _, o = lax.scan(step, jnp.zeros((B, H, dk, dv), F32), xs)
    return jnp.moveaxis(o, 0, 2).reshape(B, H, T, dv).transpose(0, 2, 1, 3)


def deltanet_mixer(p_lat, p_ctx, conv_w, a_log, dt_bias, norm_g, with_ctx):
    n_ctx = p_ctx["dn_qkv"].shape[1]

    def prep(p):
        qkv = jax.nn.silu(centred_dwconv(p["dn_qkv"], conv_w))
        b_, t_ = qkv.shape[:2]
        q, k, v = jnp.split(qkv, [DN_HEADS * DN_DK, 2 * DN_HEADS * DN_DK], axis=-1)
        q = l2norm(q.reshape(b_, t_, DN_HEADS, DN_DK))
        k = l2norm(k.reshape(b_, t_, DN_HEADS, DN_DK))
        return q, k, v.reshape(b_, t_, DN_HEADS, DN_DV)

    ql, kl, vl = prep(p_lat)
    qc, kc, vc = prep(p_ctx)
    o_lat, o_ctx = 0.0, 0.0
    for d in range(2):
        rev = d == 1
        cols = slice(d * DN_HEADS, (d + 1) * DN_HEADS)

        def gates(p):
            a = p["dn_a"][..., cols].astype(F32)
            b = p["dn_b"][..., cols].astype(F32)
            g = -jnp.exp(a_log[d].astype(F32)) * jax.nn.softplus(a + dt_bias[d].astype(F32))
            return g, jax.nn.sigmoid(b)

        gl, bl = gates(p_lat)
        gc, bc = gates(p_ctx)
        o = gated_delta_rule_chunked(joint_order(qc, ql, rev), joint_order(kc, kl, rev),
                                     joint_order(vc, vl, rev), joint_order(gc, gl, rev),
                                     joint_order(bc, bl, rev))
        oc, ol = split_order(o, n_ctx, rev)
        o_lat, o_ctx = o_lat + ol, o_ctx + oc

    def finish(o, p):
        z = p["dn_z"].reshape(o.shape).astype(F32)
        return (rmsnorm(o, norm_g) * jax.nn.silu(z)).reshape(o.shape[0], o.shape[1], DN_HEADS * DN_DV)

    return finish(o_lat, p_lat), (finish(o_ctx, p_ctx) if with_ctx else None)


def complex_affine_combine(e1, e2):
    a1r, a1i, b1r, b1i = e1
    a2r, a2i, b2r, b2i = e2
    return (a2r * a1r - a2i * a1i, a2r * a1i + a2i * a1r,
            a2r * b1r - a2i * b1i + b2r, a2r * b1i + a2i * b1r + b2i)


def s5_mixer(u_lat, u_ctx, a_re, a_im, log_dt, b_re, b_im, c_re, c_im, d_skip, glu_w, glu_b, with_ctx):
    n_ctx = u_ctx.shape[1]

    def grp(u):
        return u.astype(F32).reshape(u.shape[0], u.shape[1], S5_GROUPS, S5_GROUP)

    ul, uc = grp(u_lat), grp(u_ctx)
    br, bi = b_re.astype(F32), b_im.astype(F32)
    y_lat, y_ctx = 0.0, 0.0
    for d in range(2):
        rev = d == 1
        lam_re, lam_im = a_re[d].astype(F32), a_im[d].astype(F32)
        dt = jnp.exp(log_dt[d].astype(F32))[:, None]
        mag = jnp.exp(lam_re * dt)
        ab_re, ab_im = mag * jnp.cos(lam_im * dt), mag * jnp.sin(lam_im * dt)
        den = lam_re * lam_re + lam_im * lam_im
        f_re = ((ab_re - 1.0) * lam_re + ab_im * lam_im) / den
        f_im = (ab_im * lam_re - (ab_re - 1.0) * lam_im) / den
        bb_re = f_re[..., None] * br - f_im[..., None] * bi
        bb_im = f_re[..., None] * bi + f_im[..., None] * br
        u = joint_order(uc, ul, rev)
        bu_re = jnp.einsum("btgc,gpc->btgp", u, bb_re)
        bu_im = jnp.einsum("btgc,gpc->btgp", u, bb_im)
        a_r = jnp.broadcast_to(ab_re, bu_re.shape)
        a_i = jnp.broadcast_to(ab_im, bu_re.shape)
        _, _, x_re, x_im = lax.associative_scan(complex_affine_combine, (a_r, a_i, bu_re, bu_im), axis=1)
        y = (jnp.einsum("btgp,gcp->btgc", x_re, c_re[d].astype(F32))
             - jnp.einsum("btgp,gcp->btgc", x_im, c_im[d].astype(F32)))
        yc, yl = split_order(y, n_ctx, rev)
        y_lat, y_ctx = y_lat + yl, y_ctx + yc

    def finish(y, u):
        y = y.reshape(y.shape[0], y.shape[1], S5_WIDTH) + d_skip.astype(F32) * u.astype(F32)
        z = jax.nn.gelu(y)
        return z * jax.nn.sigmoid(z @ glu_w.astype(F32) + glu_b.astype(F32))

    return finish(y_lat, u_lat), (finish(y_ctx, u_ctx) if with_ctx else None)


def diff_core(q, k, v, lam):
    s = jnp.einsum("bhmqd,bhmkd->bhmqk", q, k).astype(F32) * (q.shape[-1] ** -0.5)
    p = jax.nn.softmax(s, axis=-1)
    a = p[:, :, 0] - lam * p[:, :, 1]
    return jnp.einsum("bhqk,bhkv->bhqv", a, v.astype(F32))


def diff_attention(q_lat, k_lat, v_lat, q_ctx, k_ctx, v_ctx, lam_vec, norm_g, lam_init, cos, sin, with_ctx):
    b_, s_ = q_lat.shape[:2]

    def heads(t):
        return t.reshape(t.shape[0], t.shape[1], DA_HEADS, 2, DA_DK)

    def to_bhm(t):
        return t.transpose(0, 2, 3, 1, 4)

    def vheads(t):
        return t.reshape(t.shape[0], t.shape[1], DA_HEADS, DA_DV).transpose(0, 2, 1, 3)

    lf = lam_vec.astype(F32)
    lam = jnp.exp(jnp.sum(lf[0] * lf[1])) - jnp.exp(jnp.sum(lf[2] * lf[3])) + lam_init
    ql = apply_rope(heads(q_lat), cos, sin)
    kl = apply_rope(heads(k_lat), cos, sin)
    kc = to_bhm(heads(k_ctx))
    vc = vheads(v_ctx)
    k_all = jnp.concatenate([to_bhm(kl), kc], axis=3)
    v_all = jnp.concatenate([vheads(v_lat), vc], axis=2)
    nb = s_ // DA_QBLOCK
    qb = jnp.moveaxis(to_bhm(ql).reshape(b_, DA_HEADS, 2, nb, DA_QBLOCK, DA_DK), 3, 0)
    o = lax.map(lambda qblk: diff_core(qblk, k_all, v_all, lam), qb)
    o = jnp.moveaxis(o, 0, 2).reshape(b_, DA_HEADS, s_, DA_DV).transpose(0, 2, 1, 3)

    def finish(o):
        o = rmsnorm(o, norm_g, eps=1e-5) * (1.0 - lam_init)
        return o.reshape(o.shape[0], o.shape[1], DA_HEADS * DA_DV)

    y_ctx = None
    if with_ctx:
        oc = diff_core(to_bhm(heads(q_ctx)), kc, vc, lam).transpose(0, 2, 1, 3)
        y_ctx = finish(oc)
    return finish(o), y_ctx


def gla_chunked(q, k, v, log_a):
    B, T, H, dk = q.shape
    dv = v.shape[-1]
    C = GLA_CHUNK
    n = T // C

    def to_chunks(t):
        return jnp.moveaxis(t.astype(F32), 1, 2).reshape(B, H, n, C, t.shape[-1])

    q = to_chunks(q) * dk ** -0.5
    k, v = to_chunks(k), to_chunks(v)
    b = jnp.cumsum(to_chunks(log_a), axis=3)
    incl = jnp.tril(jnp.ones((C, C), bool))[..., None]
    rel = b[..., :, None, :] - b[..., None, :, :]
    decay = jnp.exp(jnp.where(incl, rel, -jnp.inf))
    a_intra = jnp.einsum("bhnid,bhnjd,bhnijd->bhnij", q, k, decay)
    q_dec = q * jnp.exp(b)
    k_dec = k * jnp.exp(b[..., -1:, :] - b)
    a_last = jnp.exp(b[..., -1, :])

    def step(state, xs):
        qd, kd, v_i, a_i, al = xs
        o = qd @ state + a_i @ v_i
        state = state * al[..., :, None] + jnp.einsum("bhcd,bhcv->bhdv", kd, v_i)
        return state, o

    xs = tuple(jnp.moveaxis(t, 2, 0) for t in (q_dec, k_dec, v, a_intra, a_last))
    _, o = lax.scan(step, jnp.zeros((B, H, dk, dv), F32), xs)
    return jnp.moveaxis(o, 0, 2).reshape(B, H, T, dv).transpose(0, 2, 1, 3)


def gla_mixer(p_lat, p_ctx, w_gate2, b_gate2, norm_g, with_ctx):
    n_ctx = p_ctx["gla_q"].shape[1]

    def heads(t, dim):
        return t.reshape(t.shape[0], t.shape[1], GLA_HEADS, dim)

    ql, kl, vl = heads(p_lat["gla_q"], GLA_DK), heads(p_lat["gla_k"], GLA_DK), heads(p_lat["gla_v"], GLA_DV)
    qc, kc, vc = heads(p_ctx["gla_q"], GLA_DK), heads(p_ctx["gla_k"], GLA_DK), heads(p_ctx["gla_v"], GLA_DV)
    o_lat, o_ctx = 0.0, 0.0
    for d in range(2):
        rev = d == 1

        def log_forget(p):
            low = p["gla_gate"][..., d * GLA_GATE_RANK:(d + 1) * GLA_GATE_RANK].astype(F32)
            z = low @ w_gate2[d].astype(F32) + b_gate2[d].astype(F32)
            return heads(jax.nn.log_sigmoid(z) / GLA_TAU, GLA_DK)

        o = gla_chunked(joint_order(qc, ql, rev), joint_order(kc, kl, rev), joint_order(vc, vl, rev),
                        joint_order(log_forget(p_ctx), log_forget(p_lat), rev))
        oc, ol = split_order(o, n_ctx, rev)
        o_lat, o_ctx = o_lat + ol, o_ctx + oc

    def finish(o, p):
        r = heads(p["gla_r"], GLA_DV).astype(F32)
        return (rmsnorm(o, norm_g) * jax.nn.silu(r)).reshape(o.shape[0], o.shape[1], GLA_HEADS * GLA_DV)

    return finish(o_lat, p_lat), (finish(o_ctx, p_ctx) if with_ctx else None)


def merge_branches(a, ys, w_branch, w_gate, b_gate, w_out):
    dm = a.shape[-1]
    acc = 0.0
    for i, y in enumerate(ys):
        gate = jax.nn.sigmoid(a @ w_gate[:, i * dm:(i + 1) * dm] + b_gate[i * dm:(i + 1) * dm])
        acc = acc + gate * (y.astype(a.dtype) @ w_branch[i])
    return acc @ w_out


def moe_ffn(h, w_router, b_router, w_e_gate, w_e_up, w_e_down):
    n_tok, dm = h.shape
    scores = jax.nn.sigmoid((h @ w_router).astype(F32))
    grouped = (scores + b_router.astype(F32)).reshape(n_tok, N_GROUPS, EXPERTS_PER_GROUP)
    group_score = jnp.sum(lax.top_k(grouped, TOP_K)[0], axis=-1)
    best = jnp.argmax(group_score, axis=-1)
    cand = grouped[jnp.arange(n_tok), best]
    _, local = lax.top_k(cand, TOP_K)
    expert = (best[:, None] * EXPERTS_PER_GROUP + local).astype(jnp.int32)
    weight = jnp.take_along_axis(scores, expert, axis=1)
    weight = weight / jnp.sum(weight, axis=-1, keepdims=True)
    n_pair = n_tok * TOP_K
    flat_e = expert.reshape(n_pair)
    order = jnp.argsort(flat_e)
    counts = jnp.bincount(flat_e, length=N_EXPERTS)
    padded = (counts + MOE_BLOCK - 1) // MOE_BLOCK * MOE_BLOCK
    pad_end = jnp.cumsum(padded)
    start = jnp.cumsum(counts) - counts
    sorted_e = flat_e[order]
    slot_sorted = pad_end[sorted_e] - padded[sorted_e] + jnp.arange(n_pair) - start[sorted_e]
    slot = jnp.zeros((n_pair,), jnp.int32).at[order].set(slot_sorted.astype(jnp.int32))
    n_blocks = -(-n_pair // MOE_BLOCK) + N_EXPERTS
    token_of_pair = jnp.arange(n_pair) // TOP_K
    buf = jnp.zeros((n_blocks * MOE_BLOCK, dm), h.dtype).at[slot].set(h[token_of_pair])
    block_expert = jnp.minimum(
        jnp.searchsorted(pad_end, jnp.arange(n_blocks) * MOE_BLOCK, side="right"), N_EXPERTS - 1)

    def expert_block(args):
        rows, e = args
        hid = jax.nn.silu(rows @ w_e_gate[e]) * (rows @ w_e_up[e])
        return hid @ w_e_down[e]

    out = lax.map(expert_block, (buf.reshape(n_blocks, MOE_BLOCK, dm), block_expert)).reshape(-1, dm)
    pair_out = out[slot].reshape(n_tok, TOP_K, dm)
    return jnp.einsum("nk,nkd->nd", weight.astype(h.dtype), pair_out)


def setup_inputs(seed: int = 0) -> dict:
    key = jax.random.key(seed)
    keys = iter(jax.random.split(key, 48))

    def normal(shape, scale):
        return jax.random.normal(next(keys), shape, F32) * scale

    def gain(shape):
        return 1.0 + normal(shape, 0.05)

    def uniform(shape, lo, hi):
        return jax.random.uniform(next(keys), shape, F32, minval=lo, maxval=hi)

    dm, ly, ne, fe = D_MODEL, DEPTH, N_EXPERTS, D_EXPERT
    g5, p5, n5 = S5_GROUPS, S5_STATE, S5_GROUP
    dn_dt = jnp.exp(uniform((ly, 2, DN_HEADS), math.log(DT_MIN), math.log(DT_MAX)))
    return {
        "x": normal((BATCH, SEQ, dm), 1.0),
        "c": normal((BATCH, dm), 1.0),
        "ctx": normal((BATCH, CTX_LEN, dm), 1.0),
        "c_ctx": normal((dm,), 1.0),
        "w_mod": normal((ly, dm, 6 * dm), 0.5 * dm ** -0.5),
        "b_mod": normal((ly, 6 * dm), 0.01),
        "norm1_g": gain((ly, dm)),
        "norm2_g": gain((ly, dm)),
        "w_in": normal((ly, dm, D_IN), dm ** -0.5),
        "dn_conv": normal((ly, DN_CONV, DN_HEADS * (2 * DN_DK + DN_DV)), DN_CONV ** -0.5),
        "dn_a_log": jnp.log(uniform((ly, 2, DN_HEADS), 1.0, 16.0)),
        "dn_dt_bias": dn_dt + jnp.log(-jnp.expm1(-dn_dt)),
        "dn_norm_g": gain((ly, DN_DV)),
        "s5_a_re": -0.5 + normal((ly, 2, g5, p5), 0.01),
        "s5_a_im": math.pi * jnp.arange(p5, dtype=F32) + normal((ly, 2, g5, p5), 0.01),
        "s5_log_dt": uniform((ly, 2, g5), math.log(DT_MIN), math.log(DT_MAX)),
        "s5_b_re": normal((ly, g5, p5, n5), (2 * n5) ** -0.5),
        "s5_b_im": normal((ly, g5, p5, n5), (2 * n5) ** -0.5),
        "s5_c_re": normal((ly, 2, g5, n5, p5), (2 * p5) ** -0.5),
        "s5_c_im": normal((ly, 2, g5, n5, p5), (2 * p5) ** -0.5),
        "s5_d": normal((ly, S5_WIDTH), 1.0),
        "s5_glu_w": normal((ly, S5_WIDTH, S5_WIDTH), S5_WIDTH ** -0.5),
        "s5_glu_b": normal((ly, S5_WIDTH), 0.01),
        "da_lambda": normal((ly, 4, DA_DK), 0.1),
        "da_norm_g": gain((ly, DA_DV)),
        "gla_w_gate": normal((ly, 2, GLA_GATE_RANK, GLA_HEADS * GLA_DK), GLA_GATE_RANK ** -0.5),
        "gla_b_gate": normal((ly, 2, GLA_HEADS * GLA_DK), 0.1),
        "gla_norm_g": gain((ly, GLA_DV)),
        "w_branch": normal((ly, N_BRANCH, BRANCH_WIDTH, dm), BRANCH_WIDTH ** -0.5),
        "w_gate": normal((ly, dm, N_BRANCH * dm), dm ** -0.5),
        "b_gate": normal((ly, N_BRANCH * dm), 0.01),
        "w_out": normal((ly, dm, dm), dm ** -0.5),
        "w_router": normal((dm, ne), dm ** -0.5),
        "b_router": normal((ne,), 0.01),
        "w_e_gate": normal((ly, ne, dm, fe), dm ** -0.5),
        "w_e_up": normal((ly, ne, dm, fe), dm ** -0.5),
        "w_e_down": normal((ly, ne, fe, dm), fe ** -0.5),
        "final_g": gain((dm,)),
    }


def reference(x, c, ctx, c_ctx, w_mod, b_mod, norm1_g, norm2_g, w_in,
              dn_conv, dn_a_log, dn_dt_bias, dn_norm_g,
              s5_a_re, s5_a_im, s5_log_dt, s5_b_re, s5_b_im, s5_c_re, s5_c_im, s5_d, s5_glu_w, s5_glu_b,
              da_lambda, da_norm_g,
              gla_w_gate, gla_b_gate, gla_norm_g,
              w_branch, w_gate, b_gate, w_out,
              w_router, b_router, w_e_gate, w_e_up, w_e_down, final_g):
    b_, s_, dm = x.shape
    n_ctx = ctx.shape[1]
    ROWS = s_ // GRID_W
    cos, sin = axial_rope_tables(ROWS, DA_DK)
    sc_lat = jax.nn.silu(c)[:, None, :]
    sc_ctx = jax.nn.silu(c_ctx)[None, None, :]
    h_lat, h_ctx = x, ctx
    for layer in range(DEPTH):
        with_ctx = layer < DEPTH - 1
        lam_init = 0.8 - 0.6 * math.exp(-0.3 * layer)
        mod_lat = jnp.split(sc_lat @ w_mod[layer] + b_mod[layer], 6, axis=-1)
        mod_ctx = jnp.split(sc_ctx @ w_mod[layer] + b_mod[layer], 6, axis=-1)

        a_lat = modulate(rmsnorm(h_lat, norm1_g[layer]), mod_lat[0], mod_lat[1])
        a_ctx = modulate(rmsnorm(h_ctx, norm1_g[layer]), mod_ctx[0], mod_ctx[1])
        p_lat = split_proj(a_lat @ w_in[layer])
        p_ctx = split_proj(a_ctx @ w_in[layer])
        y_a = deltanet_mixer(p_lat, p_ctx, dn_conv[layer], dn_a_log[layer], dn_dt_bias[layer],
                             dn_norm_g[layer], with_ctx)
        y_b = s5_mixer(p_lat["s5_u"], p_ctx["s5_u"], s5_a_re[layer], s5_a_im[layer], s5_log_dt[layer],
                       s5_b_re[layer], s5_b_im[layer], s5_c_re[layer], s5_c_im[layer], s5_d[layer],
                       s5_glu_w[layer], s5_glu_b[layer], with_ctx)
        y_c = diff_attention(p_lat["da_q"], p_lat["da_k"], p_lat["da_v"],
                             p_ctx["da_q"], p_ctx["da_k"], p_ctx["da_v"],
                             da_lambda[layer], da_norm_g[layer], lam_init, cos, sin, with_ctx)
        y_d = gla_mixer(p_lat, p_ctx, gla_w_gate[layer], gla_b_gate[layer], gla_norm_g[layer], with_ctx)
        merge_w = (w_branch[layer], w_gate[layer], b_gate[layer], w_out[layer])
        h_lat = h_lat + mod_lat[2] * merge_branches(a_lat, (y_a[0], y_b[0], y_c[0], y_d[0]), *merge_w)

        expert_w = (w_e_gate[layer], w_e_up[layer], w_e_down[layer])
        f_lat = modulate(rmsnorm(h_lat, norm2_g[layer]), mod_lat[3], mod_lat[4])
        if with_ctx:
            h_ctx = h_ctx + mod_ctx[2] * merge_branches(a_ctx, (y_a[1], y_b[1], y_c[1], y_d[1]), *merge_w)
            f_ctx = modulate(rmsnorm(h_ctx, norm2_g[layer]), mod_ctx[3], mod_ctx[4])
            tokens = jnp.concatenate([f_ctx.reshape(-1, dm), f_lat.reshape(-1, dm)], axis=0)
            ffn = moe_ffn(tokens, w_router, b_router, *expert_w)
            h_ctx = h_ctx + mod_ctx[5] * ffn[:b_ * n_ctx].reshape(b_, n_ctx, dm)
            h_lat = h_lat + mod_lat[5] * ffn[b_ * n_ctx:].reshape(b_, s_, dm)
        else:
            ffn = moe_ffn(f_lat.reshape(-1, dm), w_router, b_router, *expert_w)
            h_lat = h_lat + mod_lat[5] * ffn.reshape(b_, s_, dm)
    return rmsnorm(h_lat, final_g)
```

```cpp
#include <hip/hip_runtime.h>
#include <stdint.h>

typedef unsigned short bf16_t;

#define DM 1024
#define NB 4
#define SEQ 8192
#define NCTX 256
#define TJ (SEQ + NCTX)
#define NTOK (NB * TJ)
#define DIN 2864
#define DINP 3072
#define NEXP 16
#define DEXP 512
#define NLAYER 2
#define C_DNQ 0
#define C_DNK 256
#define C_DNV 512
#define C_DNZ 768
#define C_DNA 1024
#define C_DNB 1032
#define C_S5U 1040
#define C_DAQ 1296
#define C_DAK 1552
#define C_DAV 1808
#define C_GLQ 2064
#define C_GLK 2192
#define C_GLV 2320
#define C_GLR 2576
#define C_GLG 2832

#define MAXSLOT (2 * NTOK + NEXP * 256)

__device__ __forceinline__ float bf2f(bf16_t v) { return __uint_as_float(((unsigned)v) << 16); }
__device__ __forceinline__ bf16_t f2bf(float f) { unsigned u = __float_as_uint(f); u += 0x7FFFu + ((u >> 16) & 1u); return (bf16_t)(u >> 16); }
__device__ __forceinline__ float sigmoidf_(float x) { return 1.0f / (1.0f + __expf(-x)); }
__device__ __forceinline__ float siluf_(float x) { return x / (1.0f + __expf(-x)); }
__device__ __forceinline__ float softplusf_(float x) { return x > 20.f ? x : log1pf(expf(x)); }
__device__ __forceinline__ float logsigmoidf_(float x) { return fminf(x, 0.f) - log1pf(expf(-fabsf(x))); }
__device__ __forceinline__ float gelu_tanh(float x) { const float k = 0.7978845608028654f; float u = k * (x + 0.044715f * x * x * x); return 0.5f * x * (1.0f + tanhf(u)); }
__device__ __forceinline__ float wave_sum(float v) {
#pragma unroll
    for (int o = 32; o >= 1; o >>= 1) v += __shfl_xor(v, o, 64);
    return v;
}
__device__ __forceinline__ float rdlane(float v, int l) { return __int_as_float(__builtin_amdgcn_readlane(__float_as_int(v), l)); }

struct Params {
    const float *x, *c, *ctx, *c_ctx, *w_mod, *b_mod, *norm1_g, *norm2_g, *w_in, *dn_conv, *dn_a_log, *dn_dt_bias, *dn_norm_g;
    const float *s5_a_re, *s5_a_im, *s5_log_dt, *s5_b_re, *s5_b_im, *s5_c_re, *s5_c_im, *s5_d, *s5_glu_w, *s5_glu_b;
    const float *da_lambda, *da_norm_g, *gla_w_gate, *gla_b_gate, *gla_norm_g, *w_branch, *w_gate, *b_gate, *w_out;
    const float *w_router, *b_router, *w_e_gate, *w_e_up, *w_e_down, *final_g;
    float* out;
    float* mod;
    float* hctx;
    bf16_t* A;
    bf16_t* P;
    bf16_t* Y;
    bf16_t* QKVN;
    bf16_t* ODN;
    bf16_t* OS5;
    bf16_t* OGLA;
    bf16_t* G;
    bf16_t* T;
    bf16_t* BUF;
    bf16_t* HID;
    bf16_t* PO;
    int* cnt;
    int* tok_e;
    float* tok_w;
    int* tok_pos;
    int* tok_slot;
};

__device__ __forceinline__ float* hrow(const Params& p, int r) {
    int b = r / TJ, tau = r - b * TJ;
    return tau < NCTX ? p.hctx + ((size_t)b * NCTX + tau) * DM : p.out + ((size_t)b * SEQ + (tau - NCTX)) * DM;
}
__device__ __forceinline__ const float* modrow(const Params& p, int layer, int r) {
    int b = r / TJ, tau = r - b * TJ;
    return p.mod + ((size_t)layer * 5 + (tau < NCTX ? 4 : b)) * (6 * DM);
}

__global__ __launch_bounds__(256) void k_mod(Params p) {
    int idx = blockIdx.x * 256 + threadIdx.x;
    if (idx >= NLAYER * 5 * 6 * DM) return;
    int col = idx % (6 * DM), v = (idx / (6 * DM)) % 5, l = idx / (5 * 6 * DM);
    const float* cv = v < 4 ? p.c + v * DM : p.c_ctx;
    const float* w = p.w_mod + (size_t)l * DM * 6 * DM + col;
    float acc = p.b_mod[l * 6 * DM + col];
    for (int k = 0; k < DM; ++k) acc += siluf_(cv[k]) * w[(size_t)k * 6 * DM];
    p.mod[idx] = acc;
}

__global__ __launch_bounds__(256) void k_norm1(Params p, int layer) {
    int lane = threadIdx.x & 63, wv = threadIdx.x >> 6;
    for (int r = blockIdx.x * 4 + wv; r < NTOK; r += gridDim.x * 4) {
        int b = r / TJ, tau = r - b * TJ;
        float* h = hrow(p, r);
        const float* src = h;
        if (layer == 0) src = tau < NCTX ? p.ctx + ((size_t)b * NCTX + tau) * DM : p.x + ((size_t)b * SEQ + (tau - NCTX)) * DM;
        const float* md = modrow(p, layer, r);
        float4 v[4]; float ss = 0.f;
#pragma unroll
        for (int i = 0; i < 4; ++i) { v[i] = *(const float4*)(src + i * 256 + lane * 4); ss += v[i].x * v[i].x + v[i].y * v[i].y + v[i].z * v[i].z + v[i].w * v[i].w; }
        ss = wave_sum(ss);
        float rs = rsqrtf(ss * (1.0f / DM) + 1e-6f);
        const float* g = p.norm1_g + layer * DM;
#pragma unroll
        for (int i = 0; i < 4; ++i) {
            int c0 = i * 256 + lane * 4;
            if (layer == 0) *(float4*)(h + c0) = v[i];
            float4 gg = *(const float4*)(g + c0), sh = *(const float4*)(md + c0), sc = *(const float4*)(md + DM + c0);
            float o0 = v[i].x * rs * gg.x * (1.f + sc.x) + sh.x, o1 = v[i].y * rs * gg.y * (1.f + sc.y) + sh.y;
            float o2 = v[i].z * rs * gg.z * (1.f + sc.z) + sh.z, o3 = v[i].w * rs * gg.w * (1.f + sc.w) + sh.w;
            ushort4 ob; ob.x = f2bf(o0); ob.y = f2bf(o1); ob.z = f2bf(o2); ob.w = f2bf(o3);
            *(ushort4*)(p.A + (size_t)r * DM + c0) = ob;
        }
    }
}

template <class Epi>
__global__ __launch_bounds__(256) void k_gemm_naive(const bf16_t* A, int lda, const float* W, int ldw, int N, int K, Epi epi, const int* grp, size_t wstride, int skip_ctx) {
    __shared__ float sA[16][68];
    __shared__ float sB[16][68];
    int bm = blockIdx.y * 64, bn = blockIdx.x * 64;
    if (grp) {
        if (bm >= grp[32]) return;
        int e = 0;
        for (int i = 0; i < 16; ++i) e += (grp[16 + i] <= bm) ? 1 : 0;
        if (e > 15) e = 15;
        W += (size_t)e * wstride;
    }
    if (skip_ctx && (bm % TJ) < NCTX) return;
    int tid = threadIdx.x, tx = tid & 15, ty = tid >> 4;
    float acc[4][4] = {};
    for (int k0 = 0; k0 < K; k0 += 16) {
        {
            int r = tid >> 2, kk = (tid & 3) * 4;
            ushort4 a = *(const ushort4*)(A + (size_t)(bm + r) * lda + k0 + kk);
            sA[kk + 0][r] = bf2f(a.x); sA[kk + 1][r] = bf2f(a.y); sA[kk + 2][r] = bf2f(a.z); sA[kk + 3][r] = bf2f(a.w);
            int kr = tid >> 4, cc = (tid & 15) * 4;
#pragma unroll
            for (int j = 0; j < 4; ++j) { int col = bn + cc + j; sB[kr][cc + j] = col < N ? W[(size_t)(k0 + kr) * ldw + col] : 0.f; }
        }
        __syncthreads();
#pragma unroll
        for (int kk = 0; kk < 16; ++kk) {
            float a[4], b[4];
#pragma unroll
            for (int i = 0; i < 4; ++i) { a[i] = sA[kk][ty * 4 + i]; b[i] = sB[kk][tx * 4 + i]; }
#pragma unroll
            for (int i = 0; i < 4; ++i)
#pragma unroll
                for (int j = 0; j < 4; ++j) acc[i][j] += a[i] * b[j];
        }
        __syncthreads();
    }
#pragma unroll
    for (int i = 0; i < 4; ++i)
#pragma unroll
        for (int j = 0; j < 4; ++j) { int col = bn + tx * 4 + j; if (col < N) epi(bm + ty * 4 + i, col, acc[i][j]); }
}

struct EpiStoreBf16 { bf16_t* C; int ldc; int pad; __device__ void operator()(int r, int c, float v) const { C[(size_t)r * ldc + c] = f2bf(v); } };
struct EpiSigmoidBias { bf16_t* C; const float* bias; int ldc; int pad; __device__ void operator()(int r, int c, float v) const { C[(size_t)r * ldc + c] = f2bf(sigmoidf_(v + bias[c])); } };
struct EpiGateAcc { bf16_t* T; const bf16_t* G; int i; int pad; __device__ void operator()(int r, int c, float v) const {
    float g = bf2f(G[(size_t)r * 4096 + i * DM + c]); float t = g * v; if (i > 0) t += bf2f(T[(size_t)r * DM + c]); T[(size_t)r * DM + c] = f2bf(t); } };
struct EpiResid { Params p; int layer; int modoff; __device__ void operator()(int r, int c, float v) const { float* h = hrow(p, r); const float* md = modrow(p, layer, r); h[c] += md[modoff * DM + c] * v; } };
struct EpiSiluMul { bf16_t* H; __device__ void operator()(int r, int c, float v) const { float g = bf2f(H[(size_t)r * DEXP + c]); H[(size_t)r * DEXP + c] = f2bf(siluf_(g) * v); } };

__global__ __launch_bounds__(256) void k_dn_prep(Params p, int layer) {
    int lane = threadIdx.x & 63, wv = threadIdx.x >> 6;
    const float* cw = p.dn_conv + (size_t)layer * 5 * 768;
    for (long it = (long)blockIdx.x * 4 + wv; it < (long)NTOK * 12; it += (long)gridDim.x * 4) {
        int r = (int)(it / 12), grp = (int)(it % 12);
        int b = r / TJ, tau = r - b * TJ;
        int lo = tau < NCTX ? 0 : NCTX, hi = tau < NCTX ? NCTX : TJ;
        int col = grp * 64 + lane;
        float acc = 0.f;
#pragma unroll
        for (int j = 0; j < 5; ++j) { int t2 = tau + j - 2; if (t2 >= lo && t2 < hi) acc += bf2f(p.P[((size_t)b * TJ + t2) * DINP + col]) * cw[j * 768 + col]; }
        acc = siluf_(acc);
        if (grp < 8) { float ss = wave_sum(acc * acc); acc *= rsqrtf(ss + 1e-6f); }
        p.QKVN[(size_t)r * 768 + col] = f2bf(acc);
    }
}

__device__ __forceinline__ int pos2tau(int d, int pos) { return d == 0 ? pos : (pos < NCTX ? NCTX - 1 - pos : (TJ + NCTX - 1) - pos); }

__global__ __launch_bounds__(64) void k_dn_naive(Params p, int layer) {
    int chain = blockIdx.x, b = chain >> 3, h = (chain >> 1) & 3, d = chain & 1, lane = threadIdx.x;
    float S[64];
#pragma unroll
    for (int i = 0; i < 64; ++i) S[i] = 0.f;
    const float nalog = -expf(p.dn_a_log[layer * 8 + d * 4 + h]), dtb = p.dn_dt_bias[layer * 8 + d * 4 + h];
    bf16_t* O = p.ODN + (size_t)d * NTOK * 256;
    size_t r = (size_t)b * TJ + pos2tau(d, 0);
    float a_n = bf2f(p.P[r * DINP + C_DNA + d * 4 + h]), b_n = bf2f(p.P[r * DINP + C_DNB + d * 4 + h]);
    float q_n = bf2f(p.QKVN[r * 768 + h * 64 + lane]), k_n = bf2f(p.QKVN[r * 768 + 256 + h * 64 + lane]), v_n = bf2f(p.QKVN[r * 768 + 512 + h * 64 + lane]);
    for (int pos = 0; pos < TJ; ++pos) {
        float a_in = a_n, b_in = b_n, qv = q_n, kv = k_n, vv = v_n; size_t rc = r;
        if (pos + 1 < TJ) {
            r = (size_t)b * TJ + pos2tau(d, pos + 1);
            a_n = bf2f(p.P[r * DINP + C_DNA + d * 4 + h]); b_n = bf2f(p.P[r * DINP + C_DNB + d * 4 + h]);
            q_n = bf2f(p.QKVN[r * 768 + h * 64 + lane]); k_n = bf2f(p.QKVN[r * 768 + 256 + h * 64 + lane]); v_n = bf2f(p.QKVN[r * 768 + 512 + h * 64 + lane]);
        }
        float decay = expf(nalog * softplusf_(a_in + dtb)), beta = sigmoidf_(b_in);
        float kS = 0.f;
#pragma unroll
        for (int i = 0; i < 64; ++i) { S[i] *= decay; kS += rdlane(kv, i) * S[i]; }
        float vnew = beta * (vv - kS), o = 0.f;
#pragma unroll
        for (int i = 0; i < 64; ++i) { S[i] += rdlane(kv, i) * vnew; o += rdlane(qv, i) * S[i]; }
        O[rc * 256 + h * 64 + lane] = f2bf(o * 0.125f);
    }
}

__global__ __launch_bounds__(64) void k_s5_naive(Params p, int layer) {
    int chain = blockIdx.x, b = chain >> 5, g = (chain >> 1) & 15, d = chain & 1, lane = threadIdx.x;
    float lre = p.s5_a_re[((layer * 2 + d) * 16 + g) * 64 + lane], lim = p.s5_a_im[((layer * 2 + d) * 16 + g) * 64 + lane];
    float dt = expf(p.s5_log_dt[(layer * 2 + d) * 16 + g]);
    float mag = expf(lre * dt), are = mag * cosf(lim * dt), aim = mag * sinf(lim * dt);
    float den = lre * lre + lim * lim;
    float fre = ((are - 1.f) * lre + aim * lim) / den, fim = (aim * lre - (are - 1.f) * lim) / den;
    float bbr[16], bbi[16], cr[16], ci[16];
#pragma unroll
    for (int c = 0; c < 16; ++c) {
        float br = p.s5_b_re[((layer * 16 + g) * 64 + lane) * 16 + c], bi = p.s5_b_im[((layer * 16 + g) * 64 + lane) * 16 + c];
        bbr[c] = fre * br - fim * bi; bbi[c] = fre * bi + fim * br;
        cr[c] = p.s5_c_re[(((layer * 2 + d) * 16 + g) * 16 + c) * 64 + lane]; ci[c] = p.s5_c_im[(((layer * 2 + d) * 16 + g) * 16 + c) * 64 + lane];
    }
    bf16_t* O = p.OS5 + (size_t)d * NTOK * 256;
    float xr = 0.f, xi = 0.f;
    size_t r = (size_t)b * TJ + pos2tau(d, 0);
    float u_n = bf2f(p.P[r * DINP + C_S5U + g * 16 + (lane & 15)]);
    for (int pos = 0; pos < TJ; ++pos) {
        float u = u_n; size_t rc = r;
        if (pos + 1 < TJ) { r = (size_t)b * TJ + pos2tau(d, pos + 1); u_n = bf2f(p.P[r * DINP + C_S5U + g * 16 + (lane & 15)]); }
        float nr = are * xr - aim * xi, ni = are * xi + aim * xr;
#pragma unroll
        for (int c = 0; c < 16; ++c) { float uc = rdlane(u, c); nr += bbr[c] * uc; ni += bbi[c] * uc; }
        xr = nr; xi = ni;
        float my = 0.f;
#pragma unroll
        for (int c = 0; c < 16; ++c) { float t = wave_sum(cr[c] * xr - ci[c] * xi); if (lane == c) my = t; }
        if (lane < 16) O[rc * 256 + g * 16 + lane] = f2bf(my);
    }
}

__global__ __launch_bounds__(64) void k_gla_naive(Params p, int layer) {
    int chain = blockIdx.x, b = chain >> 3, h = (chain >> 1) & 3, d = chain & 1, lane = threadIdx.x;
    float S[32];
#pragma unroll
    for (int i = 0; i < 32; ++i) S[i] = 0.f;
    float w2[16];
#pragma unroll
    for (int rr = 0; rr < 16; ++rr) w2[rr] = p.gla_w_gate[((layer * 2 + d) * 16 + rr) * 128 + h * 32 + (lane & 31)];
    float b2 = p.gla_b_gate[(layer * 2 + d) * 128 + h * 32 + (lane & 31)];
    bf16_t* O = p.OGLA + (size_t)d * NTOK * 256;
    size_t r = (size_t)b * TJ + pos2tau(d, 0);
    float low_n = bf2f(p.P[r * DINP + C_GLG + d * 16 + (lane & 15)]), q_n = bf2f(p.P[r * DINP + C_GLQ + h * 32 + (lane & 31)]);
    float k_n = bf2f(p.P[r * DINP + C_GLK + h * 32 + (lane & 31)]), v_n = bf2f(p.P[r * DINP + C_GLV + h * 64 + lane]);
    for (int pos = 0; pos < TJ; ++pos) {
        float low = low_n, qv = q_n, kv = k_n, vv = v_n; size_t rc = r;
        if (pos + 1 < TJ) {
            r = (size_t)b * TJ + pos2tau(d, pos + 1);
            low_n = bf2f(p.P[r * DINP + C_GLG + d * 16 + (lane & 15)]); q_n = bf2f(p.P[r * DINP + C_GLQ + h * 32 + (lane & 31)]);
            k_n = bf2f(p.P[r * DINP + C_GLK + h * 32 + (lane & 31)]); v_n = bf2f(p.P[r * DINP + C_GLV + h * 64 + lane]);
        }
        float z = b2;
#pragma unroll
        for (int rr = 0; rr < 16; ++rr) z += rdlane(low, rr) * w2[rr];
        float a = expf(logsigmoidf_(z) * (1.0f / 16.0f));
        float o = 0.f;
#pragma unroll
        for (int i = 0; i < 32; ++i) { S[i] = rdlane(a, i) * S[i] + rdlane(kv, i) * vv; o += rdlane(qv, i) * S[i]; }
        O[rc * 256 + h * 64 + lane] = f2bf(o * 0.17677669529663687f);
    }
}

__global__ __launch_bounds__(256) void k_attn_naive(Params p, int layer, int is_ctx) {
    __shared__ float sK[64][64];
    __shared__ float sV[64][64];
    int bh = blockIdx.y, b = bh >> 2, h = bh & 3, tid = threadIdx.x;
    int qtau = is_ctx ? tid : NCTX + blockIdx.x * 256 + tid;
    size_t qr = (size_t)b * TJ + qtau;
    const float scale = 0.17677669529663687f;
    float q[64];
    {
        const bf16_t* qp = p.P + qr * DINP + C_DAQ + h * 64;
#pragma unroll
        for (int i = 0; i < 64; ++i) q[i] = bf2f(qp[i]);
        if (!is_ctx) {
            int t = qtau - NCTX; float rowf = (float)(t / 64), colf = (float)(t % 64);
#pragma unroll
            for (int m = 0; m < 2; ++m)
#pragma unroll
                for (int i = 0; i < 16; ++i) {
                    float inv = powf(10000.0f, -(float)(i & 7) / 8.0f); float ang = (i < 8 ? rowf : colf) * inv;
                    float cs = cosf(ang), sn = sinf(ang); float x1 = q[m * 32 + i], x2 = q[m * 32 + 16 + i];
                    q[m * 32 + i] = x1 * cs - x2 * sn; q[m * 32 + 16 + i] = x1 * sn + x2 * cs;
                }
        }
#pragma unroll
        for (int i = 0; i < 64; ++i) q[i] *= scale;
    }
    float o1[64], o2[64];
#pragma unroll
    for (int i = 0; i < 64; ++i) { o1[i] = 0.f; o2[i] = 0.f; }
    float m1 = -1e30f, m2 = -1e30f, l1 = 0.f, l2 = 0.f;
    int ntile = is_ctx ? 4 : TJ / 64;
    for (int kt = 0; kt < ntile; ++kt) {
        __syncthreads();
        {
            int key = tid >> 2, part = (tid & 3) * 16;
            int ktau = kt * 64 + key; size_t kr = (size_t)b * TJ + ktau;
            const bf16_t* kp = p.P + kr * DINP + C_DAK + h * 64; const bf16_t* vp = p.P + kr * DINP + C_DAV + h * 64;
#pragma unroll
            for (int i = 0; i < 16; ++i) sV[key][part + i] = bf2f(vp[part + i]);
            int m = part >> 5, half = (part >> 4) & 1;
            float rowf = 0.f, colf = 0.f; bool rope = ktau >= NCTX;
            if (rope) { int t = ktau - NCTX; rowf = (float)(t / 64); colf = (float)(t % 64); }
#pragma unroll
            for (int i = 0; i < 16; ++i) {
                float x1 = bf2f(kp[m * 32 + i]), x2 = bf2f(kp[m * 32 + 16 + i]);
                float val;
                if (rope) {
                    float inv = powf(10000.0f, -(float)(i & 7) / 8.0f); float ang = (i < 8 ? rowf : colf) * inv;
                    float cs = cosf(ang), sn = sinf(ang);
                    val = half == 0 ? (x1 * cs - x2 * sn) : (x1 * sn + x2 * cs);
                } else val = half == 0 ? x1 : x2;
                sK[key][part + i] = val;
            }
        }
        __syncthreads();
        for (int key = 0; key < 64; ++key) {
            float s1 = 0.f, s2 = 0.f;
#pragma unroll
            for (int i = 0; i < 32; ++i) { s1 += q[i] * sK[key][i]; s2 += q[32 + i] * sK[key][32 + i]; }
            float nm1 = fmaxf(m1, s1), nm2 = fmaxf(m2, s2);
            float c1 = __expf(m1 - nm1), c2 = __expf(m2 - nm2), p1 = __expf(s1 - nm1), p2 = __expf(s2 - nm2);
            l1 = l1 * c1 + p1; l2 = l2 * c2 + p2; m1 = nm1; m2 = nm2;
#pragma unroll
            for (int i = 0; i < 64; ++i) { float vv = sV[key][i]; o1[i] = o1[i] * c1 + p1 * vv; o2[i] = o2[i] * c2 + p2 * vv; }
        }
    }
    const float* lf = p.da_lambda + layer * 128;
    float d01 = 0.f, d23 = 0.f;
    for (int i = 0; i < 32; ++i) { d01 += lf[i] * lf[32 + i]; d23 += lf[64 + i] * lf[96 + i]; }
    float lam_init = 0.8f - 0.6f * expf(-0.3f * (float)layer);
    float lam = expf(d01) - expf(d23) + lam_init;
    float il1 = 1.f / l1, il2 = lam / l2, ss = 0.f;
#pragma unroll
    for (int i = 0; i < 64; ++i) { o1[i] = o1[i] * il1 - o2[i] * il2; ss += o1[i] * o1[i]; }
    float rs = rsqrtf(ss * (1.0f / 64.0f) + 1e-5f) * (1.0f - lam_init);
    const float* g = p.da_norm_g + layer * 64;
    bf16_t* yo = p.Y + qr * DM + 512 + h * 64;
#pragma unroll
    for (int i = 0; i < 64; ++i) yo[i] = f2bf(o1[i] * rs * g[i]);
}

__global__ __launch_bounds__(256) void k_finish(Params p, int layer) {
    __shared__ float sz[256];
    int tid = threadIdx.x, lane = tid & 63, h = tid >> 6;
    for (int r = blockIdx.x; r < NTOK; r += gridDim.x) {
        if (layer == NLAYER - 1 && (r % TJ) < NCTX) continue;
        const bf16_t* pr = p.P + (size_t)r * DINP;
        size_t o0 = (size_t)r * 256, o1 = (size_t)NTOK * 256 + o0;
        {
            float o = bf2f(p.ODN[o0 + tid]) + bf2f(p.ODN[o1 + tid]);
            float ss = wave_sum(o * o); float rs = rsqrtf(ss * (1.f / 64.f) + 1e-6f);
            float z = bf2f(pr[C_DNZ + tid]);
            p.Y[(size_t)r * DM + tid] = f2bf(o * rs * p.dn_norm_g[layer * 64 + lane] * siluf_(z));
        }
        {
            float o = bf2f(p.OGLA[o0 + tid]) + bf2f(p.OGLA[o1 + tid]);
            float ss = wave_sum(o * o); float rs = rsqrtf(ss * (1.f / 64.f) + 1e-6f);
            float rr = bf2f(pr[C_GLR + tid]);
            p.Y[(size_t)r * DM + 768 + tid] = f2bf(o * rs * p.gla_norm_g[layer * 64 + lane] * siluf_(rr));
        }
        {
            float y = bf2f(p.OS5[o0 + tid]) + bf2f(p.OS5[o1 + tid]) + p.s5_d[layer * 256 + tid] * bf2f(pr[C_S5U + tid]);
            float z = gelu_tanh(y);
            __syncthreads();
            sz[tid] = z;
            __syncthreads();
            const float* w = p.s5_glu_w + (size_t)layer * 65536 + tid;
            float acc = p.s5_glu_b[layer * 256 + tid];
            for (int k = 0; k < 256; ++k) acc += sz[k] * w[k * 256];
            p.Y[(size_t)r * DM + 256 + tid] = f2bf(z * sigmoidf_(acc));
        }
        (void)h;
    }
}

__global__ __launch_bounds__(256) void k_norm2_route(Params p, int layer) {
    int lane = threadIdx.x & 63, wv = threadIdx.x >> 6;
    for (int r = blockIdx.x * 4 + wv; r < NTOK; r += gridDim.x * 4) {
        if (layer == NLAYER - 1 && (r % TJ) < NCTX) continue;
        const float* h = hrow(p, r); const float* md = modrow(p, layer, r);
        float f[16]; float ss = 0.f;
#pragma unroll
        for (int i = 0; i < 4; ++i) { float4 v = *(const float4*)(h + i * 256 + lane * 4); f[i * 4] = v.x; f[i * 4 + 1] = v.y; f[i * 4 + 2] = v.z; f[i * 4 + 3] = v.w; ss += v.x * v.x + v.y * v.y + v.z * v.z + v.w * v.w; }
        ss = wave_sum(ss);
        float rs = rsqrtf(ss * (1.0f / DM) + 1e-6f);
        const float* g = p.norm2_g + layer * DM;
        float sc[16];
#pragma unroll
        for (int e = 0; e < 16; ++e) sc[e] = 0.f;
#pragma unroll
        for (int i = 0; i < 4; ++i) {
            int c0 = i * 256 + lane * 4; ushort4 ob; bf16_t* obp = (bf16_t*)&ob;
#pragma unroll
            for (int j = 0; j < 4; ++j) {
                float v = f[i * 4 + j] * rs * g[c0 + j] * (1.f + md[4 * DM + c0 + j]) + md[3 * DM + c0 + j];
                obp[j] = f2bf(v);
                const float4* wr = (const float4*)(p.w_router + (size_t)(c0 + j) * 16);
#pragma unroll
                for (int e4 = 0; e4 < 4; ++e4) { float4 w = wr[e4]; sc[e4 * 4] += v * w.x; sc[e4 * 4 + 1] += v * w.y; sc[e4 * 4 + 2] += v * w.z; sc[e4 * 4 + 3] += v * w.w; }
            }
            *(ushort4*)(p.A + (size_t)r * DM + c0) = ob;
        }
#pragma unroll
        for (int e = 0; e < 16; ++e) sc[e] = wave_sum(sc[e]);
        if (lane == 0) {
            float s[16], gb[16];
#pragma unroll
            for (int e = 0; e < 16; ++e) { s[e] = sigmoidf_(sc[e]); gb[e] = s[e] + p.b_router[e]; }
            int best = 0; float bestv = -1e30f;
#pragma unroll
            for (int gI = 0; gI < 4; ++gI) {
                float a0 = -1e30f, a1 = -1e30f;
#pragma unroll
                for (int j = 0; j < 4; ++j) { float v = gb[gI * 4 + j]; if (v > a0) { a1 = a0; a0 = v; } else if (v > a1) a1 = v; }
                float gs = a0 + a1; if (gs > bestv) { bestv = gs; best = gI; }
            }
            int i0 = 0, i1 = 0; float v0 = -1e30f, v1 = -1e30f;
#pragma unroll
            for (int j = 0; j < 4; ++j) {
                float v = 0.f;
#pragma unroll
                for (int gI = 0; gI < 4; ++gI) if (gI == best) v = gb[gI * 4 + j];
                if (v > v0) { v1 = v0; i1 = i0; v0 = v; i0 = j; } else if (v > v1) { v1 = v; i1 = j; }
            }
            int e0 = best * 4 + i0, e1 = best * 4 + i1;
            float w0 = 0.f, w1 = 0.f;
#pragma unroll
            for (int e = 0; e < 16; ++e) { if (e == e0) w0 = s[e]; if (e == e1) w1 = s[e]; }
            float inv = 1.f / (w0 + w1);
            p.tok_e[r * 2] = e0; p.tok_e[r * 2 + 1] = e1; p.tok_w[r * 2] = w0 * inv; p.tok_w[r * 2 + 1] = w1 * inv;
            p.tok_pos[r * 2] = atomicAdd(&p.cnt[e0], 1); p.tok_pos[r * 2 + 1] = atomicAdd(&p.cnt[e1], 1);
        }
    }
}

__global__ __launch_bounds__(256) void k_moe_gather(Params p, int layer) {
    __shared__ int sstart[16];
    if (threadIdx.x == 0) {
        int acc = 0;
        for (int e = 0; e < 16; ++e) { sstart[e] = acc; acc += (p.cnt[e] + 255) / 256 * 256; if (blockIdx.x == 0) p.cnt[16 + e] = acc; }
        if (blockIdx.x == 0) p.cnt[32] = acc;
    }
    __syncthreads();
    int lane = threadIdx.x & 63, wv = threadIdx.x >> 6;
    for (int pr = blockIdx.x * 4 + wv; pr < NTOK * 2; pr += gridDim.x * 4) {
        int r = pr >> 1;
        if (layer == NLAYER - 1 && (r % TJ) < NCTX) continue;
        int slot = sstart[p.tok_e[pr]] + p.tok_pos[pr];
        if (lane == 0) p.tok_slot[pr] = slot;
        const uint4* src = (const uint4*)(p.A + (size_t)r * DM); uint4* dst = (uint4*)(p.BUF + (size_t)slot * DM);
        dst[lane] = src[lane]; dst[lane + 64] = src[lane + 64];
    }
}

__global__ __launch_bounds__(256) void k_moe_combine(Params p, int layer) {
    int lane = threadIdx.x & 63, wv = threadIdx.x >> 6;
    for (int r = blockIdx.x * 4 + wv; r < NTOK; r += gridDim.x * 4) {
        if (layer == NLAYER - 1 && (r % TJ) < NCTX) continue;
        float* h = hrow(p, r); const float* md = modrow(p, layer, r) + 5 * DM;
        int s0 = p.tok_slot[r * 2], s1 = p.tok_slot[r * 2 + 1]; float w0 = p.tok_w[r * 2], w1 = p.tok_w[r * 2 + 1];
        const bf16_t* p0 = p.PO + (size_t)s0 * DM; const bf16_t* p1 = p.PO + (size_t)s1 * DM;
        float v[16]; float ss = 0.f;
#pragma unroll
        for (int i = 0; i < 4; ++i) {
            int c0 = i * 256 + lane * 4;
            float4 hv = *(const float4*)(h + c0); ushort4 a = *(const ushort4*)(p0 + c0), bq = *(const ushort4*)(p1 + c0); float4 m = *(const float4*)(md + c0);
            hv.x += m.x * (w0 * bf2f(a.x) + w1 * bf2f(bq.x)); hv.y += m.y * (w0 * bf2f(a.y) + w1 * bf2f(bq.y));
            hv.z += m.z * (w0 * bf2f(a.z) + w1 * bf2f(bq.z)); hv.w += m.w * (w0 * bf2f(a.w) + w1 * bf2f(bq.w));
            v[i * 4] = hv.x; v[i * 4 + 1] = hv.y; v[i * 4 + 2] = hv.z; v[i * 4 + 3] = hv.w;
            ss += hv.x * hv.x + hv.y * hv.y + hv.z * hv.z + hv.w * hv.w;
        }
        if (layer == NLAYER - 1) {
            ss = wave_sum(ss); float rs = rsqrtf(ss * (1.0f / DM) + 1e-6f);
#pragma unroll
            for (int i = 0; i < 4; ++i) { int c0 = i * 256 + lane * 4; float4 g = *(const float4*)(p.final_g + c0);
                float4 o; o.x = v[i * 4] * rs * g.x; o.y = v[i * 4 + 1] * rs * g.y; o.z = v[i * 4 + 2] * rs * g.z; o.w = v[i * 4 + 3] * rs * g.w; *(float4*)(h + c0) = o; }
        } else {
#pragma unroll
            for (int i = 0; i < 4; ++i) { int c0 = i * 256 + lane * 4; float4 o; o.x = v[i * 4]; o.y = v[i * 4 + 1]; o.z = v[i * 4 + 2]; o.w = v[i * 4 + 3]; *(float4*)(h + c0) = o; }
        }
    }
}

static inline size_t al(size_t x) { return (x + 255) & ~(size_t)255; }

extern "C" void kernel_launch(void* const* d_in, const int* in_sizes, int n_in, void* d_out, int out_size, void* d_ws, size_t ws_size, hipStream_t stream) {
    Params p{};
    const float** ins = (const float**)d_in;
    p.x = ins[0]; p.c = ins[1]; p.ctx = ins[2]; p.c_ctx = ins[3]; p.w_mod = ins[4]; p.b_mod = ins[5]; p.norm1_g = ins[6]; p.norm2_g = ins[7]; p.w_in = ins[8];
    p.dn_conv = ins[9]; p.dn_a_log = ins[10]; p.dn_dt_bias = ins[11]; p.dn_norm_g = ins[12];
    p.s5_a_re = ins[13]; p.s5_a_im = ins[14]; p.s5_log_dt = ins[15]; p.s5_b_re = ins[16]; p.s5_b_im = ins[17]; p.s5_c_re = ins[18]; p.s5_c_im = ins[19]; p.s5_d = ins[20]; p.s5_glu_w = ins[21]; p.s5_glu_b = ins[22];
    p.da_lambda = ins[23]; p.da_norm_g = ins[24]; p.gla_w_gate = ins[25]; p.gla_b_gate = ins[26]; p.gla_norm_g = ins[27];
    p.w_branch = ins[28]; p.w_gate = ins[29]; p.b_gate = ins[30]; p.w_out = ins[31]; p.w_router = ins[32]; p.b_router = ins[33];
    p.w_e_gate = ins[34]; p.w_e_up = ins[35]; p.w_e_down = ins[36]; p.final_g = ins[37];
    p.out = (float*)d_out;
    char* ws = (char*)d_ws; size_t off = 0;
    auto take = [&](size_t bytes) { char* q = ws + off; off += al(bytes); return q; };
    p.cnt = (int*)take(256 * 4);
    p.mod = (float*)take((size_t)NLAYER * 5 * 6 * DM * 4);
    p.hctx = (float*)take((size_t)NB * NCTX * DM * 4);
    p.tok_e = (int*)take((size_t)NTOK * 2 * 4); p.tok_w = (float*)take((size_t)NTOK * 2 * 4); p.tok_pos = (int*)take((size_t)NTOK * 2 * 4); p.tok_slot = (int*)take((size_t)NTOK * 2 * 4);
    p.A = (bf16_t*)take((size_t)NTOK * DM * 2);
    p.Y = (bf16_t*)take((size_t)NTOK * DM * 2);
    char* big = ws + off;
    p.P = (bf16_t*)take((size_t)NTOK * DINP * 2);
    p.QKVN = (bf16_t*)take((size_t)NTOK * 768 * 2);
    p.ODN = (bf16_t*)take((size_t)2 * NTOK * 256 * 2);
    p.OS5 = (bf16_t*)take((size_t)2 * NTOK * 256 * 2);
    p.OGLA = (bf16_t*)take((size_t)2 * NTOK * 256 * 2);
    p.G = (bf16_t*)big;
    p.T = p.OS5;
    p.BUF = (bf16_t*)big; p.PO = (bf16_t*)big;
    p.HID = (bf16_t*)(big + al((size_t)MAXSLOT * DM * 2));
    if (off > ws_size) return;

    k_mod<<<(NLAYER * 5 * 6 * DM + 255) / 256, 256, 0, stream>>>(p);
    for (int l = 0; l < NLAYER; ++l) {
        const int last = (l == NLAYER - 1);
        k_norm1<<<2048, 256, 0, stream>>>(p, l);
        k_gemm_naive<<<dim3((DIN + 63) / 64, NTOK / 64), 256, 0, stream>>>(p.A, DM, p.w_in + (size_t)l * DM * DIN, DIN, DIN, DM, EpiStoreBf16{p.P, DINP, 0}, nullptr, 0, 0);
        k_dn_prep<<<4096, 256, 0, stream>>>(p, l);
        k_dn_naive<<<32, 64, 0, stream>>>(p, l);
        k_s5_naive<<<128, 64, 0, stream>>>(p, l);
        k_gla_naive<<<32, 64, 0, stream>>>(p, l);
        k_attn_naive<<<dim3(SEQ / 256, NB * 4), 256, 0, stream>>>(p, l, 0);
        if (!last) k_attn_naive<<<dim3(1, NB * 4), 256, 0, stream>>>(p, l, 1);
        k_finish<<<4096, 256, 0, stream>>>(p, l);
        k_gemm_naive<<<dim3(4096 / 64, NTOK / 64), 256, 0, stream>>>(p.A, DM, p.w_gate + (size_t)l * DM * 4096, 4096, 4096, DM, EpiSigmoidBias{p.G, p.b_gate + l * 4096, 4096, 0}, nullptr, 0, last);
        for (int i = 0; i < 4; ++i)
            k_gemm_naive<<<dim3(DM / 64, NTOK / 64), 256, 0, stream>>>(p.Y + i * 256, DM, p.w_branch + ((size_t)l * 4 + i) * 256 * DM, DM, DM, 256, EpiGateAcc{p.T, p.G, i, 0}, nullptr, 0, last);
        k_gemm_naive<<<dim3(DM / 64, NTOK / 64), 256, 0, stream>>>(p.T, DM, p.w_out + (size_t)l * DM * DM, DM, DM, DM, EpiResid{p, l, 2}, nullptr, 0, last);
        hipMemsetAsync(p.cnt, 0, 256 * 4, stream);
        k_norm2_route<<<2048, 256, 0, stream>>>(p, l);
        k_moe_gather<<<2048, 256, 0, stream>>>(p, l);
        k_gemm_naive<<<dim3(DEXP / 64, MAXSLOT / 64), 256, 0, stream>>>(p.BUF, DM, p.w_e_gate + (size_t)l * NEXP * DM * DEXP, DEXP, DEXP, DM, EpiStoreBf16{p.HID, DEXP, 0}, p.cnt, (size_t)DM * DEXP, 0);
        k_gemm_naive<<<dim3(DEXP / 64, MAXSLOT / 64), 256, 0, stream>>>(p.BUF, DM, p.w_e_up + (size_t)l * NEXP * DM * DEXP, DEXP, DEXP, DM, EpiSiluMul{p.HID}, p.cnt, (size_t)DM * DEXP, 0);
        k_gemm_naive<<<dim3(DM / 64, MAXSLOT / 64), 256, 0, stream>>>(p.HID, DEXP, p.w_e_down + (size_t)l * NEXP * DEXP * DM, DM, DM, DEXP, EpiStoreBf16{p.PO, DM, 0}, p.cnt, (size_t)DEXP * DM, 0);
        k_moe_combine<<<2048, 256, 0, stream>>>(p, l);
    }
}
```

```cpp
#include <hip/hip_runtime.h>
#include <stdint.h>

typedef unsigned short bf16_t;

#define DM 1024
#define NB 4
#define SEQ 8192
#define NCTX 256
#define TJ (SEQ + NCTX)
#define NTOK (NB * TJ)
#define DIN 2864
#define DINP 3072
#define NEXP 16
#define DEXP 512
#define NLAYER 2
#define C_DNQ 0
#define C_DNK 256
#define C_DNV 512
#define C_DNZ 768
#define C_DNA 1024
#define C_DNB 1032
#define C_S5U 1040
#define C_DAQ 1296
#define C_DAK 1552
#define C_DAV 1808
#define C_GLQ 2064
#define C_GLK 2192
#define C_GLV 2320
#define C_GLR 2576
#define C_GLG 2832

#define MAXSLOT (2 * NTOK + NEXP * 256)

__device__ __forceinline__ float bf2f(bf16_t v) { return __uint_as_float(((unsigned)v) << 16); }
__device__ __forceinline__ bf16_t f2bf(float f) { unsigned u = __float_as_uint(f); u += 0x7FFFu + ((u >> 16) & 1u); return (bf16_t)(u >> 16); }
__device__ __forceinline__ float sigmoidf_(float x) { return 1.0f / (1.0f + __expf(-x)); }
__device__ __forceinline__ float siluf_(float x) { return x / (1.0f + __expf(-x)); }
__device__ __forceinline__ float softplusf_(float x) { return x > 20.f ? x : log1pf(expf(x)); }
__device__ __forceinline__ float logsigmoidf_(float x) { return fminf(x, 0.f) - log1pf(expf(-fabsf(x))); }
__device__ __forceinline__ float gelu_tanh(float x) { const float k = 0.7978845608028654f; float u = k * (x + 0.044715f * x * x * x); return 0.5f * x * (1.0f + tanhf(u)); }
__device__ __forceinline__ float wave_sum(float v) {
#pragma unroll
    for (int o = 32; o >= 1; o >>= 1) v += __shfl_xor(v, o, 64);
    return v;
}
__device__ __forceinline__ float rdlane(float v, int l) { return __int_as_float(__builtin_amdgcn_readlane(__float_as_int(v), l)); }

struct Params {
    const float *x, *c, *ctx, *c_ctx, *w_mod, *b_mod, *norm1_g, *norm2_g, *w_in, *dn_conv, *dn_a_log, *dn_dt_bias, *dn_norm_g;
    const float *s5_a_re, *s5_a_im, *s5_log_dt, *s5_b_re, *s5_b_im, *s5_c_re, *s5_c_im, *s5_d, *s5_glu_w, *s5_glu_b;
    const float *da_lambda, *da_norm_g, *gla_w_gate, *gla_b_gate, *gla_norm_g, *w_branch, *w_gate, *b_gate, *w_out;
    const float *w_router, *b_router, *w_e_gate, *w_e_up, *w_e_down, *final_g;
    float* out;
    float* mod;
    float* hctx;
    bf16_t* A;
    bf16_t* P;
    bf16_t* Y;
    bf16_t* QKVN;
    bf16_t* ODN;
    bf16_t* OS5;
    bf16_t* OGLA;
    bf16_t* G;
    bf16_t* T;
    bf16_t* BUF;
    bf16_t* HID;
    bf16_t* PO;
    unsigned* bar;
    int* cnt;
    int* tok_e;
    float* tok_w;
    int* tok_pos;
    int* tok_slot;
};

__device__ __forceinline__ float* hrow(const Params& p, int r) {
    int b = r / TJ, tau = r - b * TJ;
    return tau < NCTX ? p.hctx + ((size_t)b * NCTX + tau) * DM : p.out + ((size_t)b * SEQ + (tau - NCTX)) * DM;
}
__device__ __forceinline__ const float* modrow(const Params& p, int layer, int r) {
    int b = r / TJ, tau = r - b * TJ;
    return p.mod + ((size_t)layer * 5 + (tau < NCTX ? 4 : b)) * (6 * DM);
}


#define XB_TMO      128
#define XB_XCNT(j)  (256  + 64 * (j))
#define XB_XSUB(j)  (1280 + 64 * (j))
#define XB_XGEN(j)  (2304 + 64 * (j))
#define XB_TOP      3328
#define XB_TOPGEN   3392
#define XCD_BAR_WORDS 3456
#define XB_SPIN_CAP (1u << 18)
#define LAS __attribute__((address_space(3)))
__device__ __forceinline__ unsigned xb_ld(unsigned* p)              { return __hip_atomic_load(p, __ATOMIC_RELAXED, __HIP_MEMORY_SCOPE_AGENT); }
__device__ __forceinline__ unsigned xb_add(unsigned* p, unsigned v) { return __hip_atomic_fetch_add(p, v, __ATOMIC_RELAXED, __HIP_MEMORY_SCOPE_AGENT); }
__device__ __forceinline__ unsigned xb_xcc_id() { return (unsigned)__builtin_amdgcn_s_getreg((3 << 11) | 20) & 0xFu; }
#define XB_SPIN(cond, bar) do { unsigned _sp = 0; while (cond) { __builtin_amdgcn_s_sleep(1); \
    if ((++_sp & 255u) == 0u) { if (xb_ld(&(bar)[XB_TMO])) break; if (_sp > XB_SPIN_CAP) { atomicAdd(&(bar)[XB_TMO], 1u); break; } } } } while (0)
struct XcdBarrier { unsigned* bar; unsigned x; volatile LAS unsigned* st; };
__device__ __forceinline__ XcdBarrier xcd_barrier_post(unsigned* bar, volatile LAS unsigned* st) {
    XcdBarrier b; b.bar = bar; b.x = xb_xcc_id(); b.st = st;
    if (threadIdx.x == 0) (void)xb_add(&bar[XB_XCNT(b.x)], 1u);
    return b;
}
__device__ __forceinline__ void xcd_barrier_complete(unsigned* bar, unsigned x, unsigned& nloc, unsigned& nx) {
    const unsigned G = gridDim.x * gridDim.y * gridDim.z;
    unsigned sum, cnt, mine, sp = 0u;
    for (;;) {
        sum = 0u; cnt = 0u; mine = 0u;
#pragma unroll
        for (unsigned j = 0; j < 16; ++j) { const unsigned c = xb_ld(&bar[XB_XCNT(j)]); sum += c; cnt += (c > 0u) ? 1u : 0u; mine = (j == x) ? c : mine; }
        if (sum == G) break;
        __builtin_amdgcn_s_sleep(1);
        if ((++sp & 255u) == 0u) { if (xb_ld(&bar[XB_TMO])) break; if (sp > XB_SPIN_CAP) { atomicAdd(&bar[XB_TMO], 1u); break; } }
    }
    nloc = mine > 0u ? mine : 1u; nx = cnt > 0u ? cnt : 1u;
}
__device__ __forceinline__ void xcd_barrier(const XcdBarrier& b) {
    asm volatile("s_waitcnt vmcnt(0)" ::: "memory");
    __syncthreads();
    if (threadIdx.x == 0) {
        unsigned* bar = b.bar;
        __builtin_amdgcn_s_waitcnt(0);
        unsigned nloc = b.st[0], nx = b.st[1];
        if (nloc == 0u) { xcd_barrier_complete(bar, b.x, nloc, nx); b.st[0] = nloc; b.st[1] = nx; }
        const unsigned old = xb_add(&bar[XB_XSUB(b.x)], 1u);
        const unsigned gen = old / nloc;
        if (old + 1u == (gen + 1u) * nloc) {
            __builtin_amdgcn_fence(__ATOMIC_RELEASE, "agent");
            asm volatile("s_waitcnt vmcnt(0)" ::: "memory");
            const unsigned og = xb_add(&bar[XB_TOP], 1u);
            const unsigned tg = og / nx;
            if (og + 1u == (tg + 1u) * nx) xb_add(&bar[XB_TOPGEN], 1u);
            else XB_SPIN(xb_ld(&bar[XB_TOPGEN]) == tg, bar);
            __builtin_amdgcn_fence(__ATOMIC_ACQUIRE, "agent");
            xb_add(&bar[XB_XGEN(b.x)], 1u);
            asm volatile("s_waitcnt vmcnt(0)" ::: "memory");
        } else {
            XB_SPIN(xb_ld(&bar[XB_XGEN(b.x)]) == gen, bar);
            __builtin_amdgcn_fence(__ATOMIC_ACQUIRE, "agent");
            asm volatile("s_waitcnt vmcnt(0)" ::: "memory");
        }
    }
    __syncthreads();
}

#define NTHR 512
#define NWV 8
#define PH_IDS() int tid_ = threadIdx.x; asm volatile("" : "+v"(tid_)); int bid_ = blockIdx.x; asm volatile("" : "+s"(bid_)); int nblk_ = gridDim.x; asm volatile("" : "+s"(nblk_)); (void)tid_; (void)bid_; (void)nblk_
#define GWV (nblk_ * NWV)
#define WID (bid_ * NWV + (tid_ >> 6))

__device__ __forceinline__ void ph_mod(const Params& p) {
    PH_IDS();
    for (int idx = bid_ * NTHR + tid_; idx < NLAYER * 5 * 6 * DM; idx += nblk_ * NTHR) {
        int col = idx % (6 * DM), v = (idx / (6 * DM)) % 5, l = idx / (5 * 6 * DM);
        const float* cv = v < 4 ? p.c + v * DM : p.c_ctx;
        const float* w = p.w_mod + (size_t)l * DM * 6 * DM + col;
        float acc = p.b_mod[l * 6 * DM + col];
        for (int k = 0; k < DM; ++k) acc += siluf_(cv[k]) * w[(size_t)k * 6 * DM];
        p.mod[idx] = acc;
    }
}

__device__ __forceinline__ void ph_norm1(const Params& p, int layer) {
    PH_IDS();
    int lane = tid_ & 63;
    if (bid_ == 0 && tid_ < 64) p.cnt[tid_] = 0;
    for (int r = WID; r < NTOK; r += GWV) {
        int b = r / TJ, tau = r - b * TJ;
        float* h = hrow(p, r);
        const float* src = h;
        if (layer == 0) src = tau < NCTX ? p.ctx + ((size_t)b * NCTX + tau) * DM : p.x + ((size_t)b * SEQ + (tau - NCTX)) * DM;
        const float* md = modrow(p, layer, r);
        float4 v[4]; float ss = 0.f;
#pragma unroll
        for (int i = 0; i < 4; ++i) { v[i] = *(const float4*)(src + i * 256 + lane * 4); ss += v[i].x * v[i].x + v[i].y * v[i].y + v[i].z * v[i].z + v[i].w * v[i].w; }
        ss = wave_sum(ss);
        float rs = rsqrtf(ss * (1.0f / DM) + 1e-6f);
        const float* g = p.norm1_g + layer * DM;
#pragma unroll
        for (int i = 0; i < 4; ++i) {
            int c0 = i * 256 + lane * 4;
            if (layer == 0) *(float4*)(h + c0) = v[i];
            float4 gg = *(const float4*)(g + c0), sh = *(const float4*)(md + c0), sc = *(const float4*)(md + DM + c0);
            float o0 = v[i].x * rs * gg.x * (1.f + sc.x) + sh.x, o1 = v[i].y * rs * gg.y * (1.f + sc.y) + sh.y;
            float o2 = v[i].z * rs * gg.z * (1.f + sc.z) + sh.z, o3 = v[i].w * rs * gg.w * (1.f + sc.w) + sh.w;
            ushort4 ob; ob.x = f2bf(o0); ob.y = f2bf(o1); ob.z = f2bf(o2); ob.w = f2bf(o3);
            *(ushort4*)(p.A + (size_t)r * DM + c0) = ob;
        }
    }
}

struct EpiStoreBf16 { bf16_t* C; int ldc; __device__ void operator()(int r, int c, float v) const { C[(size_t)r * ldc + c] = f2bf(v); } };
struct EpiSigmoidBias { bf16_t* C; const float* bias; int ldc; __device__ void operator()(int r, int c, float v) const { C[(size_t)r * ldc + c] = f2bf(sigmoidf_(v + bias[c])); } };
struct EpiGateAcc { bf16_t* T; const bf16_t* G; int i; __device__ void operator()(int r, int c, float v) const {
    float g = bf2f(G[(size_t)r * 4096 + i * DM + c]); float t = g * v; if (i > 0) t += bf2f(T[(size_t)r * DM + c]); T[(size_t)r * DM + c] = f2bf(t); } };
struct EpiResid { float* hctx; float* out; const float* mod; int layer; int modoff; __device__ void operator()(int r, int c, float v) const {
    int b = r / TJ, tau = r - b * TJ;
    float* h = tau < NCTX ? hctx + ((size_t)b * NCTX + tau) * DM : out + ((size_t)b * SEQ + (tau - NCTX)) * DM;
    const float* md = mod + ((size_t)layer * 5 + (tau < NCTX ? 4 : b)) * (6 * DM);
    h[c] += md[modoff * DM + c] * v; } };
struct EpiSiluMul { bf16_t* H; __device__ void operator()(int r, int c, float v) const { float g = bf2f(H[(size_t)r * DEXP + c]); H[(size_t)r * DEXP + c] = f2bf(siluf_(g) * v); } };

template <class Epi>
__device__ __forceinline__ void ph_gemm_naive(unsigned char* smem, const bf16_t* A, int lda, const float* W0, int ldw, int M, int N, int K, const Epi& epi, const int* grp, size_t wstride, int skip_ctx) {
    PH_IDS();
    const int half = tid_ >> 8, tid = tid_ & 255, tx = tid & 15, ty = tid >> 4;
    float (*sA)[68] = (float (*)[68])(smem + 64 + half * 8704);
    float (*sB)[68] = (float (*)[68])(smem + 64 + half * 8704 + 4352);
    const int ntn = (N + 63) / 64, ntiles = (M / 64) * ntn;
    for (int t0 = bid_ * 2; t0 < ntiles; t0 += nblk_ * 2) {
        const int t = t0 + half;
        bool active = t < ntiles;
        int bm = active ? (t / ntn) * 64 : 0, bn = active ? (t % ntn) * 64 : 0;
        const float* W = W0;
        if (grp && active) {
            if (bm >= grp[32]) active = false;
            int e = 0;
            for (int i = 0; i < 16; ++i) e += (grp[16 + i] <= bm) ? 1 : 0;
            if (e > 15) e = 15;
            W += (size_t)e * wstride;
        }
        if (skip_ctx && (bm % TJ) < NCTX) active = false;
        float acc[4][4] = {};
        for (int k0 = 0; k0 < K; k0 += 16) {
            if (active) {
                int r = tid >> 2, kk = (tid & 3) * 4;
                ushort4 a = *(const ushort4*)(A + (size_t)(bm + r) * lda + k0 + kk);
                sA[kk + 0][r] = bf2f(a.x); sA[kk + 1][r] = bf2f(a.y); sA[kk + 2][r] = bf2f(a.z); sA[kk + 3][r] = bf2f(a.w);
                int kr = tid >> 4, cc = (tid & 15) * 4;
#pragma unroll
                for (int j = 0; j < 4; ++j) { int col = bn + cc + j; sB[kr][cc + j] = col < N ? W[(size_t)(k0 + kr) * ldw + col] : 0.f; }
            }
            __syncthreads();
            if (active) {
#pragma unroll
                for (int kk = 0; kk < 16; ++kk) {
                    float a[4], b[4];
#pragma unroll
                    for (int i = 0; i < 4; ++i) { a[i] = sA[kk][ty * 4 + i]; b[i] = sB[kk][tx * 4 + i]; }
#pragma unroll
                    for (int i = 0; i < 4; ++i)
#pragma unroll
                        for (int j = 0; j < 4; ++j) acc[i][j] += a[i] * b[j];
                }
            }
            __syncthreads();
        }
        if (active) {
#pragma unroll
            for (int i = 0; i < 4; ++i)
#pragma unroll
                for (int j = 0; j < 4; ++j) { int col = bn + tx * 4 + j; if (col < N) epi(bm + ty * 4 + i, col, acc[i][j]); }
        }
    }
}

__device__ __forceinline__ void ph_dn_prep(const Params& p, int layer) {
    PH_IDS();
    int lane = tid_ & 63;
    const float* cw = p.dn_conv + (size_t)layer * 5 * 768;
    for (long it = WID; it < (long)NTOK * 12; it += GWV) {
        int r = (int)(it / 12), grp = (int)(it % 12);
        int b = r / TJ, tau = r - b * TJ;
        int lo = tau < NCTX ? 0 : NCTX, hi = tau < NCTX ? NCTX : TJ;
        int col = grp * 64 + lane;
        float acc = 0.f;
#pragma unroll
        for (int j = 0; j < 5; ++j) { int t2 = tau + j - 2; if (t2 >= lo && t2 < hi) acc += bf2f(p.P[((size_t)b * TJ + t2) * DINP + col]) * cw[j * 768 + col]; }
        acc = siluf_(acc);
        if (grp < 8) { float ss = wave_sum(acc * acc); acc *= rsqrtf(ss + 1e-6f); }
        p.QKVN[(size_t)r * 768 + col] = f2bf(acc);
    }
}

__device__ __forceinline__ int pos2tau(int d, int pos) { return d == 0 ? pos : (pos < NCTX ? NCTX - 1 - pos : (TJ + NCTX - 1) - pos); }

__device__ __forceinline__ void dn_chain_naive(const Params& p, int layer, int chain, int lane) {
    int b = chain >> 3, h = (chain >> 1) & 3, d = chain & 1;
    float S[64];
#pragma unroll
    for (int i = 0; i < 64; ++i) S[i] = 0.f;
    const float nalog = -expf(p.dn_a_log[layer * 8 + d * 4 + h]), dtb = p.dn_dt_bias[layer * 8 + d * 4 + h];
    bf16_t* O = p.ODN + (size_t)d * NTOK * 256;
    size_t r = (size_t)b * TJ + pos2tau(d, 0);
    float a_n = bf2f(p.P[r * DINP + C_DNA + d * 4 + h]), b_n = bf2f(p.P[r * DINP + C_DNB + d * 4 + h]);
    float q_n = bf2f(p.QKVN[r * 768 + h * 64 + lane]), k_n = bf2f(p.QKVN[r * 768 + 256 + h * 64 + lane]), v_n = bf2f(p.QKVN[r * 768 + 512 + h * 64 + lane]);
    for (int pos = 0; pos < TJ; ++pos) {
        float a_in = a_n, b_in = b_n, qv = q_n, kv = k_n, vv = v_n; size_t rc = r;
        if (pos + 1 < TJ) {
            r = (size_t)b * TJ + pos2tau(d, pos + 1);
            a_n = bf2f(p.P[r * DINP + C_DNA + d * 4 + h]); b_n = bf2f(p.P[r * DINP + C_DNB + d * 4 + h]);
            q_n = bf2f(p.QKVN[r * 768 + h * 64 + lane]); k_n = bf2f(p.QKVN[r * 768 + 256 + h * 64 + lane]); v_n = bf2f(p.QKVN[r * 768 + 512 + h * 64 + lane]);
        }
        float decay = expf(nalog * softplusf_(a_in + dtb)), beta = sigmoidf_(b_in);
        float kS = 0.f;
#pragma unroll
        for (int i = 0; i < 64; ++i) { S[i] *= decay; kS += rdlane(kv, i) * S[i]; }
        float vnew = beta * (vv - kS), o = 0.f;
#pragma unroll
        for (int i = 0; i < 64; ++i) { S[i] += rdlane(kv, i) * vnew; o += rdlane(qv, i) * S[i]; }
        O[rc * 256 + h * 64 + lane] = f2bf(o * 0.125f);
    }
}

__device__ __forceinline__ void s5_chain_naive(const Params& p, int layer, int chain, int lane) {
    int b = chain >> 5, g = (chain >> 1) & 15, d = chain & 1;
    float lre = p.s5_a_re[((layer * 2 + d) * 16 + g) * 64 + lane], lim = p.s5_a_im[((layer * 2 + d) * 16 + g) * 64 + lane];
    float dt = expf(p.s5_log_dt[(layer * 2 + d) * 16 + g]);
    float mag = expf(lre * dt), are = mag * cosf(lim * dt), aim = mag * sinf(lim * dt);
    float den = lre * lre + lim * lim;
    float fre = ((are - 1.f) * lre + aim * lim) / den, fim = (aim * lre - (are - 1.f) * lim) / den;
    float bbr[16], bbi[16], cr[16], ci[16];
#pragma unroll
    for (int c = 0; c < 16; ++c) {
        float br = p.s5_b_re[((layer * 16 + g) * 64 + lane) * 16 + c], bi = p.s5_b_im[((layer * 16 + g) * 64 + lane) * 16 + c];
        bbr[c] = fre * br - fim * bi; bbi[c] = fre * bi + fim * br;
        cr[c] = p.s5_c_re[(((layer * 2 + d) * 16 + g) * 16 + c) * 64 + lane]; ci[c] = p.s5_c_im[(((layer * 2 + d) * 16 + g) * 16 + c) * 64 + lane];
    }
    bf16_t* O = p.OS5 + (size_t)d * NTOK * 256;
    float xr = 0.f, xi = 0.f;
    size_t r = (size_t)b * TJ + pos2tau(d, 0);
    float u_n = bf2f(p.P[r * DINP + C_S5U + g * 16 + (lane & 15)]);
    for (int pos = 0; pos < TJ; ++pos) {
        float u = u_n; size_t rc = r;
        if (pos + 1 < TJ) { r = (size_t)b * TJ + pos2tau(d, pos + 1); u_n = bf2f(p.P[r * DINP + C_S5U + g * 16 + (lane & 15)]); }
        float nr = are * xr - aim * xi, ni = are * xi + aim * xr;
#pragma unroll
        for (int c = 0; c < 16; ++c) { float uc = rdlane(u, c); nr += bbr[c] * uc; ni += bbi[c] * uc; }
        xr = nr; xi = ni;
        float my = 0.f;
#pragma unroll
        for (int c = 0; c < 16; ++c) { float t = wave_sum(cr[c] * xr - ci[c] * xi); if (lane == c) my = t; }
        if (lane < 16) O[rc * 256 + g * 16 + lane] = f2bf(my);
    }
}

__device__ __forceinline__ void gla_chain_naive(const Params& p, int layer, int chain, int lane) {
    int b = chain >> 3, h = (chain >> 1) & 3, d = chain & 1;
    float S[32];
#pragma unroll
    for (int i = 0; i < 32; ++i) S[i] = 0.f;
    float w2[16];
#pragma unroll
    for (int rr = 0; rr < 16; ++rr) w2[rr] = p.gla_w_gate[((layer * 2 + d) * 16 + rr) * 128 + h * 32 + (lane & 31)];
    float b2 = p.gla_b_gate[(layer * 2 + d) * 128 + h * 32 + (lane & 31)];
    bf16_t* O = p.OGLA + (size_t)d * NTOK * 256;
    size_t r = (size_t)b * TJ + pos2tau(d, 0);
    float low_n = bf2f(p.P[r * DINP + C_GLG + d * 16 + (lane & 15)]), q_n = bf2f(p.P[r * DINP + C_GLQ + h * 32 + (lane & 31)]);
    float k_n = bf2f(p.P[r * DINP + C_GLK + h * 32 + (lane & 31)]), v_n = bf2f(p.P[r * DINP + C_GLV + h * 64 + lane]);
    for (int pos = 0; pos < TJ; ++pos) {
        float low = low_n, qv = q_n, kv = k_n, vv = v_n; size_t rc = r;
        if (pos + 1 < TJ) {
            r = (size_t)b * TJ + pos2tau(d, pos + 1);
            low_n = bf2f(p.P[r * DINP + C_GLG + d * 16 + (lane & 15)]); q_n = bf2f(p.P[r * DINP + C_GLQ + h * 32 + (lane & 31)]);
            k_n = bf2f(p.P[r * DINP + C_GLK + h * 32 + (lane & 31)]); v_n = bf2f(p.P[r * DINP + C_GLV + h * 64 + lane]);
        }
        float z = b2;
#pragma unroll
        for (int rr = 0; rr < 16; ++rr) z += rdlane(low, rr) * w2[rr];
        float a = expf(logsigmoidf_(z) * (1.0f / 16.0f));
        float o = 0.f;
#pragma unroll
        for (int i = 0; i < 32; ++i) { S[i] = rdlane(a, i) * S[i] + rdlane(kv, i) * vv; o += rdlane(qv, i) * S[i]; }
        O[rc * 256 + h * 64 + lane] = f2bf(o * 0.17677669529663687f);
    }
}

__device__ __forceinline__ void ph_scans_naive(const Params& p, int layer) {
    PH_IDS();
    if (tid_ >= 64) return;
    int it = bid_, lane = tid_;
    for (; it < 192; it += nblk_) {
        if (it < 32) dn_chain_naive(p, layer, it, lane);
        else if (it < 160) s5_chain_naive(p, layer, it - 32, lane);
        else gla_chain_naive(p, layer, it - 160, lane);
    }
}

__device__ __forceinline__ void ph_attn_naive(unsigned char* smem, const Params& p, int layer) {
    PH_IDS();
    float (*sK)[64] = (float (*)[64])(smem + 64);
    float (*sV)[64] = (float (*)[64])(smem + 64 + 16384);
    float* sS = (float*)(smem + 64 + 32768);
    const int tid = tid_, qi = tid & 255, hv = tid >> 8;
    const int nitem = 512 + (layer < NLAYER - 1 ? 16 : 0);
    const float* lf = p.da_lambda + layer * 128;
    float d01 = 0.f, d23 = 0.f;
    for (int i = 0; i < 32; ++i) { d01 += lf[i] * lf[32 + i]; d23 += lf[64 + i] * lf[96 + i]; }
    const float lam_init = 0.8f - 0.6f * expf(-0.3f * (float)layer);
    const float lam = expf(d01) - expf(d23) + lam_init;
    for (int item = bid_; item < nitem; item += nblk_) {
        const int is_ctx = item >= 512;
        const int bh = is_ctx ? item - 512 : item >> 5, b = bh >> 2, h = bh & 3;
        int qtau = is_ctx ? qi : NCTX + (item & 31) * 256 + qi;
        size_t qr = (size_t)b * TJ + qtau;
        const float scale = 0.17677669529663687f;
        float q[64];
        {
            const bf16_t* qp = p.P + qr * DINP + C_DAQ + h * 64;
#pragma unroll
            for (int i = 0; i < 64; ++i) q[i] = bf2f(qp[i]);
            if (!is_ctx) {
                int t = qtau - NCTX; float rowf = (float)(t / 64), colf = (float)(t % 64);
#pragma unroll
                for (int m = 0; m < 2; ++m)
#pragma unroll
                    for (int i = 0; i < 16; ++i) {
                        float inv = powf(10000.0f, -(float)(i & 7) / 8.0f); float ang = (i < 8 ? rowf : colf) * inv;
                        float cs = cosf(ang), sn = sinf(ang); float x1 = q[m * 32 + i], x2 = q[m * 32 + 16 + i];
                        q[m * 32 + i] = x1 * cs - x2 * sn; q[m * 32 + 16 + i] = x1 * sn + x2 * cs;
                    }
            }
#pragma unroll
            for (int i = 0; i < 64; ++i) q[i] *= scale;
        }
        float o1[32], o2[32];
#pragma unroll
        for (int i = 0; i < 32; ++i) { o1[i] = 0.f; o2[i] = 0.f; }
        float m1 = -1e30f, m2 = -1e30f, l1 = 0.f, l2 = 0.f;
        int ntile = is_ctx ? 4 : TJ / 64;
        for (int kt = 0; kt < ntile; ++kt) {
            __syncthreads();
            if (tid < 256) {
                int key = tid >> 2, part = (tid & 3) * 16;
                int ktau = kt * 64 + key; size_t kr = (size_t)b * TJ + ktau;
                const bf16_t* kp = p.P + kr * DINP + C_DAK + h * 64; const bf16_t* vp = p.P + kr * DINP + C_DAV + h * 64;
#pragma unroll
                for (int i = 0; i < 16; ++i) sV[key][part + i] = bf2f(vp[part + i]);
                int m = part >> 5, hf = (part >> 4) & 1;
                float rowf = 0.f, colf = 0.f; bool rope = ktau >= NCTX;
                if (rope) { int t = ktau - NCTX; rowf = (float)(t / 64); colf = (float)(t % 64); }
#pragma unroll
                for (int i = 0; i < 16; ++i) {
                    float x1 = bf2f(kp[m * 32 + i]), x2 = bf2f(kp[m * 32 + 16 + i]);
                    float val;
                    if (rope) {
                        float inv = powf(10000.0f, -(float)(i & 7) / 8.0f); float ang = (i < 8 ? rowf : colf) * inv;
                        float cs = cosf(ang), sn = sinf(ang);
                        val = hf == 0 ? (x1 * cs - x2 * sn) : (x1 * sn + x2 * cs);
                    } else val = hf == 0 ? x1 : x2;
                    sK[key][part + i] = val;
                }
            }
            __syncthreads();
            for (int key = 0; key < 64; ++key) {
                float s1 = 0.f, s2 = 0.f;
#pragma unroll
                for (int i = 0; i < 32; ++i) { s1 += q[i] * sK[key][i]; s2 += q[32 + i] * sK[key][32 + i]; }
                float nm1 = fmaxf(m1, s1), nm2 = fmaxf(m2, s2);
                float c1 = __expf(m1 - nm1), c2 = __expf(m2 - nm2), p1 = __expf(s1 - nm1), p2 = __expf(s2 - nm2);
                l1 = l1 * c1 + p1; l2 = l2 * c2 + p2; m1 = nm1; m2 = nm2;
#pragma unroll
                for (int i = 0; i < 32; ++i) { float vv = sV[key][hv * 32 + i]; o1[i] = o1[i] * c1 + p1 * vv; o2[i] = o2[i] * c2 + p2 * vv; }
            }
        }
        float il1 = 1.f / l1, il2 = lam / l2, ss = 0.f;
#pragma unroll
        for (int i = 0; i < 32; ++i) { o1[i] = o1[i] * il1 - o2[i] * il2; ss += o1[i] * o1[i]; }
        __syncthreads();
        sS[tid] = ss;
        __syncthreads();
        ss += sS[tid ^ 256];
        float rs = rsqrtf(ss * (1.0f / 64.0f) + 1e-5f) * (1.0f - lam_init);
        const float* g = p.da_norm_g + layer * 64 + hv * 32;
        bf16_t* yo = p.Y + qr * DM + 512 + h * 64 + hv * 32;
#pragma unroll
        for (int i = 0; i < 32; ++i) yo[i] = f2bf(o1[i] * rs * g[i]);
    }
}

__device__ __forceinline__ void ph_finish(unsigned char* smem, const Params& p, int layer) {
    PH_IDS();
    const int half = tid_ >> 8, tid = tid_ & 255, lane = tid & 63;
    float* sz = (float*)(smem + 64) + half * 256;
    for (int r0 = bid_ * 2; r0 < NTOK; r0 += nblk_ * 2) {
        const int r = r0 + half;
        const bool act = !(layer == NLAYER - 1 && (r % TJ) < NCTX);
        const bf16_t* pr = p.P + (size_t)r * DINP;
        size_t o0 = (size_t)r * 256, o1 = (size_t)NTOK * 256 + o0;
        if (act) {
            {
                float o = bf2f(p.ODN[o0 + tid]) + bf2f(p.ODN[o1 + tid]);
                float ss = wave_sum(o * o); float rs = rsqrtf(ss * (1.f / 64.f) + 1e-6f);
                float z = bf2f(pr[C_DNZ + tid]);
                p.Y[(size_t)r * DM + tid] = f2bf(o * rs * p.dn_norm_g[layer * 64 + lane] * siluf_(z));
            }
            {
                float o = bf2f(p.OGLA[o0 + tid]) + bf2f(p.OGLA[o1 + tid]);
                float ss = wave_sum(o * o); float rs = rsqrtf(ss * (1.f / 64.f) + 1e-6f);
                float rr = bf2f(pr[C_GLR + tid]);
                p.Y[(size_t)r * DM + 768 + tid] = f2bf(o * rs * p.gla_norm_g[layer * 64 + lane] * siluf_(rr));
            }
        }
        float z = 0.f;
        if (act) { float y = bf2f(p.OS5[o0 + tid]) + bf2f(p.OS5[o1 + tid]) + p.s5_d[layer * 256 + tid] * bf2f(pr[C_S5U + tid]); z = gelu_tanh(y); }
        __syncthreads();
        sz[tid] = z;
        __syncthreads();
        if (act) {
            const float* w = p.s5_glu_w + (size_t)layer * 65536 + tid;
            float acc = p.s5_glu_b[layer * 256 + tid];
            for (int k = 0; k < 256; ++k) acc += sz[k] * w[k * 256];
            p.Y[(size_t)r * DM + 256 + tid] = f2bf(z * sigmoidf_(acc));
        }
    }
}

__device__ __forceinline__ void ph_norm2_route(const Params& p, int layer) {
    PH_IDS();
    int lane = tid_ & 63;
    for (int r = WID; r < NTOK; r += GWV) {
        if (layer == NLAYER - 1 && (r % TJ) < NCTX) continue;
        const float* h = hrow(p, r); const float* md = modrow(p, layer, r);
        float f[16]; float ss = 0.f;
#pragma unroll
        for (int i = 0; i < 4; ++i) { float4 v = *(const float4*)(h + i * 256 + lane * 4); f[i * 4] = v.x; f[i * 4 + 1] = v.y; f[i * 4 + 2] = v.z; f[i * 4 + 3] = v.w; ss += v.x * v.x + v.y * v.y + v.z * v.z + v.w * v.w; }
        ss = wave_sum(ss);
        float rs = rsqrtf(ss * (1.0f / DM) + 1e-6f);
        const float* g = p.norm2_g + layer * DM;
        float sc[16];
#pragma unroll
        for (int e = 0; e < 16; ++e) sc[e] = 0.f;
#pragma unroll
        for (int i = 0; i < 4; ++i) {
            int c0 = i * 256 + lane * 4; ushort4 ob; bf16_t* obp = (bf16_t*)&ob;
#pragma unroll
            for (int j = 0; j < 4; ++j) {
                float v = f[i * 4 + j] * rs * g[c0 + j] * (1.f + md[4 * DM + c0 + j]) + md[3 * DM + c0 + j];
                obp[j] = f2bf(v);
                const float4* wr = (const float4*)(p.w_router + (size_t)(c0 + j) * 16);
#pragma unroll
                for (int e4 = 0; e4 < 4; ++e4) { float4 w = wr[e4]; sc[e4 * 4] += v * w.x; sc[e4 * 4 + 1] += v * w.y; sc[e4 * 4 + 2] += v * w.z; sc[e4 * 4 + 3] += v * w.w; }
            }
            *(ushort4*)(p.A + (size_t)r * DM + c0) = ob;
        }
#pragma unroll
        for (int e = 0; e < 16; ++e) sc[e] = wave_sum(sc[e]);
        if (lane == 0) {
            float s[16], gb[16];
#pragma unroll
            for (int e = 0; e < 16; ++e) { s[e] = sigmoidf_(sc[e]); gb[e] = s[e] + p.b_router[e]; }
            int best = 0; float bestv = -1e30f;
#pragma unroll
            for (int gI = 0; gI < 4; ++gI) {
                float a0 = -1e30f, a1 = -1e30f;
#pragma unroll
                for (int j = 0; j < 4; ++j) { float v = gb[gI * 4 + j]; if (v > a0) { a1 = a0; a0 = v; } else if (v > a1) a1 = v; }
                float gs = a0 + a1; if (gs > bestv) { bestv = gs; best = gI; }
            }
            int i0 = 0, i1 = 0; float v0 = -1e30f, v1 = -1e30f;
#pragma unroll
            for (int j = 0; j < 4; ++j) {
                float v = 0.f;
#pragma unroll
                for (int gI = 0; gI < 4; ++gI) if (gI == best) v = gb[gI * 4 + j];
                if (v > v0) { v1 = v0; i1 = i0; v0 = v; i0 = j; } else if (v > v1) { v1 = v; i1 = j; }
            }
            int e0 = best * 4 + i0, e1 = best * 4 + i1;
            float w0 = 0.f, w1 = 0.f;
#pragma unroll
            for (int e = 0; e < 16; ++e) { if (e == e0) w0 = s[e]; if (e == e1) w1 = s[e]; }
            float inv = 1.f / (w0 + w1);
            p.tok_e[r * 2] = e0; p.tok_e[r * 2 + 1] = e1; p.tok_w[r * 2] = w0 * inv; p.tok_w[r * 2 + 1] = w1 * inv;
            p.tok_pos[r * 2] = atomicAdd(&p.cnt[e0], 1); p.tok_pos[r * 2 + 1] = atomicAdd(&p.cnt[e1], 1);
        }
    }
}

__device__ __forceinline__ void ph_moe_gather(unsigned char* smem, const Params& p, int layer) {
    PH_IDS();
    int* sstart = (int*)(smem + 64);
    __syncthreads();
    if (tid_ == 0) {
        int acc = 0;
        for (int e = 0; e < 16; ++e) { sstart[e] = acc; acc += (p.cnt[e] + 255) / 256 * 256; if (bid_ == 0) p.cnt[16 + e] = acc; }
        if (bid_ == 0) p.cnt[32] = acc;
    }
    __syncthreads();
    int lane = tid_ & 63;
    for (int pr = WID; pr < NTOK * 2; pr += GWV) {
        int r = pr >> 1;
        if (layer == NLAYER - 1 && (r % TJ) < NCTX) continue;
        int slot = sstart[p.tok_e[pr]] + p.tok_pos[pr];
        if (lane == 0) p.tok_slot[pr] = slot;
        const uint4* src = (const uint4*)(p.A + (size_t)r * DM); uint4* dst = (uint4*)(p.BUF + (size_t)slot * DM);
        dst[lane] = src[lane]; dst[lane + 64] = src[lane + 64];
    }
}

__device__ __forceinline__ void ph_moe_combine(const Params& p, int layer) {
    PH_IDS();
    int lane = tid_ & 63;
    for (int r = WID; r < NTOK; r += GWV) {
        if (layer == NLAYER - 1 && (r % TJ) < NCTX) continue;
        float* h = hrow(p, r); const float* md = modrow(p, layer, r) + 5 * DM;
        int s0 = p.tok_slot[r * 2], s1 = p.tok_slot[r * 2 + 1]; float w0 = p.tok_w[r * 2], w1 = p.tok_w[r * 2 + 1];
        const bf16_t* p0 = p.PO + (size_t)s0 * DM; const bf16_t* p1 = p.PO + (size_t)s1 * DM;
        float v[16]; float ss = 0.f;
#pragma unroll
        for (int i = 0; i < 4; ++i) {
            int c0 = i * 256 + lane * 4;
            float4 hv = *(const float4*)(h + c0); ushort4 a = *(const ushort4*)(p0 + c0), bq = *(const ushort4*)(p1 + c0); float4 m = *(const float4*)(md + c0);
            hv.x += m.x * (w0 * bf2f(a.x) + w1 * bf2f(bq.x)); hv.y += m.y * (w0 * bf2f(a.y) + w1 * bf2f(bq.y));
            hv.z += m.z * (w0 * bf2f(a.z) + w1 * bf2f(bq.z)); hv.w += m.w * (w0 * bf2f(a.w) + w1 * bf2f(bq.w));
            v[i * 4] = hv.x; v[i * 4 + 1] = hv.y; v[i * 4 + 2] = hv.z; v[i * 4 + 3] = hv.w;
            ss += hv.x * hv.x + hv.y * hv.y + hv.z * hv.z + hv.w * hv.w;
        }
        if (layer == NLAYER - 1) {
            ss = wave_sum(ss); float rs = rsqrtf(ss * (1.0f / DM) + 1e-6f);
#pragma unroll
            for (int i = 0; i < 4; ++i) { int c0 = i * 256 + lane * 4; float4 g = *(const float4*)(p.final_g + c0);
                float4 o; o.x = v[i * 4] * rs * g.x; o.y = v[i * 4 + 1] * rs * g.y; o.z = v[i * 4 + 2] * rs * g.z; o.w = v[i * 4 + 3] * rs * g.w; *(float4*)(h + c0) = o; }
        } else {
#pragma unroll
            for (int i = 0; i < 4; ++i) { int c0 = i * 256 + lane * 4; float4 o; o.x = v[i * 4]; o.y = v[i * 4 + 1]; o.z = v[i * 4 + 2]; o.w = v[i * 4 + 3]; *(float4*)(h + c0) = o; }
        }
    }
}

#define LDS_BYTES (132 * 1024)
__global__ __launch_bounds__(NTHR, 2) void k_mega(Params p) {
    extern __shared__ __attribute__((aligned(16))) unsigned char smem[];
    if (threadIdx.x == 0) *(uint4*)smem = make_uint4(0u, 0u, 0u, 0u);
    __syncthreads();
    XcdBarrier bar = xcd_barrier_post(p.bar, (volatile LAS unsigned*)smem);
    ph_mod(p);
    xcd_barrier(bar);
    for (int l = 0; l < NLAYER; ++l) {
        const int last = (l == NLAYER - 1);
        ph_norm1(p, l);
        xcd_barrier(bar);
        ph_gemm_naive(smem, p.A, DM, p.w_in + (size_t)l * DM * DIN, DIN, NTOK, DIN, DM, EpiStoreBf16{p.P, DINP}, nullptr, 0, 0);
        xcd_barrier(bar);
        ph_dn_prep(p, l);
        xcd_barrier(bar);
        ph_scans_naive(p, l);
        ph_attn_naive(smem, p, l);
        xcd_barrier(bar);
        ph_finish(smem, p, l);
        xcd_barrier(bar);
        ph_gemm_naive(smem, p.A, DM, p.w_gate + (size_t)l * DM * 4096, 4096, NTOK, 4096, DM, EpiSigmoidBias{p.G, p.b_gate + l * 4096, 4096}, nullptr, 0, last);
        xcd_barrier(bar);
        for (int i = 0; i < 4; ++i)
            ph_gemm_naive(smem, p.Y + i * 256, DM, p.w_branch + ((size_t)l * 4 + i) * 256 * DM, DM, NTOK, DM, 256, EpiGateAcc{p.T, p.G, i}, nullptr, 0, last);
        xcd_barrier(bar);
        ph_gemm_naive(smem, p.T, DM, p.w_out + (size_t)l * DM * DM, DM, NTOK, DM, DM, EpiResid{p.hctx, p.out, p.mod, l, 2}, nullptr, 0, last);
        xcd_barrier(bar);
        ph_norm2_route(p, l);
        xcd_barrier(bar);
        ph_moe_gather(smem, p, l);
        xcd_barrier(bar);
        ph_gemm_naive(smem, p.BUF, DM, p.w_e_gate + (size_t)l * NEXP * DM * DEXP, DEXP, MAXSLOT, DEXP, DM, EpiStoreBf16{p.HID, DEXP}, p.cnt, (size_t)DM * DEXP, 0);
        ph_gemm_naive(smem, p.BUF, DM, p.w_e_up + (size_t)l * NEXP * DM * DEXP, DEXP, MAXSLOT, DEXP, DM, EpiSiluMul{p.HID}, p.cnt, (size_t)DM * DEXP, 0);
        xcd_barrier(bar);
        ph_gemm_naive(smem, p.HID, DEXP, p.w_e_down + (size_t)l * NEXP * DEXP * DM, DM, MAXSLOT, DM, DEXP, EpiStoreBf16{p.PO, DM}, p.cnt, (size_t)DEXP * DM, 0);
        xcd_barrier(bar);
        ph_moe_combine(p, l);
        xcd_barrier(bar);
    }
}

static inline size_t al(size_t x) { return (x + 255) & ~(size_t)255; }

extern "C" void kernel_launch(void* const* d_in, const int* in_sizes, int n_in, void* d_out, int out_size, void* d_ws, size_t ws_size, hipStream_t stream) {
    Params p{};
    const float** ins = (const float**)d_in;
    p.x = ins[0]; p.c = ins[1]; p.ctx = ins[2]; p.c_ctx = ins[3]; p.w_mod = ins[4]; p.b_mod = ins[5]; p.norm1_g = ins[6]; p.norm2_g = ins[7]; p.w_in = ins[8];
    p.dn_conv = ins[9]; p.dn_a_log = ins[10]; p.dn_dt_bias = ins[11]; p.dn_norm_g = ins[12];
    p.s5_a_re = ins[13]; p.s5_a_im = ins[14]; p.s5_log_dt = ins[15]; p.s5_b_re = ins[16]; p.s5_b_im = ins[17]; p.s5_c_re = ins[18]; p.s5_c_im = ins[19]; p.s5_d = ins[20]; p.s5_glu_w = ins[21]; p.s5_glu_b = ins[22];
    p.da_lambda = ins[23]; p.da_norm_g = ins[24]; p.gla_w_gate = ins[25]; p.gla_b_gate = ins[26]; p.gla_norm_g = ins[27];
    p.w_branch = ins[28]; p.w_gate = ins[29]; p.b_gate = ins[30]; p.w_out = ins[31]; p.w_router = ins[32]; p.b_router = ins[33];
    p.w_e_gate = ins[34]; p.w_e_up = ins[35]; p.w_e_down = ins[36]; p.final_g = ins[37];
    p.out = (float*)d_out;
    char* ws = (char*)d_ws; size_t off = 0;
    auto take = [&](size_t bytes) { char* q = ws + off; off += al(bytes); return q; };
    p.bar = (unsigned*)take((size_t)XCD_BAR_WORDS * 4);
    p.cnt = (int*)take(256 * 4);
    p.mod = (float*)take((size_t)NLAYER * 5 * 6 * DM * 4);
    p.hctx = (float*)take((size_t)NB * NCTX * DM * 4);
    p.tok_e = (int*)take((size_t)NTOK * 2 * 4); p.tok_w = (float*)take((size_t)NTOK * 2 * 4); p.tok_pos = (int*)take((size_t)NTOK * 2 * 4); p.tok_slot = (int*)take((size_t)NTOK * 2 * 4);
    p.A = (bf16_t*)take((size_t)NTOK * DM * 2);
    p.Y = (bf16_t*)take((size_t)NTOK * DM * 2);
    char* big = ws + off;
    p.P = (bf16_t*)take((size_t)NTOK * DINP * 2);
    p.QKVN = (bf16_t*)take((size_t)NTOK * 768 * 2);
    p.ODN = (bf16_t*)take((size_t)2 * NTOK * 256 * 2);
    p.OS5 = (bf16_t*)take((size_t)2 * NTOK * 256 * 2);
    p.OGLA = (bf16_t*)take((size_t)2 * NTOK * 256 * 2);
    p.G = (bf16_t*)big;
    p.T = p.OS5;
    p.BUF = (bf16_t*)big; p.PO = (bf16_t*)big;
    p.HID = (bf16_t*)(big + al((size_t)MAXSLOT * DM * 2));
    if (off > ws_size) return;

    static int grid = 0;
    if (!grid) {
        int dev = 0, cus = 0, per_cu = 0;
        (void)hipGetDevice(&dev);
        (void)hipDeviceGetAttribute(&cus, hipDeviceAttributeMultiprocessorCount, dev);
        (void)hipFuncSetAttribute((const void*)k_mega, hipFuncAttributeMaxDynamicSharedMemorySize, LDS_BYTES);
        (void)hipOccupancyMaxActiveBlocksPerMultiprocessor(&per_cu, (const void*)k_mega, NTHR, LDS_BYTES);
        grid = per_cu >= 1 ? cus : 0;
    }
    if (!grid) return;
    (void)hipMemsetAsync(p.bar, 0, (size_t)XCD_BAR_WORDS * 4, stream);
    k_mega<<<grid, NTHR, LDS_BYTES, stream>>>(p);
}
```

```cpp
#ifndef EMU
#include <hip/hip_runtime.h>
#include <stdint.h>
#define OPQV(x) asm volatile("" : "+v"(x))
#define OPQS(x) asm volatile("" : "+s"(x))
#define WAVE_LDS_FENCE() __builtin_amdgcn_fence(__ATOMIC_RELEASE, "wavefront")
#endif

typedef unsigned short bf16_t;

#define DM 1024
#define NB 4
#ifndef SEQ
#define SEQ 8192
#endif
#define NCTX 256
#define TJ (SEQ + NCTX)
#define NTOK (NB * TJ)
#define DIN 2864
#define DINP 3072
#define NEXP 16
#define DEXP 512
#define NLAYER 2
#define C_DNQ 0
#define C_DNK 256
#define C_DNV 512
#define C_DNZ 768
#define C_DNA 1024
#define C_DNB 1032
#define C_S5U 1040
#define C_DAQ 1296
#define C_DAK 1552
#define C_DAV 1808
#define C_GLQ 2064
#define C_GLK 2192
#define C_GLV 2320
#define C_GLR 2576
#define C_GLG 2832

#define MAXSLOT (2 * NTOK + NEXP * 256)

__device__ __forceinline__ float bf2f(bf16_t v) { return __uint_as_float(((unsigned)v) << 16); }
__device__ __forceinline__ bf16_t f2bf(float f) { unsigned u = __float_as_uint(f); u += 0x7FFFu + ((u >> 16) & 1u); return (bf16_t)(u >> 16); }
__device__ __forceinline__ float sigmoidf_(float x) { return 1.0f / (1.0f + __expf(-x)); }
__device__ __forceinline__ float siluf_(float x) { return x / (1.0f + __expf(-x)); }
__device__ __forceinline__ float softplusf_(float x) { return x > 20.f ? x : log1pf(expf(x)); }
__device__ __forceinline__ float logsigmoidf_(float x) { return fminf(x, 0.f) - log1pf(expf(-fabsf(x))); }
__device__ __forceinline__ float gelu_tanh(float x) { const float k = 0.7978845608028654f; float u = k * (x + 0.044715f * x * x * x); return 0.5f * x * (1.0f + tanhf(u)); }
__device__ __forceinline__ float wave_sum(float v) {
#pragma unroll
    for (int o = 32; o >= 1; o >>= 1) v += __shfl_xor(v, o, 64);
    return v;
}
__device__ __forceinline__ float rdlane(float v, int l) { return __int_as_float(__builtin_amdgcn_readlane(__float_as_int(v), l)); }

typedef float f32x16 __attribute__((ext_vector_type(16)));
#ifndef EMU
typedef __bf16 bfx8 __attribute__((ext_vector_type(8)));
typedef __bf16 bf16x2_t_ __attribute__((ext_vector_type(2)));
typedef float f32x2_t_ __attribute__((ext_vector_type(2)));
__device__ __forceinline__ unsigned cvt_pk_bf16_(float lo, float hi) { f32x2_t_ f = {lo, hi}; bf16x2_t_ b = __builtin_convertvector(f, bf16x2_t_); return *(unsigned*)&b; }
#endif

struct Params {
    const float *x, *c, *ctx, *c_ctx, *w_mod, *b_mod, *norm1_g, *norm2_g, *w_in, *dn_conv, *dn_a_log, *dn_dt_bias, *dn_norm_g;
    const float *s5_a_re, *s5_a_im, *s5_log_dt, *s5_b_re, *s5_b_im, *s5_c_re, *s5_c_im, *s5_d, *s5_glu_w, *s5_glu_b;
    const float *da_lambda, *da_norm_g, *gla_w_gate, *gla_b_gate, *gla_norm_g, *w_branch, *w_gate, *b_gate, *w_out;
    const float *w_router, *b_router, *w_e_gate, *w_e_up, *w_e_down, *final_g;
    float* out;
    float* mod;
    float* hctx;
    bf16_t* A;
    bf16_t* P;
    bf16_t* Y;
    bf16_t* Qr;
    bf16_t* Kr;
    bf16_t* Vt;
    float* Qn;
    unsigned* kmax;
    bf16_t* ODN;
    bf16_t* OS5;
    bf16_t* XS;
    bf16_t* SB;
    bf16_t* SE;
    bf16_t* GLUt;
    float* A16;
    bf16_t* OGLA;
    bf16_t* GST;
    float* DCY;
    bf16_t* T;
    bf16_t* STASH;
    bf16_t *WinT, *WgT, *WbrT, *WoT, *WguT, *WdT;
    bf16_t* BUF;
    bf16_t* HID;
    bf16_t* PO;
    unsigned* bar;
    int* cnt;
    int* tok_e;
    float* tok_w;
    int* tok_pos;
    int* tok_slot;
};

__device__ __forceinline__ float* hrow(const Params& p, int r) {
    int b = r / TJ, tau = r - b * TJ;
    return tau < NCTX ? p.hctx + ((size_t)b * NCTX + tau) * DM : p.out + ((size_t)b * SEQ + (tau - NCTX)) * DM;
}
__device__ __forceinline__ const float* modrow(const Params& p, int layer, int r) {
    int b = r / TJ, tau = r - b * TJ;
    return p.mod + ((size_t)layer * 5 + (tau < NCTX ? 4 : b)) * (6 * DM);
}


#ifndef EMU
#define XB_TMO      128
#define XB_XCNT(j)  (256  + 64 * (j))
#define XB_XSUB(j)  (1280 + 64 * (j))
#define XB_XGEN(j)  (2304 + 64 * (j))
#define XB_TOP      3328
#define XB_TOPGEN   3392
#define XCD_BAR_WORDS 3456
#define XB_SPIN_CAP (1u << 18)
#define LAS __attribute__((address_space(3)))
__device__ __forceinline__ unsigned xb_ld(unsigned* p)              { return __hip_atomic_load(p, __ATOMIC_RELAXED, __HIP_MEMORY_SCOPE_AGENT); }
__device__ __forceinline__ unsigned xb_add(unsigned* p, unsigned v) { return __hip_atomic_fetch_add(p, v, __ATOMIC_RELAXED, __HIP_MEMORY_SCOPE_AGENT); }
__device__ __forceinline__ unsigned xb_xcc_id() { return (unsigned)__builtin_amdgcn_s_getreg((3 << 11) | 20) & 0xFu; }
#define XB_SPIN(cond, bar) do { unsigned _sp = 0; while (cond) { __builtin_amdgcn_s_sleep(1); \
    if ((++_sp & 255u) == 0u) { if (xb_ld(&(bar)[XB_TMO])) break; if (_sp > XB_SPIN_CAP) { atomicAdd(&(bar)[XB_TMO], 1u); break; } } } } while (0)
struct XcdBarrier { unsigned* bar; unsigned x; volatile LAS unsigned* st; };
__device__ __forceinline__ XcdBarrier xcd_barrier_post(unsigned* bar, volatile LAS unsigned* st) {
    XcdBarrier b; b.bar = bar; b.x = xb_xcc_id(); b.st = st;
    if (threadIdx.x == 0) (void)xb_add(&bar[XB_XCNT(b.x)], 1u);
    return b;
}
__device__ __forceinline__ void xcd_barrier_complete(unsigned* bar, unsigned x, unsigned& nloc, unsigned& nx) {
    const unsigned G = gridDim.x * gridDim.y * gridDim.z;
    unsigned sum, cnt, mine, sp = 0u;
    for (;;) {
        sum = 0u; cnt = 0u; mine = 0u;
#pragma unroll
        for (unsigned j = 0; j < 16; ++j) { const unsigned c = xb_ld(&bar[XB_XCNT(j)]); sum += c; cnt += (c > 0u) ? 1u : 0u; mine = (j == x) ? c : mine; }
        if (sum == G) break;
        __builtin_amdgcn_s_sleep(1);
        if ((++sp & 255u) == 0u) { if (xb_ld(&bar[XB_TMO])) break; if (sp > XB_SPIN_CAP) { atomicAdd(&bar[XB_TMO], 1u); break; } }
    }
    nloc = mine > 0u ? mine : 1u; nx = cnt > 0u ? cnt : 1u;
}
__device__ __forceinline__ void xcd_barrier_(const XcdBarrier& b, const int tid0) {
    asm volatile("s_waitcnt vmcnt(0)" ::: "memory");
    __syncthreads();
    if (tid0 == 0) {
        unsigned* bar = b.bar;
        __builtin_amdgcn_s_waitcnt(0);
        unsigned nloc = b.st[0], nx = b.st[1];
        if (nloc == 0u) { xcd_barrier_complete(bar, b.x, nloc, nx); b.st[0] = nloc; b.st[1] = nx; }
        const unsigned old = xb_add(&bar[XB_XSUB(b.x)], 1u);
        const unsigned gen = old / nloc;
        if (old + 1u == (gen + 1u) * nloc) {
            __builtin_amdgcn_fence(__ATOMIC_RELEASE, "agent");
            asm volatile("s_waitcnt vmcnt(0)" ::: "memory");
            const unsigned og = xb_add(&bar[XB_TOP], 1u);
            const unsigned tg = og / nx;
            if (og + 1u == (tg + 1u) * nx) xb_add(&bar[XB_TOPGEN], 1u);
            else XB_SPIN(xb_ld(&bar[XB_TOPGEN]) == tg, bar);
            __builtin_amdgcn_fence(__ATOMIC_ACQUIRE, "agent");
            xb_add(&bar[XB_XGEN(b.x)], 1u);
            asm volatile("s_waitcnt vmcnt(0)" ::: "memory");
        } else {
            XB_SPIN(xb_ld(&bar[XB_XGEN(b.x)]) == gen, bar);
            __builtin_amdgcn_fence(__ATOMIC_ACQUIRE, "agent");
            asm volatile("s_waitcnt vmcnt(0)" ::: "memory");
        }
    }
    __syncthreads();
}

#endif
#define NTHR 512
#define NWV 8
#define PH_IDS() int tid_ = wv_ * 64 + (int)__builtin_amdgcn_mbcnt_hi(~0u, __builtin_amdgcn_mbcnt_lo(~0u, 0u)); OPQV(tid_); int bid_ = blockIdx.x; OPQS(bid_); int nblk_ = gridDim.x; OPQS(nblk_); (void)tid_; (void)bid_; (void)nblk_
#define GWV (nblk_ * NWV)
#define WID (bid_ * NWV + (tid_ >> 6))

__device__ __forceinline__ void ph_mod(const int wv_, const Params& p) {
    PH_IDS();
    for (int idx = bid_ * NTHR + tid_; idx < NLAYER * 5 * 6 * DM; idx += nblk_ * NTHR) {
        int col = idx % (6 * DM), v = (idx / (6 * DM)) % 5, l = idx / (5 * 6 * DM);
        const float* cv = v < 4 ? p.c + v * DM : p.c_ctx;
        const float* w = p.w_mod + (size_t)l * DM * 6 * DM + col;
        float acc = p.b_mod[l * 6 * DM + col];
        for (int k = 0; k < DM; ++k) acc += siluf_(cv[k]) * w[(size_t)k * 6 * DM];
        p.mod[idx] = acc;
    }
}

__device__ __forceinline__ void ph_norm1(const int wv_, const Params& p, int layer) {
    PH_IDS();
    int lane = tid_ & 63;
    if (bid_ == 0 && tid_ < 64) { p.cnt[tid_] = 0; if (tid_ < 32) p.kmax[tid_] = 0u; }
    for (int r = WID; r < NTOK; r += GWV) {
        int b = r / TJ, tau = r - b * TJ;
        float* h = hrow(p, r);
        const float* src = h;
        if (layer == 0) src = tau < NCTX ? p.ctx + ((size_t)b * NCTX + tau) * DM : p.x + ((size_t)b * SEQ + (tau - NCTX)) * DM;
        const float* md = modrow(p, layer, r);
        float4 v[4]; float ss = 0.f;
#pragma unroll
        for (int i = 0; i < 4; ++i) { v[i] = *(const float4*)(src + i * 256 + lane * 4); ss += v[i].x * v[i].x + v[i].y * v[i].y + v[i].z * v[i].z + v[i].w * v[i].w; }
        ss = wave_sum(ss);
        float rs = rsqrtf(ss * (1.0f / DM) + 1e-6f);
        const float* g = p.norm1_g + layer * DM;
#pragma unroll
        for (int i = 0; i < 4; ++i) {
            int c0 = i * 256 + lane * 4;
            if (layer == 0) *(float4*)(h + c0) = v[i];
            float4 gg = *(const float4*)(g + c0), sh = *(const float4*)(md + c0), sc = *(const float4*)(md + DM + c0);
            float o0 = v[i].x * rs * gg.x * (1.f + sc.x) + sh.x, o1 = v[i].y * rs * gg.y * (1.f + sc.y) + sh.y;
            float o2 = v[i].z * rs * gg.z * (1.f + sc.z) + sh.z, o3 = v[i].w * rs * gg.w * (1.f + sc.w) + sh.w;
            ushort4 ob; ob.x = f2bf(o0); ob.y = f2bf(o1); ob.z = f2bf(o2); ob.w = f2bf(o3);
            *(ushort4*)(p.A + (size_t)r * DM + c0) = ob;
        }
    }
}

struct EpiStoreBf16 { bf16_t* C; int ldc; __device__ void operator()(int r, int c, float v) const { C[(size_t)r * ldc + c] = f2bf(v); } };
struct EpiSigmoidBias { bf16_t* C; const float* bias; int ldc; __device__ void operator()(int r, int c, float v) const { C[(size_t)r * ldc + c] = f2bf(sigmoidf_(v + bias[c])); } };
struct EpiGateAcc { bf16_t* T; const bf16_t* G; int i; __device__ void operator()(int r, int c, float v) const {
    float g = bf2f(G[(size_t)r * 4096 + i * DM + c]); float t = g * v; if (i > 0) t += bf2f(T[(size_t)r * DM + c]); T[(size_t)r * DM + c] = f2bf(t); } };
struct EpiResid { float* hctx; float* out; const float* mod; int layer; int modoff; __device__ void operator()(int r, int c, float v) const {
    int b = r / TJ, tau = r - b * TJ;
    float* h = tau < NCTX ? hctx + ((size_t)b * NCTX + tau) * DM : out + ((size_t)b * SEQ + (tau - NCTX)) * DM;
    const float* md = mod + ((size_t)layer * 5 + (tau < NCTX ? 4 : b)) * (6 * DM);
    h[c] += md[modoff * DM + c] * v; } };
struct EpiSiluMul { bf16_t* H; __device__ void operator()(int r, int c, float v) const { float g = bf2f(H[(size_t)r * DEXP + c]); H[(size_t)r * DEXP + c] = f2bf(siluf_(g) * v); } };

template <class Epi>
__device__ __forceinline__ void ph_gemm_naive(const int wv_, unsigned char* smem, const bf16_t* A, int lda, const float* W0, int ldw, int M, int N, int K, const Epi& epi, const int* grp, size_t wstride, int skip_ctx) {
    PH_IDS();
    const int half = tid_ >> 8, tid = tid_ & 255, tx = tid & 15, ty = tid >> 4;
    float (*sA)[68] = (float (*)[68])(smem + 64 + half * 8704);
    float (*sB)[68] = (float (*)[68])(smem + 64 + half * 8704 + 4352);
    const int ntn = (N + 63) / 64, ntiles = (M / 64) * ntn;
    for (int t0 = bid_ * 2; t0 < ntiles; t0 += nblk_ * 2) {
        const int t = t0 + half;
        bool active = t < ntiles;
        int bm = active ? (t / ntn) * 64 : 0, bn = active ? (t % ntn) * 64 : 0;
        const float* W = W0;
        if (grp && active) {
            if (bm >= grp[32]) active = false;
            int e = 0;
            for (int i = 0; i < 16; ++i) e += (grp[16 + i] <= bm) ? 1 : 0;
            if (e > 15) e = 15;
            W += (size_t)e * wstride;
        }
        if (skip_ctx && (bm % TJ) < NCTX) active = false;
        float acc[4][4] = {};
        for (int k0 = 0; k0 < K; k0 += 16) {
            if (active) {
                int r = tid >> 2, kk = (tid & 3) * 4;
                ushort4 a = *(const ushort4*)(A + (size_t)(bm + r) * lda + k0 + kk);
                sA[kk + 0][r] = bf2f(a.x); sA[kk + 1][r] = bf2f(a.y); sA[kk + 2][r] = bf2f(a.z); sA[kk + 3][r] = bf2f(a.w);
                int kr = tid >> 4, cc = (tid & 15) * 4;
#pragma unroll
                for (int j = 0; j < 4; ++j) { int col = bn + cc + j; sB[kr][cc + j] = col < N ? W[(size_t)(k0 + kr) * ldw + col] : 0.f; }
            }
            __syncthreads();
            if (active) {
#pragma unroll
                for (int kk = 0; kk < 16; ++kk) {
                    float a[4], b[4];
#pragma unroll
                    for (int i = 0; i < 4; ++i) { a[i] = sA[kk][ty * 4 + i]; b[i] = sB[kk][tx * 4 + i]; }
#pragma unroll
                    for (int i = 0; i < 4; ++i)
#pragma unroll
                        for (int j = 0; j < 4; ++j) acc[i][j] += a[i] * b[j];
                }
            }
            __syncthreads();
        }
        if (active) {
#pragma unroll
            for (int i = 0; i < 4; ++i)
#pragma unroll
                for (int j = 0; j < 4; ++j) { int col = bn + tx * 4 + j; if (col < N) epi(bm + ty * 4 + i, col, acc[i][j]); }
        }
    }
}

__device__ __forceinline__ int pos2tau(int d, int pos) { return d == 0 ? pos : (pos < NCTX ? NCTX - 1 - pos : (TJ + NCTX - 1) - pos); }

__device__ __forceinline__ void dn_load_raw(const Params& p, int b, int tau, int h, int lane, float (&q)[5], float (&k)[5], float (&v)[5]) {
    const int lo = tau < NCTX ? 0 : NCTX, hi = tau < NCTX ? NCTX : TJ;
#pragma unroll
    for (int j = 0; j < 5; ++j) {
        const int t2 = tau + j - 2; const bool ok = t2 >= lo && t2 < hi;
        const bf16_t* pr = p.P + ((size_t)b * TJ + (ok ? t2 : tau)) * DINP + h * 64 + lane;
        q[j] = ok ? bf2f(pr[0]) : 0.f; k[j] = ok ? bf2f(pr[256]) : 0.f; v[j] = ok ? bf2f(pr[512]) : 0.f;
    }
}
__device__ __forceinline__ void dn_chain_naive(const Params& p, int layer, int chain, int lane) {
    int b = chain >> 3, h = (chain >> 1) & 3, d = chain & 1;
    float S[64];
#pragma unroll
    for (int i = 0; i < 64; ++i) S[i] = 0.f;
    const float nalog = -expf(p.dn_a_log[layer * 8 + d * 4 + h]), dtb = p.dn_dt_bias[layer * 8 + d * 4 + h];
    float cq[5], ck[5], cv[5];
#pragma unroll
    for (int j = 0; j < 5; ++j) { const float* cw = p.dn_conv + ((size_t)layer * 5 + j) * 768 + h * 64 + lane; cq[j] = cw[0]; ck[j] = cw[256]; cv[j] = cw[512]; }
    bf16_t* O = d == 0 ? p.Y : p.ODN; const int ldo = d == 0 ? DM : 256;
    int tau = pos2tau(d, 0);
    size_t r = (size_t)b * TJ + tau;
    float a_n = bf2f(p.P[r * DINP + C_DNA + d * 4 + h]), b_n = bf2f(p.P[r * DINP + C_DNB + d * 4 + h]);
    float qn[5], kn[5], vn[5];
    dn_load_raw(p, b, tau, h, lane, qn, kn, vn);
    for (int pos = 0; pos < TJ; ++pos) {
        float a_in = a_n, b_in = b_n; size_t rc = r;
        float qa = 0.f, ka = 0.f, va = 0.f;
#pragma unroll
        for (int j = 0; j < 5; ++j) { qa += qn[j] * cq[j]; ka += kn[j] * ck[j]; va += vn[j] * cv[j]; }
        if (pos + 1 < TJ) {
            tau = pos2tau(d, pos + 1); r = (size_t)b * TJ + tau;
            a_n = bf2f(p.P[r * DINP + C_DNA + d * 4 + h]); b_n = bf2f(p.P[r * DINP + C_DNB + d * 4 + h]);
            dn_load_raw(p, b, tau, h, lane, qn, kn, vn);
        }
        float qv = siluf_(qa), kv = siluf_(ka), vv = siluf_(va);
        qv *= rsqrtf(wave_sum(qv * qv) + 1e-6f); kv *= rsqrtf(wave_sum(kv * kv) + 1e-6f);
        float decay = expf(nalog * softplusf_(a_in + dtb)), beta = sigmoidf_(b_in);
        float kS = 0.f;
#pragma unroll
        for (int i = 0; i < 64; ++i) { S[i] *= decay; kS += rdlane(kv, i) * S[i]; }
        float vnew = beta * (vv - kS), o = 0.f;
#pragma unroll
        for (int i = 0; i < 64; ++i) { S[i] += rdlane(kv, i) * vnew; o += rdlane(qv, i) * S[i]; }
        O[rc * ldo + h * 64 + lane] = f2bf(o * 0.125f);
    }
}

__device__ __forceinline__ void s5_chain_naive(const Params& p, int layer, int chain, int lane) {
    int b = chain >> 5, g = (chain >> 1) & 15, d = chain & 1;
    float lre = p.s5_a_re[((layer * 2 + d) * 16 + g) * 64 + lane], lim = p.s5_a_im[((layer * 2 + d) * 16 + g) * 64 + lane];
    float dt = expf(p.s5_log_dt[(layer * 2 + d) * 16 + g]);
    float mag = expf(lre * dt), are = mag * cosf(lim * dt), aim = mag * sinf(lim * dt);
    float den = lre * lre + lim * lim;
    float fre = ((are - 1.f) * lre + aim * lim) / den, fim = (aim * lre - (are - 1.f) * lim) / den;
    float bbr[16], bbi[16], cr[16], ci[16];
#pragma unroll
    for (int c = 0; c < 16; ++c) {
        float br = p.s5_b_re[((layer * 16 + g) * 64 + lane) * 16 + c], bi = p.s5_b_im[((layer * 16 + g) * 64 + lane) * 16 + c];
        bbr[c] = fre * br - fim * bi; bbi[c] = fre * bi + fim * br;
        cr[c] = p.s5_c_re[(((layer * 2 + d) * 16 + g) * 16 + c) * 64 + lane]; ci[c] = p.s5_c_im[(((layer * 2 + d) * 16 + g) * 16 + c) * 64 + lane];
    }
    bf16_t* O = d == 0 ? p.Y + 256 : p.OS5; const int ldo = d == 0 ? DM : 256;
    float xr = 0.f, xi = 0.f;
    size_t r = (size_t)b * TJ + pos2tau(d, 0);
    float u_n = bf2f(p.P[r * DINP + C_S5U + g * 16 + (lane & 15)]);
    for (int pos = 0; pos < TJ; ++pos) {
        float u = u_n; size_t rc = r;
        if (pos + 1 < TJ) { r = (size_t)b * TJ + pos2tau(d, pos + 1); u_n = bf2f(p.P[r * DINP + C_S5U + g * 16 + (lane & 15)]); }
        float nr = are * xr - aim * xi, ni = are * xi + aim * xr;
#pragma unroll
        for (int c = 0; c < 16; ++c) { float uc = rdlane(u, c); nr += bbr[c] * uc; ni += bbi[c] * uc; }
        xr = nr; xi = ni;
        float my = 0.f;
#pragma unroll
        for (int c = 0; c < 16; ++c) { float t = wave_sum(cr[c] * xr - ci[c] * xi); if (lane == c) my = t; }
        if (lane < 16) O[rc * ldo + g * 16 + lane] = f2bf(my);
    }
}

__device__ __forceinline__ void gla_chain_naive(const Params& p, int layer, int chain, int lane) {
    int b = chain >> 3, h = (chain >> 1) & 3, d = chain & 1;
    float S[32];
#pragma unroll
    for (int i = 0; i < 32; ++i) S[i] = 0.f;
    float w2[16];
#pragma unroll
    for (int rr = 0; rr < 16; ++rr) w2[rr] = p.gla_w_gate[((layer * 2 + d) * 16 + rr) * 128 + h * 32 + (lane & 31)];
    float b2 = p.gla_b_gate[(layer * 2 + d) * 128 + h * 32 + (lane & 31)];
    bf16_t* O = d == 0 ? p.Y + 768 : p.OGLA; const int ldo = d == 0 ? DM : 256;
    size_t r = (size_t)b * TJ + pos2tau(d, 0);
    float low_n = bf2f(p.P[r * DINP + C_GLG + d * 16 + (lane & 15)]), q_n = bf2f(p.P[r * DINP + C_GLQ + h * 32 + (lane & 31)]);
    float k_n = bf2f(p.P[r * DINP + C_GLK + h * 32 + (lane & 31)]), v_n = bf2f(p.P[r * DINP + C_GLV + h * 64 + lane]);
    for (int pos = 0; pos < TJ; ++pos) {
        float low = low_n, qv = q_n, kv = k_n, vv = v_n; size_t rc = r;
        if (pos + 1 < TJ) {
            r = (size_t)b * TJ + pos2tau(d, pos + 1);
            low_n = bf2f(p.P[r * DINP + C_GLG + d * 16 + (lane & 15)]); q_n = bf2f(p.P[r * DINP + C_GLQ + h * 32 + (lane & 31)]);
            k_n = bf2f(p.P[r * DINP + C_GLK + h * 32 + (lane & 31)]); v_n = bf2f(p.P[r * DINP + C_GLV + h * 64 + lane]);
        }
        float z = b2;
#pragma unroll
        for (int rr = 0; rr < 16; ++rr) z += rdlane(low, rr) * w2[rr];
        float a = expf(logsigmoidf_(z) * (1.0f / 16.0f));
        float o = 0.f;
#pragma unroll
        for (int i = 0; i < 32; ++i) { S[i] = rdlane(a, i) * S[i] + rdlane(kv, i) * vv; o += rdlane(qv, i) * S[i]; }
        O[rc * ldo + h * 64 + lane] = f2bf(o * 0.17677669529663687f);
    }
}

#define DN_SB 72
#define DN_RAW 0
#define DN_QN 26624
#define DN_KN (DN_QN + 9216)
#define DN_V (DN_KN + 9216)
#define DN_NL (DN_V + 9216)
#define DN_AI (DN_NL + 9216)
#define DN_NW (DN_AI + 9216)
#define DN_KDT (DN_NW + 9216)
#define DN_U (DN_KDT + 9216)
#define DN_TD (DN_U + 17408)
#define DN_GAM (DN_TD + 2048)
typedef float f32x4_ __attribute__((ext_vector_type(4)));
__device__ __forceinline__ bfx8 pack8(const f32x4_& x, const f32x4_& y) {
    unsigned u[4]; u[0] = cvt_pk_bf16_(x[0], x[1]); u[1] = cvt_pk_bf16_(x[2], x[3]); u[2] = cvt_pk_bf16_(y[0], y[1]); u[3] = cvt_pk_bf16_(y[2], y[3]);
    return *(const bfx8*)u;
}
__device__ __forceinline__ bfx8 ld_split(const unsigned char* base, int row, int k0, int q4) {
    const unsigned char* a = base + (row * DN_SB + k0 + 4 * q4) * 2;
    uint2 lo = *(const uint2*)a, hi = *(const uint2*)(a + 32);
    unsigned u[4] = {lo.x, lo.y, hi.x, hi.y}; return *(const bfx8*)u;
}
__device__ __forceinline__ bfx8 ld_half(const unsigned char* base, int rowstride, int row, int k0, int q4) {
    uint2 lo = *(const uint2*)(base + (row * rowstride + k0 + 4 * q4) * 2);
    unsigned u[4] = {lo.x, lo.y, 0u, 0u}; return *(const bfx8*)u;
}
#define MFMA16(a, b, c) __builtin_amdgcn_mfma_f32_16x16x32_bf16(a, b, c, 0, 0, 0)

__device__ __forceinline__ void dn_chain(unsigned char* smem, const Params& p, int layer, int chain, int tid_) {
    unsigned char* L = smem + 1024;
    const int b = chain >> 3, h = (chain >> 1) & 3, d = chain & 1;
    const int w0_ = tid_ >> 6, lane0_ = tid_ & 63;
#define DN_IDS() int tt_ = tid_; OPQV(tt_); const int lane = tt_ & 63, w = __builtin_amdgcn_readfirstlane(tt_ >> 6), l15 = lane & 15, q4 = lane >> 4; (void)l15; (void)q4; (void)w
    const float nalog = -expf(p.dn_a_log[layer * 8 + d * 4 + h]), dtb = p.dn_dt_bias[layer * 8 + d * 4 + h];
    float* gam = (float*)(L + DN_GAM);
    const int cpg = tid_ / 24, combo = tid_ - cpg * 24, cwhich = combo >> 3, cg = combo & 7;
    float cw[5][8];
    if (tid_ < 384) {
#pragma unroll
        for (int j = 0; j < 5; ++j)
#pragma unroll
            for (int e = 0; e < 8; ++e) cw[j][e] = p.dn_conv[((size_t)layer * 5 + (d ? 4 - j : j)) * 768 + cwhich * 256 + h * 64 + cg * 8 + e];
    }
    f32x4_ Sst[4];
#pragma unroll
    for (int mt = 0; mt < 4; ++mt) Sst[mt] = (f32x4_){0.f, 0.f, 0.f, 0.f};
    bf16_t* Oout = d == 0 ? p.Y : p.ODN; const int ldo = d == 0 ? DM : 256;
    uint4 pre[4]; float a_n = 0.f, b_n = 0.f;
    auto chunk_lo = [&](int c) { return d == 0 ? c * 64 : (c < 4 ? 192 - c * 64 : (TJ + NCTX - 64) - c * 64); };
    auto issue = [&](int c) {
        const int tlo = chunk_lo(c), slo = tlo < NCTX ? 0 : NCTX, shi = tlo < NCTX ? NCTX : TJ;
#pragma unroll
        for (int k = 0; k < 4; ++k) {
            const int e = tid_ + NTHR * k; pre[k] = make_uint4(0u, 0u, 0u, 0u);
            if (e < 68 * 24) { const int row = e / 24, ch = e - row * 24, tau = tlo - 2 + row;
                if (tau >= slo && tau < shi) pre[k] = *(const uint4*)(p.P + ((size_t)b * TJ + tau) * DINP + (ch >> 3) * 256 + h * 64 + (ch & 7) * 8); }
        }
        if (w0_ == 6) { const int tau = d ? tlo + 63 - lane0_ : tlo + lane0_; const bf16_t* pr = p.P + ((size_t)b * TJ + tau) * DINP;
            a_n = bf2f(pr[C_DNA + d * 4 + h]); b_n = bf2f(pr[C_DNB + d * 4 + h]); }
    };
    auto commit = [&]() {
#pragma unroll
        for (int k = 0; k < 4; ++k) { const int e = tid_ + NTHR * k; if (e < 68 * 24) *(uint4*)(L + DN_RAW + e * 16) = pre[k]; }
    };
    issue(0);
    __syncthreads();
    commit();
    for (int c = 0; c < TJ / 64; ++c) {
        const int tlo = chunk_lo(c);
        const float a_c = a_n, b_c = b_n;
        __syncthreads();
        if (c + 1 < TJ / 64) issue(c + 1);
        { DN_IDS();
        if (w == 6) {
            float g = nalog * softplusf_(a_c + dtb);
#pragma unroll
            for (int o = 1; o < 64; o <<= 1) { float t = __shfl_up(g, o, 64); if (lane >= o) g += t; }
            const float glast = rdlane(g, 63);
            gam[lane] = g; gam[64 + lane] = sigmoidf_(b_c); gam[128 + lane] = __expf(g); gam[192 + lane] = __expf(glast - g);
        }
        if (tid_ < 384) {
            const int rlo = d ? (63 - (4 * cpg + 3)) : 4 * cpg;
            float x[8][8];
#pragma unroll
            for (int rr = 0; rr < 8; ++rr) {
                const uint4 v = *(const uint4*)(L + DN_RAW + (((d ? rlo + 7 - rr : rlo + rr)) * 192 + cwhich * 64 + cg * 8) * 2);
                const unsigned vv[4] = {v.x, v.y, v.z, v.w};
#pragma unroll
                for (int e = 0; e < 4; ++e) { x[rr][2 * e] = __uint_as_float(vv[e] << 16); x[rr][2 * e + 1] = __uint_as_float(vv[e] & 0xffff0000u); }
            }
#pragma unroll
            for (int e2 = 0; e2 < 4; ++e2) {
                const int i = 4 * cpg + e2;
                float y[8]; float ss = 0.f;
#pragma unroll
                for (int e = 0; e < 8; ++e) { float acc = 0.f;
#pragma unroll
                    for (int j = 0; j < 5; ++j) acc += x[e2 + j][e] * cw[j][e];
                    y[e] = siluf_(acc); ss += y[e] * y[e]; }
                ss += __shfl_xor(ss, 1, 64); ss += __shfl_xor(ss, 2, 64); ss += __shfl_xor(ss, 4, 64);
                const float rs = cwhich < 2 ? rsqrtf(ss + 1e-6f) : 1.0f;
                uint4 o; o.x = cvt_pk_bf16_(y[0] * rs, y[1] * rs); o.y = cvt_pk_bf16_(y[2] * rs, y[3] * rs); o.z = cvt_pk_bf16_(y[4] * rs, y[5] * rs); o.w = cvt_pk_bf16_(y[6] * rs, y[7] * rs);
                *(uint4*)(L + (cwhich == 0 ? DN_QN : cwhich == 1 ? DN_KN : DN_V) + (i * DN_SB + cg * 8) * 2) = o;
            }
        }
        }
        __syncthreads();
        { DN_IDS();
#pragma unroll
        for (int tt = 0; tt < 2; ++tt) {
            const int t = 2 * w + tt, it = t >> 2, jt = t & 3;
            f32x4_ kk = {0.f, 0.f, 0.f, 0.f}, qk = {0.f, 0.f, 0.f, 0.f};
            if (jt <= it) {
#pragma unroll
                for (int ks = 0; ks < 2; ++ks) {
                    const bfx8 bk = *(const bfx8*)(L + DN_KN + ((jt * 16 + l15) * DN_SB + ks * 32 + q4 * 8) * 2);
                    const bfx8 ak = *(const bfx8*)(L + DN_KN + ((it * 16 + l15) * DN_SB + ks * 32 + q4 * 8) * 2);
                    const bfx8 aq = *(const bfx8*)(L + DN_QN + ((it * 16 + l15) * DN_SB + ks * 32 + q4 * 8) * 2);
                    kk = MFMA16(ak, bk, kk); qk = MFMA16(aq, bk, qk);
                }
            }
            const int j = jt * 16 + l15; const float gj = gam[j];
#pragma unroll
            for (int r = 0; r < 4; ++r) {
                const int i = it * 16 + q4 * 4 + r;
                const float dec = (j <= i) ? __expf(gam[i] - gj) : 0.f;
                const float lv = (j < i) ? -gam[64 + i] * kk[r] * dec : 0.f;
                *(bf16_t*)(L + DN_NL + (i * DN_SB + j) * 2) = f2bf(lv);
                *(bf16_t*)(L + DN_AI + (i * DN_SB + j) * 2) = f2bf(0.125f * qk[r] * dec);
            }
        }
        }
        __syncthreads();
        f32x4_ R[4];
        { DN_IDS();
        if (w == 0) {
            const int a = q4, cc = l15; float xs[16];
#pragma unroll
            for (int r = 0; r < 16; ++r) {
                const unsigned char* rowp = L + DN_NL + ((16 * a + r) * DN_SB + 16 * a) * 2;
                const uint4 v0 = *(const uint4*)rowp, v1 = *(const uint4*)(rowp + 16);
                const unsigned vv[8] = {v0.x, v0.y, v0.z, v0.w, v1.x, v1.y, v1.z, v1.w};
                float s = (r == cc) ? 1.f : 0.f;
#pragma unroll
                for (int j = 0; j < 16; ++j) if (j < r) { const float lij = (j & 1) ? __uint_as_float(vv[j >> 1] & 0xffff0000u) : __uint_as_float(vv[j >> 1] << 16); s += lij * xs[j]; }
                xs[r] = s;
                *(bf16_t*)(L + DN_TD + ((a * 16 + r) * 16 + cc) * 2) = f2bf(s);
            }
        }
#pragma unroll
        for (int a = 0; a < 4; ++a)
#pragma unroll
            for (int r = 0; r < 4; ++r) {
                const int i = 16 * a + 4 * q4 + r;
                R[a][r] = w < 4 ? gam[64 + i] * bf2f(*(const bf16_t*)(L + DN_V + (i * DN_SB + 16 * w + l15) * 2))
                                : gam[64 + i] * gam[128 + i] * bf2f(*(const bf16_t*)(L + DN_KN + (i * DN_SB + 16 * (w - 4) + l15) * 2));
            }
        {
            const int i = tt_ >> 3, c8 = (tt_ & 7) * 8;
            uint4 qv = *(const uint4*)(L + DN_QN + (i * DN_SB + c8) * 2); const uint4 kv = *(const uint4*)(L + DN_KN + (i * DN_SB + c8) * 2);
            const float sq = 0.125f * gam[128 + i], sk = gam[192 + i];
            unsigned* qq = (unsigned*)&qv; const unsigned* kq = (const unsigned*)&kv;
#pragma unroll
            for (int e = 0; e < 4; ++e) {
                qq[e] = cvt_pk_bf16_(__uint_as_float(qq[e] << 16) * sq, __uint_as_float(qq[e] & 0xffff0000u) * sq);
                *(bf16_t*)(L + DN_KDT + ((c8 + 2 * e) * DN_SB + i) * 2) = f2bf(__uint_as_float(kq[e] << 16) * sk);
                *(bf16_t*)(L + DN_KDT + ((c8 + 2 * e + 1) * DN_SB + i) * 2) = f2bf(__uint_as_float(kq[e] & 0xffff0000u) * sk);
            }
            *(uint4*)(L + DN_QN + (i * DN_SB + c8) * 2) = qv;
        }
        }
        __syncthreads();
        { DN_IDS();
            const f32x4_ z4 = {0.f, 0.f, 0.f, 0.f};
            f32x4_ X[4];
#pragma unroll
            for (int a = 0; a < 4; ++a) {
                f32x4_ acc = R[a];
                if (a == 1) acc = MFMA16(ld_half(L + DN_NL, DN_SB, 16 + l15, 0, q4), pack8(X[0], z4), acc);
                if (a >= 2) acc = MFMA16(ld_split(L + DN_NL, 16 * a + l15, 0, q4), pack8(X[0], X[1]), acc);
                if (a == 3) acc = MFMA16(ld_half(L + DN_NL, DN_SB, 48 + l15, 32, q4), pack8(X[2], z4), acc);
                X[a] = MFMA16(ld_half(L + DN_TD, 16, a * 16 + l15, 0, q4), pack8(acc, z4), z4);
            }
#pragma unroll
            for (int a = 0; a < 4; ++a)
#pragma unroll
                for (int r = 0; r < 4; ++r) {
                    const int i = 16 * a + 4 * q4 + r;
                    if (w < 4) *(float*)(L + DN_U + (i * 68 + 16 * w + l15) * 4) = X[a][r];
                    else *(bf16_t*)(L + DN_NW + (i * DN_SB + 16 * (w - 4) + l15) * 2) = f2bf(-X[a][r]);
                }
        }
        __syncthreads();
        { DN_IDS();
        if (w < 4) {
            const f32x4_ z4 = {0.f, 0.f, 0.f, 0.f};
            bfx8 sb[2]; sb[0] = pack8(Sst[0], Sst[1]); sb[1] = pack8(Sst[2], Sst[3]);
            f32x4_ vn[4];
#pragma unroll
            for (int mt = 0; mt < 4; ++mt) {
                f32x4_ acc;
#pragma unroll
                for (int r = 0; r < 4; ++r) acc[r] = *(const float*)(L + DN_U + ((16 * mt + 4 * q4 + r) * 68 + 16 * w + l15) * 4);
                acc = MFMA16(ld_split(L + DN_NW, 16 * mt + l15, 0, q4), sb[0], acc);
                acc = MFMA16(ld_split(L + DN_NW, 16 * mt + l15, 32, q4), sb[1], acc);
                vn[mt] = acc;
            }
            bfx8 vb[2]; vb[0] = pack8(vn[0], vn[1]); vb[1] = pack8(vn[2], vn[3]);
#pragma unroll
            for (int mt = 0; mt < 4; ++mt) {
                f32x4_ acc = z4;
                acc = MFMA16(ld_split(L + DN_QN, 16 * mt + l15, 0, q4), sb[0], acc);
                acc = MFMA16(ld_split(L + DN_QN, 16 * mt + l15, 32, q4), sb[1], acc);
                acc = MFMA16(ld_split(L + DN_AI, 16 * mt + l15, 0, q4), vb[0], acc);
                acc = MFMA16(ld_split(L + DN_AI, 16 * mt + l15, 32, q4), vb[1], acc);
#pragma unroll
                for (int r = 0; r < 4; ++r) {
                    const int i = 16 * mt + 4 * q4 + r, tau = d ? tlo + 63 - i : tlo + i;
                    Oout[((size_t)b * TJ + tau) * ldo + h * 64 + 16 * w + l15] = f2bf(acc[r]);
                }
            }
            const float glast = gam[128 + 63];
#pragma unroll
            for (int mt = 0; mt < 4; ++mt) {
                f32x4_ acc = Sst[mt] * glast;
                acc = MFMA16(ld_split(L + DN_KDT, 16 * mt + l15, 0, q4), vb[0], acc);
                acc = MFMA16(ld_split(L + DN_KDT, 16 * mt + l15, 32, q4), vb[1], acc);
                Sst[mt] = acc;
            }
        }
        }
        if (c + 1 < TJ / 64) commit();
    }
    __syncthreads();
}

__device__ __forceinline__ int gla_scan_chunk(int d, int tc) { return d == 0 ? tc : (tc < 4 ? 3 - tc : (TJ / 64 + 3) - tc); }
__device__ __forceinline__ void gla_low(const bf16_t* prow, int d, float (&low)[16]) {
    const uint4 v0 = *(const uint4*)(prow + C_GLG + d * 16), v1 = *(const uint4*)(prow + C_GLG + d * 16 + 8);
    const unsigned vv[8] = {v0.x, v0.y, v0.z, v0.w, v1.x, v1.y, v1.z, v1.w};
#pragma unroll
    for (int e = 0; e < 8; ++e) { low[2 * e] = __uint_as_float(vv[e] << 16); low[2 * e + 1] = __uint_as_float(vv[e] & 0xffff0000u); }
}
__device__ __forceinline__ void gla_gate4(const Params& p, int layer, int h, int d, const float (&low)[16], int c4, int lane, float (&bb)[4], float (&tot)[4]) {
    const float* w2 = p.gla_w_gate + (size_t)(layer * 2 + d) * 16 * 128 + h * 32 + c4 * 4;
    const float* b2 = p.gla_b_gate + (size_t)(layer * 2 + d) * 128 + h * 32 + c4 * 4;
#pragma unroll
    for (int e = 0; e < 4; ++e) {
        float z = b2[e];
#pragma unroll
        for (int r = 0; r < 16; ++r) z += low[r] * w2[r * 128 + e];
        const float x = logsigmoidf_(z) * (1.0f / 16.0f);
        float pre = x;
#pragma unroll
        for (int o = 1; o < 64; o <<= 1) { const float t = __shfl_up(pre, o, 64); if (lane >= o) pre += t; }
        const float tt = rdlane(pre, 63);
        tot[e] = tt; bb[e] = d == 0 ? pre : tt - pre + x;
    }
}
#define GLA_VS 68
#define GLA_WAVE_LDS 17408
__device__ __forceinline__ bfx8 ld_split_s(const unsigned char* base, int strideB, int row, int k0, int q4) {
    const unsigned char* a = base + row * strideB + (k0 + 4 * q4) * 2;
    const uint2 lo = *(const uint2*)a, hi = *(const uint2*)(a + 32);
    unsigned u[4] = {lo.x, lo.y, hi.x, hi.y}; return *(const bfx8*)u;
}
__device__ __forceinline__ void gla_load_row32(const bf16_t* src, float (&x)[32]) {
#pragma unroll
    for (int c = 0; c < 4; ++c) { const uint4 v = *(const uint4*)(src + c * 8); const unsigned vv[4] = {v.x, v.y, v.z, v.w};
#pragma unroll
        for (int e = 0; e < 4; ++e) { x[c * 8 + 2 * e] = __uint_as_float(vv[e] << 16); x[c * 8 + 2 * e + 1] = __uint_as_float(vv[e] & 0xffff0000u); } }
}
__device__ __forceinline__ void gla_store_vT(unsigned char* vT, const bf16_t* vsrc, int lane) {
#pragma unroll
    for (int c = 0; c < 8; ++c) { const uint4 v = *(const uint4*)(vsrc + c * 8); const unsigned vv[4] = {v.x, v.y, v.z, v.w};
#pragma unroll
        for (int e = 0; e < 4; ++e) { *(bf16_t*)(vT + ((c * 8 + 2 * e) * GLA_VS + lane) * 2) = (bf16_t)(vv[e] & 0xffffu); *(bf16_t*)(vT + ((c * 8 + 2 * e + 1) * GLA_VS + lane) * 2) = (bf16_t)(vv[e] >> 16); } }
}
__device__ __forceinline__ void ph_gla1(const int wv_, unsigned char* smem, const Params& p, int layer) {
    PH_IDS();
    const int lane = tid_ & 63, w = tid_ >> 6, l15 = lane & 15, q4 = lane >> 4;
    unsigned char* vT = smem + 1024 + w * GLA_WAVE_LDS; unsigned char* khT = vT + 8704 + 4096;
    for (int item = bid_ * NWV + w; item < NB * 4 * 2 * (TJ / 64); item += nblk_ * NWV) {
        const int tc = item % (TJ / 64), bhd = item / (TJ / 64), d = bhd & 1, h = (bhd >> 1) & 3, b = bhd >> 3;
        const bf16_t* prow = p.P + ((size_t)b * TJ + tc * 64 + lane) * DINP;
        const int cs = gla_scan_chunk(d, tc);
        float low[16]; gla_low(prow, d, low);
#pragma unroll 1
        for (int c4 = 0; c4 < 8; ++c4) {
            float bb[4], tot[4];
            gla_gate4(p, layer, h, d, low, c4, lane, bb, tot);
            const uint2 kv = *(const uint2*)(prow + C_GLK + h * 32 + c4 * 4);
            const float k0 = __uint_as_float(kv.x << 16), k1 = __uint_as_float(kv.x & 0xffff0000u), k2 = __uint_as_float(kv.y << 16), k3 = __uint_as_float(kv.y & 0xffff0000u);
            *(bf16_t*)(khT + ((c4 * 4 + 0) * GLA_VS + lane) * 2) = f2bf(k0 * __expf(tot[0] - bb[0]));
            *(bf16_t*)(khT + ((c4 * 4 + 1) * GLA_VS + lane) * 2) = f2bf(k1 * __expf(tot[1] - bb[1]));
            *(bf16_t*)(khT + ((c4 * 4 + 2) * GLA_VS + lane) * 2) = f2bf(k2 * __expf(tot[2] - bb[2]));
            *(bf16_t*)(khT + ((c4 * 4 + 3) * GLA_VS + lane) * 2) = f2bf(k3 * __expf(tot[3] - bb[3]));
            if (lane < 4) { const float tl = lane == 0 ? tot[0] : lane == 1 ? tot[1] : lane == 2 ? tot[2] : tot[3];
                p.DCY[((size_t)bhd * (TJ / 64) + cs) * 32 + c4 * 4 + lane] = __expf(tl); }
        }
        gla_store_vT(vT, prow + C_GLV + h * 64, lane);
        WAVE_LDS_FENCE();
        bf16_t* gout = p.GST + ((size_t)bhd * (TJ / 64) + cs) * 2048;
#pragma unroll
        for (int dt = 0; dt < 4; ++dt)
#pragma unroll
            for (int nt = 0; nt < 2; ++nt) {
                f32x4_ acc = {0.f, 0.f, 0.f, 0.f};
#pragma unroll
                for (int ks = 0; ks < 2; ++ks) acc = MFMA16(ld_split_s(vT, GLA_VS * 2, 16 * dt + l15, 32 * ks, q4), ld_split_s(khT, GLA_VS * 2, 16 * nt + l15, 32 * ks, q4), acc);
#pragma unroll
                for (int r = 0; r < 4; ++r) gout[(16 * dt + 4 * q4 + r) * 32 + 16 * nt + l15] = f2bf(acc[r]);
            }
        WAVE_LDS_FENCE();
    }
}
__device__ __forceinline__ void gla2_scan(const Params& p, int wg, int tid_) {
    const int chain = wg >> 1, pr = (wg & 1) * 512 + tid_, dk0 = (2 * pr) & 31;
    unsigned* g = (unsigned*)(p.GST + (size_t)chain * (TJ / 64) * 2048) + pr;
    const float* dc = p.DCY + (size_t)chain * (TJ / 64) * 32 + dk0;
    float s0 = 0.f, s1 = 0.f;
    unsigned gv = g[0]; float d0 = dc[0], d1 = dc[1];
    for (int c = 0; c < TJ / 64; ++c) {
        const unsigned cur = gv; const float c0 = d0, c1 = d1;
        if (c + 1 < TJ / 64) { gv = g[(size_t)(c + 1) * 1024]; d0 = dc[(c + 1) * 32]; d1 = dc[(c + 1) * 32 + 1]; }
        g[(size_t)c * 1024] = cvt_pk_bf16_(s0, s1);
        s0 = c0 * s0 + __uint_as_float(cur << 16); s1 = c1 * s1 + __uint_as_float(cur & 0xffff0000u);
    }
}
__device__ __forceinline__ void ph_gla3(const int wv_, unsigned char* smem, const Params& p, int layer) {
    PH_IDS();
    const int lane = tid_ & 63, w = tid_ >> 6, l15 = lane & 15, q4 = lane >> 4;
    unsigned char* vT = smem + 1024 + w * GLA_WAVE_LDS; unsigned char* Qt = vT + 8704; unsigned char* Kt = Qt + 4096;
    for (int item = bid_ * NWV + w; item < NB * 4 * (TJ / 64); item += nblk_ * NWV) {
        const int tc = item % (TJ / 64), bh = item / (TJ / 64), h = bh & 3, b = bh >> 2;
        if (layer == NLAYER - 1 && tc < 4) continue;
        const bf16_t* prow = p.P + ((size_t)b * TJ + tc * 64 + lane) * DINP;
        gla_store_vT(vT, prow + C_GLV + h * 64, lane);
        f32x4_ o[4][4];
#pragma unroll
        for (int dt = 0; dt < 4; ++dt)
#pragma unroll
            for (int nt = 0; nt < 4; ++nt) o[dt][nt] = (f32x4_){0.f, 0.f, 0.f, 0.f};
#pragma unroll 1
        for (int d = 0; d < 2; ++d) {
#ifdef EMU
            if (g_dbg_dir >= 0 && d != g_dbg_dir) continue;
#endif
            {
                float low[16]; gla_low(prow, d, low);
#pragma unroll 1
                for (int c4 = 0; c4 < 8; ++c4) {
                    float bb[4], tot[4];
                    gla_gate4(p, layer, h, d, low, c4, lane, bb, tot);
                    const uint2 qv = *(const uint2*)(prow + C_GLQ + h * 32 + c4 * 4), kv = *(const uint2*)(prow + C_GLK + h * 32 + c4 * 4);
                    const float sc = 0.17677669529663687f;
                    const float e0 = __expf(bb[0]), e1 = __expf(bb[1]), e2 = __expf(bb[2]), e3 = __expf(bb[3]);
                    uint2 qo, ko;
                    qo.x = cvt_pk_bf16_(__uint_as_float(qv.x << 16) * sc * e0, __uint_as_float(qv.x & 0xffff0000u) * sc * e1);
                    qo.y = cvt_pk_bf16_(__uint_as_float(qv.y << 16) * sc * e2, __uint_as_float(qv.y & 0xffff0000u) * sc * e3);
                    ko.x = cvt_pk_bf16_(__uint_as_float(kv.x << 16) / e0, __uint_as_float(kv.x & 0xffff0000u) / e1);
                    ko.y = cvt_pk_bf16_(__uint_as_float(kv.y << 16) / e2, __uint_as_float(kv.y & 0xffff0000u) / e3);
                    *(uint2*)(Qt + lane * 64 + c4 * 8) = qo; *(uint2*)(Kt + lane * 64 + c4 * 8) = ko;
                }
            }
            WAVE_LDS_FENCE();
            const bf16_t* sst = p.GST + ((size_t)((bh * 2 + d) * (TJ / 64)) + gla_scan_chunk(d, tc)) * 2048;
            bfx8 qb[4];
#pragma unroll
            for (int nt = 0; nt < 4; ++nt) qb[nt] = *(const bfx8*)(Qt + (16 * nt + l15) * 64 + q4 * 16);
#pragma unroll
            for (int nt = 0; nt < 4; ++nt) {
                f32x4_ at[4];
#pragma unroll
                for (int mt = 0; mt < 4; ++mt) {
                    const bfx8 ka = *(const bfx8*)(Kt + (16 * mt + l15) * 64 + q4 * 16);
                    f32x4_ a = MFMA16(ka, qb[nt], ((f32x4_){0.f, 0.f, 0.f, 0.f}));
                    const int t = 16 * nt + l15;
#pragma unroll
                    for (int r = 0; r < 4; ++r) { const int sidx = 16 * mt + 4 * q4 + r; const bool keep = d == 0 ? sidx <= t : sidx >= t; a[r] = keep ? a[r] : 0.f; }
                    at[mt] = a;
                }
                const bfx8 ab0 = pack8(at[0], at[1]), ab1 = pack8(at[2], at[3]);
#pragma unroll
                for (int dt = 0; dt < 4; ++dt) {
                    f32x4_ acc = o[dt][nt];
                    acc = MFMA16(ld_split_s(vT, GLA_VS * 2, 16 * dt + l15, 0, q4), ab0, acc);
                    acc = MFMA16(ld_split_s(vT, GLA_VS * 2, 16 * dt + l15, 32, q4), ab1, acc);
                    acc = MFMA16(*(const bfx8*)(sst + (16 * dt + l15) * 32 + q4 * 8), qb[nt], acc);
                    o[dt][nt] = acc;
                }
            }
            WAVE_LDS_FENCE();
        }
        const float* g = p.gla_norm_g + layer * 64;
#pragma unroll
        for (int nt = 0; nt < 4; ++nt) {
            float ss = 0.f;
#pragma unroll
            for (int dt = 0; dt < 4; ++dt)
#pragma unroll
                for (int r = 0; r < 4; ++r) ss += o[dt][nt][r] * o[dt][nt][r];
            ss += __shfl_xor(ss, 16, 64); ss += __shfl_xor(ss, 32, 64);
            const float rs = rsqrtf(ss * (1.0f / 64.0f) + 1e-6f);
            const size_t row = (size_t)b * TJ + tc * 64 + 16 * nt + l15;
#ifdef EMU
            if (g_dbg_dir >= 0) { for (int dt = 0; dt < 4; ++dt) for (int r = 0; r < 4; ++r) g_dbg[row * 256 + h * 64 + 16 * dt + 4 * q4 + r] = o[dt][nt][r]; }
#endif
#pragma unroll
            for (int dt = 0; dt < 4; ++dt) {
                const int dv0 = 16 * dt + 4 * q4;
                const uint2 rg = *(const uint2*)(p.P + row * DINP + C_GLR + h * 64 + dv0);
                const float r0 = __uint_as_float(rg.x << 16), r1 = __uint_as_float(rg.x & 0xffff0000u), r2 = __uint_as_float(rg.y << 16), r3 = __uint_as_float(rg.y & 0xffff0000u);
                uint2 w2;
                w2.x = cvt_pk_bf16_(o[dt][nt][0] * rs * g[dv0] * siluf_(r0), o[dt][nt][1] * rs * g[dv0 + 1] * siluf_(r1));
                w2.y = cvt_pk_bf16_(o[dt][nt][2] * rs * g[dv0 + 2] * siluf_(r2), o[dt][nt][3] * rs * g[dv0 + 3] * siluf_(r3));
                *(uint2*)(p.Y + row * DM + 768 + h * 64 + dv0) = w2;
            }
        }
    }
}

#define S5NS (TJ / 16)
#define S5NT (TJ / 256)
__device__ __forceinline__ void ph_s5_prep(const int wv_, unsigned char* smem, const Params& p, int layer) {
    PH_IDS();
    if (bid_ >= 16) {
        if (bid_ < 32) for (int idx = (bid_ - 16) * NTHR + tid_; idx < 65536; idx += 16 * NTHR) { const int co = idx >> 8, ch = idx & 255; p.GLUt[idx] = f2bf(p.s5_glu_w[(size_t)layer * 65536 + ch * 256 + co]); }
        return;
    }
    const int g = bid_;
    float2* APOW = (float2*)(smem + 1024);
    float2* BBAR = APOW + 2 * 64 * 17;
    float2* CC = BBAR + 2 * 64 * 16;
    float* KC = (float*)(CC + 2 * 16 * 64);
    __syncthreads();
    if (tid_ < 128) {
        const int d = tid_ >> 6, pp = tid_ & 63;
        const float lre = p.s5_a_re[((layer * 2 + d) * 16 + g) * 64 + pp], lim = p.s5_a_im[((layer * 2 + d) * 16 + g) * 64 + pp];
        const float dt = expf(p.s5_log_dt[(layer * 2 + d) * 16 + g]);
        for (int m = 0; m <= 16; ++m) { const float mag = expf(lre * dt * (float)m), ang = lim * dt * (float)m; APOW[(d * 64 + pp) * 17 + m] = make_float2(mag * cosf(ang), mag * sinf(ang)); }
        const float2 a1 = APOW[(d * 64 + pp) * 17 + 1]; const float den = lre * lre + lim * lim;
        const float fre = ((a1.x - 1.f) * lre + a1.y * lim) / den, fim = (a1.y * lre - (a1.x - 1.f) * lim) / den;
        for (int c = 0; c < 16; ++c) {
            const float br = p.s5_b_re[((layer * 16 + g) * 64 + pp) * 16 + c], bi = p.s5_b_im[((layer * 16 + g) * 64 + pp) * 16 + c];
            BBAR[(d * 64 + pp) * 16 + c] = make_float2(fre * br - fim * bi, fre * bi + fim * br);
            CC[(d * 16 + c) * 64 + pp] = make_float2(p.s5_c_re[(((layer * 2 + d) * 16 + g) * 16 + c) * 64 + pp], p.s5_c_im[(((layer * 2 + d) * 16 + g) * 16 + c) * 64 + pp]);
        }
        const float2 a16 = APOW[(d * 64 + pp) * 17 + 16];
        p.A16[((d * 16 + g) * 64 + pp) * 2] = a16.x; p.A16[((d * 16 + g) * 64 + pp) * 2 + 1] = a16.y;
    }
    __syncthreads();
    for (int idx = tid_; idx < 8192; idx += NTHR) {
        const int d = idx >> 12, tau = (idx >> 8) & 15, c = (idx >> 4) & 15, c2 = idx & 15;
        float acc = 0.f;
        for (int pp = 0; pp < 64; ++pp) {
            const float2 cc = CC[(d * 16 + c) * 64 + pp], ap = APOW[(d * 64 + pp) * 17 + tau], bbv = BBAR[(d * 64 + pp) * 16 + c2];
            const float tr = cc.x * ap.x - cc.y * ap.y, ti = cc.x * ap.y + cc.y * ap.x;
            acc += tr * bbv.x - ti * bbv.y;
        }
        KC[idx] = acc;
    }
    __syncthreads();
    for (int idx = tid_; idx < 256 * 512; idx += NTHR) {
        const int n = idx >> 9, k = idx & 511, i = n >> 4, c = n & 15;
        float v;
        if (k < 256) { const int j = k >> 4, c2 = k & 15;
            v = (i >= j ? KC[((0 * 16 + (i - j)) * 16 + c) * 16 + c2] : 0.f) + (j >= i ? KC[((1 * 16 + (j - i)) * 16 + c) * 16 + c2] : 0.f);
        } else { const int kk = k - 256, d = kk >> 7, im = (kk >> 6) & 1, pp = kk & 63, m = d == 0 ? i + 1 : 16 - i;
            const float2 cc = CC[(d * 16 + c) * 64 + pp], ap = APOW[(d * 64 + pp) * 17 + m];
            v = im == 0 ? (cc.x * ap.x - cc.y * ap.y) : -(cc.x * ap.y + cc.y * ap.x); }
        p.SB[((size_t)g * 256 + n) * 512 + k] = f2bf(v);
    }
    for (int idx = tid_; idx < 256 * 256; idx += NTHR) {
        const int n = idx >> 8, k = idx & 255, j = k >> 4, c2 = k & 15, d = n >> 7, im = (n >> 6) & 1, pp = n & 63, m = d == 0 ? 15 - j : j;
        const float2 ap = APOW[(d * 64 + pp) * 17 + m], bbv = BBAR[(d * 64 + pp) * 16 + c2];
        p.SE[((size_t)g * 256 + n) * 256 + k] = f2bf(im == 0 ? ap.x * bbv.x - ap.y * bbv.y : ap.x * bbv.y + ap.y * bbv.x);
    }
}
__device__ __forceinline__ void ph_s5_1(const int wv_, const Params& p, int layer) {
    PH_IDS();
    const int lane = tid_ & 63, w = tid_ >> 6, l15 = lane & 15, q4 = lane >> 4;
    for (int item = bid_ * NWV + w; item < NB * S5NT * 16; item += nblk_ * NWV) {
        const int g = item & 15, st = (item >> 4) % S5NT, b = item / (16 * S5NT), s0 = st * 16;
        bfx8 ua[8];
#pragma unroll
        for (int ks = 0; ks < 8; ++ks) ua[ks] = *(const bfx8*)(p.P + ((size_t)b * TJ + 16 * (s0 + l15) + 2 * ks + (q4 >> 1)) * DINP + C_S5U + 16 * g + 8 * (q4 & 1));
        const bf16_t* se = p.SE + (size_t)g * 65536;
#pragma unroll 2
        for (int nt = 0; nt < 16; ++nt) {
            f32x4_ acc = {0.f, 0.f, 0.f, 0.f};
#pragma unroll
            for (int ks = 0; ks < 8; ++ks) acc = MFMA16(ua[ks], *(const bfx8*)(se + (16 * nt + l15) * 256 + 32 * ks + 8 * q4), acc);
#pragma unroll
            for (int r = 0; r < 4; ++r) p.XS[(((size_t)b * S5NS + s0 + 4 * q4 + r) * 16 + g) * 256 + 16 * nt + l15] = f2bf(acc[r]);
        }
    }
}
__device__ __forceinline__ void s5_2_scan(const Params& p, int wg, int tid_) {
    const int idx = wg * NTHR + tid_, pp = idx & 63, d = (idx >> 6) & 1, g = (idx >> 7) & 15, b = idx >> 11;
    const float ar = p.A16[((d * 16 + g) * 64 + pp) * 2], ai = p.A16[((d * 16 + g) * 64 + pp) * 2 + 1];
    bf16_t* base = p.XS + ((size_t)b * S5NS * 16 + g) * 256 + d * 128 + pp;
    float xr = 0.f, xi = 0.f;
    for (int q0 = 0; q0 < S5NS; q0 += 8) {
        float er[8], ei[8]; int sidx[8];
#pragma unroll
        for (int u = 0; u < 8; ++u) { const int q = q0 + u; const int sq = d == 0 ? q : (q < NCTX / 16 ? NCTX / 16 - 1 - q : S5NS + NCTX / 16 - 1 - q); sidx[u] = sq;
            er[u] = bf2f(base[(size_t)sq * 4096]); ei[u] = bf2f(base[(size_t)sq * 4096 + 64]); }
#pragma unroll
        for (int u = 0; u < 8; ++u) {
            base[(size_t)sidx[u] * 4096] = f2bf(xr); base[(size_t)sidx[u] * 4096 + 64] = f2bf(xi);
            const float nr = ar * xr - ai * xi + er[u], ni = ar * xi + ai * xr + ei[u]; xr = nr; xi = ni;
        }
    }
}
#define S5_ZS 264
__device__ __forceinline__ void ph_s5_3(const int wv_, unsigned char* smem, const Params& p, int layer) {
    PH_IDS();
    const int lane = tid_ & 63, w = tid_ >> 6, l15 = lane & 15, q4 = lane >> 4;
    bf16_t* Z = (bf16_t*)(smem + 1024);
    for (int item = bid_; item < NB * S5NT; item += nblk_) {
        const int b = item / S5NT, st = item - b * S5NT, s0 = st * 16;
        if (layer == NLAYER - 1 && st == 0) continue;
        __syncthreads();
#pragma unroll 1
        for (int gi = 0; gi < 2; ++gi) {
            const int g = 2 * w + gi;
            bfx8 ua[8], xa[8];
#pragma unroll
            for (int ks = 0; ks < 8; ++ks) {
                ua[ks] = *(const bfx8*)(p.P + ((size_t)b * TJ + 16 * (s0 + l15) + 2 * ks + (q4 >> 1)) * DINP + C_S5U + 16 * g + 8 * (q4 & 1));
                xa[ks] = *(const bfx8*)(p.XS + (((size_t)b * S5NS + s0 + l15) * 16 + g) * 256 + 32 * ks + 8 * q4);
            }
            const bf16_t* sb = p.SB + (size_t)g * 131072;
            const float dsk = p.s5_d[layer * 256 + 16 * g + l15];
#pragma unroll 2
            for (int nt = 0; nt < 16; ++nt) {
                f32x4_ acc = {0.f, 0.f, 0.f, 0.f};
#pragma unroll
                for (int ks = 0; ks < 8; ++ks) acc = MFMA16(ua[ks], *(const bfx8*)(sb + (16 * nt + l15) * 512 + 32 * ks + 8 * q4), acc);
#pragma unroll
                for (int ks = 0; ks < 8; ++ks) acc = MFMA16(xa[ks], *(const bfx8*)(sb + (16 * nt + l15) * 512 + 256 + 32 * ks + 8 * q4), acc);
#pragma unroll
                for (int r = 0; r < 4; ++r) {
                    const int tl = 16 * (4 * q4 + r) + nt;
                    const float u = bf2f(p.P[((size_t)b * TJ + 16 * s0 + tl) * DINP + C_S5U + 16 * g + l15]);
                    Z[tl * S5_ZS + 16 * g + l15] = f2bf(gelu_tanh(acc[r] + dsk * u));
                }
            }
        }
        __syncthreads();
#pragma unroll 1
        for (int m2 = 0; m2 < 2; ++m2) {
            const int mt = 2 * w + m2;
            bfx8 za[8];
#pragma unroll
            for (int ks = 0; ks < 8; ++ks) za[ks] = *(const bfx8*)(Z + (16 * mt + l15) * S5_ZS + 32 * ks + 8 * q4);
#pragma unroll 2
            for (int nt = 0; nt < 16; ++nt) {
                f32x4_ acc = {0.f, 0.f, 0.f, 0.f};
#pragma unroll
                for (int ks = 0; ks < 8; ++ks) acc = MFMA16(za[ks], *(const bfx8*)(p.GLUt + (16 * nt + l15) * 256 + 32 * ks + 8 * q4), acc);
                const int co = 16 * nt + l15; const float gb = p.s5_glu_b[layer * 256 + co];
#pragma unroll
                for (int r = 0; r < 4; ++r) {
                    const int tl = 16 * mt + 4 * q4 + r;
                    const float z = bf2f(Z[tl * S5_ZS + co]);
                    p.Y[((size_t)b * TJ + 16 * s0 + tl) * DM + 256 + co] = f2bf(z * sigmoidf_(acc[r] + gb));
                }
            }
        }
    }
}

__device__ __forceinline__ void ph_scans(const int wv_, unsigned char* smem, const Params& p, int layer) {
    PH_IDS();
    if (bid_ < 32) { dn_chain(smem, p, layer, bid_, tid_); return; }
    if (bid_ < 96) { gla2_scan(p, bid_ - 32, tid_); return; }
    if (bid_ < 112) { s5_2_scan(p, bid_ - 96, tid_); return; }
}

__device__ __forceinline__ void ph_attn_prep(const int wv_, unsigned char* smem, const Params& p, int layer) {
    PH_IDS();
    float2 (*sCS)[16] = (float2 (*)[16])(smem + 1024);
    bf16_t* sVt = (bf16_t*)(smem + 1024 + 8192);
    unsigned* sMax = (unsigned*)(smem + 64);
    const float qscale = 0.17677669529663687f * 1.4426950408889634f;
    for (int item = bid_; item < NB * 132; item += nblk_) {
        const int b = item / 132, kt = item - b * 132, tau0 = kt * 64; const bool lat = tau0 >= NCTX;
        __syncthreads();
        if (tid_ < 8) sMax[tid_] = 0u;
        for (int idx = tid_; idx < 1024; idx += NTHR) {
            const int tk = idx >> 4, i = idx & 15; float cs = 1.f, sn = 0.f;
            if (lat) { const int t = tau0 + tk - NCTX; const float base = (i < 8) ? (float)(t >> 6) : (float)(t & 63);
                const float inv = exp2f(-(float)(i & 7) * (13.287712379549449f / 8.0f)); sincosf(base * inv, &sn, &cs); }
            sCS[tk][i] = make_float2(cs, sn);
        }
        __syncthreads();
        const int tk = tid_ >> 3, hm = tid_ & 7, h = hm >> 1, m = hm & 1, tau = tau0 + tk, bh = b * 4 + h;
        const size_t r = (size_t)b * TJ + tau;
#pragma unroll
        for (int which = 0; which < 2; ++which) {
            const uint4* src = (const uint4*)(p.P + r * DINP + (which ? C_DAQ : C_DAK) + h * 64 + m * 32);
            uint4 raw[4]; raw[0] = src[0]; raw[1] = src[1]; raw[2] = src[2]; raw[3] = src[3];
            const unsigned* rw = (const unsigned*)raw; float x[32], o[32];
#pragma unroll
            for (int i = 0; i < 16; ++i) { x[2 * i] = __uint_as_float(rw[i] << 16); x[2 * i + 1] = __uint_as_float(rw[i] & 0xffff0000u); }
            float n2 = 0.f; const float sc = which ? qscale : 1.0f;
#pragma unroll
            for (int i = 0; i < 16; ++i) { const float2 c = sCS[tk][i]; o[i] = (x[i] * c.x - x[16 + i] * c.y) * sc; o[16 + i] = (x[i] * c.y + x[16 + i] * c.x) * sc; n2 += o[i] * o[i] + o[16 + i] * o[16 + i]; }
            uint4 w[4]; unsigned* ww = (unsigned*)w;
#pragma unroll
            for (int i = 0; i < 16; ++i) ww[i] = cvt_pk_bf16_(o[2 * i], o[2 * i + 1]);
            uint4* dst = (uint4*)((which ? p.Qr : p.Kr) + ((size_t)bh * TJ + tau) * 64 + m * 32);
            dst[0] = w[0]; dst[1] = w[1]; dst[2] = w[2]; dst[3] = w[3];
            if (which) p.Qn[((size_t)bh * TJ + tau) * 2 + m] = sqrtf(n2);
            else atomicMax(&sMax[hm], __float_as_uint(n2 * 1.02f));
        }
        {
            const uint4* src = (const uint4*)(p.P + r * DINP + C_DAV + h * 64 + m * 32);
            uint4 raw[4]; raw[0] = src[0]; raw[1] = src[1]; raw[2] = src[2]; raw[3] = src[3];
            const bf16_t* rv = (const bf16_t*)raw;
            const int pos = (tk & ~15) | ((tk & 4) << 1) | ((tk & 8) >> 1) | (tk & 3);
#pragma unroll
            for (int i = 0; i < 32; ++i) sVt[(h * 64 + m * 32 + i) * 64 + pos] = rv[i];
        }
        __syncthreads();
        if (tid_ < 8) atomicMax(&p.kmax[(b * 4 + (tid_ >> 1)) * 2 + (tid_ & 1)], sMax[tid_]);
        for (int c = tid_; c < 2048; c += NTHR) {
            const int row = c >> 3, ch = c & 7, hq = row >> 6, dv = row & 63;
            *(uint4*)(p.Vt + ((((size_t)(b * 4 + hq) * 132 + kt) * 64 + dv) * 64 + ch * 8)) = *(const uint4*)(sVt + row * 64 + ch * 8);
        }
    }
}

__device__ __forceinline__ void ph_attn(const int wv_, unsigned char* smem, const Params& p, int layer) {
    PH_IDS();
    const int lane = tid_ & 63, w = tid_ >> 6, ql = lane & 31, hh = lane >> 5;
    unsigned char* sK0 = smem + 1024;
    const int nitem = 512 + (layer < NLAYER - 1 ? 16 : 0);
    const float* lf = p.da_lambda + layer * 128;
    float d01 = 0.f, d23 = 0.f;
    for (int i = 0; i < 32; ++i) { d01 += lf[i] * lf[32 + i]; d23 += lf[64 + i] * lf[96 + i]; }
    const float lam_init = 0.8f - 0.6f * expf(-0.3f * (float)layer);
    const float lam = expf(d01) - expf(d23) + lam_init;
    const int skey = tid_ >> 3, sc = tid_ & 7;
    const unsigned sdst = (unsigned)(skey * 128 + ((sc ^ ((skey >> 1) & 7)) << 4));
    for (int item = bid_; item < nitem; item += nblk_) {
        const int is_ctx = item >= 512;
        const int bh = is_ctx ? item - 512 : item >> 5, b = bh >> 2, h = bh & 3;
        const int qtau = is_ctx ? w * 32 + ql : NCTX + (item & 31) * 256 + w * 32 + ql;
        const int ntile = is_ctx ? 4 : TJ / 64;
        bfx8 qf[2][2];
        const bf16_t* qp = p.Qr + ((size_t)bh * TJ + qtau) * 64 + hh * 8;
#pragma unroll
        for (int m = 0; m < 2; ++m)
#pragma unroll
            for (int ks = 0; ks < 2; ++ks) qf[m][ks] = *(const bfx8*)(qp + m * 32 + ks * 16);
        float negm[2];
#pragma unroll
        for (int m = 0; m < 2; ++m) negm[m] = -p.Qn[((size_t)bh * TJ + qtau) * 2 + m] * sqrtf(__uint_as_float(p.kmax[bh * 2 + m]));
        f32x16 O[2][2];
#pragma unroll
        for (int m = 0; m < 2; ++m)
#pragma unroll
            for (int t = 0; t < 2; ++t)
#pragma unroll
                for (int i = 0; i < 16; ++i) O[m][t][i] = 0.f;
        float l[2] = {0.f, 0.f};
        const char* kbase = (const char*)(p.Kr + (size_t)bh * TJ * 64) + tid_ * 16;
        const char* vbase = (const char*)(p.Vt + (size_t)bh * 132 * 4096) + tid_ * 16;
        __syncthreads();
        {
            uint4 k0 = *(const uint4*)kbase, v0 = *(const uint4*)vbase;
            *(uint4*)(sK0 + sdst) = k0; *(uint4*)(sK0 + 8192 + sdst) = v0;
        }
        __syncthreads();
        for (int kt = 0; kt < ntile; ++kt) {
            unsigned char* sK = sK0 + (kt & 1) * 16384; unsigned char* sV = sK + 8192;
            uint4 kn = make_uint4(0, 0, 0, 0), vn = make_uint4(0, 0, 0, 0);
            if (kt + 1 < ntile) { kn = *(const uint4*)(kbase + (size_t)(kt + 1) * 8192); vn = *(const uint4*)(vbase + (size_t)(kt + 1) * 8192); }
#pragma unroll
            for (int sb = 0; sb < 2; ++sb) {
                bfx8 pf[2][2];
#pragma unroll
                for (int m = 0; m < 2; ++m) {
                    f32x16 S;
#pragma unroll
                    for (int i = 0; i < 16; ++i) S[i] = negm[m];
                    const int key = sb * 32 + ql;
#pragma unroll
                    for (int ks = 0; ks < 2; ++ks) {
                        const int c = m * 4 + ks * 2 + hh;
                        const bfx8 kf = *(const bfx8*)(sK + key * 128 + ((c ^ ((key >> 1) & 7)) << 4));
                        S = __builtin_amdgcn_mfma_f32_32x32x16_bf16(kf, qf[m][ks], S, 0, 0, 0);
                    }
                    float ls = 0.f;
#pragma unroll
                    for (int i = 0; i < 16; ++i) { S[i] = __builtin_amdgcn_exp2f(S[i]); ls += S[i]; }
                    l[m] += ls;
#pragma unroll
                    for (int s2 = 0; s2 < 2; ++s2) {
                        unsigned u[4];
#pragma unroll
                        for (int j = 0; j < 4; ++j) u[j] = cvt_pk_bf16_(S[8 * s2 + 2 * j], S[8 * s2 + 2 * j + 1]);
                        pf[m][s2] = *(const bfx8*)u;
                    }
                }
#pragma unroll
                for (int t = 0; t < 2; ++t)
#pragma unroll
                    for (int s2 = 0; s2 < 2; ++s2) {
                        const int dv = t * 32 + ql, c = (sb * 2 + s2) * 2 + hh;
                        const bfx8 vf = *(const bfx8*)(sV + dv * 128 + ((c ^ ((dv >> 1) & 7)) << 4));
                        O[0][t] = __builtin_amdgcn_mfma_f32_32x32x16_bf16(vf, pf[0][s2], O[0][t], 0, 0, 0);
                        O[1][t] = __builtin_amdgcn_mfma_f32_32x32x16_bf16(vf, pf[1][s2], O[1][t], 0, 0, 0);
                    }
            }
            if (kt + 1 < ntile) { unsigned char* dK = sK0 + ((kt + 1) & 1) * 16384; *(uint4*)(dK + sdst) = kn; *(uint4*)(dK + 8192 + sdst) = vn; }
            __syncthreads();
        }
        const float l0 = l[0] + __shfl_xor(l[0], 32, 64), l1 = l[1] + __shfl_xor(l[1], 32, 64);
        const float i0 = 1.0f / l0, i1 = lam / l1;
        float ss = 0.f;
#pragma unroll
        for (int t = 0; t < 2; ++t)
#pragma unroll
            for (int i = 0; i < 16; ++i) { const float o = O[0][t][i] * i0 - O[1][t][i] * i1; O[0][t][i] = o; ss += o * o; }
        ss += __shfl_xor(ss, 32, 64);
        const float rs = rsqrtf(ss * (1.0f / 64.0f) + 1e-5f) * (1.0f - lam_init);
        const float* g = p.da_norm_g + layer * 64;
        bf16_t* yo = p.Y + ((size_t)b * TJ + qtau) * DM + 512 + h * 64;
#pragma unroll
        for (int t = 0; t < 2; ++t)
#pragma unroll
            for (int gq = 0; gq < 4; ++gq) {
                const int dv0 = 32 * t + 8 * gq + 4 * hh;
                uint2 w2;
                w2.x = cvt_pk_bf16_(O[0][t][4 * gq] * rs * g[dv0], O[0][t][4 * gq + 1] * rs * g[dv0 + 1]);
                w2.y = cvt_pk_bf16_(O[0][t][4 * gq + 2] * rs * g[dv0 + 2], O[0][t][4 * gq + 3] * rs * g[dv0 + 3]);
                *(uint2*)(yo + dv0) = w2;
            }
    }
}

__device__ __forceinline__ void ph_finish(const int wv_, unsigned char* smem, const Params& p, int layer) {
    PH_IDS();
    const int lane = tid_ & 63;
    for (int it = WID; it < NTOK * 4; it += GWV) {
        const int r = it >> 2, h = it & 3;
        if (layer == NLAYER - 1 && (r % TJ) < NCTX) continue;
        const float o = bf2f(p.Y[(size_t)r * DM + h * 64 + lane]) + bf2f(p.ODN[(size_t)r * 256 + h * 64 + lane]);
        const float ss = wave_sum(o * o), rs = rsqrtf(ss * (1.f / 64.f) + 1e-6f);
        const float z = bf2f(p.P[(size_t)r * DINP + C_DNZ + h * 64 + lane]);
        p.Y[(size_t)r * DM + h * 64 + lane] = f2bf(o * rs * p.dn_norm_g[layer * 64 + lane] * siluf_(z));
    }
}

__device__ __forceinline__ void ph_norm2_route(const int wv_, const Params& p, int layer) {
    PH_IDS();
    int lane = tid_ & 63;
    for (int r = WID; r < NTOK; r += GWV) {
        if (layer == NLAYER - 1 && (r % TJ) < NCTX) continue;
        const float* h = hrow(p, r); const float* md = modrow(p, layer, r);
        float f[16]; float ss = 0.f;
#pragma unroll
        for (int i = 0; i < 4; ++i) { float4 v = *(const float4*)(h + i * 256 + lane * 4); f[i * 4] = v.x; f[i * 4 + 1] = v.y; f[i * 4 + 2] = v.z; f[i * 4 + 3] = v.w; ss += v.x * v.x + v.y * v.y + v.z * v.z + v.w * v.w; }
        ss = wave_sum(ss);
        float rs = rsqrtf(ss * (1.0f / DM) + 1e-6f);
        const float* g = p.norm2_g + layer * DM;
        float sc[16];
#pragma unroll
        for (int e = 0; e < 16; ++e) sc[e] = 0.f;
#pragma unroll
        for (int i = 0; i < 4; ++i) {
            int c0 = i * 256 + lane * 4; ushort4 ob; bf16_t* obp = (bf16_t*)&ob;
#pragma unroll
            for (int j = 0; j < 4; ++j) {
                float v = f[i * 4 + j] * rs * g[c0 + j] * (1.f + md[4 * DM + c0 + j]) + md[3 * DM + c0 + j];
                obp[j] = f2bf(v);
                const float4* wr = (const float4*)(p.w_router + (size_t)(c0 + j) * 16);
#pragma unroll
                for (int e4 = 0; e4 < 4; ++e4) { float4 w = wr[e4]; sc[e4 * 4] += v * w.x; sc[e4 * 4 + 1] += v * w.y; sc[e4 * 4 + 2] += v * w.z; sc[e4 * 4 + 3] += v * w.w; }
            }
            *(ushort4*)(p.A + (size_t)r * DM + c0) = ob;
        }
#pragma unroll
        for (int e = 0; e < 16; ++e) sc[e] = wave_sum(sc[e]);
        if (lane == 0) {
            float s[16], gb[16];
#pragma unroll
            for (int e = 0; e < 16; ++e) { s[e] = sigmoidf_(sc[e]); gb[e] = s[e] + p.b_router[e]; }
            int best = 0; float bestv = -1e30f;
#pragma unroll
            for (int gI = 0; gI < 4; ++gI) {
                float a0 = -1e30f, a1 = -1e30f;
#pragma unroll
                for (int j = 0; j < 4; ++j) { float v = gb[gI * 4 + j]; if (v > a0) { a1 = a0; a0 = v; } else if (v > a1) a1 = v; }
                float gs = a0 + a1; if (gs > bestv) { bestv = gs; best = gI; }
            }
            int i0 = 0, i1 = 0; float v0 = -1e30f, v1 = -1e30f;
#pragma unroll
            for (int j = 0; j < 4; ++j) {
                float v = 0.f;
#pragma unroll
                for (int gI = 0; gI < 4; ++gI) if (gI == best) v = gb[gI * 4 + j];
                if (v > v0) { v1 = v0; i1 = i0; v0 = v; i0 = j; } else if (v > v1) { v1 = v; i1 = j; }
            }
            int e0 = best * 4 + i0, e1 = best * 4 + i1;
            float w0 = 0.f, w1 = 0.f;
#pragma unroll
            for (int e = 0; e < 16; ++e) { if (e == e0) w0 = s[e]; if (e == e1) w1 = s[e]; }
            float inv = 1.f / (w0 + w1);
            p.tok_e[r * 2] = e0; p.tok_e[r * 2 + 1] = e1; p.tok_w[r * 2] = w0 * inv; p.tok_w[r * 2 + 1] = w1 * inv;
            p.tok_pos[r * 2] = atomicAdd(&p.cnt[e0], 1); p.tok_pos[r * 2 + 1] = atomicAdd(&p.cnt[e1], 1);
        }
    }
}

__device__ __forceinline__ void ph_moe_gather(const int wv_, unsigned char* smem, const Params& p, int layer) {
    PH_IDS();
    int* sstart = (int*)(smem + 64);
    __syncthreads();
    if (tid_ == 0) {
        int acc = 0;
        for (int e = 0; e < 16; ++e) { sstart[e] = acc; acc += (p.cnt[e] + 255) / 256 * 256; if (bid_ == 0) p.cnt[16 + e] = acc; }
        if (bid_ == 0) p.cnt[32] = acc;
    }
    __syncthreads();
    int lane = tid_ & 63;
    for (int pr = WID; pr < NTOK * 2; pr += GWV) {
        int r = pr >> 1;
        if (layer == NLAYER - 1 && (r % TJ) < NCTX) continue;
        int slot = sstart[p.tok_e[pr]] + p.tok_pos[pr];
        if (lane == 0) p.tok_slot[pr] = slot;
        const uint4* src = (const uint4*)(p.A + (size_t)r * DM); uint4* dst = (uint4*)(p.BUF + (size_t)slot * DM);
        dst[lane] = src[lane]; dst[lane + 64] = src[lane + 64];
    }
}

__device__ __forceinline__ void ph_moe_combine(const int wv_, const Params& p, int layer) {
    PH_IDS();
    int lane = tid_ & 63;
    for (int r = WID; r < NTOK; r += GWV) {
        if (layer == NLAYER - 1 && (r % TJ) < NCTX) continue;
        float* h = hrow(p, r); const float* md = modrow(p, layer, r) + 5 * DM;
        int s0 = p.tok_slot[r * 2], s1 = p.tok_slot[r * 2 + 1]; float w0 = p.tok_w[r * 2], w1 = p.tok_w[r * 2 + 1];
        const bf16_t* p0 = p.PO + (size_t)s0 * DM; const bf16_t* p1 = p.PO + (size_t)s1 * DM;
        float v[16]; float ss = 0.f;
#pragma unroll
        for (int i = 0; i < 4; ++i) {
            int c0 = i * 256 + lane * 4;
            float4 hv = *(const float4*)(h + c0); ushort4 a = *(const ushort4*)(p0 + c0), bq = *(const ushort4*)(p1 + c0); float4 m = *(const float4*)(md + c0);
            hv.x += m.x * (w0 * bf2f(a.x) + w1 * bf2f(bq.x)); hv.y += m.y * (w0 * bf2f(a.y) + w1 * bf2f(bq.y));
            hv.z += m.z * (w0 * bf2f(a.z) + w1 * bf2f(bq.z)); hv.w += m.w * (w0 * bf2f(a.w) + w1 * bf2f(bq.w));
            v[i * 4] = hv.x; v[i * 4 + 1] = hv.y; v[i * 4 + 2] = hv.z; v[i * 4 + 3] = hv.w;
            ss += hv.x * hv.x + hv.y * hv.y + hv.z * hv.z + hv.w * hv.w;
        }
        if (layer == NLAYER - 1) {
            ss = wave_sum(ss); float rs = rsqrtf(ss * (1.0f / DM) + 1e-6f);
#pragma unroll
            for (int i = 0; i < 4; ++i) { int c0 = i * 256 + lane * 4; float4 g = *(const float4*)(p.final_g + c0);
                float4 o; o.x = v[i * 4] * rs * g.x; o.y = v[i * 4 + 1] * rs * g.y; o.z = v[i * 4 + 2] * rs * g.z; o.w = v[i * 4 + 3] * rs * g.w; *(float4*)(h + c0) = o; }
        } else {
#pragma unroll
            for (int i = 0; i < 4; ++i) { int c0 = i * 256 + lane * 4; float4 o; o.x = v[i * 4]; o.y = v[i * 4 + 1]; o.z = v[i * 4 + 2]; o.w = v[i * 4 + 3]; *(float4*)(h + c0) = o; }
        }
    }
}


#ifndef EMU
struct CvtTask { const float* src; bf16_t* dst; int lds, K, N, Nsrc, ldd; };
__device__ __forceinline__ void cvt_tiles(unsigned char* smem, const CvtTask& t, int& base, int tid_, int bid_, int nblk_) {
    float (*sT)[65] = (float (*)[65])(smem + 1024);
    const int nkt = t.K / 64, nnt = t.N / 64, ntile = nkt * nnt;
    int first = (bid_ - base % nblk_ + nblk_) % nblk_;
    for (int it = first; it < ntile; it += nblk_) {
        const int kt = it % nkt, ntl = it / nkt, k0 = kt * 64, n0 = ntl * 64;
        __syncthreads();
#pragma unroll
        for (int j = 0; j < 2; ++j) {
            int k = (tid_ >> 4) + 32 * j, n4 = (tid_ & 15) * 4;
            float4 v = make_float4(0.f, 0.f, 0.f, 0.f);
            if (n0 + n4 < t.Nsrc) v = *(const float4*)(t.src + (size_t)(k0 + k) * t.lds + n0 + n4);
            sT[k][n4] = v.x; sT[k][n4 + 1] = v.y; sT[k][n4 + 2] = v.z; sT[k][n4 + 3] = v.w;
        }
        __syncthreads();
        {
            int n = tid_ >> 3, k8 = (tid_ & 7) * 8;
            ushort4 a, b;
            a.x = f2bf(sT[k8 + 0][n]); a.y = f2bf(sT[k8 + 1][n]); a.z = f2bf(sT[k8 + 2][n]); a.w = f2bf(sT[k8 + 3][n]);
            b.x = f2bf(sT[k8 + 4][n]); b.y = f2bf(sT[k8 + 5][n]); b.z = f2bf(sT[k8 + 6][n]); b.w = f2bf(sT[k8 + 7][n]);
            bf16_t* d = t.dst + (size_t)(n0 + n) * t.ldd + k0 + k8;
            *(ushort4*)d = a; *(ushort4*)(d + 4) = b;
        }
    }
    base += ntile;
}
__device__ __forceinline__ void ph_convert(const int wv_, unsigned char* smem, const Params& p, int layer) {
    PH_IDS();
    int base = 0;
    cvt_tiles(smem, CvtTask{p.w_in + (size_t)layer * DM * DIN, p.WinT, DIN, DM, DINP, DIN, DM}, base, tid_, bid_, nblk_);
    cvt_tiles(smem, CvtTask{p.w_gate + (size_t)layer * DM * 4096, p.WgT, 4096, DM, 4096, 4096, DM}, base, tid_, bid_, nblk_);
    for (int i = 0; i < 4; ++i)
        cvt_tiles(smem, CvtTask{p.w_branch + ((size_t)layer * 4 + i) * 256 * DM, p.WbrT + i * 256, DM, 256, DM, DM, DM}, base, tid_, bid_, nblk_);
    cvt_tiles(smem, CvtTask{p.w_out + (size_t)layer * DM * DM, p.WoT, DM, DM, DM, DM, DM}, base, tid_, bid_, nblk_);
    for (int e = 0; e < NEXP; ++e) {
        for (int u = 0; u < 4; ++u) {
            cvt_tiles(smem, CvtTask{p.w_e_gate + ((size_t)layer * NEXP + e) * DM * DEXP + u * 128, p.WguT + ((size_t)e * 1024 + u * 256) * DM, DEXP, DM, 128, 128, DM}, base, tid_, bid_, nblk_);
            cvt_tiles(smem, CvtTask{p.w_e_up + ((size_t)layer * NEXP + e) * DM * DEXP + u * 128, p.WguT + ((size_t)e * 1024 + u * 256 + 128) * DM, DEXP, DM, 128, 128, DM}, base, tid_, bid_, nblk_);
        }
        cvt_tiles(smem, CvtTask{p.w_e_down + ((size_t)layer * NEXP + e) * DEXP * DM, p.WdT + (size_t)e * DM * DEXP, DM, DEXP, DM, DM, DEXP}, base, tid_, bid_, nblk_);
    }
}

namespace pg8 {
#define PG8_LAS __attribute__((address_space(3)))
typedef short bf16x8 __attribute__((ext_vector_type(8)));
typedef float f32x4 __attribute__((ext_vector_type(4)));
typedef unsigned u32x4 __attribute__((ext_vector_type(4)));
constexpr int BM = 256, BK = 64, HALF = 128, HTB = HALF * BK * 2, STAGE_BYTES = 8 * HTB, NXCD = 8, WGM = 8;
__host__ __device__ __forceinline__ int lds_byte(int r, int c) { const int st = (r >> 4) * 2 + (c >> 5), rr = r & 15, cc = c & 31, ob = rr * 64 + cc * 2; return st * 1024 + (ob ^ (((ob >> 9) & 1) << 5)); }
__host__ __device__ __forceinline__ void stage_rc(int b, int& R, int& C) { const int st = b / 1024, sb = b % 1024, swz = sb ^ (((sb >> 9) & 1) << 5); R = (st >> 1) * 16 + swz / 64; C = (st & 1) * 32 + (swz % 64) / 2; }
__host__ __device__ __forceinline__ int perm32(int rho) { const int n = rho >> 4, i = rho & 15; return 8 * (i >> 2) + 4 * n + (i & 3); }
struct Unit { int pm, pn, nt, kind; const char* a; const char* b; };
__device__ __forceinline__ void static_map(int L, int nM, int nN, int& pm, int& pn) {
    const int nwg = nM * nN; int wgid = L; { const int q = nwg / NXCD, r = nwg % NXCD, xcd = wgid % NXCD, off = wgid / NXCD; wgid = (xcd < r ? xcd * (q + 1) : r * (q + 1) + (xcd - r) * q) + off; }
    const int nig = WGM * nN, gid = wgid / nig, fm = gid * WGM, gsz = (nM - fm) < WGM ? (nM - fm) : WGM;
    pm = fm + ((wgid % nig) % gsz); pn = (wgid % nig) / gsz;
}
__device__ __forceinline__ unsigned cvt_pk_bf16(float lo, float hi) { return cvt_pk_bf16_(lo, hi); }

template <class Epi, class Sched>
__device__ __forceinline__ void gemm_phase(PG8_LAS unsigned char* lds, const int lda, const int ldb, const Sched& S, const Epi& E, int tid) {
    asm volatile("" : "+v"(tid));
    const int wid = __builtin_amdgcn_readfirstlane(tid >> 6), lane = tid & 63, wr = wid >> 2, wc = wid & 3, fr = lane & 15, fq = lane >> 4;
    unsigned voffA[2], voffB[2];
#pragma unroll
    for (int i = 0; i < 2; ++i) { int R, C; stage_rc(tid * 16 + i * 8192, R, C); const int Rb = Epi::PERM ? ((R & ~31) + perm32(R & 31)) : R;
        voffA[i] = (unsigned)(R * lda + C) * 2u; voffB[i] = (unsigned)(Rb * ldb + C) * 2u; }
    const size_t kstep = (size_t)(BK * 2);
    const size_t hstepA = (size_t)HALF * lda * 2, hstepB = (size_t)HALF * ldb * 2;
    const unsigned ldsw = (unsigned)wid * 1024u;
    const int aoff = lds_byte(wr * 64 + fr, fq * 8), boff = lds_byte(wc * 32 + fr, fq * 8);
#define PG8_SA(b, h) (((b) * 2 + (h)) * HTB)
#define PG8_SB(b, h) ((4 + (b) * 2 + (h)) * HTB)
#define PG8_STAGE(bufoff, gbase, voff) do { _Pragma("unroll") for (int _i = 0; _i < 2; ++_i) \
        __builtin_amdgcn_global_load_lds((const unsigned*)((const char*)(gbase) + (voff)[_i]), (PG8_LAS unsigned*)(lds + (bufoff) + ldsw + _i * 8192), 16, 0, 0); } while (0)
#define PG8_LDA(dst, b, h) do { _Pragma("unroll") for (int m = 0; m < 4; ++m) _Pragma("unroll") for (int k = 0; k < 2; ++k) dst[m][k] = *(const PG8_LAS bf16x8*)(lds + PG8_SA(b, h) + aoff + m * 2048 + k * 1024); } while (0)
#define PG8_LDB(dst, b, h) do { _Pragma("unroll") for (int n = 0; n < 2; ++n) _Pragma("unroll") for (int k = 0; k < 2; ++k) dst[n][k] = *(const PG8_LAS bf16x8*)(lds + PG8_SB(b, h) + boff + n * 2048 + k * 1024); } while (0)
#define PG8_MMA(ai, bj, At, Bt) do { __builtin_amdgcn_s_setprio(1); _Pragma("unroll") for (int m = 0; m < 4; ++m) _Pragma("unroll") for (int n = 0; n < 2; ++n) _Pragma("unroll") for (int k = 0; k < 2; ++k) \
        acc[ai][bj][m][n] = __builtin_amdgcn_mfma_f32_16x16x32_bf16(Bt[n][k], At[m][k], acc[ai][bj][m][n], 0, 0, 0); __builtin_amdgcn_s_setprio(0); } while (0)
#define PG8_WAIT_V(n) asm volatile("s_waitcnt vmcnt(" #n ")" ::: "memory")
#define PG8_WAIT_L(n) asm volatile("s_waitcnt lgkmcnt(" #n ")" ::: "memory")
#define PG8_BAR __builtin_amdgcn_s_barrier()
#define PG8_SCHED __builtin_amdgcn_sched_barrier(0)
    Unit cur, nxt; int ui = 0;
    if (!S.next(0, cur)) return;
    f32x4 acc[2][2][4][2];
#pragma unroll
    for (int a = 0; a < 2; ++a)
#pragma unroll
        for (int b = 0; b < 2; ++b)
#pragma unroll
            for (int m = 0; m < 4; ++m)
#pragma unroll
                for (int n = 0; n < 2; ++n) acc[a][b][m][n] = (f32x4){0.f, 0.f, 0.f, 0.f};
    bf16x8 At[4][2], B0[2][2], B1[2][2];
    const char* cA = cur.a; const char* cB = cur.b;
    PG8_STAGE(PG8_SB(0, 0), cB, voffB); PG8_STAGE(PG8_SA(0, 0), cA, voffA); PG8_STAGE(PG8_SB(0, 1), cB + hstepB, voffB); PG8_STAGE(PG8_SA(0, 1), cA + hstepA, voffA);
    if (wr == 1) PG8_BAR;
    PG8_WAIT_V(4); PG8_BAR;
    PG8_STAGE(PG8_SB(1, 0), cB + kstep, voffB); PG8_STAGE(PG8_SA(1, 0), cA + kstep, voffA); PG8_STAGE(PG8_SB(1, 1), cB + hstepB + kstep, voffB);
    PG8_WAIT_V(6); PG8_BAR;
    for (;;) {
        const bool has_next = S.next(ui + 1, nxt);
        const char* nA = has_next ? nxt.a : cA; const char* nB = has_next ? nxt.b : cB;
        const int nt = cur.nt;
        for (int t = 0; t < nt; t += 2) {
            const bool last = (t == nt - 2);
            const char* a1 = cA + (size_t)(t + 1) * kstep;
            const char* a2 = last ? nA : cA + (size_t)(t + 2) * kstep; const char* b2 = last ? nB : cB + (size_t)(t + 2) * kstep;
            const char* a3 = a2 + kstep; const char* b3 = b2 + kstep;
            PG8_LDB(B0, 0, 0); PG8_SCHED; PG8_LDA(At, 0, 0); PG8_STAGE(PG8_SA(1, 1), a1 + hstepA, voffA);
            PG8_WAIT_L(8); PG8_BAR; PG8_WAIT_L(0); PG8_MMA(0, 0, At, B0); PG8_BAR; PG8_SCHED;
            PG8_LDB(B1, 0, 1); PG8_STAGE(PG8_SB(0, 0), b2, voffB);
            PG8_BAR; PG8_WAIT_L(0); PG8_MMA(0, 1, At, B1); PG8_BAR;
            PG8_LDA(At, 0, 1); PG8_STAGE(PG8_SA(0, 0), a2, voffA);
            PG8_BAR; PG8_WAIT_L(0); PG8_MMA(1, 0, At, B0); PG8_BAR; PG8_SCHED;
            PG8_STAGE(PG8_SB(0, 1), b2 + hstepB, voffB);
            PG8_WAIT_V(6); PG8_BAR; PG8_MMA(1, 1, At, B1); PG8_BAR;
            PG8_LDB(B0, 1, 0); PG8_SCHED; PG8_LDA(At, 1, 0); PG8_STAGE(PG8_SA(0, 1), a2 + hstepA, voffA);
            PG8_WAIT_L(8); PG8_BAR; PG8_WAIT_L(0); PG8_MMA(0, 0, At, B0); PG8_BAR; PG8_SCHED;
            PG8_LDB(B1, 1, 1); PG8_STAGE(PG8_SB(1, 0), b3, voffB);
            PG8_BAR; PG8_WAIT_L(0); PG8_MMA(0, 1, At, B1); PG8_BAR;
            PG8_LDA(At, 1, 1); PG8_STAGE(PG8_SA(1, 0), a3, voffA);
            PG8_BAR; PG8_WAIT_L(0); PG8_MMA(1, 0, At, B0); PG8_BAR; PG8_SCHED;
            PG8_STAGE(PG8_SB(1, 1), b3 + hstepB, voffB);
            PG8_WAIT_V(6); PG8_BAR; PG8_MMA(1, 1, At, B1); PG8_BAR;
        }
        E(acc, cur, wr, wc, fr, fq, tid);
        if (!has_next) break;
#pragma unroll
        for (int a = 0; a < 2; ++a)
#pragma unroll
            for (int b = 0; b < 2; ++b)
#pragma unroll
                for (int m = 0; m < 4; ++m)
#pragma unroll
                    for (int n = 0; n < 2; ++n) acc[a][b][m][n] = (f32x4){0.f, 0.f, 0.f, 0.f};
        cur = nxt; cA = nA; cB = nB; ++ui;
    }
    PG8_WAIT_V(0);
    if (wr == 0) PG8_BAR;
    PG8_BAR;
#undef PG8_SA
#undef PG8_SB
#undef PG8_STAGE
#undef PG8_LDA
#undef PG8_LDB
#undef PG8_MMA
#undef PG8_WAIT_V
#undef PG8_WAIT_L
#undef PG8_BAR
#undef PG8_SCHED
}

struct SchedRows {
    const char* A; const char* Bt; int lda, ldb, nt, nN, nM, skip_ctx, G, c;
    __device__ __forceinline__ bool next(int i, Unit& u) const {
        const int L = i * G + c; if (L >= nM * nN) return false;
        int pmi, pn; static_map(L, nM, nN, pmi, pn);
        const int pm = skip_ctx ? (pmi >> 5) * 33 + 1 + (pmi & 31) : pmi;
        u.pm = pm; u.pn = pn; u.nt = nt; u.kind = 0;
        u.a = A + (size_t)pm * 256 * lda * 2; u.b = Bt + (size_t)pn * 256 * ldb * 2; return true;
    }
};
struct SchedMerge {
    const char* A; const char* Y; const char* WgT; const char* WbrT; int nM, skip_ctx, G, c;
    __device__ __forceinline__ bool next(int i, Unit& u) const {
        const int ch = (i >> 3) * G + c, sub = i & 7; if (ch >= nM * 4) return false;
        int pmi, pn; static_map(ch, nM, 4, pmi, pn);
        const int pm = skip_ctx ? (pmi >> 5) * 33 + 1 + (pmi & 31) : pmi, br = sub >> 1;
        u.pm = pm; u.pn = pn; u.kind = sub;
        if (sub & 1) { u.nt = 4;  u.a = Y + ((size_t)pm * 256 * DM + br * 256) * 2; u.b = WbrT + ((size_t)pn * 256 * DM + br * 256) * 2; }
        else         { u.nt = 16; u.a = A + (size_t)pm * 256 * DM * 2;              u.b = WgT + ((size_t)br * DM + pn * 256) * DM * 2; }
        return true;
    }
};
struct SchedMoe {
    const char* A; const char* Bt; const int* pe  ; int lda, ldb, nt, nN, G, c;
    __device__ __forceinline__ bool next(int i, Unit& u) const {
        const int nM = pe[16] >> 8; const int L = i * G + c; if (L >= nM * nN) return false;
        int pm, pn; static_map(L, nM, nN, pm, pn);
        int e = 0;
#pragma unroll
        for (int j = 0; j < 16; ++j) e += (pe[j] <= pm * 256) ? 1 : 0;
        if (e > 15) e = 15;
        u.pm = pm; u.pn = pn; u.nt = nt; u.kind = e;
        u.a = A + (size_t)pm * 256 * lda * 2; u.b = Bt + ((size_t)e * nN + pn) * 256 * ldb * 2; return true;
    }
};

struct EpiBf16 {
    static constexpr bool PERM = true;
    bf16_t* O; int ldc;
    __device__ __forceinline__ void operator()(const f32x4 (&acc)[2][2][4][2], const Unit& u, int wr, int wc, int fr, int fq, int tid) const {
        const int row0 = u.pm * BM + wr * 64 + fr, col0 = u.pn * BM + wc * 32 + 8 * fq;
#pragma unroll
        for (int ai = 0; ai < 2; ++ai)
#pragma unroll
            for (int m = 0; m < 4; ++m) { bf16_t* rowp = O + (size_t)(row0 + ai * HALF + m * 16) * ldc + col0;
#pragma unroll
                for (int bj = 0; bj < 2; ++bj) { const f32x4 v0 = acc[ai][bj][m][0], v1 = acc[ai][bj][m][1];
                    u32x4 w; w.x = cvt_pk_bf16(v0[0], v0[1]); w.y = cvt_pk_bf16(v0[2], v0[3]); w.z = cvt_pk_bf16(v1[0], v1[1]); w.w = cvt_pk_bf16(v1[2], v1[3]);
                    *(u32x4*)(rowp + bj * HALF) = w; } }
    }
};
struct EpiResidual {
    static constexpr bool PERM = false;
    float* hctx; float* out; const float* mod; int layer, modoff;
    __device__ __forceinline__ void operator()(const f32x4 (&acc)[2][2][4][2], const Unit& u, int wr, int wc, int fr, int fq, int tid) const {
        const int row0 = u.pm * BM + wr * 64 + fr, col0 = u.pn * BM + wc * 32 + 4 * fq;
        const int b = (u.pm * BM) / TJ; const bool isctx = (u.pm * BM - b * TJ) < NCTX;
        const float* md = mod + ((size_t)layer * 5 + (isctx ? 4 : b)) * (6 * DM) + modoff * DM + col0;
        f32x4 mv[2][2];
#pragma unroll
        for (int bj = 0; bj < 2; ++bj)
#pragma unroll
            for (int n = 0; n < 2; ++n) mv[bj][n] = *(const f32x4*)(md + bj * HALF + n * 16);
#pragma unroll
        for (int ai = 0; ai < 2; ++ai)
#pragma unroll
            for (int m = 0; m < 4; ++m) {
                const int r = row0 + ai * HALF + m * 16, tau = r - b * TJ;
                float* rowp = (isctx ? hctx + ((size_t)b * NCTX + tau) * DM : out + ((size_t)b * SEQ + (tau - NCTX)) * DM) + col0;
#pragma unroll
                for (int bj = 0; bj < 2; ++bj)
#pragma unroll
                    for (int n = 0; n < 2; ++n) { f32x4* q = (f32x4*)(rowp + bj * HALF + n * 16); *q = *q + mv[bj][n] * acc[ai][bj][m][n]; }
            }
    }
};
struct EpiMerge {
    static constexpr bool PERM = true;
    bf16_t* T; bf16_t* stash  ; const float* bgate;
    __device__ __forceinline__ void operator()(const f32x4 (&acc)[2][2][4][2], const Unit& u, int wr, int wc, int fr, int fq, int tid) const {
        const int br = u.kind >> 1;
        asm volatile("" : "+v"(tid));
        const unsigned soff = (unsigned)tid * 16u;
        if ((u.kind & 1) == 0) {
            const float* bg = bgate + br * DM + u.pn * BM + wc * 32 + 8 * fq;
            f32x4 bv[2][2];
#pragma unroll
            for (int bj = 0; bj < 2; ++bj)
#pragma unroll
                for (int n = 0; n < 2; ++n) bv[bj][n] = *(const f32x4*)(bg + bj * HALF + 4 * n);
#pragma unroll
            for (int ai = 0; ai < 2; ++ai)
#pragma unroll
                for (int m = 0; m < 4; ++m)
#pragma unroll
                    for (int bj = 0; bj < 2; ++bj) { f32x4 v0 = acc[ai][bj][m][0] + bv[bj][0], v1 = acc[ai][bj][m][1] + bv[bj][1];
#pragma unroll
                        for (int j = 0; j < 4; ++j) { v0[j] = sigmoidf_(v0[j]); v1[j] = sigmoidf_(v1[j]); }
                        u32x4 w; w.x = cvt_pk_bf16(v0[0], v0[1]); w.y = cvt_pk_bf16(v0[2], v0[3]); w.z = cvt_pk_bf16(v1[0], v1[1]); w.w = cvt_pk_bf16(v1[2], v1[3]);
                        *(u32x4*)((char*)stash + (soff + (unsigned)(((ai * 4 + m) * 2 + bj) * NTHR * 16))) = w; }
        } else {
            const int row0 = u.pm * BM + wr * 64 + fr, col0 = u.pn * BM + wc * 32 + 8 * fq;
#pragma unroll
            for (int ai = 0; ai < 2; ++ai)
#pragma unroll
                for (int m = 0; m < 4; ++m) { bf16_t* rowp = T + (size_t)(row0 + ai * HALF + m * 16) * DM + col0;
#pragma unroll
                    for (int bj = 0; bj < 2; ++bj) {
                        const u32x4 g = *(const u32x4*)((const char*)stash + (soff + (unsigned)(((ai * 4 + m) * 2 + bj) * NTHR * 16)));
                        f32x4 v0 = acc[ai][bj][m][0], v1 = acc[ai][bj][m][1];
                        v0[0] *= __uint_as_float(g.x << 16); v0[1] *= __uint_as_float(g.x & 0xffff0000u); v0[2] *= __uint_as_float(g.y << 16); v0[3] *= __uint_as_float(g.y & 0xffff0000u);
                        v1[0] *= __uint_as_float(g.z << 16); v1[1] *= __uint_as_float(g.z & 0xffff0000u); v1[2] *= __uint_as_float(g.w << 16); v1[3] *= __uint_as_float(g.w & 0xffff0000u);
                        if (br > 0) { const u32x4 o = *(const u32x4*)(rowp + bj * HALF);
                            v0[0] += __uint_as_float(o.x << 16); v0[1] += __uint_as_float(o.x & 0xffff0000u); v0[2] += __uint_as_float(o.y << 16); v0[3] += __uint_as_float(o.y & 0xffff0000u);
                            v1[0] += __uint_as_float(o.z << 16); v1[1] += __uint_as_float(o.z & 0xffff0000u); v1[2] += __uint_as_float(o.w << 16); v1[3] += __uint_as_float(o.w & 0xffff0000u); }
                        u32x4 w; w.x = cvt_pk_bf16(v0[0], v0[1]); w.y = cvt_pk_bf16(v0[2], v0[3]); w.z = cvt_pk_bf16(v1[0], v1[1]); w.w = cvt_pk_bf16(v1[2], v1[3]);
                        *(u32x4*)(rowp + bj * HALF) = w; } }
        }
    }
};
struct EpiSwiGlu {
    static constexpr bool PERM = true;
    bf16_t* H;
    __device__ __forceinline__ void operator()(const f32x4 (&acc)[2][2][4][2], const Unit& u, int wr, int wc, int fr, int fq, int tid) const {
        const int row0 = u.pm * BM + wr * 64 + fr, col0 = u.pn * HALF + wc * 32 + 8 * fq;
#pragma unroll
        for (int ai = 0; ai < 2; ++ai)
#pragma unroll
            for (int m = 0; m < 4; ++m) {
                f32x4 v0 = acc[ai][0][m][0], v1 = acc[ai][0][m][1]; const f32x4 u0 = acc[ai][1][m][0], u1 = acc[ai][1][m][1];
#pragma unroll
                for (int j = 0; j < 4; ++j) { v0[j] = siluf_(v0[j]) * u0[j]; v1[j] = siluf_(v1[j]) * u1[j]; }
                u32x4 w; w.x = cvt_pk_bf16(v0[0], v0[1]); w.y = cvt_pk_bf16(v0[2], v0[3]); w.z = cvt_pk_bf16(v1[0], v1[1]); w.w = cvt_pk_bf16(v1[2], v1[3]);
                *(u32x4*)(H + (size_t)(row0 + ai * HALF + m * 16) * DEXP + col0) = w;
            }
    }
};
}

#define STAGE_OFF 1024
__device__ __forceinline__ void ph_gemm_inproj(const int wv_, unsigned char* smem, const Params& p) {
    PH_IDS();
    pg8::SchedRows S{(const char*)p.A, (const char*)p.WinT, DM, DM, DM / 64, DINP / 256, NTOK / 256, 0, nblk_, bid_};
    pg8::gemm_phase((PG8_LAS unsigned char*)(smem + STAGE_OFF), DM, DM, S, pg8::EpiBf16{p.P, DINP}, tid_);
}
__device__ __forceinline__ void ph_gemm_merge(const int wv_, unsigned char* smem, const Params& p, int layer, int last) {
    PH_IDS();
    pg8::SchedMerge S{(const char*)p.A, (const char*)p.Y, (const char*)p.WgT, (const char*)p.WbrT, last ? NB * 32 : NTOK / 256, last, nblk_, bid_};
    pg8::gemm_phase((PG8_LAS unsigned char*)(smem + STAGE_OFF), DM, DM, S, pg8::EpiMerge{p.T, p.STASH + (size_t)bid_ * 65536, p.b_gate + layer * 4096}, tid_);
}
__device__ __forceinline__ void ph_gemm_wout(const int wv_, unsigned char* smem, const Params& p, int layer, int last) {
    PH_IDS();
    pg8::SchedRows S{(const char*)p.T, (const char*)p.WoT, DM, DM, DM / 64, DM / 256, last ? NB * 32 : NTOK / 256, last, nblk_, bid_};
    pg8::gemm_phase((PG8_LAS unsigned char*)(smem + STAGE_OFF), DM, DM, S, pg8::EpiResidual{p.hctx, p.out, p.mod, layer, 2}, tid_);
}
__device__ __forceinline__ void moe_pad_to_lds(unsigned char* smem, const Params& p, int tid_) {
    __syncthreads();
    if (tid_ < 17) ((int*)(smem + 64))[tid_] = p.cnt[16 + tid_];
    __syncthreads();
}
__device__ __forceinline__ void ph_gemm_moe_up(const int wv_, unsigned char* smem, const Params& p) {
    PH_IDS();
    moe_pad_to_lds(smem, p, tid_);
    pg8::SchedMoe S{(const char*)p.BUF, (const char*)p.WguT, (const int*)(smem + 64), DM, DM, DM / 64, 4, nblk_, bid_};
    pg8::gemm_phase((PG8_LAS unsigned char*)(smem + STAGE_OFF), DM, DM, S, pg8::EpiSwiGlu{p.HID}, tid_);
}
__device__ __forceinline__ void ph_gemm_moe_down(const int wv_, unsigned char* smem, const Params& p) {
    PH_IDS();
    moe_pad_to_lds(smem, p, tid_);
    pg8::SchedMoe S{(const char*)p.HID, (const char*)p.WdT, (const int*)(smem + 64), DEXP, DEXP, DEXP / 64, 4, nblk_, bid_};
    pg8::gemm_phase((PG8_LAS unsigned char*)(smem + STAGE_OFF), DEXP, DEXP, S, pg8::EpiBf16{p.PO, DM}, tid_);
}

#define LDS_BYTES (152 * 1024)
typedef const __attribute__((address_space(4))) unsigned long long* KArgPtr;
__device__ __forceinline__ Params ldparams() {
    KArgPtr q = (KArgPtr)__builtin_amdgcn_kernarg_segment_ptr(); asm volatile("" : "+s"(q));
    Params r; unsigned long long* d = (unsigned long long*)&r;
#pragma unroll
    for (int i = 0; i < (int)(sizeof(Params) / 8); ++i) d[i] = q[i];
    return r;
}
#define PHASE(call) do { const Params p = ldparams(); call; } while (0)

#define GRID_SYNC() do { int t0_ = wv * 64 + (int)__builtin_amdgcn_mbcnt_hi(~0u, __builtin_amdgcn_mbcnt_lo(~0u, 0u)); asm volatile("" : "+v"(t0_)); \
    XcdBarrier b_; b_.bar = ldparams().bar; b_.x = xb_xcc_id(); b_.st = (volatile LAS unsigned*)smem; xcd_barrier_(b_, t0_); } while (0)
__global__ __launch_bounds__(NTHR, 2) void k_mega(Params p_unused) {
    extern __shared__ __attribute__((aligned(16))) unsigned char smem[];
    int wv = __builtin_amdgcn_readfirstlane(threadIdx.x >> 6); asm volatile("" : "+s"(wv));
    if (threadIdx.x == 0) *(uint4*)smem = make_uint4(0u, 0u, 0u, 0u);
    __syncthreads();
    (void)xcd_barrier_post(ldparams().bar, (volatile LAS unsigned*)smem);
    PHASE(ph_mod(wv, p));
    PHASE(ph_convert(wv, smem, p, 0));
    PHASE(ph_s5_prep(wv, smem, p, 0));
    GRID_SYNC();
    for (int l = 0; l < NLAYER; ++l) {
        const int last = (l == NLAYER - 1);
        PHASE(ph_norm1(wv, p, l));
        if (l > 0) { PHASE(ph_convert(wv, smem, p, l)); PHASE(ph_s5_prep(wv, smem, p, l)); }
        GRID_SYNC();
        PHASE(ph_gemm_inproj(wv, smem, p));
        GRID_SYNC();
        PHASE(ph_attn_prep(wv, smem, p, l));
        PHASE(ph_gla1(wv, smem, p, l));
        PHASE(ph_s5_1(wv, p, l));
        GRID_SYNC();
        PHASE(ph_scans(wv, smem, p, l));
        PHASE(ph_attn(wv, smem, p, l));
        GRID_SYNC();
        PHASE(ph_finish(wv, smem, p, l));
        PHASE(ph_gla3(wv, smem, p, l));
        PHASE(ph_s5_3(wv, smem, p, l));
        GRID_SYNC();
        PHASE(ph_gemm_merge(wv, smem, p, l, last));
        GRID_SYNC();
        PHASE(ph_gemm_wout(wv, smem, p, l, last));
        GRID_SYNC();
        PHASE(ph_norm2_route(wv, p, l));
        GRID_SYNC();
        PHASE(ph_moe_gather(wv, smem, p, l));
        GRID_SYNC();
        PHASE(ph_gemm_moe_up(wv, smem, p));
        GRID_SYNC();
        PHASE(ph_gemm_moe_down(wv, smem, p));
        GRID_SYNC();
        PHASE(ph_moe_combine(wv, p, l));
        GRID_SYNC();
    }
}

static inline size_t al(size_t x) { return (x + 255) & ~(size_t)255; }

extern "C" void kernel_launch(void* const* d_in, const int* in_sizes, int n_in, void* d_out, int out_size, void* d_ws, size_t ws_size, hipStream_t stream) {
    Params p{};
    const float** ins = (const float**)d_in;
    p.x = ins[0]; p.c = ins[1]; p.ctx = ins[2]; p.c_ctx = ins[3]; p.w_mod = ins[4]; p.b_mod = ins[5]; p.norm1_g = ins[6]; p.norm2_g = ins[7]; p.w_in = ins[8];
    p.dn_conv = ins[9]; p.dn_a_log = ins[10]; p.dn_dt_bias = ins[11]; p.dn_norm_g = ins[12];
    p.s5_a_re = ins[13]; p.s5_a_im = ins[14]; p.s5_log_dt = ins[15]; p.s5_b_re = ins[16]; p.s5_b_im = ins[17]; p.s5_c_re = ins[18]; p.s5_c_im = ins[19]; p.s5_d = ins[20]; p.s5_glu_w = ins[21]; p.s5_glu_b = ins[22];
    p.da_lambda = ins[23]; p.da_norm_g = ins[24]; p.gla_w_gate = ins[25]; p.gla_b_gate = ins[26]; p.gla_norm_g = ins[27];
    p.w_branch = ins[28]; p.w_gate = ins[29]; p.b_gate = ins[30]; p.w_out = ins[31]; p.w_router = ins[32]; p.b_router = ins[33];
    p.w_e_gate = ins[34]; p.w_e_up = ins[35]; p.w_e_down = ins[36]; p.final_g = ins[37];
    p.out = (float*)d_out;
    char* ws = (char*)d_ws; size_t off = 0;
    auto take = [&](size_t bytes) { char* q = ws + off; off += al(bytes); return q; };
    p.bar = (unsigned*)take((size_t)XCD_BAR_WORDS * 4);
    p.cnt = (int*)take(256 * 4);
    p.kmax = (unsigned*)take(256);
    p.mod = (float*)take((size_t)NLAYER * 5 * 6 * DM * 4);
    p.hctx = (float*)take((size_t)NB * NCTX * DM * 4);
    p.tok_e = (int*)take((size_t)NTOK * 2 * 4); p.tok_w = (float*)take((size_t)NTOK * 2 * 4); p.tok_pos = (int*)take((size_t)NTOK * 2 * 4); p.tok_slot = (int*)take((size_t)NTOK * 2 * 4);
    p.WinT = (bf16_t*)take((size_t)DINP * DM * 2); p.WgT = (bf16_t*)take((size_t)4096 * DM * 2); p.WbrT = (bf16_t*)take((size_t)DM * DM * 2); p.WoT = (bf16_t*)take((size_t)DM * DM * 2);
    p.WguT = (bf16_t*)take((size_t)NEXP * 1024 * DM * 2); p.WdT = (bf16_t*)take((size_t)NEXP * DM * DEXP * 2);
    p.SB = (bf16_t*)take((size_t)16 * 256 * 512 * 2); p.SE = (bf16_t*)take((size_t)16 * 256 * 256 * 2); p.GLUt = (bf16_t*)take((size_t)65536 * 2); p.A16 = (float*)take((size_t)2 * 16 * 64 * 2 * 4);
    p.A = (bf16_t*)take((size_t)NTOK * DM * 2);
    p.Y = (bf16_t*)take((size_t)NTOK * DM * 2);
    char* big = ws + off;
    p.P = (bf16_t*)take((size_t)NTOK * DINP * 2);
    p.Qr = (bf16_t*)take((size_t)16 * TJ * 64 * 2); p.Kr = (bf16_t*)take((size_t)16 * TJ * 64 * 2); p.Vt = (bf16_t*)take((size_t)16 * 132 * 4096 * 2); p.Qn = (float*)take((size_t)16 * TJ * 2 * 4);
    p.ODN = (bf16_t*)take((size_t)NTOK * 256 * 2);
    p.XS = (bf16_t*)take((size_t)NB * S5NS * 16 * 256 * 2);
    p.GST = (bf16_t*)take((size_t)32 * (TJ / 64) * 2048 * 2); p.DCY = (float*)take((size_t)32 * (TJ / 64) * 32 * 4);
    p.T = (bf16_t*)big;
    p.STASH = (bf16_t*)(big + al((size_t)NTOK * DM * 2));
    p.BUF = (bf16_t*)big; p.PO = (bf16_t*)big;
    p.HID = (bf16_t*)(big + al((size_t)MAXSLOT * DM * 2));
    if (off > ws_size) return;

    static int grid = 0;
    if (!grid) {
        int dev = 0, cus = 0, per_cu = 0;
        (void)hipGetDevice(&dev);
        (void)hipDeviceGetAttribute(&cus, hipDeviceAttributeMultiprocessorCount, dev);
        (void)hipFuncSetAttribute((const void*)k_mega, hipFuncAttributeMaxDynamicSharedMemorySize, LDS_BYTES);
        (void)hipOccupancyMaxActiveBlocksPerMultiprocessor(&per_cu, (const void*)k_mega, NTHR, LDS_BYTES);
        grid = per_cu >= 1 ? cus : 0;
    }
    if (!grid) return;
    (void)hipMemsetAsync(p.bar, 0, (size_t)XCD_BAR_WORDS * 4, stream);
    k_mega<<<grid, NTHR, LDS_BYTES, stream>>>(p);
}

#endif
```

```cpp
#ifndef EMU
#include <hip/hip_runtime.h>
#include <stdint.h>
#define OPQV(x) asm volatile("" : "+v"(x))
#define OPQS(x) asm volatile("" : "+s"(x))
#define WAVE_LDS_FENCE() __builtin_amdgcn_fence(__ATOMIC_RELEASE, "wavefront")
#endif

typedef unsigned short bf16_t;

#define DM 1024
#define NB 4
#ifndef SEQ
#define SEQ 8192
#endif
#define NCTX 256
#define TJ (SEQ + NCTX)
#define NTOK (NB * TJ)
#define DIN 2864
#define DINP 3072
#define NEXP 16
#define DEXP 512
#define NLAYER 2
#define C_DNQ 0
#define C_DNK 256
#define C_DNV 512
#define C_DNZ 768
#define C_DNA 1024
#define C_DNB 1032
#define C_S5U 1040
#define C_DAQ 1296
#define C_DAK 1552
#define C_DAV 1808
#define C_GLQ 2064
#define C_GLK 2192
#define C_GLV 2320
#define C_GLR 2576
#define C_GLG 2832

#define MAXSLOT (2 * NTOK + NEXP * 256)

__device__ __forceinline__ float bf2f(bf16_t v) { return __uint_as_float(((unsigned)v) << 16); }
__device__ __forceinline__ bf16_t f2bf(float f) { unsigned u = __float_as_uint(f); u += 0x7FFFu + ((u >> 16) & 1u); return (bf16_t)(u >> 16); }
#ifdef EMU
__device__ __forceinline__ float frcp_(float x) { return 1.0f / x; }
#else
__device__ __forceinline__ float frcp_(float x) { return __builtin_amdgcn_rcpf(x); }
#endif
__device__ __forceinline__ float sigmoidf_(float x) { return frcp_(1.0f + __expf(-x)); }
__device__ __forceinline__ float siluf_(float x) { return x * frcp_(1.0f + __expf(-x)); }
__device__ __forceinline__ float softplusf_(float x) { return x > 20.f ? x : log1pf(expf(x)); }
__device__ __forceinline__ float logsigmoidf_(float x) { return fminf(x, 0.f) - log1pf(expf(-fabsf(x))); }
__device__ __forceinline__ float gelu_tanh(float x) { const float k = 0.7978845608028654f; float u = k * (x + 0.044715f * x * x * x); return 0.5f * x * (1.0f + tanhf(u)); }
__device__ __forceinline__ float wave_sum(float v) {
#pragma unroll
    for (int o = 32; o >= 1; o >>= 1) v += __shfl_xor(v, o, 64);
    return v;
}
__device__ __forceinline__ float rdlane(float v, int l) { return __int_as_float(__builtin_amdgcn_readlane(__float_as_int(v), l)); }

typedef float f32x16 __attribute__((ext_vector_type(16)));
#ifndef EMU
typedef __bf16 bfx8 __attribute__((ext_vector_type(8)));
typedef __bf16 bf16x2_t_ __attribute__((ext_vector_type(2)));
typedef float f32x2_t_ __attribute__((ext_vector_type(2)));
__device__ __forceinline__ unsigned cvt_pk_bf16_(float lo, float hi) { f32x2_t_ f = {lo, hi}; bf16x2_t_ b = __builtin_convertvector(f, bf16x2_t_); return *(unsigned*)&b; }
#endif

struct Params {
    const float *x, *c, *ctx, *c_ctx, *w_mod, *b_mod, *norm1_g, *norm2_g, *w_in, *dn_conv, *dn_a_log, *dn_dt_bias, *dn_norm_g;
    const float *s5_a_re, *s5_a_im, *s5_log_dt, *s5_b_re, *s5_b_im, *s5_c_re, *s5_c_im, *s5_d, *s5_glu_w, *s5_glu_b;
    const float *da_lambda, *da_norm_g, *gla_w_gate, *gla_b_gate, *gla_norm_g, *w_branch, *w_gate, *b_gate, *w_out;
    const float *w_router, *b_router, *w_e_gate, *w_e_up, *w_e_down, *final_g;
    float* out;
    float* mod;
    float* hctx;
    bf16_t* A;
    bf16_t* P;
    bf16_t* Y;
    bf16_t* Qr;
    bf16_t* Kr;
    bf16_t* Vt;
    float* Qn;
    unsigned* kmax;
    bf16_t* QKVN;
    bf16_t* ODN;
    bf16_t* OS5;
    bf16_t* XS;
    bf16_t* SB;
    bf16_t* SE;
    bf16_t* GLUt;
    float* A16;
    bf16_t* OGLA;
    bf16_t* GST;
    float* DCY;
    bf16_t* T;
    bf16_t* STASH;
    bf16_t *WinT, *WgT, *WbrT, *WoT, *WguT, *WdT;
    bf16_t* BUF;
    bf16_t* HID;
    bf16_t* PO;
    unsigned* bar;
    int* cnt;
    int* tok_e;
    float* tok_w;
    int* tok_pos;
    int* tok_slot;
};

__device__ __forceinline__ float* hrow(const Params& p, int r) {
    int b = r / TJ, tau = r - b * TJ;
    return tau < NCTX ? p.hctx + ((size_t)b * NCTX + tau) * DM : p.out + ((size_t)b * SEQ + (tau - NCTX)) * DM;
}
__device__ __forceinline__ const float* modrow(const Params& p, int layer, int r) {
    int b = r / TJ, tau = r - b * TJ;
    return p.mod + ((size_t)layer * 5 + (tau < NCTX ? 4 : b)) * (6 * DM);
}


#ifndef EMU
#define XB_TMO      128
#define XB_XCNT(j)  (256  + 64 * (j))
#define XB_XSUB(j)  (1280 + 64 * (j))
#define XB_XGEN(j)  (2304 + 64 * (j))
#define XB_TOP      3328
#define XB_TOPGEN   3392
#define XCD_BAR_WORDS 3456
#define XB_SPIN_CAP (1u << 18)
#define LAS __attribute__((address_space(3)))
__device__ __forceinline__ unsigned xb_ld(unsigned* p)              { return __hip_atomic_load(p, __ATOMIC_RELAXED, __HIP_MEMORY_SCOPE_AGENT); }
__device__ __forceinline__ unsigned xb_add(unsigned* p, unsigned v) { return __hip_atomic_fetch_add(p, v, __ATOMIC_RELAXED, __HIP_MEMORY_SCOPE_AGENT); }
__device__ __forceinline__ unsigned xb_xcc_id() { return (unsigned)__builtin_amdgcn_s_getreg((3 << 11) | 20) & 0xFu; }
#define XB_SPIN(cond, bar) do { unsigned _sp = 0; while (cond) { __builtin_amdgcn_s_sleep(1); \
    if ((++_sp & 255u) == 0u) { if (xb_ld(&(bar)[XB_TMO])) break; if (_sp > XB_SPIN_CAP) { atomicAdd(&(bar)[XB_TMO], 1u); break; } } } } while (0)
struct XcdBarrier { unsigned* bar; unsigned x; volatile LAS unsigned* st; };
__device__ __forceinline__ XcdBarrier xcd_barrier_post(unsigned* bar, volatile LAS unsigned* st) {
    XcdBarrier b; b.bar = bar; b.x = xb_xcc_id(); b.st = st;
    if (threadIdx.x == 0) (void)xb_add(&bar[XB_XCNT(b.x)], 1u);
    return b;
}
__device__ __forceinline__ void xcd_barrier_complete(unsigned* bar, unsigned x, unsigned& nloc, unsigned& nx) {
    const unsigned G = gridDim.x * gridDim.y * gridDim.z;
    unsigned sum, cnt, mine, sp = 0u;
    for (;;) {
        sum = 0u; cnt = 0u; mine = 0u;
#pragma unroll
        for (unsigned j = 0; j < 16; ++j) { const unsigned c = xb_ld(&bar[XB_XCNT(j)]); sum += c; cnt += (c > 0u) ? 1u : 0u; mine = (j == x) ? c : mine; }
        if (sum == G) break;
        __builtin_amdgcn_s_sleep(1);
        if ((++sp & 255u) == 0u) { if (xb_ld(&bar[XB_TMO])) break; if (sp > XB_SPIN_CAP) { atomicAdd(&bar[XB_TMO], 1u); break; } }
    }
    nloc = mine > 0u ? mine : 1u; nx = cnt > 0u ? cnt : 1u;
}
__device__ __forceinline__ void xcd_barrier_(const XcdBarrier& b, const int tid0) {
    asm volatile("s_waitcnt vmcnt(0)" ::: "memory");
    __syncthreads();
    if (tid0 == 0) {
        unsigned* bar = b.bar;
        __builtin_amdgcn_s_waitcnt(0);
        unsigned nloc = b.st[0], nx = b.st[1];
        if (nloc == 0u) { xcd_barrier_complete(bar, b.x, nloc, nx); b.st[0] = nloc; b.st[1] = nx; }
        const unsigned old = xb_add(&bar[XB_XSUB(b.x)], 1u);
        const unsigned gen = old / nloc;
        if (old + 1u == (gen + 1u) * nloc) {
            __builtin_amdgcn_fence(__ATOMIC_RELEASE, "agent");
            asm volatile("s_waitcnt vmcnt(0)" ::: "memory");
            const unsigned og = xb_add(&bar[XB_TOP], 1u);
            const unsigned tg = og / nx;
            if (og + 1u == (tg + 1u) * nx) xb_add(&bar[XB_TOPGEN], 1u);
            else XB_SPIN(xb_ld(&bar[XB_TOPGEN]) == tg, bar);
            __builtin_amdgcn_fence(__ATOMIC_ACQUIRE, "agent");
            xb_add(&bar[XB_XGEN(b.x)], 1u);
            asm volatile("s_waitcnt vmcnt(0)" ::: "memory");
        } else {
            XB_SPIN(xb_ld(&bar[XB_XGEN(b.x)]) == gen, bar);
            __builtin_amdgcn_fence(__ATOMIC_ACQUIRE, "agent");
            asm volatile("s_waitcnt vmcnt(0)" ::: "memory");
        }
    }
    __syncthreads();
}

#endif
#ifndef PROBE_DUP
#define PROBE_DUP 0
#endif
#define NTHR 512
#define NWV 8
#define PH_IDS() int tid_ = wv_ * 64 + (int)__builtin_amdgcn_mbcnt_hi(~0u, __builtin_amdgcn_mbcnt_lo(~0u, 0u)); OPQV(tid_); int bid_ = blockIdx.x; OPQS(bid_); int nblk_ = gridDim.x; OPQS(nblk_); (void)tid_; (void)bid_; (void)nblk_
#define GWV (nblk_ * NWV)
#define WID (bid_ * NWV + (tid_ >> 6))

__device__ __forceinline__ void ph_mod(const int wv_, unsigned char* smem, const Params& p) {
    PH_IDS();
    float* sc = (float*)(smem + 1024);
    for (int i = tid_; i < 5 * DM; i += NTHR) { const int v = i >> 10, k = i & (DM - 1); sc[i] = siluf_(v < 4 ? p.c[v * DM + k] : p.c_ctx[k]); }
    __syncthreads();
    for (int idx = bid_ * NTHR + tid_; idx < NLAYER * 6 * DM; idx += nblk_ * NTHR) {
        const int col = idx % (6 * DM), l = idx / (6 * DM);
        const float* w = p.w_mod + (size_t)l * DM * 6 * DM + col;
        const float bm = p.b_mod[l * 6 * DM + col];
        float a0 = bm, a1 = bm, a2 = bm, a3 = bm, a4 = bm;
#pragma unroll 8
        for (int k = 0; k < DM; ++k) { const float wv2 = w[(size_t)k * 6 * DM]; a0 += sc[k] * wv2; a1 += sc[DM + k] * wv2; a2 += sc[2 * DM + k] * wv2; a3 += sc[3 * DM + k] * wv2; a4 += sc[4 * DM + k] * wv2; }
        float* o = p.mod + (size_t)l * 5 * 6 * DM + col;
        o[0] = a0; o[6 * DM] = a1; o[2 * 6 * DM] = a2; o[3 * 6 * DM] = a3; o[4 * 6 * DM] = a4;
    }
}

__device__ __forceinline__ void ph_norm1(const int wv_, const Params& p, int layer) {
    PH_IDS();
    int lane = tid_ & 63;
    if (bid_ == 0 && tid_ < 64) { p.cnt[tid_] = 0; if (tid_ < 32) p.kmax[tid_] = 0u; if (tid_ < 8) p.cnt[128 + tid_] = 0; }
    for (int r = WID; r < NTOK; r += GWV) {
        int b = r / TJ, tau = r - b * TJ;
        float* h = hrow(p, r);
        const float* src = h;
        if (layer == 0) src = tau < NCTX ? p.ctx + ((size_t)b * NCTX + tau) * DM : p.x + ((size_t)b * SEQ + (tau - NCTX)) * DM;
        const float* md = modrow(p, layer, r);
        float4 v[4]; float ss = 0.f;
#pragma unroll
        for (int i = 0; i < 4; ++i) { v[i] = *(const float4*)(src + i * 256 + lane * 4); ss += v[i].x * v[i].x + v[i].y * v[i].y + v[i].z * v[i].z + v[i].w * v[i].w; }
        ss = wave_sum(ss);
        float rs = rsqrtf(ss * (1.0f / DM) + 1e-6f);
        const float* g = p.norm1_g + layer * DM;
#pragma unroll
        for (int i = 0; i < 4; ++i) {
            int c0 = i * 256 + lane * 4;
            if (layer == 0) *(float4*)(h + c0) = v[i];
            float4 gg = *(const float4*)(g + c0), sh = *(const float4*)(md + c0), sc = *(const float4*)(md + DM + c0);
            float o0 = v[i].x * rs * gg.x * (1.f + sc.x) + sh.x, o1 = v[i].y * rs * gg.y * (1.f + sc.y) + sh.y;
            float o2 = v[i].z * rs * gg.z * (1.f + sc.z) + sh.z, o3 = v[i].w * rs * gg.w * (1.f + sc.w) + sh.w;
            ushort4 ob; ob.x = f2bf(o0); ob.y = f2bf(o1); ob.z = f2bf(o2); ob.w = f2bf(o3);
            *(ushort4*)(p.A + (size_t)r * DM + c0) = ob;
        }
    }
}

struct EpiStoreBf16 { bf16_t* C; int ldc; __device__ void operator()(int r, int c, float v) const { C[(size_t)r * ldc + c] = f2bf(v); } };
struct EpiSigmoidBias { bf16_t* C; const float* bias; int ldc; __device__ void operator()(int r, int c, float v) const { C[(size_t)r * ldc + c] = f2bf(sigmoidf_(v + bias[c])); } };
struct EpiGateAcc { bf16_t* T; const bf16_t* G; int i; __device__ void operator()(int r, int c, float v) const {
    float g = bf2f(G[(size_t)r * 4096 + i * DM + c]); float t = g * v; if (i > 0) t += bf2f(T[(size_t)r * DM + c]); T[(size_t)r * DM + c] = f2bf(t); } };
struct EpiResid { float* hctx; float* out; const float* mod; int layer; int modoff; __device__ void operator()(int r, int c, float v) const {
    int b = r / TJ, tau = r - b * TJ;
    float* h = tau < NCTX ? hctx + ((size_t)b * NCTX + tau) * DM : out + ((size_t)b * SEQ + (tau - NCTX)) * DM;
    const float* md = mod + ((size_t)layer * 5 + (tau < NCTX ? 4 : b)) * (6 * DM);
    h[c] += md[modoff * DM + c] * v; } };
struct EpiSiluMul { bf16_t* H; __device__ void operator()(int r, int c, float v) const { float g = bf2f(H[(size_t)r * DEXP + c]); H[(size_t)r * DEXP + c] = f2bf(siluf_(g) * v); } };

template <class Epi>
__device__ __forceinline__ void ph_gemm_naive(const int wv_, unsigned char* smem, const bf16_t* A, int lda, const float* W0, int ldw, int M, int N, int K, const Epi& epi, const int* grp, size_t wstride, int skip_ctx) {
    PH_IDS();
    const int half = tid_ >> 8, tid = tid_ & 255, tx = tid & 15, ty = tid >> 4;
    float (*sA)[68] = (float (*)[68])(smem + 64 + half * 8704);
    float (*sB)[68] = (float (*)[68])(smem + 64 + half * 8704 + 4352);
    const int ntn = (N + 63) / 64, ntiles = (M / 64) * ntn;
    for (int t0 = bid_ * 2; t0 < ntiles; t0 += nblk_ * 2) {
        const int t = t0 + half;
        bool active = t < ntiles;
        int bm = active ? (t / ntn) * 64 : 0, bn = active ? (t % ntn) * 64 : 0;
        const float* W = W0;
        if (grp && active) {
            if (bm >= grp[32]) active = false;
            int e = 0;
            for (int i = 0; i < 16; ++i) e += (grp[16 + i] <= bm) ? 1 : 0;
            if (e > 15) e = 15;
            W += (size_t)e * wstride;
        }
        if (skip_ctx && (bm % TJ) < NCTX) active = false;
        float acc[4][4] = {};
        for (int k0 = 0; k0 < K; k0 += 16) {
            if (active) {
                int r = tid >> 2, kk = (tid & 3) * 4;
                ushort4 a = *(const ushort4*)(A + (size_t)(bm + r) * lda + k0 + kk);
                sA[kk + 0][r] = bf2f(a.x); sA[kk + 1][r] = bf2f(a.y); sA[kk + 2][r] = bf2f(a.z); sA[kk + 3][r] = bf2f(a.w);
                int kr = tid >> 4, cc = (tid & 15) * 4;
#pragma unroll
                for (int j = 0; j < 4; ++j) { int col = bn + cc + j; sB[kr][cc + j] = col < N ? W[(size_t)(k0 + kr) * ldw + col] : 0.f; }
            }
            __syncthreads();
            if (active) {
#pragma unroll
                for (int kk = 0; kk < 16; ++kk) {
                    float a[4], b[4];
#pragma unroll
                    for (int i = 0; i < 4; ++i) { a[i] = sA[kk][ty * 4 + i]; b[i] = sB[kk][tx * 4 + i]; }
#pragma unroll
                    for (int i = 0; i < 4; ++i)
#pragma unroll
                        for (int j = 0; j < 4; ++j) acc[i][j] += a[i] * b[j];
                }
            }
            __syncthreads();
        }
        if (active) {
#pragma unroll
            for (int i = 0; i < 4; ++i)
#pragma unroll
                for (int j = 0; j < 4; ++j) { int col = bn + tx * 4 + j; if (col < N) epi(bm + ty * 4 + i, col, acc[i][j]); }
        }
    }
}

__device__ __forceinline__ int pos2tau(int d, int pos) { return d == 0 ? pos : (pos < NCTX ? NCTX - 1 - pos : (TJ + NCTX - 1) - pos); }

__device__ __forceinline__ void dn_load_raw(const Params& p, int b, int tau, int h, int lane, float (&q)[5], float (&k)[5], float (&v)[5]) {
    const int lo = tau < NCTX ? 0 : NCTX, hi = tau < NCTX ? NCTX : TJ;
#pragma unroll
    for (int j = 0; j < 5; ++j) {
        const int t2 = tau + j - 2; const bool ok = t2 >= lo && t2 < hi;
        const bf16_t* pr = p.P + ((size_t)b * TJ + (ok ? t2 : tau)) * DINP + h * 64 + lane;
        q[j] = ok ? bf2f(pr[0]) : 0.f; k[j] = ok ? bf2f(pr[256]) : 0.f; v[j] = ok ? bf2f(pr[512]) : 0.f;
    }
}
__device__ __forceinline__ void dn_chain_naive(const Params& p, int layer, int chain, int lane) {
    int b = chain >> 3, h = (chain >> 1) & 3, d = chain & 1;
    float S[64];
#pragma unroll
    for (int i = 0; i < 64; ++i) S[i] = 0.f;
    const float nalog = -expf(p.dn_a_log[layer * 8 + d * 4 + h]), dtb = p.dn_dt_bias[layer * 8 + d * 4 + h];
    float cq[5], ck[5], cv[5];
#pragma unroll
    for (int j = 0; j < 5; ++j) { const float* cw = p.dn_conv + ((size_t)layer * 5 + j) * 768 + h * 64 + lane; cq[j] = cw[0]; ck[j] = cw[256]; cv[j] = cw[512]; }
    bf16_t* O = d == 0 ? p.Y : p.ODN; const int ldo = d == 0 ? DM : 256;
    int tau = pos2tau(d, 0);
    size_t r = (size_t)b * TJ + tau;
    float a_n = bf2f(p.P[r * DINP + C_DNA + d * 4 + h]), b_n = bf2f(p.P[r * DINP + C_DNB + d * 4 + h]);
    float qn[5], kn[5], vn[5];
    dn_load_raw(p, b, tau, h, lane, qn, kn, vn);
    for (int pos = 0; pos < TJ; ++pos) {
        float a_in = a_n, b_in = b_n; size_t rc = r;
        float qa = 0.f, ka = 0.f, va = 0.f;
#pragma unroll
        for (int j = 0; j < 5; ++j) { qa += qn[j] * cq[j]; ka += kn[j] * ck[j]; va += vn[j] * cv[j]; }
        if (pos + 1 < TJ) {
            tau = pos2tau(d, pos + 1); r = (size_t)b * TJ + tau;
            a_n = bf2f(p.P[r * DINP + C_DNA + d * 4 + h]); b_n = bf2f(p.P[r * DINP + C_DNB + d * 4 + h]);
            dn_load_raw(p, b, tau, h, lane, qn, kn, vn);
        }
        float qv = siluf_(qa), kv = siluf_(ka), vv = siluf_(va);
        qv *= rsqrtf(wave_sum(qv * qv) + 1e-6f); kv *= rsqrtf(wave_sum(kv * kv) + 1e-6f);
        float decay = expf(nalog * softplusf_(a_in + dtb)), beta = sigmoidf_(b_in);
        float kS = 0.f;
#pragma unroll
        for (int i = 0; i < 64; ++i) { S[i] *= decay; kS += rdlane(kv, i) * S[i]; }
        float vnew = beta * (vv - kS), o = 0.f;
#pragma unroll
        for (int i = 0; i < 64; ++i) { S[i] += rdlane(kv, i) * vnew; o += rdlane(qv, i) * S[i]; }
        O[rc * ldo + h * 64 + lane] = f2bf(o * 0.125f);
    }
}

__device__ __forceinline__ void s5_chain_naive(const Params& p, int layer, int chain, int lane) {
    int b = chain >> 5, g = (chain >> 1) & 15, d = chain & 1;
    float lre = p.s5_a_re[((layer * 2 + d) * 16 + g) * 64 + lane], lim = p.s5_a_im[((layer * 2 + d) * 16 + g) * 64 + lane];
    float dt = expf(p.s5_log_dt[(layer * 2 + d) * 16 + g]);
    float mag = expf(lre * dt), are = mag * cosf(lim * dt), aim = mag * sinf(lim * dt);
    float den = lre * lre + lim * lim;
    float fre = ((are - 1.f) * lre + aim * lim) / den, fim = (aim * lre - (are - 1.f) * lim) / den;
    float bbr[16], bbi[16], cr[16], ci[16];
#pragma unroll
    for (int c = 0; c < 16; ++c) {
        float br = p.s5_b_re[((layer * 16 + g) * 64 + lane) * 16 + c], bi = p.s5_b_im[((layer * 16 + g) * 64 + lane) * 16 + c];
        bbr[c] = fre * br - fim * bi; bbi[c] = fre * bi + fim * br;
        cr[c] = p.s5_c_re[(((layer * 2 + d) * 16 + g) * 16 + c) * 64 + lane]; ci[c] = p.s5_c_im[(((layer * 2 + d) * 16 + g) * 16 + c) * 64 + lane];
    }
    bf16_t* O = d == 0 ? p.Y + 256 : p.OS5; const int ldo = d == 0 ? DM : 256;
    float xr = 0.f, xi = 0.f;
    size_t r = (size_t)b * TJ + pos2tau(d, 0);
    float u_n = bf2f(p.P[r * DINP + C_S5U + g * 16 + (lane & 15)]);
    for (int pos = 0; pos < TJ; ++pos) {
        float u = u_n; size_t rc = r;
        if (pos + 1 < TJ) { r = (size_t)b * TJ + pos2tau(d, pos + 1); u_n = bf2f(p.P[r * DINP + C_S5U + g * 16 + (lane & 15)]); }
        float nr = are * xr - aim * xi, ni = are * xi + aim * xr;
#pragma unroll
        for (int c = 0; c < 16; ++c) { float uc = rdlane(u, c); nr += bbr[c] * uc; ni += bbi[c] * uc; }
        xr = nr; xi = ni;
        float my = 0.f;
#pragma unroll
        for (int c = 0; c < 16; ++c) { float t = wave_sum(cr[c] * xr - ci[c] * xi); if (lane == c) my = t; }
        if (lane < 16) O[rc * ldo + g * 16 + lane] = f2bf(my);
    }
}

__device__ __forceinline__ void gla_chain_naive(const Params& p, int layer, int chain, int lane) {
    int b = chain >> 3, h = (chain >> 1) & 3, d = chain & 1;
    float S[32];
#pragma unroll
    for (int i = 0; i < 32; ++i) S[i] = 0.f;
    float w2[16];
#pragma unroll
    for (int rr = 0; rr < 16; ++rr) w2[rr] = p.gla_w_gate[((layer * 2 + d) * 16 + rr) * 128 + h * 32 + (lane & 31)];
    float b2 = p.gla_b_gate[(layer * 2 + d) * 128 + h * 32 + (lane & 31)];
    bf16_t* O = d == 0 ? p.Y + 768 : p.OGLA; const int ldo = d == 0 ? DM : 256;
    size_t r = (size_t)b * TJ + pos2tau(d, 0);
    float low_n = bf2f(p.P[r * DINP + C_GLG + d * 16 + (lane & 15)]), q_n = bf2f(p.P[r * DINP + C_GLQ + h * 32 + (lane & 31)]);
    float k_n = bf2f(p.P[r * DINP + C_GLK + h * 32 + (lane & 31)]), v_n = bf2f(p.P[r * DINP + C_GLV + h * 64 + lane]);
    for (int pos = 0; pos < TJ; ++pos) {
        float low = low_n, qv = q_n, kv = k_n, vv = v_n; size_t rc = r;
        if (pos + 1 < TJ) {
            r = (size_t)b * TJ + pos2tau(d, pos + 1);
            low_n = bf2f(p.P[r * DINP + C_GLG + d * 16 + (lane & 15)]); q_n = bf2f(p.P[r * DINP + C_GLQ + h * 32 + (lane & 31)]);
            k_n = bf2f(p.P[r * DINP + C_GLK + h * 32 + (lane & 31)]); v_n = bf2f(p.P[r * DINP + C_GLV + h * 64 + lane]);
        }
        float z = b2;
#pragma unroll
        for (int rr = 0; rr < 16; ++rr) z += rdlane(low, rr) * w2[rr];
        float a = expf(logsigmoidf_(z) * (1.0f / 16.0f));
        float o = 0.f;
#pragma unroll
        for (int i = 0; i < 32; ++i) { S[i] = rdlane(a, i) * S[i] + rdlane(kv, i) * vv; o += rdlane(qv, i) * S[i]; }
        O[rc * ldo + h * 64 + lane] = f2bf(o * 0.17677669529663687f);
    }
}

__device__ __forceinline__ void ph_dn_prep(const int wv_, unsigned char* smem, const Params& p, int layer) {
    PH_IDS();
    unsigned char* RAW = smem + 1024;
    const float* cwl = p.dn_conv + (size_t)layer * 5 * 768;
    for (int item = bid_; item < NB * (TJ / 64); item += nblk_) {
        const int b = item / (TJ / 64), tc = item - b * (TJ / 64), tlo = tc * 64;
        const int slo = tlo < NCTX ? 0 : NCTX, shi = tlo < NCTX ? NCTX : TJ;
        __syncthreads();
        for (int e = tid_; e < 68 * 96; e += NTHR) {
            const int row = e / 96, ch = e - row * 96, tau = tlo - 2 + row;
            uint4 v = make_uint4(0u, 0u, 0u, 0u);
            if (tau >= slo && tau < shi) v = *(const uint4*)(p.P + ((size_t)b * TJ + tau) * DINP + ch * 8);
            *(uint4*)(RAW + e * 16) = v;
        }
        __syncthreads();
#pragma unroll 1
        for (int k3 = 0; k3 < 3; ++k3) {
            const int id = tid_ + NTHR * k3, pg = id / 96, cg = id - pg * 96;
            float cw[5][8];
#pragma unroll
            for (int j = 0; j < 5; ++j) { const float4 w0 = *(const float4*)(cwl + j * 768 + cg * 8), w1 = *(const float4*)(cwl + j * 768 + cg * 8 + 4);
                cw[j][0] = w0.x; cw[j][1] = w0.y; cw[j][2] = w0.z; cw[j][3] = w0.w; cw[j][4] = w1.x; cw[j][5] = w1.y; cw[j][6] = w1.z; cw[j][7] = w1.w; }
            float x[8][8];
#pragma unroll
            for (int rr = 0; rr < 8; ++rr) {
                const uint4 v = *(const uint4*)(RAW + ((4 * pg + rr) * 96 + cg) * 16);
                const unsigned vv[4] = {v.x, v.y, v.z, v.w};
#pragma unroll
                for (int e = 0; e < 4; ++e) { x[rr][2 * e] = __uint_as_float(vv[e] << 16); x[rr][2 * e + 1] = __uint_as_float(vv[e] & 0xffff0000u); }
            }
#pragma unroll
            for (int e2 = 0; e2 < 4; ++e2) {
                float y[8]; float ss = 0.f;
#pragma unroll
                for (int e = 0; e < 8; ++e) { float acc = 0.f;
#pragma unroll
                    for (int j = 0; j < 5; ++j) acc += x[e2 + j][e] * cw[j][e];
                    y[e] = siluf_(acc); ss += y[e] * y[e]; }
                ss += __shfl_xor(ss, 1, 64); ss += __shfl_xor(ss, 2, 64); ss += __shfl_xor(ss, 4, 64);
                const float rs = cg < 64 ? rsqrtf(ss + 1e-6f) : 1.0f;
                uint4 o; o.x = cvt_pk_bf16_(y[0] * rs, y[1] * rs); o.y = cvt_pk_bf16_(y[2] * rs, y[3] * rs); o.z = cvt_pk_bf16_(y[4] * rs, y[5] * rs); o.w = cvt_pk_bf16_(y[6] * rs, y[7] * rs);
                *(uint4*)(p.QKVN + ((size_t)b * TJ + tlo + 4 * pg + e2) * 768 + cg * 8) = o;
            }
        }
        {
            const int lane = tid_ & 63, wq = tid_ >> 6, hh = wq >> 1, dd = wq & 1;
            bf16_t* prow = p.P + ((size_t)b * TJ + tlo + lane) * DINP;
            const float av = bf2f(prow[C_DNA + dd * 4 + hh]), bv = bf2f(prow[C_DNB + dd * 4 + hh]);
            const float g = -expf(p.dn_a_log[layer * 8 + dd * 4 + hh]) * softplusf_(av + p.dn_dt_bias[layer * 8 + dd * 4 + hh]);
            float pre = g;
#pragma unroll
            for (int o = 1; o < 64; o <<= 1) { const float t = __shfl_up(pre, o, 64); if (lane >= o) pre += t; }
            const float tot = rdlane(pre, 63);
            float2 gb; gb.x = dd == 0 ? pre : tot - pre + g; gb.y = sigmoidf_(bv);
            *(float2*)((float*)(prow + DIN) + (dd * 4 + hh) * 2) = gb;
        }
    }
}

#define DN_SB 72
#define DN_QN 0
#define DN_QD (DN_QN + 9216)
#define DN_KN (DN_QD + 9216)
#define DN_KB (DN_KN + 9216)
#define DN_V (DN_KB + 9216)
#define DN_NL (DN_V + 9216)
#define DN_AI (DN_NL + 9216)
#define DN_NW (DN_AI + 9216)
#define DN_KDT (DN_NW + 9216)
#define DN_U (DN_KDT + 9216)
#define DN_TD (DN_U + 17408)
#define DN_GAM (DN_TD + 2048)
typedef float f32x4_ __attribute__((ext_vector_type(4)));
__device__ __forceinline__ bfx8 pack8(const f32x4_& x, const f32x4_& y) {
    unsigned u[4]; u[0] = cvt_pk_bf16_(x[0], x[1]); u[1] = cvt_pk_bf16_(x[2], x[3]); u[2] = cvt_pk_bf16_(y[0], y[1]); u[3] = cvt_pk_bf16_(y[2], y[3]);
    return *(const bfx8*)u;
}
__device__ __forceinline__ bfx8 ld_split(const unsigned char* base, int row, int k0, int q4) {
    const unsigned char* a = base + (row * DN_SB + k0 + 4 * q4) * 2;
    uint2 lo = *(const uint2*)a, hi = *(const uint2*)(a + 32);
    unsigned u[4] = {lo.x, lo.y, hi.x, hi.y}; return *(const bfx8*)u;
}
__device__ __forceinline__ bfx8 ld_half(const unsigned char* base, int rowstride, int row, int k0, int q4) {
    uint2 lo = *(const uint2*)(base + (row * rowstride + k0 + 4 * q4) * 2);
    unsigned u[4] = {lo.x, lo.y, 0u, 0u}; return *(const bfx8*)u;
}
#define MFMA16(a, b, c) __builtin_amdgcn_mfma_f32_16x16x32_bf16(a, b, c, 0, 0, 0)

__device__ __forceinline__ void dn_tdiag(unsigned char* L, int a, int cc, int q4) {
    float xs[16];
#pragma unroll
    for (int r = 0; r < 16; ++r) {
        const unsigned char* rowp = L + DN_NL + ((16 * a + r) * DN_SB + 16 * a) * 2;
        const uint4 v0 = *(const uint4*)rowp, v1 = *(const uint4*)(rowp + 16);
        const unsigned vv[8] = {v0.x, v0.y, v0.z, v0.w, v1.x, v1.y, v1.z, v1.w};
        float sx = (r == cc) ? 1.f : 0.f;
#pragma unroll
        for (int j2 = 0; j2 < 16; ++j2) if (j2 < r) { const float lij = (j2 & 1) ? __uint_as_float(vv[j2 >> 1] & 0xffff0000u) : __uint_as_float(vv[j2 >> 1] << 16); sx += lij * xs[j2]; }
        xs[r] = sx;
        if (q4 == 0) *(bf16_t*)(L + DN_TD + ((a * 16 + r) * 16 + cc) * 2) = f2bf(sx);
    }
}
__device__ __forceinline__ void dn_chain(unsigned char* smem, const Params& p, int layer, int chain, int tid_) {
    unsigned char* L = smem + 1024;
    const int b = chain >> 3, h = (chain >> 1) & 3, d = chain & 1;
    const int w0_ = tid_ >> 6, lane0_ = tid_ & 63;
#define DN_IDS() int tt_ = tid_; OPQV(tt_); const int lane = tt_ & 63, w = __builtin_amdgcn_readfirstlane(tt_ >> 6), l15 = lane & 15, q4 = lane >> 4; (void)l15; (void)q4; (void)w
    const float nalog = -expf(p.dn_a_log[layer * 8 + d * 4 + h]), dtb = p.dn_dt_bias[layer * 8 + d * 4 + h];
    float* gam = (float*)(L + DN_GAM);
    f32x4_ Sst[4];
#pragma unroll
    for (int mt = 0; mt < 4; ++mt) Sst[mt] = (f32x4_){0.f, 0.f, 0.f, 0.f};
    bf16_t* Oout = d == 0 ? p.Y : p.ODN; const int ldo = d == 0 ? DM : 256;
    uint4 pre0, pre1, pre2; float2 gb_n = make_float2(0.f, 0.f); float gl_n = 0.f;
    auto chunk_lo = [&](int c) { return d == 0 ? c * 64 : (c < 4 ? 192 - c * 64 : (TJ + NCTX - 64) - c * 64); };
    auto issue = [&](int c) {
        const int tlo = chunk_lo(c);
        {
            const int i = tid_ >> 3, c8 = (tid_ & 7) * 8, tau = d ? tlo + 63 - i : tlo + i;
            const bf16_t* src = p.QKVN + ((size_t)b * TJ + tau) * 768 + h * 64 + c8;
            pre0 = *(const uint4*)src; pre1 = *(const uint4*)(src + 256); pre2 = *(const uint4*)(src + 512);
            gb_n = *(const float2*)((const float*)(p.P + ((size_t)b * TJ + tau) * DINP + DIN) + (d * 4 + h) * 2);
            gl_n = *((const float*)(p.P + ((size_t)b * TJ + (d ? tlo : tlo + 63)) * DINP + DIN) + (d * 4 + h) * 2);
        }
    };
    issue(0);
    for (int c = 0; c < TJ / 64; ++c) {
        const int tlo = chunk_lo(c);
        __syncthreads();
        {
            const int i = tid_ >> 3, c8 = (tid_ & 7) * 8;
            const float gmi = gb_n.x, bti = gb_n.y, egi = __expf(gmi), eki = __expf(gl_n - gmi);
            if ((tid_ & 7) == 0) { gam[i] = gmi; gam[64 + i] = bti; gam[128 + i] = egi; gam[192 + i] = eki; }
            *(uint4*)(L + DN_QN + (i * DN_SB + c8) * 2) = pre0; *(uint4*)(L + DN_KN + (i * DN_SB + c8) * 2) = pre1;
            const unsigned* qq = (const unsigned*)&pre0; const unsigned* kq = (const unsigned*)&pre1; const unsigned* vq = (const unsigned*)&pre2;
            uint4 qd, kb, vb; unsigned* qdp = (unsigned*)&qd; unsigned* kbp = (unsigned*)&kb; unsigned* vbp = (unsigned*)&vb;
            const float sq = 0.125f * egi, skb = bti * egi;
#pragma unroll
            for (int e = 0; e < 4; ++e) {
                const float k0 = __uint_as_float(kq[e] << 16), k1 = __uint_as_float(kq[e] & 0xffff0000u);
                qdp[e] = cvt_pk_bf16_(__uint_as_float(qq[e] << 16) * sq, __uint_as_float(qq[e] & 0xffff0000u) * sq);
                kbp[e] = cvt_pk_bf16_(k0 * skb, k1 * skb);
                vbp[e] = cvt_pk_bf16_(__uint_as_float(vq[e] << 16) * bti, __uint_as_float(vq[e] & 0xffff0000u) * bti);
                *(bf16_t*)(L + DN_KDT + ((c8 + 2 * e) * DN_SB + i) * 2) = f2bf(k0 * eki);
                *(bf16_t*)(L + DN_KDT + ((c8 + 2 * e + 1) * DN_SB + i) * 2) = f2bf(k1 * eki);
            }
            *(uint4*)(L + DN_QD + (i * DN_SB + c8) * 2) = qd; *(uint4*)(L + DN_KB + (i * DN_SB + c8) * 2) = kb; *(uint4*)(L + DN_V + (i * DN_SB + c8) * 2) = vb;
        }
        if (c + 1 < TJ / 64) issue(c + 1);
        __syncthreads();
        { DN_IDS();
#pragma unroll
        for (int tt = 0; tt < 2; ++tt) {
            const int t = 2 * w + tt, it = t >> 2, jt = t & 3;
            f32x4_ kk = {0.f, 0.f, 0.f, 0.f}, qk = {0.f, 0.f, 0.f, 0.f};
            if (jt <= it) {
#pragma unroll
                for (int ks = 0; ks < 2; ++ks) {
                    const bfx8 bk = *(const bfx8*)(L + DN_KN + ((jt * 16 + l15) * DN_SB + ks * 32 + q4 * 8) * 2);
                    const bfx8 ak = *(const bfx8*)(L + DN_KN + ((it * 16 + l15) * DN_SB + ks * 32 + q4 * 8) * 2);
                    const bfx8 aq = *(const bfx8*)(L + DN_QN + ((it * 16 + l15) * DN_SB + ks * 32 + q4 * 8) * 2);
                    kk = MFMA16(ak, bk, kk); qk = MFMA16(aq, bk, qk);
                }
            }
            const int j = jt * 16 + l15; const float gj = gam[j];
#pragma unroll
            for (int r = 0; r < 4; ++r) {
                const int i = it * 16 + q4 * 4 + r;
                const float dec = (j <= i) ? __expf(gam[i] - gj) : 0.f;
                const float lv = (j < i) ? -gam[64 + i] * kk[r] * dec : 0.f;
                *(bf16_t*)(L + DN_NL + (i * DN_SB + j) * 2) = f2bf(lv);
                *(bf16_t*)(L + DN_AI + (i * DN_SB + j) * 2) = f2bf(0.125f * qk[r] * dec);
            }
        }
        {
            const int adiag = w == 0 ? 0 : w == 2 ? 1 : w == 5 ? 2 : w == 7 ? 3 : -1;
            if (adiag >= 0) { WAVE_LDS_FENCE(); dn_tdiag(L, adiag, l15, q4); }
        }
        }
        __syncthreads();
        { DN_IDS();
            const f32x4_ z4 = {0.f, 0.f, 0.f, 0.f};
            f32x4_ R[4];
#pragma unroll
            for (int a = 0; a < 4; ++a)
#pragma unroll
                for (int r = 0; r < 4; ++r) {
                    const int i = 16 * a + 4 * q4 + r;
                    R[a][r] = w < 4 ? bf2f(*(const bf16_t*)(L + DN_V + (i * DN_SB + 16 * w + l15) * 2)) : bf2f(*(const bf16_t*)(L + DN_KB + (i * DN_SB + 16 * (w - 4) + l15) * 2));
                }
            f32x4_ X[4];
#pragma unroll
            for (int a = 0; a < 4; ++a) {
                f32x4_ acc = R[a];
                if (a == 1) acc = MFMA16(ld_half(L + DN_NL, DN_SB, 16 + l15, 0, q4), pack8(X[0], z4), acc);
                if (a >= 2) acc = MFMA16(ld_split(L + DN_NL, 16 * a + l15, 0, q4), pack8(X[0], X[1]), acc);
                if (a == 3) acc = MFMA16(ld_half(L + DN_NL, DN_SB, 48 + l15, 32, q4), pack8(X[2], z4), acc);
                X[a] = MFMA16(ld_half(L + DN_TD, 16, a * 16 + l15, 0, q4), pack8(acc, z4), z4);
            }
#pragma unroll
            for (int a = 0; a < 4; ++a)
#pragma unroll
                for (int r = 0; r < 4; ++r) {
                    const int i = 16 * a + 4 * q4 + r;
                    if (w < 4) *(float*)(L + DN_U + (i * 68 + 16 * w + l15) * 4) = X[a][r];
                    else *(bf16_t*)(L + DN_NW + (i * DN_SB + 16 * (w - 4) + l15) * 2) = f2bf(-X[a][r]);
                }
        }
        __syncthreads();
        { DN_IDS();
        if (w < 4) {
            const f32x4_ z4 = {0.f, 0.f, 0.f, 0.f};
            bfx8 sb[2]; sb[0] = pack8(Sst[0], Sst[1]); sb[1] = pack8(Sst[2], Sst[3]);
            f32x4_ vn[4];
#pragma unroll
            for (int mt = 0; mt < 4; ++mt) {
                f32x4_ acc;
#pragma unroll
                for (int r = 0; r < 4; ++r) acc[r] = *(const float*)(L + DN_U + ((16 * mt + 4 * q4 + r) * 68 + 16 * w + l15) * 4);
                acc = MFMA16(ld_split(L + DN_NW, 16 * mt + l15, 0, q4), sb[0], acc);
                acc = MFMA16(ld_split(L + DN_NW, 16 * mt + l15, 32, q4), sb[1], acc);
                vn[mt] = acc;
            }
            bfx8 vb[2]; vb[0] = pack8(vn[0], vn[1]); vb[1] = pack8(vn[2], vn[3]);
#pragma unroll
            for (int mt = 0; mt < 4; ++mt) {
                f32x4_ acc = z4;
                acc = MFMA16(ld_split(L + DN_QD, 16 * mt + l15, 0, q4), sb[0], acc);
                acc = MFMA16(ld_split(L + DN_QD, 16 * mt + l15, 32, q4), sb[1], acc);
                acc = MFMA16(ld_split(L + DN_AI, 16 * mt + l15, 0, q4), vb[0], acc);
                acc = MFMA16(ld_split(L + DN_AI, 16 * mt + l15, 32, q4), vb[1], acc);
#pragma unroll
                for (int r = 0; r < 4; ++r) {
                    const int i = 16 * mt + 4 * q4 + r, tau = d ? tlo + 63 - i : tlo + i;
                    Oout[((size_t)b * TJ + tau) * ldo + h * 64 + 16 * w + l15] = f2bf(acc[r]);
                }
            }
            const float glast = gam[128 + 63];
#pragma unroll
            for (int mt = 0; mt < 4; ++mt) {
                f32x4_ acc = Sst[mt] * glast;
                acc = MFMA16(ld_split(L + DN_KDT, 16 * mt + l15, 0, q4), vb[0], acc);
                acc = MFMA16(ld_split(L + DN_KDT, 16 * mt + l15, 32, q4), vb[1], acc);
                Sst[mt] = acc;
            }
        }
        }
    }
    __syncthreads();
}

__device__ __forceinline__ int gla_scan_chunk(int d, int tc) { return d == 0 ? tc : (tc < 4 ? 3 - tc : (TJ / 64 + 3) - tc); }
__device__ __forceinline__ void gla_low(const bf16_t* prow, int d, float (&low)[16]) {
    const uint4 v0 = *(const uint4*)(prow + C_GLG + d * 16), v1 = *(const uint4*)(prow + C_GLG + d * 16 + 8);
    const unsigned vv[8] = {v0.x, v0.y, v0.z, v0.w, v1.x, v1.y, v1.z, v1.w};
#pragma unroll
    for (int e = 0; e < 8; ++e) { low[2 * e] = __uint_as_float(vv[e] << 16); low[2 * e + 1] = __uint_as_float(vv[e] & 0xffff0000u); }
}
__device__ __forceinline__ void gla_gate4(const Params& p, int layer, int h, int d, const float (&low)[16], int c4, int lane, float (&bb)[4], float (&tot)[4]) {
    const float* w2 = p.gla_w_gate + (size_t)(layer * 2 + d) * 16 * 128 + h * 32 + c4 * 4;
    const float* b2 = p.gla_b_gate + (size_t)(layer * 2 + d) * 128 + h * 32 + c4 * 4;
#pragma unroll
    for (int e = 0; e < 4; ++e) {
        float z = b2[e];
#pragma unroll
        for (int r = 0; r < 16; ++r) z += low[r] * w2[r * 128 + e];
        const float x = logsigmoidf_(z) * (1.0f / 16.0f);
        float pre = x;
#pragma unroll
        for (int o = 1; o < 64; o <<= 1) { const float t = __shfl_up(pre, o, 64); if (lane >= o) pre += t; }
        const float tt = rdlane(pre, 63);
        tot[e] = tt; bb[e] = d == 0 ? pre : tt - pre + x;
    }
}
#define GLA_VS 68
#define GLA_WAVE_LDS 17408
__device__ __forceinline__ bfx8 ld_split_s(const unsigned char* base, int strideB, int row, int k0, int q4) {
    const unsigned char* a = base + row * strideB + (k0 + 4 * q4) * 2;
    const uint2 lo = *(const uint2*)a, hi = *(const uint2*)(a + 32);
    unsigned u[4] = {lo.x, lo.y, hi.x, hi.y}; return *(const bfx8*)u;
}
__device__ __forceinline__ void gla_load_row32(const bf16_t* src, float (&x)[32]) {
#pragma unroll
    for (int c = 0; c < 4; ++c) { const uint4 v = *(const uint4*)(src + c * 8); const unsigned vv[4] = {v.x, v.y, v.z, v.w};
#pragma unroll
        for (int e = 0; e < 4; ++e) { x[c * 8 + 2 * e] = __uint_as_float(vv[e] << 16); x[c * 8 + 2 * e + 1] = __uint_as_float(vv[e] & 0xffff0000u); } }
}
__device__ __forceinline__ void gla_store_vT(unsigned char* vT, const bf16_t* vsrc, int lane) {
#pragma unroll
    for (int c = 0; c < 8; ++c) { const uint4 v = *(const uint4*)(vsrc + c * 8); const unsigned vv[4] = {v.x, v.y, v.z, v.w};
#pragma unroll
        for (int e = 0; e < 4; ++e) { *(bf16_t*)(vT + ((c * 8 + 2 * e) * GLA_VS + lane) * 2) = (bf16_t)(vv[e] & 0xffffu); *(bf16_t*)(vT + ((c * 8 + 2 * e + 1) * GLA_VS + lane) * 2) = (bf16_t)(vv[e] >> 16); } }
}
__device__ __forceinline__ void ph_gla1(const int wv_, unsigned char* smem, const Params& p, int layer) {
    PH_IDS();
    const int lane = tid_ & 63, w = tid_ >> 6, l15 = lane & 15, q4 = lane >> 4;
    unsigned char* vT = smem + 1024 + w * GLA_WAVE_LDS; unsigned char* khT = vT + 8704 + 4096;
    for (int item = bid_ * NWV + w; item < NB * 4 * 2 * (TJ / 64); item += nblk_ * NWV) {
        const int tc = item % (TJ / 64), bhd = item / (TJ / 64), d = bhd & 1, h = (bhd >> 1) & 3, b = bhd >> 3;
        const bf16_t* prow = p.P + ((size_t)b * TJ + tc * 64 + lane) * DINP;
        const int cs = gla_scan_chunk(d, tc);
        float low[16]; gla_low(prow, d, low);
#pragma unroll 1
        for (int c4 = 0; c4 < 8; ++c4) {
            float bb[4], tot[4];
            gla_gate4(p, layer, h, d, low, c4, lane, bb, tot);
            const uint2 kv = *(const uint2*)(prow + C_GLK + h * 32 + c4 * 4);
            const float k0 = __uint_as_float(kv.x << 16), k1 = __uint_as_float(kv.x & 0xffff0000u), k2 = __uint_as_float(kv.y << 16), k3 = __uint_as_float(kv.y & 0xffff0000u);
            *(bf16_t*)(khT + ((c4 * 4 + 0) * GLA_VS + lane) * 2) = f2bf(k0 * __expf(tot[0] - bb[0]));
            *(bf16_t*)(khT + ((c4 * 4 + 1) * GLA_VS + lane) * 2) = f2bf(k1 * __expf(tot[1] - bb[1]));
            *(bf16_t*)(khT + ((c4 * 4 + 2) * GLA_VS + lane) * 2) = f2bf(k2 * __expf(tot[2] - bb[2]));
            *(bf16_t*)(khT + ((c4 * 4 + 3) * GLA_VS + lane) * 2) = f2bf(k3 * __expf(tot[3] - bb[3]));
            if (lane < 4) { const float tl = lane == 0 ? tot[0] : lane == 1 ? tot[1] : lane == 2 ? tot[2] : tot[3];
                p.DCY[((size_t)bhd * (TJ / 64) + cs) * 32 + c4 * 4 + lane] = __expf(tl); }
        }
        gla_store_vT(vT, prow + C_GLV + h * 64, lane);
        WAVE_LDS_FENCE();
        bf16_t* gout = p.GST + ((size_t)bhd * (TJ / 64) + cs) * 2048;
#pragma unroll
        for (int dt = 0; dt < 4; ++dt)
#pragma unroll
            for (int nt = 0; nt < 2; ++nt) {
                f32x4_ acc = {0.f, 0.f, 0.f, 0.f};
#pragma unroll
                for (int ks = 0; ks < 2; ++ks) acc = MFMA16(ld_split_s(vT, GLA_VS * 2, 16 * dt + l15, 32 * ks, q4), ld_split_s(khT, GLA_VS * 2, 16 * nt + l15, 32 * ks, q4), acc);
#pragma unroll
                for (int r = 0; r < 4; ++r) gout[(16 * dt + 4 * q4 + r) * 32 + 16 * nt + l15] = f2bf(acc[r]);
            }
        WAVE_LDS_FENCE();
    }
}
__device__ __forceinline__ void gla2_scan(const Params& p, int wg, int tid_) {
    const int chain = wg >> 1, pr = (wg & 1) * 512 + tid_, dk0 = (2 * pr) & 31;
    unsigned* g = (unsigned*)(p.GST + (size_t)chain * (TJ / 64) * 2048) + pr;
    const float* dc = p.DCY + (size_t)chain * (TJ / 64) * 32 + dk0;
    float s0 = 0.f, s1 = 0.f;
    unsigned gv = g[0]; float d0 = dc[0], d1 = dc[1];
    for (int c = 0; c < TJ / 64; ++c) {
        const unsigned cur = gv; const float c0 = d0, c1 = d1;
        if (c + 1 < TJ / 64) { gv = g[(size_t)(c + 1) * 1024]; d0 = dc[(c + 1) * 32]; d1 = dc[(c + 1) * 32 + 1]; }
        g[(size_t)c * 1024] = cvt_pk_bf16_(s0, s1);
        s0 = c0 * s0 + __uint_as_float(cur << 16); s1 = c1 * s1 + __uint_as_float(cur & 0xffff0000u);
    }
}
__device__ __forceinline__ void ph_gla3(const int wv_, unsigned char* smem, const Params& p, int layer) {
    PH_IDS();
    const int lane = tid_ & 63, w = tid_ >> 6, l15 = lane & 15, q4 = lane >> 4;
    unsigned char* vT = smem + 1024 + w * GLA_WAVE_LDS; unsigned char* Qt = vT + 8704; unsigned char* Kt = Qt + 4096;
    for (;;) {
#ifdef EMU
        const int item = g_emu_q++ ;
#else
        int item = 0; if (lane == 0) item = atomicAdd(p.cnt + 130, 1); item = __builtin_amdgcn_readfirstlane(item);
#endif
        if (item >= NB * 4 * (TJ / 64)) break;
        const int tc = item % (TJ / 64), bh = item / (TJ / 64), h = bh & 3, b = bh >> 2;
        if (layer == NLAYER - 1 && tc < 4) continue;
        const bf16_t* prow = p.P + ((size_t)b * TJ + tc * 64 + lane) * DINP;
        gla_store_vT(vT, prow + C_GLV + h * 64, lane);
        f32x4_ o[4][4];
#pragma unroll
        for (int dt = 0; dt < 4; ++dt)
#pragma unroll
            for (int nt = 0; nt < 4; ++nt) o[dt][nt] = (f32x4_){0.f, 0.f, 0.f, 0.f};
#pragma unroll 1
        for (int d = 0; d < 2; ++d) {
#ifdef EMU
            if (g_dbg_dir >= 0 && d != g_dbg_dir) continue;
#endif
            {
                float low[16]; gla_low(prow, d, low);
#pragma unroll 1
                for (int c4 = 0; c4 < 8; ++c4) {
                    float bb[4], tot[4];
                    gla_gate4(p, layer, h, d, low, c4, lane, bb, tot);
                    const uint2 qv = *(const uint2*)(prow + C_GLQ + h * 32 + c4 * 4), kv = *(const uint2*)(prow + C_GLK + h * 32 + c4 * 4);
                    const float sc = 0.17677669529663687f;
                    const float e0 = __expf(bb[0]), e1 = __expf(bb[1]), e2 = __expf(bb[2]), e3 = __expf(bb[3]);
                    uint2 qo, ko;
                    qo.x = cvt_pk_bf16_(__uint_as_float(qv.x << 16) * sc * e0, __uint_as_float(qv.x & 0xffff0000u) * sc * e1);
                    qo.y = cvt_pk_bf16_(__uint_as_float(qv.y << 16) * sc * e2, __uint_as_float(qv.y & 0xffff0000u) * sc * e3);
                    ko.x = cvt_pk_bf16_(__uint_as_float(kv.x << 16) / e0, __uint_as_float(kv.x & 0xffff0000u) / e1);
                    ko.y = cvt_pk_bf16_(__uint_as_float(kv.y << 16) / e2, __uint_as_float(kv.y & 0xffff0000u) / e3);
                    *(uint2*)(Qt + lane * 64 + c4 * 8) = qo; *(uint2*)(Kt + lane * 64 + c4 * 8) = ko;
                }
            }
            WAVE_LDS_FENCE();
            const bf16_t* sst = p.GST + ((size_t)((bh * 2 + d) * (TJ / 64)) + gla_scan_chunk(d, tc)) * 2048;
            bfx8 qb[4];
#pragma unroll
            for (int nt = 0; nt < 4; ++nt) qb[nt] = *(const bfx8*)(Qt + (16 * nt + l15) * 64 + q4 * 16);
#pragma unroll
            for (int nt = 0; nt < 4; ++nt) {
                f32x4_ at[4];
#pragma unroll
                for (int mt = 0; mt < 4; ++mt) {
                    const bfx8 ka = *(const bfx8*)(Kt + (16 * mt + l15) * 64 + q4 * 16);
                    f32x4_ a = MFMA16(ka, qb[nt], ((f32x4_){0.f, 0.f, 0.f, 0.f}));
                    const int t = 16 * nt + l15;
#pragma unroll
                    for (int r = 0; r < 4; ++r) { const int sidx = 16 * mt + 4 * q4 + r; const bool keep = d == 0 ? sidx <= t : sidx >= t; a[r] = keep ? a[r] : 0.f; }
                    at[mt] = a;
                }
                const bfx8 ab0 = pack8(at[0], at[1]), ab1 = pack8(at[2], at[3]);
#pragma unroll
                for (int dt = 0; dt < 4; ++dt) {
                    f32x4_ acc = o[dt][nt];
                    acc = MFMA16(ld_split_s(vT, GLA_VS * 2, 16 * dt + l15, 0, q4), ab0, acc);
                    acc = MFMA16(ld_split_s(vT, GLA_VS * 2, 16 * dt + l15, 32, q4), ab1, acc);
                    acc = MFMA16(*(const bfx8*)(sst + (16 * dt + l15) * 32 + q4 * 8), qb[nt], acc);
                    o[dt][nt] = acc;
                }
            }
            WAVE_LDS_FENCE();
        }
        const float* g = p.gla_norm_g + layer * 64;
#pragma unroll
        for (int nt = 0; nt < 4; ++nt) {
            float ss = 0.f;
#pragma unroll
            for (int dt = 0; dt < 4; ++dt)
#pragma unroll
                for (int r = 0; r < 4; ++r) ss += o[dt][nt][r] * o[dt][nt][r];
            ss += __shfl_xor(ss, 16, 64); ss += __shfl_xor(ss, 32, 64);
            const float rs = rsqrtf(ss * (1.0f / 64.0f) + 1e-6f);
            const size_t row = (size_t)b * TJ + tc * 64 + 16 * nt + l15;
#ifdef EMU
            if (g_dbg_dir >= 0) { for (int dt = 0; dt < 4; ++dt) for (int r = 0; r < 4; ++r) g_dbg[row * 256 + h * 64 + 16 * dt + 4 * q4 + r] = o[dt][nt][r]; }
#endif
#pragma unroll
            for (int dt = 0; dt < 4; ++dt) {
                const int dv0 = 16 * dt + 4 * q4;
                const uint2 rg = *(const uint2*)(p.P + row * DINP + C_GLR + h * 64 + dv0);
                const float r0 = __uint_as_float(rg.x << 16), r1 = __uint_as_float(rg.x & 0xffff0000u), r2 = __uint_as_float(rg.y << 16), r3 = __uint_as_float(rg.y & 0xffff0000u);
                uint2 w2;
                w2.x = cvt_pk_bf16_(o[dt][nt][0] * rs * g[dv0] * siluf_(r0), o[dt][nt][1] * rs * g[dv0 + 1] * siluf_(r1));
                w2.y = cvt_pk_bf16_(o[dt][nt][2] * rs * g[dv0 + 2] * siluf_(r2), o[dt][nt][3] * rs * g[dv0 + 3] * siluf_(r3));
                *(uint2*)(p.Y + row * DM + 768 + h * 64 + dv0) = w2;
            }
        }
    }
}

#define S5NS (TJ / 16)
#define S5NT (TJ / 256)
__device__ __forceinline__ void ph_s5_prep(const int wv_, unsigned char* smem, const Params& p, int layer) {
    PH_IDS();
    if (bid_ >= 16) {
        if (bid_ < 32) for (int idx = (bid_ - 16) * NTHR + tid_; idx < 65536; idx += 16 * NTHR) { const int co = idx >> 8, ch = idx & 255; p.GLUt[idx] = f2bf(p.s5_glu_w[(size_t)layer * 65536 + ch * 256 + co]); }
        return;
    }
    const int g = bid_;
    float2* APOW = (float2*)(smem + 1024);
    float2* BBAR = APOW + 2 * 64 * 17;
    float2* CC = BBAR + 2 * 64 * 16;
    float* KC = (float*)(CC + 2 * 16 * 64);
    __syncthreads();
    if (tid_ < 128) {
        const int d = tid_ >> 6, pp = tid_ & 63;
        const float lre = p.s5_a_re[((layer * 2 + d) * 16 + g) * 64 + pp], lim = p.s5_a_im[((layer * 2 + d) * 16 + g) * 64 + pp];
        const float dt = expf(p.s5_log_dt[(layer * 2 + d) * 16 + g]);
        for (int m = 0; m <= 16; ++m) { const float mag = expf(lre * dt * (float)m), ang = lim * dt * (float)m; APOW[(d * 64 + pp) * 17 + m] = make_float2(mag * cosf(ang), mag * sinf(ang)); }
        const float2 a1 = APOW[(d * 64 + pp) * 17 + 1]; const float den = lre * lre + lim * lim;
        const float fre = ((a1.x - 1.f) * lre + a1.y * lim) / den, fim = (a1.y * lre - (a1.x - 1.f) * lim) / den;
        for (int c = 0; c < 16; ++c) {
            const float br = p.s5_b_re[((layer * 16 + g) * 64 + pp) * 16 + c], bi = p.s5_b_im[((layer * 16 + g) * 64 + pp) * 16 + c];
            BBAR[(d * 64 + pp) * 16 + c] = make_float2(fre * br - fim * bi, fre * bi + fim * br);
            CC[(d * 16 + c) * 64 + pp] = make_float2(p.s5_c_re[(((layer * 2 + d) * 16 + g) * 16 + c) * 64 + pp], p.s5_c_im[(((layer * 2 + d) * 16 + g) * 16 + c) * 64 + pp]);
        }
        const float2 a16 = APOW[(d * 64 + pp) * 17 + 16];
        p.A16[((d * 16 + g) * 64 + pp) * 2] = a16.x; p.A16[((d * 16 + g) * 64 + pp) * 2 + 1] = a16.y;
    }
    __syncthreads();
    for (int idx = tid_; idx < 8192; idx += NTHR) {
        const int d = idx >> 12, tau = (idx >> 8) & 15, c = (idx >> 4) & 15, c2 = idx & 15;
        float acc = 0.f;
        for (int pp = 0; pp < 64; ++pp) {
            const float2 cc = CC[(d * 16 + c) * 64 + pp], ap = APOW[(d * 64 + pp) * 17 + tau], bbv = BBAR[(d * 64 + pp) * 16 + c2];
            const float tr = cc.x * ap.x - cc.y * ap.y, ti = cc.x * ap.y + cc.y * ap.x;
            acc += tr * bbv.x - ti * bbv.y;
        }
        KC[idx] = acc;
    }
    __syncthreads();
    for (int idx = tid_; idx < 256 * 512; idx += NTHR) {
        const int n = idx >> 9, k = idx & 511, i = n >> 4, c = n & 15;
        float v;
        if (k < 256) { const int j = k >> 4, c2 = k & 15;
            v = (i >= j ? KC[((0 * 16 + (i - j)) * 16 + c) * 16 + c2] : 0.f) + (j >= i ? KC[((1 * 16 + (j - i)) * 16 + c) * 16 + c2] : 0.f);
        } else { const int kk = k - 256, d = kk >> 7, im = (kk >> 6) & 1, pp = kk & 63, m = d == 0 ? i + 1 : 16 - i;
            const float2 cc = CC[(d * 16 + c) * 64 + pp], ap = APOW[(d * 64 + pp) * 17 + m];
            v = im == 0 ? (cc.x * ap.x - cc.y * ap.y) : -(cc.x * ap.y + cc.y * ap.x); }
        p.SB[((size_t)g * 256 + n) * 512 + k] = f2bf(v);
    }
    for (int idx = tid_; idx < 256 * 256; idx += NTHR) {
        const int n = idx >> 8, k = idx & 255, j = k >> 4, c2 = k & 15, d = n >> 7, im = (n >> 6) & 1, pp = n & 63, m = d == 0 ? 15 - j : j;
        const float2 ap = APOW[(d * 64 + pp) * 17 + m], bbv = BBAR[(d * 64 + pp) * 16 + c2];
        p.SE[((size_t)g * 256 + n) * 256 + k] = f2bf(im == 0 ? ap.x * bbv.x - ap.y * bbv.y : ap.x * bbv.y + ap.y * bbv.x);
    }
}
__device__ __forceinline__ void ph_s5_1(const int wv_, const Params& p, int layer) {
    PH_IDS();
    const int lane = tid_ & 63, w = tid_ >> 6, l15 = lane & 15, q4 = lane >> 4;
    for (int item = bid_ * NWV + w; item < NB * S5NT * 16; item += nblk_ * NWV) {
        const int g = item & 15, st = (item >> 4) % S5NT, b = item / (16 * S5NT), s0 = st * 16;
        bfx8 ua[8];
#pragma unroll
        for (int ks = 0; ks < 8; ++ks) ua[ks] = *(const bfx8*)(p.P + ((size_t)b * TJ + 16 * (s0 + l15) + 2 * ks + (q4 >> 1)) * DINP + C_S5U + 16 * g + 8 * (q4 & 1));
        const bf16_t* se = p.SE + (size_t)g * 65536;
#pragma unroll 2
        for (int nt = 0; nt < 16; ++nt) {
            f32x4_ acc = {0.f, 0.f, 0.f, 0.f};
#pragma unroll
            for (int ks = 0; ks < 8; ++ks) acc = MFMA16(ua[ks], *(const bfx8*)(se + (16 * nt + l15) * 256 + 32 * ks + 8 * q4), acc);
#pragma unroll
            for (int r = 0; r < 4; ++r) p.XS[(((size_t)b * S5NS + s0 + 4 * q4 + r) * 16 + g) * 256 + 16 * nt + l15] = f2bf(acc[r]);
        }
    }
}
__device__ __forceinline__ void s5_2_scan(const Params& p, int wg, int tid_) {
    const int idx = wg * NTHR + tid_, pp = idx & 63, d = (idx >> 6) & 1, g = (idx >> 7) & 15, b = idx >> 11;
    const float ar = p.A16[((d * 16 + g) * 64 + pp) * 2], ai = p.A16[((d * 16 + g) * 64 + pp) * 2 + 1];
    bf16_t* base = p.XS + ((size_t)b * S5NS * 16 + g) * 256 + d * 128 + pp;
    float xr = 0.f, xi = 0.f;
    for (int q0 = 0; q0 < S5NS; q0 += 8) {
        float er[8], ei[8]; int sidx[8];
#pragma unroll
        for (int u = 0; u < 8; ++u) { const int q = q0 + u; const int sq = d == 0 ? q : (q < NCTX / 16 ? NCTX / 16 - 1 - q : S5NS + NCTX / 16 - 1 - q); sidx[u] = sq;
            er[u] = bf2f(base[(size_t)sq * 4096]); ei[u] = bf2f(base[(size_t)sq * 4096 + 64]); }
#pragma unroll
        for (int u = 0; u < 8; ++u) {
            base[(size_t)sidx[u] * 4096] = f2bf(xr); base[(size_t)sidx[u] * 4096 + 64] = f2bf(xi);
            const float nr = ar * xr - ai * xi + er[u], ni = ar * xi + ai * xr + ei[u]; xr = nr; xi = ni;
        }
    }
}
#define S5_ZS 264
__device__ __forceinline__ void ph_s5_3(const int wv_, unsigned char* smem, const Params& p, int layer) {
    PH_IDS();
    const int lane = tid_ & 63, w = tid_ >> 6, l15 = lane & 15, q4 = lane >> 4;
    bf16_t* Z = (bf16_t*)(smem + 1024);
    int* sitem = (int*)(smem + 64);
    for (;;) {
        __syncthreads();
#ifdef EMU
        if (tid_ == 0) sitem[0] = g_emu_q2++;
#else
        if (tid_ == 0) sitem[0] = atomicAdd(p.cnt + 131, 1);
#endif
        __syncthreads();
        const int item = sitem[0];
        if (item >= NB * S5NT) break;
        const int b = item / S5NT, st = item - b * S5NT, s0 = st * 16;
        if (layer == NLAYER - 1 && st == 0) continue;
        __syncthreads();
#pragma unroll 1
        for (int gi = 0; gi < 2; ++gi) {
            const int g = 2 * w + gi;
            bfx8 ua[8], xa[8];
#pragma unroll
            for (int ks = 0; ks < 8; ++ks) {
                ua[ks] = *(const bfx8*)(p.P + ((size_t)b * TJ + 16 * (s0 + l15) + 2 * ks + (q4 >> 1)) * DINP + C_S5U + 16 * g + 8 * (q4 & 1));
                xa[ks] = *(const bfx8*)(p.XS + (((size_t)b * S5NS + s0 + l15) * 16 + g) * 256 + 32 * ks + 8 * q4);
            }
            const bf16_t* sb = p.SB + (size_t)g * 131072;
            const float dsk = p.s5_d[layer * 256 + 16 * g + l15];
#pragma unroll 2
            for (int nt = 0; nt < 16; ++nt) {
                f32x4_ acc = {0.f, 0.f, 0.f, 0.f};
#pragma unroll
                for (int ks = 0; ks < 8; ++ks) acc = MFMA16(ua[ks], *(const bfx8*)(sb + (16 * nt + l15) * 512 + 32 * ks + 8 * q4), acc);
#pragma unroll
                for (int ks = 0; ks < 8; ++ks) acc = MFMA16(xa[ks], *(const bfx8*)(sb + (16 * nt + l15) * 512 + 256 + 32 * ks + 8 * q4), acc);
#pragma unroll
                for (int r = 0; r < 4; ++r) {
                    const int tl = 16 * (4 * q4 + r) + nt;
                    const float u = bf2f(p.P[((size_t)b * TJ + 16 * s0 + tl) * DINP + C_S5U + 16 * g + l15]);
                    Z[tl * S5_ZS + 16 * g + l15] = f2bf(gelu_tanh(acc[r] + dsk * u));
                }
            }
        }
        __syncthreads();
#pragma unroll 1
        for (int m2 = 0; m2 < 2; ++m2) {
            const int mt = 2 * w + m2;
            bfx8 za[8];
#pragma unroll
            for (int ks = 0; ks < 8; ++ks) za[ks] = *(const bfx8*)(Z + (16 * mt + l15) * S5_ZS + 32 * ks + 8 * q4);
#pragma unroll 2
            for (int nt = 0; nt < 16; ++nt) {
                f32x4_ acc = {0.f, 0.f, 0.f, 0.f};
#pragma unroll
                for (int ks = 0; ks < 8; ++ks) acc = MFMA16(za[ks], *(const bfx8*)(p.GLUt + (16 * nt + l15) * 256 + 32 * ks + 8 * q4), acc);
                const int co = 16 * nt + l15; const float gb = p.s5_glu_b[layer * 256 + co];
#pragma unroll
                for (int r = 0; r < 4; ++r) {
                    const int tl = 16 * mt + 4 * q4 + r;
                    const float z = bf2f(Z[tl * S5_ZS + co]);
                    p.Y[((size_t)b * TJ + 16 * s0 + tl) * DM + 256 + co] = f2bf(z * sigmoidf_(acc[r] + gb));
                }
            }
        }
    }
}

__device__ __forceinline__ void ph_scans_dn_only(const int wv_, unsigned char* smem, const Params& p, int layer) {
    PH_IDS();
    if (bid_ < 32) dn_chain(smem, p, layer, bid_, tid_);
}
__device__ __forceinline__ void ph_scans(const int wv_, unsigned char* smem, const Params& p, int layer) {
    PH_IDS();
    if (bid_ < 32) { dn_chain(smem, p, layer, bid_, tid_); return; }
    if (bid_ < 112) {
        if (bid_ < 96) gla2_scan(p, bid_ - 32, tid_); else s5_2_scan(p, bid_ - 96, tid_);
#ifndef EMU
        asm volatile("s_waitcnt vmcnt(0)" ::: "memory");
        __syncthreads();
        if (tid_ == 0) { __builtin_amdgcn_fence(__ATOMIC_RELEASE, "agent"); asm volatile("s_waitcnt vmcnt(0)" ::: "memory"); (void)xb_add((unsigned*)p.cnt + 129, 1u); }
#endif
    }
}
#ifndef EMU
__device__ __forceinline__ void ph_wait_scans(const int wv_, const Params& p) {
    PH_IDS();
    if (tid_ == 0) {
        unsigned sp = 0;
        while (xb_ld((unsigned*)p.cnt + 129) < 80u) { __builtin_amdgcn_s_sleep(2); if (++sp > (1u << 22)) break; }
        __builtin_amdgcn_fence(__ATOMIC_ACQUIRE, "agent");
        asm volatile("s_waitcnt vmcnt(0)" ::: "memory");
    }
    __syncthreads();
}
#endif

__device__ __forceinline__ void ph_attn_prep(const int wv_, unsigned char* smem, const Params& p, int layer) {
    PH_IDS();
    float2 (*sCS)[16] = (float2 (*)[16])(smem + 1024);
    bf16_t* sVt = (bf16_t*)(smem + 1024 + 8192);
    unsigned* sMax = (unsigned*)(smem + 64);
    const float qscale = 0.17677669529663687f * 1.4426950408889634f;
    for (int item = bid_; item < NB * 132; item += nblk_) {
        const int b = item / 132, kt = item - b * 132, tau0 = kt * 64; const bool lat = tau0 >= NCTX;
        __syncthreads();
        if (tid_ < 8) sMax[tid_] = 0u;
        for (int idx = tid_; idx < 1024; idx += NTHR) {
            const int tk = idx >> 4, i = idx & 15; float cs = 1.f, sn = 0.f;
            if (lat) { const int t = tau0 + tk - NCTX; const float base = (i < 8) ? (float)(t >> 6) : (float)(t & 63);
                const float inv = exp2f(-(float)(i & 7) * (13.287712379549449f / 8.0f)); sincosf(base * inv, &sn, &cs); }
            sCS[tk][i] = make_float2(cs, sn);
        }
        __syncthreads();
        const int tk = tid_ >> 3, hm = tid_ & 7, h = hm >> 1, m = hm & 1, tau = tau0 + tk, bh = b * 4 + h;
        const size_t r = (size_t)b * TJ + tau;
#pragma unroll
        for (int which = 0; which < 2; ++which) {
            const uint4* src = (const uint4*)(p.P + r * DINP + (which ? C_DAQ : C_DAK) + h * 64 + m * 32);
            uint4 raw[4]; raw[0] = src[0]; raw[1] = src[1]; raw[2] = src[2]; raw[3] = src[3];
            const unsigned* rw = (const unsigned*)raw; float x[32], o[32];
#pragma unroll
            for (int i = 0; i < 16; ++i) { x[2 * i] = __uint_as_float(rw[i] << 16); x[2 * i + 1] = __uint_as_float(rw[i] & 0xffff0000u); }
            float n2 = 0.f; const float sc = which ? qscale : 1.0f;
#pragma unroll
            for (int i = 0; i < 16; ++i) { const float2 c = sCS[tk][i]; o[i] = (x[i] * c.x - x[16 + i] * c.y) * sc; o[16 + i] = (x[i] * c.y + x[16 + i] * c.x) * sc; n2 += o[i] * o[i] + o[16 + i] * o[16 + i]; }
            uint4 w[4]; unsigned* ww = (unsigned*)w;
#pragma unroll
            for (int i = 0; i < 16; ++i) ww[i] = cvt_pk_bf16_(o[2 * i], o[2 * i + 1]);
            uint4* dst = (uint4*)((which ? p.Qr : p.Kr) + ((size_t)bh * TJ + tau) * 64 + m * 32);
            dst[0] = w[0]; dst[1] = w[1]; dst[2] = w[2]; dst[3] = w[3];
            if (which) p.Qn[((size_t)bh * TJ + tau) * 2 + m] = sqrtf(n2);
            else atomicMax(&sMax[hm], __float_as_uint(n2 * 1.02f));
        }
        {
            const uint4* src = (const uint4*)(p.P + r * DINP + C_DAV + h * 64 + m * 32);
            uint4 raw[4]; raw[0] = src[0]; raw[1] = src[1]; raw[2] = src[2]; raw[3] = src[3];
            const bf16_t* rv = (const bf16_t*)raw;
            const int pos = (tk & ~15) | ((tk & 4) << 1) | ((tk & 8) >> 1) | (tk & 3);
#pragma unroll
            for (int i = 0; i < 32; ++i) sVt[(h * 64 + m * 32 + i) * 64 + pos] = rv[i];
        }
        __syncthreads();
        if (tid_ < 8) atomicMax(&p.kmax[(b * 4 + (tid_ >> 1)) * 2 + (tid_ & 1)], sMax[tid_]);
        for (int c = tid_; c < 2048; c += NTHR) {
            const int row = c >> 3, ch = c & 7, hq = row >> 6, dv = row & 63;
            *(uint4*)(p.Vt + ((((size_t)(b * 4 + hq) * 132 + kt) * 64 + dv) * 64 + ch * 8)) = *(const uint4*)(sVt + row * 64 + ch * 8);
        }
    }
}

__device__ __forceinline__ void ph_attn(const int wv_, unsigned char* smem, const Params& p, int layer) {
    PH_IDS();
    const int lane = tid_ & 63, w = tid_ >> 6, ql = lane & 31, hh = lane >> 5;
    unsigned char* sK0 = smem + 1024;
    const int nitem = 512 + (layer < NLAYER - 1 ? 16 : 0);
    const float* lf = p.da_lambda + layer * 128;
    float d01 = 0.f, d23 = 0.f;
    for (int i = 0; i < 32; ++i) { d01 += lf[i] * lf[32 + i]; d23 += lf[64 + i] * lf[96 + i]; }
    const float lam_init = 0.8f - 0.6f * expf(-0.3f * (float)layer);
    const float lam = expf(d01) - expf(d23) + lam_init;
    const int skey = tid_ >> 3, sc = tid_ & 7;
    const unsigned sdst = (unsigned)(skey * 128 + ((sc ^ ((skey >> 1) & 7)) << 4));
    int* qctr = p.cnt + 128;
    int* sitem = (int*)(smem + 64);
    for (;;) {
        __syncthreads();
        if (tid_ == 0) sitem[0] = atomicAdd(qctr, 1);
        __syncthreads();
        const int item = sitem[0];
        if (item >= nitem) break;
        const int is_ctx = item >= 512;
        const int bh = is_ctx ? item - 512 : item >> 5, b = bh >> 2, h = bh & 3;
        const int qtau = is_ctx ? w * 32 + ql : NCTX + (item & 31) * 256 + w * 32 + ql;
        const int ntile = is_ctx ? 4 : TJ / 64;
        bfx8 qf[2][2];
        const bf16_t* qp = p.Qr + ((size_t)bh * TJ + qtau) * 64 + hh * 8;
#pragma unroll
        for (int m = 0; m < 2; ++m)
#pragma unroll
            for (int ks = 0; ks < 2; ++ks) qf[m][ks] = *(const bfx8*)(qp + m * 32 + ks * 16);
        float negm[2];
#pragma unroll
        for (int m = 0; m < 2; ++m) negm[m] = -p.Qn[((size_t)bh * TJ + qtau) * 2 + m] * sqrtf(__uint_as_float(p.kmax[bh * 2 + m]));
        f32x16 O[2][2];
#pragma unroll
        for (int m = 0; m < 2; ++m)
#pragma unroll
            for (int t = 0; t < 2; ++t)
#pragma unroll
                for (int i = 0; i < 16; ++i) O[m][t][i] = 0.f;
        float l[2] = {0.f, 0.f};
        const char* kbase = (const char*)(p.Kr + (size_t)bh * TJ * 64) + tid_ * 16;
        const char* vbase = (const char*)(p.Vt + (size_t)bh * 132 * 4096) + tid_ * 16;
        __syncthreads();
        {
            uint4 k0 = *(const uint4*)kbase, v0 = *(const uint4*)vbase;
            *(uint4*)(sK0 + sdst) = k0; *(uint4*)(sK0 + 8192 + sdst) = v0;
        }
        __syncthreads();
        for (int kt = 0; kt < ntile; ++kt) {
            unsigned char* sK = sK0 + (kt & 1) * 16384; unsigned char* sV = sK + 8192;
            uint4 kn = make_uint4(0, 0, 0, 0), vn = make_uint4(0, 0, 0, 0);
            if (kt + 1 < ntile) { kn = *(const uint4*)(kbase + (size_t)(kt + 1) * 8192); vn = *(const uint4*)(vbase + (size_t)(kt + 1) * 8192); }
#pragma unroll
            for (int sb = 0; sb < 2; ++sb) {
                bfx8 pf[2][2];
#pragma unroll
                for (int m = 0; m < 2; ++m) {
                    f32x16 S;
#pragma unroll
                    for (int i = 0; i < 16; ++i) S[i] = negm[m];
                    const int key = sb * 32 + ql;
#pragma unroll
                    for (int ks = 0; ks < 2; ++ks) {
                        const int c = m * 4 + ks * 2 + hh;
                        const bfx8 kf = *(const bfx8*)(sK + key * 128 + ((c ^ ((key >> 1) & 7)) << 4));
                        S = __builtin_amdgcn_mfma_f32_32x32x16_bf16(kf, qf[m][ks], S, 0, 0, 0);
                    }
                    float ls = 0.f;
#pragma unroll
                    for (int i = 0; i < 16; ++i) { S[i] = __builtin_amdgcn_exp2f(S[i]); ls += S[i]; }
                    l[m] += ls;
#pragma unroll
                    for (int s2 = 0; s2 < 2; ++s2) {
                        unsigned u[4];
#pragma unroll
                        for (int j = 0; j < 4; ++j) u[j] = cvt_pk_bf16_(S[8 * s2 + 2 * j], S[8 * s2 + 2 * j + 1]);
                        pf[m][s2] = *(const bfx8*)u;
                    }
                }
#pragma unroll
                for (int t = 0; t < 2; ++t)
#pragma unroll
                    for (int s2 = 0; s2 < 2; ++s2) {
                        const int dv = t * 32 + ql, c = (sb * 2 + s2) * 2 + hh;
                        const bfx8 vf = *(const bfx8*)(sV + dv * 128 + ((c ^ ((dv >> 1) & 7)) << 4));
                        O[0][t] = __builtin_amdgcn_mfma_f32_32x32x16_bf16(vf, pf[0][s2], O[0][t], 0, 0, 0);
                        O[1][t] = __builtin_amdgcn_mfma_f32_32x32x16_bf16(vf, pf[1][s2], O[1][t], 0, 0, 0);
                    }
            }
            if (kt + 1 < ntile) { unsigned char* dK = sK0 + ((kt + 1) & 1) * 16384; *(uint4*)(dK + sdst) = kn; *(uint4*)(dK + 8192 + sdst) = vn; }
            __syncthreads();
        }
        const float l0 = l[0] + __shfl_xor(l[0], 32, 64), l1 = l[1] + __shfl_xor(l[1], 32, 64);
        const float i0 = 1.0f / l0, i1 = lam / l1;
        float ss = 0.f;
#pragma unroll
        for (int t = 0; t < 2; ++t)
#pragma unroll
            for (int i = 0; i < 16; ++i) { const float o = O[0][t][i] * i0 - O[1][t][i] * i1; O[0][t][i] = o; ss += o * o; }
        ss += __shfl_xor(ss, 32, 64);
        const float rs = rsqrtf(ss * (1.0f / 64.0f) + 1e-5f) * (1.0f - lam_init);
        const float* g = p.da_norm_g + layer * 64;
        bf16_t* yo = p.Y + ((size_t)b * TJ + qtau) * DM + 512 + h * 64;
#pragma unroll
        for (int t = 0; t < 2; ++t)
#pragma unroll
            for (int gq = 0; gq < 4; ++gq) {
                const int dv0 = 32 * t + 8 * gq + 4 * hh;
                uint2 w2;
                w2.x = cvt_pk_bf16_(O[0][t][4 * gq] * rs * g[dv0], O[0][t][4 * gq + 1] * rs * g[dv0 + 1]);
                w2.y = cvt_pk_bf16_(O[0][t][4 * gq + 2] * rs * g[dv0 + 2], O[0][t][4 * gq + 3] * rs * g[dv0 + 3]);
                *(uint2*)(yo + dv0) = w2;
            }
    }
}

__device__ __forceinline__ void ph_finish(const int wv_, unsigned char* smem, const Params& p, int layer) {
    PH_IDS();
    const int lane = tid_ & 63;
    for (int it = WID; it < NTOK * 4; it += GWV) {
        const int r = it >> 2, h = it & 3;
        if (layer == NLAYER - 1 && (r % TJ) < NCTX) continue;
        const float o = bf2f(p.Y[(size_t)r * DM + h * 64 + lane]) + bf2f(p.ODN[(size_t)r * 256 + h * 64 + lane]);
        const float ss = wave_sum(o * o), rs = rsqrtf(ss * (1.f / 64.f) + 1e-6f);
        const float z = bf2f(p.P[(size_t)r * DINP + C_DNZ + h * 64 + lane]);
        p.Y[(size_t)r * DM + h * 64 + lane] = f2bf(o * rs * p.dn_norm_g[layer * 64 + lane] * siluf_(z));
    }
}

__device__ __forceinline__ void ph_norm2_route(const int wv_, unsigned char* smem, const Params& p, int layer) {
    PH_IDS();
    int lane = tid_ & 63;
    float* swr = (float*)(smem + 1024);
    __syncthreads();
    for (int i = tid_; i < DM * 16; i += NTHR) { const int k = i >> 4, e = i & 15; swr[e * DM + k] = p.w_router[i]; }
    __syncthreads();
    for (int r = WID; r < NTOK; r += GWV) {
        if (layer == NLAYER - 1 && (r % TJ) < NCTX) continue;
        const float* h = hrow(p, r); const float* md = modrow(p, layer, r);
        float f[16]; float ss = 0.f;
#pragma unroll
        for (int i = 0; i < 4; ++i) { float4 v = *(const float4*)(h + i * 256 + lane * 4); f[i * 4] = v.x; f[i * 4 + 1] = v.y; f[i * 4 + 2] = v.z; f[i * 4 + 3] = v.w; ss += v.x * v.x + v.y * v.y + v.z * v.z + v.w * v.w; }
        ss = wave_sum(ss);
        float rs = rsqrtf(ss * (1.0f / DM) + 1e-6f);
        const float* g = p.norm2_g + layer * DM;
        float sc[16];
#pragma unroll
        for (int e = 0; e < 16; ++e) sc[e] = 0.f;
#pragma unroll
        for (int i = 0; i < 4; ++i) {
            int c0 = i * 256 + lane * 4; ushort4 ob; bf16_t* obp = (bf16_t*)&ob;
            float vq[4];
#pragma unroll
            for (int j = 0; j < 4; ++j) { vq[j] = f[i * 4 + j] * rs * g[c0 + j] * (1.f + md[4 * DM + c0 + j]) + md[3 * DM + c0 + j]; obp[j] = f2bf(vq[j]); }
#pragma unroll
            for (int e = 0; e < 16; ++e) { const float4 w = *(const float4*)(swr + e * DM + c0); sc[e] += vq[0] * w.x + vq[1] * w.y + vq[2] * w.z + vq[3] * w.w; }
            *(ushort4*)(p.A + (size_t)r * DM + c0) = ob;
        }
#pragma unroll
        for (int e = 0; e < 16; ++e) sc[e] = wave_sum(sc[e]);
        if (lane == 0) {
            float s[16], gb[16];
#pragma unroll
            for (int e = 0; e < 16; ++e) { s[e] = sigmoidf_(sc[e]); gb[e] = s[e] + p.b_router[e]; }
            int best = 0; float bestv = -1e30f;
#pragma unroll
            for (int gI = 0; gI < 4; ++gI) {
                float a0 = -1e30f, a1 = -1e30f;
#pragma unroll
                for (int j = 0; j < 4; ++j) { float v = gb[gI * 4 + j]; if (v > a0) { a1 = a0; a0 = v; } else if (v > a1) a1 = v; }
                float gs = a0 + a1; if (gs > bestv) { bestv = gs; best = gI; }
            }
            int i0 = 0, i1 = 0; float v0 = -1e30f, v1 = -1e30f;
#pragma unroll
            for (int j = 0; j < 4; ++j) {
                float v = 0.f;
#pragma unroll
                for (int gI = 0; gI < 4; ++gI) if (gI == best) v = gb[gI * 4 + j];
                if (v > v0) { v1 = v0; i1 = i0; v0 = v; i0 = j; } else if (v > v1) { v1 = v; i1 = j; }
            }
            int e0 = best * 4 + i0, e1 = best * 4 + i1;
            float w0 = 0.f, w1 = 0.f;
#pragma unroll
            for (int e = 0; e < 16; ++e) { if (e == e0) w0 = s[e]; if (e == e1) w1 = s[e]; }
            float inv = 1.f / (w0 + w1);
            p.tok_e[r * 2] = e0; p.tok_e[r * 2 + 1] = e1; p.tok_w[r * 2] = w0 * inv; p.tok_w[r * 2 + 1] = w1 * inv;
            p.tok_pos[r * 2] = atomicAdd(&p.cnt[e0], 1); p.tok_pos[r * 2 + 1] = atomicAdd(&p.cnt[e1], 1);
        }
    }
}

__device__ __forceinline__ void ph_moe_gather(const int wv_, unsigned char* smem, const Params& p, int layer) {
    PH_IDS();
    int* sstart = (int*)(smem + 64);
    __syncthreads();
    if (tid_ == 0) {
        int acc = 0;
        for (int e = 0; e < 16; ++e) { sstart[e] = acc; acc += (p.cnt[e] + 255) / 256 * 256; if (bid_ == 0) p.cnt[16 + e] = acc; }
        if (bid_ == 0) p.cnt[32] = acc;
    }
    __syncthreads();
    int lane = tid_ & 63;
    for (int pr = WID; pr < NTOK * 2; pr += GWV) {
        int r = pr >> 1;
        if (layer == NLAYER - 1 && (r % TJ) < NCTX) continue;
        int slot = sstart[p.tok_e[pr]] + p.tok_pos[pr];
        if (lane == 0) p.tok_slot[pr] = slot;
        const uint4* src = (const uint4*)(p.A + (size_t)r * DM); uint4* dst = (uint4*)(p.BUF + (size_t)slot * DM);
        dst[lane] = src[lane]; dst[lane + 64] = src[lane + 64];
    }
}

__device__ __forceinline__ void ph_moe_combine(const int wv_, const Params& p, int layer) {
    PH_IDS();
    int lane = tid_ & 63;
    for (int r = WID; r < NTOK; r += GWV) {
        if (layer == NLAYER - 1 && (r % TJ) < NCTX) continue;
        float* h = hrow(p, r); const float* md = modrow(p, layer, r) + 5 * DM;
        int s0 = p.tok_slot[r * 2], s1 = p.tok_slot[r * 2 + 1]; float w0 = p.tok_w[r * 2], w1 = p.tok_w[r * 2 + 1];
        const bf16_t* p0 = p.PO + (size_t)s0 * DM; const bf16_t* p1 = p.PO + (size_t)s1 * DM;
        float v[16]; float ss = 0.f;
#pragma unroll
        for (int i = 0; i < 4; ++i) {
            int c0 = i * 256 + lane * 4;
            float4 hv = *(const float4*)(h + c0); ushort4 a = *(const ushort4*)(p0 + c0), bq = *(const ushort4*)(p1 + c0); float4 m = *(const float4*)(md + c0);
            hv.x += m.x * (w0 * bf2f(a.x) + w1 * bf2f(bq.x)); hv.y += m.y * (w0 * bf2f(a.y) + w1 * bf2f(bq.y));
            hv.z += m.z * (w0 * bf2f(a.z) + w1 * bf2f(bq.z)); hv.w += m.w * (w0 * bf2f(a.w) + w1 * bf2f(bq.w));
            v[i * 4] = hv.x; v[i * 4 + 1] = hv.y; v[i * 4 + 2] = hv.z; v[i * 4 + 3] = hv.w;
            ss += hv.x * hv.x + hv.y * hv.y + hv.z * hv.z + hv.w * hv.w;
        }
        if (layer == NLAYER - 1) {
            ss = wave_sum(ss); float rs = rsqrtf(ss * (1.0f / DM) + 1e-6f);
#pragma unroll
            for (int i = 0; i < 4; ++i) { int c0 = i * 256 + lane * 4; float4 g = *(const float4*)(p.final_g + c0);
                float4 o; o.x = v[i * 4] * rs * g.x; o.y = v[i * 4 + 1] * rs * g.y; o.z = v[i * 4 + 2] * rs * g.z; o.w = v[i * 4 + 3] * rs * g.w; *(float4*)(h + c0) = o; }
        } else {
#pragma unroll
            for (int i = 0; i < 4; ++i) { int c0 = i * 256 + lane * 4; float4 o; o.x = v[i * 4]; o.y = v[i * 4 + 1]; o.z = v[i * 4 + 2]; o.w = v[i * 4 + 3]; *(float4*)(h + c0) = o; }
        }
    }
}


#ifndef EMU
struct CvtTask { const float* src; bf16_t* dst; int lds, K, N, Nsrc, ldd; };
__device__ __forceinline__ void cvt_tiles(unsigned char* smem, const CvtTask& t, int& base, int tid_, int bid_, int nblk_) {
    float (*sT)[65] = (float (*)[65])(smem + 1024);
    const int nkt = t.K / 64, nnt = t.N / 64, ntile = nkt * nnt;
    int first = (bid_ - base % nblk_ + nblk_) % nblk_;
    for (int it = first; it < ntile; it += nblk_) {
        const int kt = it % nkt, ntl = it / nkt, k0 = kt * 64, n0 = ntl * 64;
        __syncthreads();
#pragma unroll
        for (int j = 0; j < 2; ++j) {
            int k = (tid_ >> 4) + 32 * j, n4 = (tid_ & 15) * 4;
            float4 v = make_float4(0.f, 0.f, 0.f, 0.f);
            if (n0 + n4 < t.Nsrc) v = *(const float4*)(t.src + (size_t)(k0 + k) * t.lds + n0 + n4);
            sT[k][n4] = v.x; sT[k][n4 + 1] = v.y; sT[k][n4 + 2] = v.z; sT[k][n4 + 3] = v.w;
        }
        __syncthreads();
        {
            int n = tid_ >> 3, k8 = (tid_ & 7) * 8;
            ushort4 a, b;
            a.x = f2bf(sT[k8 + 0][n]); a.y = f2bf(sT[k8 + 1][n]); a.z = f2bf(sT[k8 + 2][n]); a.w = f2bf(sT[k8 + 3][n]);
            b.x = f2bf(sT[k8 + 4][n]); b.y = f2bf(sT[k8 + 5][n]); b.z = f2bf(sT[k8 + 6][n]); b.w = f2bf(sT[k8 + 7][n]);
            bf16_t* d = t.dst + (size_t)(n0 + n) * t.ldd + k0 + k8;
            *(ushort4*)d = a; *(ushort4*)(d + 4) = b;
        }
    }
    base += ntile;
}
__device__ __forceinline__ void ph_convert(const int wv_, unsigned char* smem, const Params& p, int layer) {
    PH_IDS();
    int base = 0;
    cvt_tiles(smem, CvtTask{p.w_in + (size_t)layer * DM * DIN, p.WinT, DIN, DM, DINP, DIN, DM}, base, tid_, bid_, nblk_);
    cvt_tiles(smem, CvtTask{p.w_gate + (size_t)layer * DM * 4096, p.WgT, 4096, DM, 4096, 4096, DM}, base, tid_, bid_, nblk_);
    for (int i = 0; i < 4; ++i)
        cvt_tiles(smem, CvtTask{p.w_branch + ((size_t)layer * 4 + i) * 256 * DM, p.WbrT + i * 256, DM, 256, DM, DM, DM}, base, tid_, bid_, nblk_);
    cvt_tiles(smem, CvtTask{p.w_out + (size_t)layer * DM * DM, p.WoT, DM, DM, DM, DM, DM}, base, tid_, bid_, nblk_);
}
__device__ __forceinline__ void ph_convert_experts(const int wv_, unsigned char* smem, const Params& p, int layer) {
    PH_IDS();
    int base = 0;
    for (int e = 0; e < NEXP; ++e) {
        for (int u = 0; u < 4; ++u) {
            cvt_tiles(smem, CvtTask{p.w_e_gate + ((size_t)layer * NEXP + e) * DM * DEXP + u * 128, p.WguT + ((size_t)e * 1024 + u * 256) * DM, DEXP, DM, 128, 128, DM}, base, tid_, bid_, nblk_);
            cvt_tiles(smem, CvtTask{p.w_e_up + ((size_t)layer * NEXP + e) * DM * DEXP + u * 128, p.WguT + ((size_t)e * 1024 + u * 256 + 128) * DM, DEXP, DM, 128, 128, DM}, base, tid_, bid_, nblk_);
        }
        cvt_tiles(smem, CvtTask{p.w_e_down + ((size_t)layer * NEXP + e) * DEXP * DM, p.WdT + (size_t)e * DM * DEXP, DM, DEXP, DM, DM, DEXP}, base, tid_, bid_, nblk_);
    }
}

namespace pg8 {
#define PG8_LAS __attribute__((address_space(3)))
typedef short bf16x8 __attribute__((ext_vector_type(8)));
typedef float f32x4 __attribute__((ext_vector_type(4)));
typedef unsigned u32x4 __attribute__((ext_vector_type(4)));
constexpr int BM = 256, BK = 64, HALF = 128, HTB = HALF * BK * 2, STAGE_BYTES = 8 * HTB, NXCD = 8, WGM = 8;
__host__ __device__ __forceinline__ int lds_byte(int r, int c) { const int st = (r >> 4) * 2 + (c >> 5), rr = r & 15, cc = c & 31, ob = rr * 64 + cc * 2; return st * 1024 + (ob ^ (((ob >> 9) & 1) << 5)); }
__host__ __device__ __forceinline__ void stage_rc(int b, int& R, int& C) { const int st = b / 1024, sb = b % 1024, swz = sb ^ (((sb >> 9) & 1) << 5); R = (st >> 1) * 16 + swz / 64; C = (st & 1) * 32 + (swz % 64) / 2; }
__host__ __device__ __forceinline__ int perm32(int rho) { const int n = rho >> 4, i = rho & 15; return 8 * (i >> 2) + 4 * n + (i & 3); }
struct Unit { int pm, pn, nt, kind; const char* a; const char* b; };
__device__ __forceinline__ void static_map(int L, int nM, int nN, int& pm, int& pn) {
    const int nwg = nM * nN; int wgid = L; { const int q = nwg / NXCD, r = nwg % NXCD, xcd = wgid % NXCD, off = wgid / NXCD; wgid = (xcd < r ? xcd * (q + 1) : r * (q + 1) + (xcd - r) * q) + off; }
    const int nig = WGM * nN, gid = wgid / nig, fm = gid * WGM, gsz = (nM - fm) < WGM ? (nM - fm) : WGM;
    pm = fm + ((wgid % nig) % gsz); pn = (wgid % nig) / gsz;
}
__device__ __forceinline__ unsigned cvt_pk_bf16(float lo, float hi) { return cvt_pk_bf16_(lo, hi); }

template <class Epi, class Sched>
__device__ __forceinline__ void gemm_phase(PG8_LAS unsigned char* lds, const int lda, const int ldb, const Sched& S, const Epi& E, int tid) {
    asm volatile("" : "+v"(tid));
    const int wid = __builtin_amdgcn_readfirstlane(tid >> 6), lane = tid & 63, wr = wid >> 2, wc = wid & 3, fr = lane & 15, fq = lane >> 4;
    unsigned voffA[2], voffB[2];
#pragma unroll
    for (int i = 0; i < 2; ++i) { int R, C; stage_rc(tid * 16 + i * 8192, R, C); const int Rb = Epi::PERM ? ((R & ~31) + perm32(R & 31)) : R;
        voffA[i] = (unsigned)(R * lda + C) * 2u; voffB[i] = (unsigned)(Rb * ldb + C) * 2u; }
    const size_t kstep = (size_t)(BK * 2);
    const size_t hstepA = (size_t)HALF * lda * 2, hstepB = (size_t)HALF * ldb * 2;
    const unsigned ldsw = (unsigned)wid * 1024u;
    const int aoff = lds_byte(wr * 64 + fr, fq * 8), boff = lds_byte(wc * 32 + fr, fq * 8);
#define PG8_SA(b, h) (((b) * 2 + (h)) * HTB)
#define PG8_SB(b, h) ((4 + (b) * 2 + (h)) * HTB)
#define PG8_STAGE(bufoff, gbase, voff) do { _Pragma("unroll") for (int _i = 0; _i < 2; ++_i) \
        __builtin_amdgcn_global_load_lds((const unsigned*)((const char*)(gbase) + (voff)[_i]), (PG8_LAS unsigned*)(lds + (bufoff) + ldsw + _i * 8192), 16, 0, 0); } while (0)
#define PG8_LDA(dst, b, h) do { _Pragma("unroll") for (int m = 0; m < 4; ++m) _Pragma("unroll") for (int k = 0; k < 2; ++k) dst[m][k] = *(const PG8_LAS bf16x8*)(lds + PG8_SA(b, h) + aoff + m * 2048 + k * 1024); } while (0)
#define PG8_LDB(dst, b, h) do { _Pragma("unroll") for (int n = 0; n < 2; ++n) _Pragma("unroll") for (int k = 0; k < 2; ++k) dst[n][k] = *(const PG8_LAS bf16x8*)(lds + PG8_SB(b, h) + boff + n * 2048 + k * 1024); } while (0)
#define PG8_MMA(ai, bj, At, Bt) do { __builtin_amdgcn_s_setprio(1); _Pragma("unroll") for (int m = 0; m < 4; ++m) _Pragma("unroll") for (int n = 0; n < 2; ++n) _Pragma("unroll") for (int k = 0; k < 2; ++k) \
        acc[ai][bj][m][n] = __builtin_amdgcn_mfma_f32_16x16x32_bf16(Bt[n][k], At[m][k], acc[ai][bj][m][n], 0, 0, 0); __builtin_amdgcn_s_setprio(0); } while (0)
#define PG8_WAIT_V(n) asm volatile("s_waitcnt vmcnt(" #n ")" ::: "memory")
#define PG8_WAIT_L(n) asm volatile("s_waitcnt lgkmcnt(" #n ")" ::: "memory")
#define PG8_BAR __builtin_amdgcn_s_barrier()
#define PG8_SCHED __builtin_amdgcn_sched_barrier(0)
    Unit cur, nxt; int ui = 0;
    if (!S.next(0, cur)) return;
    f32x4 acc[2][2][4][2];
#pragma unroll
    for (int a = 0; a < 2; ++a)
#pragma unroll
        for (int b = 0; b < 2; ++b)
#pragma unroll
            for (int m = 0; m < 4; ++m)
#pragma unroll
                for (int n = 0; n < 2; ++n) acc[a][b][m][n] = (f32x4){0.f, 0.f, 0.f, 0.f};
    bf16x8 At[4][2], B0[2][2], B1[2][2];
    const char* cA = cur.a; const char* cB = cur.b;
    PG8_STAGE(PG8_SB(0, 0), cB, voffB); PG8_STAGE(PG8_SA(0, 0), cA, voffA); PG8_STAGE(PG8_SB(0, 1), cB + hstepB, voffB); PG8_STAGE(PG8_SA(0, 1), cA + hstepA, voffA);
    if (wr == 1) PG8_BAR;
    PG8_WAIT_V(4); PG8_BAR;
    PG8_STAGE(PG8_SB(1, 0), cB + kstep, voffB); PG8_STAGE(PG8_SA(1, 0), cA + kstep, voffA); PG8_STAGE(PG8_SB(1, 1), cB + hstepB + kstep, voffB);
    PG8_WAIT_V(6); PG8_BAR;
    for (;;) {
        const bool has_next = S.next(ui + 1, nxt);
        const char* nA = has_next ? nxt.a : cA; const char* nB = has_next ? nxt.b : cB;
        const int nt = cur.nt;
        for (int t = 0; t < nt; t += 2) {
            const bool last = (t == nt - 2);
            const char* a1 = cA + (size_t)(t + 1) * kstep;
            const char* a2 = last ? nA : cA + (size_t)(t + 2) * kstep; const char* b2 = last ? nB : cB + (size_t)(t + 2) * kstep;
            const char* a3 = a2 + kstep; const char* b3 = b2 + kstep;
            PG8_LDB(B0, 0, 0); PG8_SCHED; PG8_LDA(At, 0, 0); PG8_STAGE(PG8_SA(1, 1), a1 + hstepA, voffA);
            PG8_WAIT_L(8); PG8_BAR; PG8_WAIT_L(0); PG8_MMA(0, 0, At, B0); PG8_BAR; PG8_SCHED;
            PG8_LDB(B1, 0, 1); PG8_STAGE(PG8_SB(0, 0), b2, voffB);
            PG8_BAR; PG8_WAIT_L(0); PG8_MMA(0, 1, At, B1); PG8_BAR;
            PG8_LDA(At, 0, 1); PG8_STAGE(PG8_SA(0, 0), a2, voffA);
            PG8_BAR; PG8_WAIT_L(0); PG8_MMA(1, 0, At, B0); PG8_BAR; PG8_SCHED;
            PG8_STAGE(PG8_SB(0, 1), b2 + hstepB, voffB);
            PG8_WAIT_V(6); PG8_BAR; PG8_MMA(1, 1, At, B1); PG8_BAR;
            PG8_LDB(B0, 1, 0); PG8_SCHED; PG8_LDA(At, 1, 0); PG8_STAGE(PG8_SA(0, 1), a2 + hstepA, voffA);
            PG8_WAIT_L(8); PG8_BAR; PG8_WAIT_L(0); PG8_MMA(0, 0, At, B0); PG8_BAR; PG8_SCHED;
            PG8_LDB(B1, 1, 1); PG8_STAGE(PG8_SB(1, 0), b3, voffB);
            PG8_BAR; PG8_WAIT_L(0); PG8_MMA(0, 1, At, B1); PG8_BAR;
            PG8_LDA(At, 1, 1); PG8_STAGE(PG8_SA(1, 0), a3, voffA);
            PG8_BAR; PG8_WAIT_L(0); PG8_MMA(1, 0, At, B0); PG8_BAR; PG8_SCHED;
            PG8_STAGE(PG8_SB(1, 1), b3 + hstepB, voffB);
            PG8_WAIT_V(6); PG8_BAR; PG8_MMA(1, 1, At, B1); PG8_BAR;
        }
        E(acc, cur, wr, wc, fr, fq, tid);
        if (!has_next) break;
#pragma unroll
        for (int a = 0; a < 2; ++a)
#pragma unroll
            for (int b = 0; b < 2; ++b)
#pragma unroll
                for (int m = 0; m < 4; ++m)
#pragma unroll
                    for (int n = 0; n < 2; ++n) acc[a][b][m][n] = (f32x4){0.f, 0.f, 0.f, 0.f};
        cur = nxt; cA = nA; cB = nB; ++ui;
    }
    PG8_WAIT_V(0);
    if (wr == 0) PG8_BAR;
    PG8_BAR;
#undef PG8_SA
#undef PG8_SB
#undef PG8_STAGE
#undef PG8_LDA
#undef PG8_LDB
#undef PG8_MMA
#undef PG8_WAIT_V
#undef PG8_WAIT_L
#undef PG8_BAR
#undef PG8_SCHED
}

struct SchedRows {
    const char* A; const char* Bt; int lda, ldb, nt, nN, nM, skip_ctx, G, c;
    __device__ __forceinline__ bool next(int i, Unit& u) const {
        const int L = i * G + c; if (L >= nM * nN) return false;
        int pmi, pn; static_map(L, nM, nN, pmi, pn);
        const int pm = skip_ctx ? (pmi >> 5) * 33 + 1 + (pmi & 31) : pmi;
        u.pm = pm; u.pn = pn; u.nt = nt; u.kind = 0;
        u.a = A + (size_t)pm * 256 * lda * 2; u.b = Bt + (size_t)pn * 256 * ldb * 2; return true;
    }
};
struct SchedMerge {
    const char* A; const char* Y; const char* WgT; const char* WbrT; int nM, skip_ctx, G, c;
    __device__ __forceinline__ bool next(int i, Unit& u) const {
        const int ch = (i >> 3) * G + c, sub = i & 7; if (ch >= nM * 4) return false;
        int pmi, pn; static_map(ch, nM, 4, pmi, pn);
        const int pm = skip_ctx ? (pmi >> 5) * 33 + 1 + (pmi & 31) : pmi, br = sub >> 1;
        u.pm = pm; u.pn = pn; u.kind = sub;
        if (sub & 1) { u.nt = 4;  u.a = Y + ((size_t)pm * 256 * DM + br * 256) * 2; u.b = WbrT + ((size_t)pn * 256 * DM + br * 256) * 2; }
        else         { u.nt = 16; u.a = A + (size_t)pm * 256 * DM * 2;              u.b = WgT + ((size_t)br * DM + pn * 256) * DM * 2; }
        return true;
    }
};
struct SchedMoe {
    const char* A; const char* Bt; const int* pe  ; int lda, ldb, nt, nN, G, c;
    __device__ __forceinline__ bool next(int i, Unit& u) const {
        const int nM = pe[16] >> 8; const int L = i * G + c; if (L >= nM * nN) return false;
        int pm, pn; static_map(L, nM, nN, pm, pn);
        int e = 0;
#pragma unroll
        for (int j = 0; j < 16; ++j) e += (pe[j] <= pm * 256) ? 1 : 0;
        if (e > 15) e = 15;
        u.pm = pm; u.pn = pn; u.nt = nt; u.kind = e;
        u.a = A + (size_t)pm * 256 * lda * 2; u.b = Bt + ((size_t)e * nN + pn) * 256 * ldb * 2; return true;
    }
};

struct EpiBf16 {
    static constexpr bool PERM = true;
    bf16_t* O; int ldc;
    __device__ __forceinline__ void operator()(const f32x4 (&acc)[2][2][4][2], const Unit& u, int wr, int wc, int fr, int fq, int tid) const {
        const int row0 = u.pm * BM + wr * 64 + fr, col0 = u.pn * BM + wc * 32 + 8 * fq;
#pragma unroll
        for (int ai = 0; ai < 2; ++ai)
#pragma unroll
            for (int m = 0; m < 4; ++m) { bf16_t* rowp = O + (size_t)(row0 + ai * HALF + m * 16) * ldc + col0;
#pragma unroll
                for (int bj = 0; bj < 2; ++bj) { const f32x4 v0 = acc[ai][bj][m][0], v1 = acc[ai][bj][m][1];
                    u32x4 w; w.x = cvt_pk_bf16(v0[0], v0[1]); w.y = cvt_pk_bf16(v0[2], v0[3]); w.z = cvt_pk_bf16(v1[0], v1[1]); w.w = cvt_pk_bf16(v1[2], v1[3]);
                    *(u32x4*)(rowp + bj * HALF) = w; } }
    }
};
struct EpiResidual {
    static constexpr bool PERM = false;
    float* hctx; float* out; const float* mod; int layer, modoff;
    __device__ __forceinline__ void operator()(const f32x4 (&acc)[2][2][4][2], const Unit& u, int wr, int wc, int fr, int fq, int tid) const {
        const int row0 = u.pm * BM + wr * 64 + fr, col0 = u.pn * BM + wc * 32 + 4 * fq;
        const int b = (u.pm * BM) / TJ; const bool isctx = (u.pm * BM - b * TJ) < NCTX;
        const float* md = mod + ((size_t)layer * 5 + (isctx ? 4 : b)) * (6 * DM) + modoff * DM + col0;
        f32x4 mv[2][2];
#pragma unroll
        for (int bj = 0; bj < 2; ++bj)
#pragma unroll
            for (int n = 0; n < 2; ++n) mv[bj][n] = *(const f32x4*)(md + bj * HALF + n * 16);
#pragma unroll
        for (int ai = 0; ai < 2; ++ai)
#pragma unroll
            for (int m = 0; m < 4; ++m) {
                const int r = row0 + ai * HALF + m * 16, tau = r - b * TJ;
                float* rowp = (isctx ? hctx + ((size_t)b * NCTX + tau) * DM : out + ((size_t)b * SEQ + (tau - NCTX)) * DM) + col0;
#pragma unroll
                for (int bj = 0; bj < 2; ++bj)
#pragma unroll
                    for (int n = 0; n < 2; ++n) { f32x4* q = (f32x4*)(rowp + bj * HALF + n * 16); *q = *q + mv[bj][n] * acc[ai][bj][m][n]; }
            }
    }
};
struct EpiMerge {
    static constexpr bool PERM = true;
    bf16_t* T; bf16_t* stash  ; const float* bgate;
    __device__ __forceinline__ void operator()(const f32x4 (&acc)[2][2][4][2], const Unit& u, int wr, int wc, int fr, int fq, int tid) const {
        const int br = u.kind >> 1;
        asm volatile("" : "+v"(tid));
        const unsigned soff = (unsigned)tid * 16u;
        if ((u.kind & 1) == 0) {
            const float* bg = bgate + br * DM + u.pn * BM + wc * 32 + 8 * fq;
            f32x4 bv[2][2];
#pragma unroll
            for (int bj = 0; bj < 2; ++bj)
#pragma unroll
                for (int n = 0; n < 2; ++n) bv[bj][n] = *(const f32x4*)(bg + bj * HALF + 4 * n);
#pragma unroll
            for (int ai = 0; ai < 2; ++ai)
#pragma unroll
                for (int m = 0; m < 4; ++m)
#pragma unroll
                    for (int bj = 0; bj < 2; ++bj) { f32x4 v0 = acc[ai][bj][m][0] + bv[bj][0], v1 = acc[ai][bj][m][1] + bv[bj][1];
#pragma unroll
                        for (int j = 0; j < 4; ++j) { v0[j] = sigmoidf_(v0[j]); v1[j] = sigmoidf_(v1[j]); }
                        u32x4 w; w.x = cvt_pk_bf16(v0[0], v0[1]); w.y = cvt_pk_bf16(v0[2], v0[3]); w.z = cvt_pk_bf16(v1[0], v1[1]); w.w = cvt_pk_bf16(v1[2], v1[3]);
                        *(u32x4*)((char*)stash + (soff + (unsigned)(((ai * 4 + m) * 2 + bj) * NTHR * 16))) = w; }
        } else {
            const int row0 = u.pm * BM + wr * 64 + fr, col0 = u.pn * BM + wc * 32 + 8 * fq;
#pragma unroll
            for (int ai = 0; ai < 2; ++ai)
#pragma unroll
                for (int m = 0; m < 4; ++m) { bf16_t* rowp = T + (size_t)(row0 + ai * HALF + m * 16) * DM + col0;
#pragma unroll
                    for (int bj = 0; bj < 2; ++bj) {
                        const u32x4 g = *(const u32x4*)((const char*)stash + (soff + (unsigned)(((ai * 4 + m) * 2 + bj) * NTHR * 16)));
                        f32x4 v0 = acc[ai][bj][m][0], v1 = acc[ai][bj][m][1];
                        v0[0] *= __uint_as_float(g.x << 16); v0[1] *= __uint_as_float(g.x & 0xffff0000u); v0[2] *= __uint_as_float(g.y << 16); v0[3] *= __uint_as_float(g.y & 0xffff0000u);
                        v1[0] *= __uint_as_float(g.z << 16); v1[1] *= __uint_as_float(g.z & 0xffff0000u); v1[2] *= __uint_as_float(g.w << 16); v1[3] *= __uint_as_float(g.w & 0xffff0000u);
                        if (br > 0) { const u32x4 o = *(const u32x4*)(rowp + bj * HALF);
                            v0[0] += __uint_as_float(o.x << 16); v0[1] += __uint_as_float(o.x & 0xffff0000u); v0[2] += __uint_as_float(o.y << 16); v0[3] += __uint_as_float(o.y & 0xffff0000u);
                            v1[0] += __uint_as_float(o.z << 16); v1[1] += __uint_as_float(o.z & 0xffff0000u); v1[2] += __uint_as_float(o.w << 16); v1[3] += __uint_as_float(o.w & 0xffff0000u); }
                        u32x4 w; w.x = cvt_pk_bf16(v0[0], v0[1]); w.y = cvt_pk_bf16(v0[2], v0[3]); w.z = cvt_pk_bf16(v1[0], v1[1]); w.w = cvt_pk_bf16(v1[2], v1[3]);
                        *(u32x4*)(rowp + bj * HALF) = w; } }
        }
    }
};
struct EpiSwiGlu {
    static constexpr bool PERM = true;
    bf16_t* H;
    __device__ __forceinline__ void operator()(const f32x4 (&acc)[2][2][4][2], const Unit& u, int wr, int wc, int fr, int fq, int tid) const {
        const int row0 = u.pm * BM + wr * 64 + fr, col0 = u.pn * HALF + wc * 32 + 8 * fq;
#pragma unroll
        for (int ai = 0; ai < 2; ++ai)
#pragma unroll
            for (int m = 0; m < 4; ++m) {
                f32x4 v0 = acc[ai][0][m][0], v1 = acc[ai][0][m][1]; const f32x4 u0 = acc[ai][1][m][0], u1 = acc[ai][1][m][1];
#pragma unroll
                for (int j = 0; j < 4; ++j) { v0[j] = siluf_(v0[j]) * u0[j]; v1[j] = siluf_(v1[j]) * u1[j]; }
                u32x4 w; w.x = cvt_pk_bf16(v0[0], v0[1]); w.y = cvt_pk_bf16(v0[2], v0[3]); w.z = cvt_pk_bf16(v1[0], v1[1]); w.w = cvt_pk_bf16(v1[2], v1[3]);
                *(u32x4*)(H + (size_t)(row0 + ai * HALF + m * 16) * DEXP + col0) = w;
            }
    }
};
}

#define STAGE_OFF 1024
__device__ __forceinline__ void ph_gemm_inproj(const int wv_, unsigned char* smem, const Params& p) {
    PH_IDS();
    pg8::SchedRows S{(const char*)p.A, (const char*)p.WinT, DM, DM, DM / 64, DINP / 256, NTOK / 256, 0, nblk_, bid_};
    pg8::gemm_phase((PG8_LAS unsigned char*)(smem + STAGE_OFF), DM, DM, S, pg8::EpiBf16{p.P, DINP}, tid_);
}
__device__ __forceinline__ void ph_gemm_merge(const int wv_, unsigned char* smem, const Params& p, int layer, int last) {
    PH_IDS();
    pg8::SchedMerge S{(const char*)p.A, (const char*)p.Y, (const char*)p.WgT, (const char*)p.WbrT, last ? NB * 32 : NTOK / 256, last, nblk_, bid_};
    pg8::gemm_phase((PG8_LAS unsigned char*)(smem + STAGE_OFF), DM, DM, S, pg8::EpiMerge{p.T, p.STASH + (size_t)bid_ * 65536, p.b_gate + layer * 4096}, tid_);
}
__device__ __forceinline__ void ph_gemm_wout(const int wv_, unsigned char* smem, const Params& p, int layer, int last) {
    PH_IDS();
    pg8::SchedRows S{(const char*)p.T, (const char*)p.WoT, DM, DM, DM / 64, DM / 256, last ? NB * 32 : NTOK / 256, last, nblk_, bid_};
    pg8::gemm_phase((PG8_LAS unsigned char*)(smem + STAGE_OFF), DM, DM, S, pg8::EpiResidual{p.hctx, p.out, p.mod, layer, 2}, tid_);
}
__device__ __forceinline__ void moe_pad_to_lds(unsigned char* smem, const Params& p, int tid_) {
    __syncthreads();
    if (tid_ < 17) ((int*)(smem + 64))[tid_] = p.cnt[16 + tid_];
    __syncthreads();
}
__device__ __forceinline__ void ph_gemm_moe_up(const int wv_, unsigned char* smem, const Params& p) {
    PH_IDS();
    moe_pad_to_lds(smem, p, tid_);
    pg8::SchedMoe S{(const char*)p.BUF, (const char*)p.WguT, (const int*)(smem + 64), DM, DM, DM / 64, 4, nblk_, bid_};
    pg8::gemm_phase((PG8_LAS unsigned char*)(smem + STAGE_OFF), DM, DM, S, pg8::EpiSwiGlu{p.HID}, tid_);
}
__device__ __forceinline__ void ph_gemm_moe_down(const int wv_, unsigned char* smem, const Params& p) {
    PH_IDS();
    moe_pad_to_lds(smem, p, tid_);
    pg8::SchedMoe S{(const char*)p.HID, (const char*)p.WdT, (const int*)(smem + 64), DEXP, DEXP, DEXP / 64, 4, nblk_, bid_};
    pg8::gemm_phase((PG8_LAS unsigned char*)(smem + STAGE_OFF), DEXP, DEXP, S, pg8::EpiBf16{p.PO, DM}, tid_);
}

#define LDS_BYTES (152 * 1024)
typedef const __attribute__((address_space(4))) unsigned long long* KArgPtr;
__device__ __forceinline__ Params ldparams() {
    KArgPtr q = (KArgPtr)__builtin_amdgcn_kernarg_segment_ptr(); asm volatile("" : "+s"(q));
    Params r; unsigned long long* d = (unsigned long long*)&r;
#pragma unroll
    for (int i = 0; i < (int)(sizeof(Params) / 8); ++i) d[i] = q[i];
    return r;
}
#define PHASE(call) do { const Params p = ldparams(); call; } while (0)

#define GRID_SYNC() do { int t0_ = wv * 64 + (int)__builtin_amdgcn_mbcnt_hi(~0u, __builtin_amdgcn_mbcnt_lo(~0u, 0u)); asm volatile("" : "+v"(t0_)); \
    XcdBarrier b_; b_.bar = ldparams().bar; b_.x = xb_xcc_id(); b_.st = (volatile LAS unsigned*)smem; xcd_barrier_(b_, t0_); } while (0)
__global__ __launch_bounds__(NTHR, 2) void k_mega(Params p_unused) {
    extern __shared__ __attribute__((aligned(16))) unsigned char smem[];
    int wv = __builtin_amdgcn_readfirstlane(threadIdx.x >> 6); asm volatile("" : "+s"(wv));
    if (threadIdx.x == 0) *(uint4*)smem = make_uint4(0u, 0u, 0u, 0u);
    __syncthreads();
    (void)xcd_barrier_post(ldparams().bar, (volatile LAS unsigned*)smem);
    PHASE(ph_mod(wv, smem, p));
    PHASE(ph_convert(wv, smem, p, 0));
    PHASE(ph_s5_prep(wv, smem, p, 0));
    GRID_SYNC();
    for (int l = 0; l < NLAYER; ++l) {
        const int last = (l == NLAYER - 1);
        PHASE(ph_norm1(wv, p, l));
        if (l > 0) { PHASE(ph_convert(wv, smem, p, l)); PHASE(ph_s5_prep(wv, smem, p, l)); }
        GRID_SYNC();
        PHASE(ph_gemm_inproj(wv, smem, p));
        GRID_SYNC();
#if PROBE_DUP == 4
        PHASE(ph_gemm_inproj(wv, smem, p));
        GRID_SYNC();
#endif
        PHASE(ph_attn_prep(wv, smem, p, l));
        PHASE(ph_gla1(wv, smem, p, l));
        PHASE(ph_s5_1(wv, p, l));
        PHASE(ph_dn_prep(wv, smem, p, l));
        GRID_SYNC();
#if PROBE_DUP == 7
        PHASE(ph_gla1(wv, smem, p, l));
        PHASE(ph_s5_1(wv, p, l));
        GRID_SYNC();
#endif
        PHASE(ph_scans(wv, smem, p, l));
        PHASE(ph_attn(wv, smem, p, l));
        PHASE(ph_wait_scans(wv, p));
        PHASE(ph_s5_3(wv, smem, p, l));
        PHASE(ph_gla3(wv, smem, p, l));
        GRID_SYNC();
#if PROBE_DUP == 1
        PHASE(ph_scans_dn_only(wv, smem, p, l));
        PHASE(ph_attn(wv, smem, p, l));
        GRID_SYNC();
#elif PROBE_DUP == 2
        PHASE(ph_attn(wv, smem, p, l));
        GRID_SYNC();
#elif PROBE_DUP == 3
        PHASE(ph_scans_dn_only(wv, smem, p, l));
        GRID_SYNC();
#endif
        PHASE(ph_finish(wv, smem, p, l));
        GRID_SYNC();
        PHASE(ph_gemm_merge(wv, smem, p, l, last));
        GRID_SYNC();
#if PROBE_DUP == 5
        PHASE(ph_gemm_merge(wv, smem, p, l, last));
        GRID_SYNC();
#endif
        PHASE(ph_gemm_wout(wv, smem, p, l, last));
        GRID_SYNC();
        PHASE(ph_convert_experts(wv, smem, p, l));
        PHASE(ph_norm2_route(wv, smem, p, l));
        GRID_SYNC();
        PHASE(ph_moe_gather(wv, smem, p, l));
        GRID_SYNC();
#if PROBE_DUP == 8
        PHASE(ph_moe_gather(wv, smem, p, l));
        GRID_SYNC();
#endif
        PHASE(ph_gemm_moe_up(wv, smem, p));
        GRID_SYNC();
#if PROBE_DUP == 6
        PHASE(ph_gemm_moe_up(wv, smem, p));
        GRID_SYNC();
#endif
        PHASE(ph_gemm_moe_down(wv, smem, p));
        GRID_SYNC();
#if PROBE_DUP == 6
        PHASE(ph_gemm_moe_down(wv, smem, p));
        GRID_SYNC();
#endif
        PHASE(ph_moe_combine(wv, p, l));
        GRID_SYNC();
    }
}

static inline size_t al(size_t x) { return (x + 255) & ~(size_t)255; }

extern "C" void kernel_launch(void* const* d_in, const int* in_sizes, int n_in, void* d_out, int out_size, void* d_ws, size_t ws_size, hipStream_t stream) {
    Params p{};
    const float** ins = (const float**)d_in;
    p.x = ins[0]; p.c = ins[1]; p.ctx = ins[2]; p.c_ctx = ins[3]; p.w_mod = ins[4]; p.b_mod = ins[5]; p.norm1_g = ins[6]; p.norm2_g = ins[7]; p.w_in = ins[8];
    p.dn_conv = ins[9]; p.dn_a_log = ins[10]; p.dn_dt_bias = ins[11]; p.dn_norm_g = ins[12];
    p.s5_a_re = ins[13]; p.s5_a_im = ins[14]; p.s5_log_dt = ins[15]; p.s5_b_re = ins[16]; p.s5_b_im = ins[17]; p.s5_c_re = ins[18]; p.s5_c_im = ins[19]; p.s5_d = ins[20]; p.s5_glu_w = ins[21]; p.s5_glu_b = ins[22];
    p.da_lambda = ins[23]; p.da_norm_g = ins[24]; p.gla_w_gate = ins[25]; p.gla_b_gate = ins[26]; p.gla_norm_g = ins[27];
    p.w_branch = ins[28]; p.w_gate = ins[29]; p.b_gate = ins[30]; p.w_out = ins[31]; p.w_router = ins[32]; p.b_router = ins[33];
    p.w_e_gate = ins[34]; p.w_e_up = ins[35]; p.w_e_down = ins[36]; p.final_g = ins[37];
    p.out = (float*)d_out;
    char* ws = (char*)d_ws; size_t off = 0;
    auto take = [&](size_t bytes) { char* q = ws + off; off += al(bytes); return q; };
    p.bar = (unsigned*)take((size_t)XCD_BAR_WORDS * 4);
    p.cnt = (int*)take(256 * 4);
    p.kmax = (unsigned*)take(256);
    p.mod = (float*)take((size_t)NLAYER * 5 * 6 * DM * 4);
    p.hctx = (float*)take((size_t)NB * NCTX * DM * 4);
    p.tok_e = (int*)take((size_t)NTOK * 2 * 4); p.tok_w = (float*)take((size_t)NTOK * 2 * 4); p.tok_pos = (int*)take((size_t)NTOK * 2 * 4); p.tok_slot = (int*)take((size_t)NTOK * 2 * 4);
    p.WinT = (bf16_t*)take((size_t)DINP * DM * 2); p.WgT = (bf16_t*)take((size_t)4096 * DM * 2); p.WbrT = (bf16_t*)take((size_t)DM * DM * 2); p.WoT = (bf16_t*)take((size_t)DM * DM * 2);
    p.SB = (bf16_t*)take((size_t)16 * 256 * 512 * 2); p.SE = (bf16_t*)take((size_t)16 * 256 * 256 * 2); p.GLUt = (bf16_t*)take((size_t)65536 * 2); p.A16 = (float*)take((size_t)2 * 16 * 64 * 2 * 4);
    p.A = (bf16_t*)take((size_t)NTOK * DM * 2);
    p.Y = (bf16_t*)take((size_t)NTOK * DM * 2);
    char* big = ws + off;
    p.P = (bf16_t*)take((size_t)NTOK * DINP * 2);
    char* ms = ws + off;
    p.WguT = (bf16_t*)(ms + ((size_t)16 << 20)); p.WdT = (bf16_t*)(ms + ((size_t)16 << 20) + (size_t)NEXP * 1024 * DM * 2);
    p.Qr = (bf16_t*)take((size_t)16 * TJ * 64 * 2); p.Kr = (bf16_t*)take((size_t)16 * TJ * 64 * 2); p.Vt = (bf16_t*)take((size_t)16 * 132 * 4096 * 2); p.Qn = (float*)take((size_t)16 * TJ * 2 * 4);
    p.ODN = (bf16_t*)take((size_t)NTOK * 256 * 2);
    p.QKVN = (bf16_t*)take((size_t)NTOK * 768 * 2);
    p.XS = (bf16_t*)take((size_t)NB * S5NS * 16 * 256 * 2);
    p.GST = (bf16_t*)take((size_t)32 * (TJ / 64) * 2048 * 2); p.DCY = (float*)take((size_t)32 * (TJ / 64) * 32 * 4);
    p.T = (bf16_t*)big;
    p.STASH = (bf16_t*)(big + al((size_t)NTOK * DM * 2));
    p.BUF = (bf16_t*)big; p.PO = (bf16_t*)big;
    p.HID = (bf16_t*)(big + al((size_t)MAXSLOT * DM * 2));
    if (off > ws_size) return;

    static int grid = 0;
    if (!grid) {
        int dev = 0, cus = 0, per_cu = 0;
        (void)hipGetDevice(&dev);
        (void)hipDeviceGetAttribute(&cus, hipDeviceAttributeMultiprocessorCount, dev);
        (void)hipFuncSetAttribute((const void*)k_mega, hipFuncAttributeMaxDynamicSharedMemorySize, LDS_BYTES);
        (void)hipOccupancyMaxActiveBlocksPerMultiprocessor(&per_cu, (const void*)k_mega, NTHR, LDS_BYTES);
        grid = per_cu >= 1 ? cus : 0;
    }
    if (!grid) return;
    (void)hipMemsetAsync(p.bar, 0, (size_t)XCD_BAR_WORDS * 4, stream);
    k_mega<<<grid, NTHR, LDS_BYTES, stream>>>(p);
}

#endif
```

```cpp
#ifndef EMU
#include <hip/hip_runtime.h>
#include <stdint.h>
#define OPQV(x) asm volatile("" : "+v"(x))
#define OPQS(x) asm volatile("" : "+s"(x))
#define WAVE_LDS_FENCE() asm volatile("s_waitcnt lgkmcnt(0)" ::: "memory")
#endif

typedef unsigned short bf16_t;

#define DM 1024
#define NB 4
#ifndef SEQ
#define SEQ 8192
#endif
#define NCTX 256
#define TJ (SEQ + NCTX)
#define NTOK (NB * TJ)
#define DIN 2864
#define DINP 3072
#define NEXP 16
#define DEXP 512
#define NLAYER 2
#define C_DNQ 0
#define C_DNK 256
#define C_DNV 512
#define C_DNZ 768
#define C_DNA 1024
#define C_DNB 1032
#define C_S5U 1040
#define C_DAQ 1296
#define C_DAK 1552
#define C_DAV 1808
#define C_GLQ 2064
#define C_GLK 2192
#define C_GLV 2320
#define C_GLR 2576
#define C_GLG 2832

#define MAXSLOT (2 * NTOK + NEXP * 256)

__device__ __forceinline__ float bf2f(bf16_t v) { return __uint_as_float(((unsigned)v) << 16); }
__device__ __forceinline__ bf16_t f2bf(float f) { unsigned u = __float_as_uint(f); u += 0x7FFFu + ((u >> 16) & 1u); return (bf16_t)(u >> 16); }
#ifdef EMU
__device__ __forceinline__ float frcp_(float x) { return 1.0f / x; }
#else
__device__ __forceinline__ float frcp_(float x) { return __builtin_amdgcn_rcpf(x); }
#endif
__device__ __forceinline__ float sigmoidf_(float x) { return frcp_(1.0f + __expf(-x)); }
__device__ __forceinline__ float siluf_(float x) { return x * frcp_(1.0f + __expf(-x)); }
__device__ __forceinline__ float softplusf_(float x) { return x > 20.f ? x : log1pf(expf(x)); }
__device__ __forceinline__ float logsigmoidf_(float x) { return fminf(x, 0.f) - __logf(1.0f + __expf(-fabsf(x))); }
__device__ __forceinline__ float gelu_tanh(float x) { const float k = 0.7978845608028654f; float u = k * (x + 0.044715f * x * x * x); return x * frcp_(1.0f + __expf(-2.0f * u)); }
__device__ __forceinline__ float wave_sum(float v) {
#pragma unroll
    for (int o = 32; o >= 1; o >>= 1) v += __shfl_xor(v, o, 64);
    return v;
}
__device__ __forceinline__ float rdlane(float v, int l) { return __int_as_float(__builtin_amdgcn_readlane(__float_as_int(v), l)); }

typedef float f32x16 __attribute__((ext_vector_type(16)));
#ifndef EMU
typedef __bf16 bfx8 __attribute__((ext_vector_type(8)));
typedef __bf16 bf16x2_t_ __attribute__((ext_vector_type(2)));
typedef float f32x2_t_ __attribute__((ext_vector_type(2)));
__device__ __forceinline__ unsigned cvt_pk_bf16_(float lo, float hi) { f32x2_t_ f = {lo, hi}; bf16x2_t_ b = __builtin_convertvector(f, bf16x2_t_); return *(unsigned*)&b; }
#endif

struct Params {
    const float *x, *c, *ctx, *c_ctx, *w_mod, *b_mod, *norm1_g, *norm2_g, *w_in, *dn_conv, *dn_a_log, *dn_dt_bias, *dn_norm_g;
    const float *s5_a_re, *s5_a_im, *s5_log_dt, *s5_b_re, *s5_b_im, *s5_c_re, *s5_c_im, *s5_d, *s5_glu_w, *s5_glu_b;
    const float *da_lambda, *da_norm_g, *gla_w_gate, *gla_b_gate, *gla_norm_g, *w_branch, *w_gate, *b_gate, *w_out;
    const float *w_router, *b_router, *w_e_gate, *w_e_up, *w_e_down, *final_g;
    float* out;
    float* mod;
    float* hctx;
    bf16_t* A;
    bf16_t* P;
    bf16_t* Y;
    bf16_t* Qr;
    bf16_t* Kr;
    bf16_t* Vt;
    float* Qn;
    unsigned* kmax;
    bf16_t* QKVN;
    bf16_t* ODN;
    bf16_t* OS5;
    bf16_t* XS;
    bf16_t* SB;
    bf16_t* SE;
    bf16_t* GLUt;
    float* A16;
    bf16_t* OGLA;
    bf16_t* GST;
    float* DCY;
    bf16_t* T;
    bf16_t* STASH;
    bf16_t *WinT, *WgT, *WbrT, *WoT, *WguT, *WdT;
    bf16_t* BUF;
    bf16_t* HID;
    bf16_t* PO;
    unsigned* bar;
    int* cnt;
    int* tok_e;
    float* tok_w;
    int* tok_pos;
    int* tok_slot;
};

__device__ __forceinline__ float* hrow(const Params& p, int r) {
    int b = r / TJ, tau = r - b * TJ;
    return tau < NCTX ? p.hctx + ((size_t)b * NCTX + tau) * DM : p.out + ((size_t)b * SEQ + (tau - NCTX)) * DM;
}
__device__ __forceinline__ const float* modrow(const Params& p, int layer, int r) {
    int b = r / TJ, tau = r - b * TJ;
    return p.mod + ((size_t)layer * 5 + (tau < NCTX ? 4 : b)) * (6 * DM);
}


#ifndef EMU
#define XB_TMO      128
#define XB_XCNT(j)  (256  + 64 * (j))
#define XB_XSUB(j)  (1280 + 64 * (j))
#define XB_XGEN(j)  (2304 + 64 * (j))
#define XB_TOP      3328
#define XB_TOPGEN   3392
#define XCD_BAR_WORDS 3456
#define XB_SPIN_CAP (1u << 18)
#define LAS __attribute__((address_space(3)))
__device__ __forceinline__ unsigned xb_ld(unsigned* p)              { return __hip_atomic_load(p, __ATOMIC_RELAXED, __HIP_MEMORY_SCOPE_AGENT); }
__device__ __forceinline__ unsigned xb_add(unsigned* p, unsigned v) { return __hip_atomic_fetch_add(p, v, __ATOMIC_RELAXED, __HIP_MEMORY_SCOPE_AGENT); }
__device__ __forceinline__ unsigned xb_xcc_id() { return (unsigned)__builtin_amdgcn_s_getreg((3 << 11) | 20) & 0xFu; }
#define XB_SPIN(cond, bar) do { unsigned _sp = 0; while (cond) { __builtin_amdgcn_s_sleep(1); \
    if ((++_sp & 255u) == 0u) { if (xb_ld(&(bar)[XB_TMO])) break; if (_sp > XB_SPIN_CAP) { atomicAdd(&(bar)[XB_TMO], 1u); break; } } } } while (0)
struct XcdBarrier { unsigned* bar; unsigned x; volatile LAS unsigned* st; };
__device__ __forceinline__ XcdBarrier xcd_barrier_post(unsigned* bar, volatile LAS unsigned* st) {
    XcdBarrier b; b.bar = bar; b.x = xb_xcc_id(); b.st = st;
    if (threadIdx.x == 0) (void)xb_add(&bar[XB_XCNT(b.x)], 1u);
    return b;
}
__device__ __forceinline__ void xcd_barrier_complete(unsigned* bar, unsigned x, unsigned& nloc, unsigned& nx) {
    const unsigned G = gridDim.x * gridDim.y * gridDim.z;
    unsigned sum, cnt, mine, sp = 0u;
    for (;;) {
        sum = 0u; cnt = 0u; mine = 0u;
#pragma unroll
        for (unsigned j = 0; j < 16; ++j) { const unsigned c = xb_ld(&bar[XB_XCNT(j)]); sum += c; cnt += (c > 0u) ? 1u : 0u; mine = (j == x) ? c : mine; }
        if (sum == G) break;
        __builtin_amdgcn_s_sleep(1);
        if ((++sp & 255u) == 0u) { if (xb_ld(&bar[XB_TMO])) break; if (sp > XB_SPIN_CAP) { atomicAdd(&bar[XB_TMO], 1u); break; } }
    }
    nloc = mine > 0u ? mine : 1u; nx = cnt > 0u ? cnt : 1u;
}
__device__ __forceinline__ void xcd_barrier_(const XcdBarrier& b, const int tid0) {
    asm volatile("s_waitcnt vmcnt(0)" ::: "memory");
    __syncthreads();
    if (tid0 == 0) {
        unsigned* bar = b.bar;
        __builtin_amdgcn_s_waitcnt(0);
        unsigned nloc = b.st[0], nx = b.st[1];
        if (nloc == 0u) { xcd_barrier_complete(bar, b.x, nloc, nx); b.st[0] = nloc; b.st[1] = nx; }
        const unsigned old = xb_add(&bar[XB_XSUB(b.x)], 1u);
        const unsigned gen = old / nloc;
        if (old + 1u == (gen + 1u) * nloc) {
            __builtin_amdgcn_fence(__ATOMIC_RELEASE, "agent");
            asm volatile("s_waitcnt vmcnt(0)" ::: "memory");
            const unsigned og = xb_add(&bar[XB_TOP], 1u);
            const unsigned tg = og / nx;
            if (og + 1u == (tg + 1u) * nx) xb_add(&bar[XB_TOPGEN], 1u);
            else XB_SPIN(xb_ld(&bar[XB_TOPGEN]) == tg, bar);
            __builtin_amdgcn_fence(__ATOMIC_ACQUIRE, "agent");
            xb_add(&bar[XB_XGEN(b.x)], 1u);
            asm volatile("s_waitcnt vmcnt(0)" ::: "memory");
        } else {
            XB_SPIN(xb_ld(&bar[XB_XGEN(b.x)]) == gen, bar);
            __builtin_amdgcn_fence(__ATOMIC_ACQUIRE, "agent");
            asm volatile("s_waitcnt vmcnt(0)" ::: "memory");
        }
    }
    __syncthreads();
}

#endif
#ifndef PROBE_DUP
#define PROBE_DUP 0
#endif
#define NTHR 512
#define NWV 8
#define PH_IDS() int tid_ = wv_ * 64 + (int)__builtin_amdgcn_mbcnt_hi(~0u, __builtin_amdgcn_mbcnt_lo(~0u, 0u)); OPQV(tid_); int bid_ = blockIdx.x; OPQS(bid_); int nblk_ = gridDim.x; OPQS(nblk_); (void)tid_; (void)bid_; (void)nblk_
#define GWV (nblk_ * NWV)
#define WID (bid_ * NWV + (tid_ >> 6))

__device__ __forceinline__ void ph_mod(const int wv_, unsigned char* smem, const Params& p) {
    PH_IDS();
    float* sc = (float*)(smem + 1024);
    float* part = sc + 5 * DM;
    for (int i = tid_; i < 5 * DM; i += NTHR) { const int v = i >> 10, k = i & (DM - 1); sc[i] = siluf_(v < 4 ? p.c[v * DM + k] : p.c_ctx[k]); }
    __syncthreads();
    const int ksl = tid_ >> 6, cl = tid_ & 63;
    for (int item = bid_; item < NLAYER * 6 * DM / 64; item += nblk_) {
        const int l = item / (6 * DM / 64), col = (item - l * (6 * DM / 64)) * 64 + cl;
        const float* w = p.w_mod + (size_t)l * DM * 6 * DM + (size_t)ksl * 128 * 6 * DM + col;
        float a0 = 0.f, a1 = 0.f, a2 = 0.f, a3 = 0.f, a4 = 0.f;
#pragma unroll 8
        for (int k = 0; k < 128; ++k) { const float wv2 = w[(size_t)k * 6 * DM]; const int kk = ksl * 128 + k; a0 += sc[kk] * wv2; a1 += sc[DM + kk] * wv2; a2 += sc[2 * DM + kk] * wv2; a3 += sc[3 * DM + kk] * wv2; a4 += sc[4 * DM + kk] * wv2; }
        __syncthreads();
        part[(ksl * 5 + 0) * 64 + cl] = a0; part[(ksl * 5 + 1) * 64 + cl] = a1; part[(ksl * 5 + 2) * 64 + cl] = a2; part[(ksl * 5 + 3) * 64 + cl] = a3; part[(ksl * 5 + 4) * 64 + cl] = a4;
        __syncthreads();
        if (tid_ < 320) { const int v = tid_ >> 6; float acc = p.b_mod[l * 6 * DM + col];
#pragma unroll
            for (int q = 0; q < 8; ++q) acc += part[(q * 5 + v) * 64 + cl];
            p.mod[((size_t)l * 5 + v) * 6 * DM + col] = acc; }
    }
}

__device__ __forceinline__ void ph_norm1(const int wv_, const Params& p, int layer) {
    PH_IDS();
    int lane = tid_ & 63;
    if (bid_ == 0 && tid_ < 64) { p.cnt[tid_] = 0; if (tid_ < 32) p.kmax[tid_] = 0u; if (tid_ < 8) p.cnt[128 + tid_] = 0; }
    for (int r = WID; r < NTOK; r += GWV) {
        int b = r / TJ, tau = r - b * TJ;
        float* h = hrow(p, r);
        const float* src = h;
        if (layer == 0) src = tau < NCTX ? p.ctx + ((size_t)b * NCTX + tau) * DM : p.x + ((size_t)b * SEQ + (tau - NCTX)) * DM;
        const float* md = modrow(p, layer, r);
        float4 v[4]; float ss = 0.f;
#pragma unroll
        for (int i = 0; i < 4; ++i) { v[i] = *(const float4*)(src + i * 256 + lane * 4); ss += v[i].x * v[i].x + v[i].y * v[i].y + v[i].z * v[i].z + v[i].w * v[i].w; }
        ss = wave_sum(ss);
        float rs = rsqrtf(ss * (1.0f / DM) + 1e-6f);
        const float* g = p.norm1_g + layer * DM;
#pragma unroll
        for (int i = 0; i < 4; ++i) {
            int c0 = i * 256 + lane * 4;
            if (layer == 0) *(float4*)(h + c0) = v[i];
            float4 gg = *(const float4*)(g + c0), sh = *(const float4*)(md + c0), sc = *(const float4*)(md + DM + c0);
            float o0 = v[i].x * rs * gg.x * (1.f + sc.x) + sh.x, o1 = v[i].y * rs * gg.y * (1.f + sc.y) + sh.y;
            float o2 = v[i].z * rs * gg.z * (1.f + sc.z) + sh.z, o3 = v[i].w * rs * gg.w * (1.f + sc.w) + sh.w;
            ushort4 ob; ob.x = f2bf(o0); ob.y = f2bf(o1); ob.z = f2bf(o2); ob.w = f2bf(o3);
            *(ushort4*)(p.A + (size_t)r * DM + c0) = ob;
        }
    }
}

struct EpiStoreBf16 { bf16_t* C; int ldc; __device__ void operator()(int r, int c, float v) const { C[(size_t)r * ldc + c] = f2bf(v); } };
struct EpiSigmoidBias { bf16_t* C; const float* bias; int ldc; __device__ void operator()(int r, int c, float v) const { C[(size_t)r * ldc + c] = f2bf(sigmoidf_(v + bias[c])); } };
struct EpiGateAcc { bf16_t* T; const bf16_t* G; int i; __device__ void operator()(int r, int c, float v) const {
    float g = bf2f(G[(size_t)r * 4096 + i * DM + c]); float t = g * v; if (i > 0) t += bf2f(T[(size_t)r * DM + c]); T[(size_t)r * DM + c] = f2bf(t); } };
struct EpiResid { float* hctx; float* out; const float* mod; int layer; int modoff; __device__ void operator()(int r, int c, float v) const {
    int b = r / TJ, tau = r - b * TJ;
    float* h = tau < NCTX ? hctx + ((size_t)b * NCTX + tau) * DM : out + ((size_t)b * SEQ + (tau - NCTX)) * DM;
    const float* md = mod + ((size_t)layer * 5 + (tau < NCTX ? 4 : b)) * (6 * DM);
    h[c] += md[modoff * DM + c] * v; } };
struct EpiSiluMul { bf16_t* H; __device__ void operator()(int r, int c, float v) const { float g = bf2f(H[(size_t)r * DEXP + c]); H[(size_t)r * DEXP + c] = f2bf(siluf_(g) * v); } };

template <class Epi>
__device__ __forceinline__ void ph_gemm_naive(const int wv_, unsigned char* smem, const bf16_t* A, int lda, const float* W0, int ldw, int M, int N, int K, const Epi& epi, const int* grp, size_t wstride, int skip_ctx) {
    PH_IDS();
    const int half = tid_ >> 8, tid = tid_ & 255, tx = tid & 15, ty = tid >> 4;
    float (*sA)[68] = (float (*)[68])(smem + 64 + half * 8704);
    float (*sB)[68] = (float (*)[68])(smem + 64 + half * 8704 + 4352);
    const int ntn = (N + 63) / 64, ntiles = (M / 64) * ntn;
    for (int t0 = bid_ * 2; t0 < ntiles; t0 += nblk_ * 2) {
        const int t = t0 + half;
        bool active = t < ntiles;
        int bm = active ? (t / ntn) * 64 : 0, bn = active ? (t % ntn) * 64 : 0;
        const float* W = W0;
        if (grp && active) {
            if (bm >= grp[32]) active = false;
            int e = 0;
            for (int i = 0; i < 16; ++i) e += (grp[16 + i] <= bm) ? 1 : 0;
            if (e > 15) e = 15;
            W += (size_t)e * wstride;
        }
        if (skip_ctx && (bm % TJ) < NCTX) active = false;
        float acc[4][4] = {};
        for (int k0 = 0; k0 < K; k0 += 16) {
            if (active) {
                int r = tid >> 2, kk = (tid & 3) * 4;
                ushort4 a = *(const ushort4*)(A + (size_t)(bm + r) * lda + k0 + kk);
                sA[kk + 0][r] = bf2f(a.x); sA[kk + 1][r] = bf2f(a.y); sA[kk + 2][r] = bf2f(a.z); sA[kk + 3][r] = bf2f(a.w);
                int kr = tid >> 4, cc = (tid & 15) * 4;
#pragma unroll
                for (int j = 0; j < 4; ++j) { int col = bn + cc + j; sB[kr][cc + j] = col < N ? W[(size_t)(k0 + kr) * ldw + col] : 0.f; }
            }
            __syncthreads();
            if (active) {
#pragma unroll
                for (int kk = 0; kk < 16; ++kk) {
                    float a[4], b[4];
#pragma unroll
                    for (int i = 0; i < 4; ++i) { a[i] = sA[kk][ty * 4 + i]; b[i] = sB[kk][tx * 4 + i]; }
#pragma unroll
                    for (int i = 0; i < 4; ++i)
#pragma unroll
                        for (int j = 0; j < 4; ++j) acc[i][j] += a[i] * b[j];
                }
            }
            __syncthreads();
        }
        if (active) {
#pragma unroll
            for (int i = 0; i < 4; ++i)
#pragma unroll
                for (int j = 0; j < 4; ++j) { int col = bn + tx * 4 + j; if (col < N) epi(bm + ty * 4 + i, col, acc[i][j]); }
        }
    }
}

__device__ __forceinline__ int pos2tau(int d, int pos) { return d == 0 ? pos : (pos < NCTX ? NCTX - 1 - pos : (TJ + NCTX - 1) - pos); }

__device__ __forceinline__ void dn_load_raw(const Params& p, int b, int tau, int h, int lane, float (&q)[5], float (&k)[5], float (&v)[5]) {
    const int lo = tau < NCTX ? 0 : NCTX, hi = tau < NCTX ? NCTX : TJ;
#pragma unroll
    for (int j = 0; j < 5; ++j) {
        const int t2 = tau + j - 2; const bool ok = t2 >= lo && t2 < hi;
        const bf16_t* pr = p.P + ((size_t)b * TJ + (ok ? t2 : tau)) * DINP + h * 64 + lane;
        q[j] = ok ? bf2f(pr[0]) : 0.f; k[j] = ok ? bf2f(pr[256]) : 0.f; v[j] = ok ? bf2f(pr[512]) : 0.f;
    }
}
__device__ __forceinline__ void dn_chain_naive(const Params& p, int layer, int chain, int lane) {
    int b = chain >> 3, h = (chain >> 1) & 3, d = chain & 1;
    float S[64];
#pragma unroll
    for (int i = 0; i < 64; ++i) S[i] = 0.f;
    const float nalog = -expf(p.dn_a_log[layer * 8 + d * 4 + h]), dtb = p.dn_dt_bias[layer * 8 + d * 4 + h];
    float cq[5], ck[5], cv[5];
#pragma unroll
    for (int j = 0; j < 5; ++j) { const float* cw = p.dn_conv + ((size_t)layer * 5 + j) * 768 + h * 64 + lane; cq[j] = cw[0]; ck[j] = cw[256]; cv[j] = cw[512]; }
    bf16_t* O = d == 0 ? p.Y : p.ODN; const int ldo = d == 0 ? DM : 256;
    int tau = pos2tau(d, 0);
    size_t r = (size_t)b * TJ + tau;
    float a_n = bf2f(p.P[r * DINP + C_DNA + d * 4 + h]), b_n = bf2f(p.P[r * DINP + C_DNB + d * 4 + h]);
    float qn[5], kn[5], vn[5];
    dn_load_raw(p, b, tau, h, lane, qn, kn, vn);
    for (int pos = 0; pos < TJ; ++pos) {
        float a_in = a_n, b_in = b_n; size_t rc = r;
        float qa = 0.f, ka = 0.f, va = 0.f;
#pragma unroll
        for (int j = 0; j < 5; ++j) { qa += qn[j] * cq[j]; ka += kn[j] * ck[j]; va += vn[j] * cv[j]; }
        if (pos + 1 < TJ) {
            tau = pos2tau(d, pos + 1); r = (size_t)b * TJ + tau;
            a_n = bf2f(p.P[r * DINP + C_DNA + d * 4 + h]); b_n = bf2f(p.P[r * DINP + C_DNB + d * 4 + h]);
            dn_load_raw(p, b, tau, h, lane, qn, kn, vn);
        }
        float qv = siluf_(qa), kv = siluf_(ka), vv = siluf_(va);
        qv *= rsqrtf(wave_sum(qv * qv) + 1e-6f); kv *= rsqrtf(wave_sum(kv * kv) + 1e-6f);
        float decay = expf(nalog * softplusf_(a_in + dtb)), beta = sigmoidf_(b_in);
        float kS = 0.f;
#pragma unroll
        for (int i = 0; i < 64; ++i) { S[i] *= decay; kS += rdlane(kv, i) * S[i]; }
        float vnew = beta * (vv - kS), o = 0.f;
#pragma unroll
        for (int i = 0; i < 64; ++i) { S[i] += rdlane(kv, i) * vnew; o += rdlane(qv, i) * S[i]; }
        O[rc * ldo + h * 64 + lane] = f2bf(o * 0.125f);
    }
}

__device__ __forceinline__ void s5_chain_naive(const Params& p, int layer, int chain, int lane) {
    int b = chain >> 5, g = (chain >> 1) & 15, d = chain & 1;
    float lre = p.s5_a_re[((layer * 2 + d) * 16 + g) * 64 + lane], lim = p.s5_a_im[((layer * 2 + d) * 16 + g) * 64 + lane];
    float dt = expf(p.s5_log_dt[(layer * 2 + d) * 16 + g]);
    float mag = expf(lre * dt), are = mag * cosf(lim * dt), aim = mag * sinf(lim * dt);
    float den = lre * lre + lim * lim;
    float fre = ((are - 1.f) * lre + aim * lim) / den, fim = (aim * lre - (are - 1.f) * lim) / den;
    float bbr[16], bbi[16], cr[16], ci[16];
#pragma unroll
    for (int c = 0; c < 16; ++c) {
        float br = p.s5_b_re[((layer * 16 + g) * 64 + lane) * 16 + c], bi = p.s5_b_im[((layer * 16 + g) * 64 + lane) * 16 + c];
        bbr[c] = fre * br - fim * bi; bbi[c] = fre * bi + fim * br;
        cr[c] = p.s5_c_re[(((layer * 2 + d) * 16 + g) * 16 + c) * 64 + lane]; ci[c] = p.s5_c_im[(((layer * 2 + d) * 16 + g) * 16 + c) * 64 + lane];
    }
    bf16_t* O = d == 0 ? p.Y + 256 : p.OS5; const int ldo = d == 0 ? DM : 256;
    float xr = 0.f, xi = 0.f;
    size_t r = (size_t)b * TJ + pos2tau(d, 0);
    float u_n = bf2f(p.P[r * DINP + C_S5U + g * 16 + (lane & 15)]);
    for (int pos = 0; pos < TJ; ++pos) {
        float u = u_n; size_t rc = r;
        if (pos + 1 < TJ) { r = (size_t)b * TJ + pos2tau(d, pos + 1); u_n = bf2f(p.P[r * DINP + C_S5U + g * 16 + (lane & 15)]); }
        float nr = are * xr - aim * xi, ni = are * xi + aim * xr;
#pragma unroll
        for (int c = 0; c < 16; ++c) { float uc = rdlane(u, c); nr += bbr[c] * uc; ni += bbi[c] * uc; }
        xr = nr; xi = ni;
        float my = 0.f;
#pragma unroll
        for (int c = 0; c < 16; ++c) { float t = wave_sum(cr[c] * xr - ci[c] * xi); if (lane == c) my = t; }
        if (lane < 16) O[rc * ldo + g * 16 + lane] = f2bf(my);
    }
}

__device__ __forceinline__ void gla_chain_naive(const Params& p, int layer, int chain, int lane) {
    int b = chain >> 3, h = (chain >> 1) & 3, d = chain & 1;
    float S[32];
#pragma unroll
    for (int i = 0; i < 32; ++i) S[i] = 0.f;
    float w2[16];
#pragma unroll
    for (int rr = 0; rr < 16; ++rr) w2[rr] = p.gla_w_gate[((layer * 2 + d) * 16 + rr) * 128 + h * 32 + (lane & 31)];
    float b2 = p.gla_b_gate[(layer * 2 + d) * 128 + h * 32 + (lane & 31)];
    bf16_t* O = d == 0 ? p.Y + 768 : p.OGLA; const int ldo = d == 0 ? DM : 256;
    size_t r = (size_t)b * TJ + pos2tau(d, 0);
    float low_n = bf2f(p.P[r * DINP + C_GLG + d * 16 + (lane & 15)]), q_n = bf2f(p.P[r * DINP + C_GLQ + h * 32 + (lane & 31)]);
    float k_n = bf2f(p.P[r * DINP + C_GLK + h * 32 + (lane & 31)]), v_n = bf2f(p.P[r * DINP + C_GLV + h * 64 + lane]);
    for (int pos = 0; pos < TJ; ++pos) {
        float low = low_n, qv = q_n, kv = k_n, vv = v_n; size_t rc = r;
        if (pos + 1 < TJ) {
            r = (size_t)b * TJ + pos2tau(d, pos + 1);
            low_n = bf2f(p.P[r * DINP + C_GLG + d * 16 + (lane & 15)]); q_n = bf2f(p.P[r * DINP + C_GLQ + h * 32 + (lane & 31)]);
            k_n = bf2f(p.P[r * DINP + C_GLK + h * 32 + (lane & 31)]); v_n = bf2f(p.P[r * DINP + C_GLV + h * 64 + lane]);
        }
        float z = b2;
#pragma unroll
        for (int rr = 0; rr < 16; ++rr) z += rdlane(low, rr) * w2[rr];
        float a = expf(logsigmoidf_(z) * (1.0f / 16.0f));
        float o = 0.f;
#pragma unroll
        for (int i = 0; i < 32; ++i) { S[i] = rdlane(a, i) * S[i] + rdlane(kv, i) * vv; o += rdlane(qv, i) * S[i]; }
        O[rc * ldo + h * 64 + lane] = f2bf(o * 0.17677669529663687f);
    }
}

__device__ __forceinline__ void ph_dn_prep(const int wv_, unsigned char* smem, const Params& p, int layer) {
    PH_IDS();
    unsigned char* RAW = smem + 1024;
    const float* cwl = p.dn_conv + (size_t)layer * 5 * 768;
    for (int item = bid_; item < NB * (TJ / 64); item += nblk_) {
        const int b = item / (TJ / 64), tc = item - b * (TJ / 64), tlo = tc * 64;
        const int slo = tlo < NCTX ? 0 : NCTX, shi = tlo < NCTX ? NCTX : TJ;
        __syncthreads();
        for (int e = tid_; e < 68 * 96; e += NTHR) {
            const int row = e / 96, ch = e - row * 96, tau = tlo - 2 + row;
            uint4 v = make_uint4(0u, 0u, 0u, 0u);
            if (tau >= slo && tau < shi) v = *(const uint4*)(p.P + ((size_t)b * TJ + tau) * DINP + ch * 8);
            *(uint4*)(RAW + e * 16) = v;
        }
        __syncthreads();
#pragma unroll 1
        for (int k3 = 0; k3 < 3; ++k3) {
            const int id = tid_ + NTHR * k3, pg = id / 96, cg = id - pg * 96;
            float cw[5][8];
#pragma unroll
            for (int j = 0; j < 5; ++j) { const float4 w0 = *(const float4*)(cwl + j * 768 + cg * 8), w1 = *(const float4*)(cwl + j * 768 + cg * 8 + 4);
                cw[j][0] = w0.x; cw[j][1] = w0.y; cw[j][2] = w0.z; cw[j][3] = w0.w; cw[j][4] = w1.x; cw[j][5] = w1.y; cw[j][6] = w1.z; cw[j][7] = w1.w; }
            float x[8][8];
#pragma unroll
            for (int rr = 0; rr < 8; ++rr) {
                const uint4 v = *(const uint4*)(RAW + ((4 * pg + rr) * 96 + cg) * 16);
                const unsigned vv[4] = {v.x, v.y, v.z, v.w};
#pragma unroll
                for (int e = 0; e < 4; ++e) { x[rr][2 * e] = __uint_as_float(vv[e] << 16); x[rr][2 * e + 1] = __uint_as_float(vv[e] & 0xffff0000u); }
            }
#pragma unroll
            for (int e2 = 0; e2 < 4; ++e2) {
                float y[8]; float ss = 0.f;
#pragma unroll
                for (int e = 0; e < 8; ++e) { float acc = 0.f;
#pragma unroll
                    for (int j = 0; j < 5; ++j) acc += x[e2 + j][e] * cw[j][e];
                    y[e] = siluf_(acc); ss += y[e] * y[e]; }
                ss += __shfl_xor(ss, 1, 64); ss += __shfl_xor(ss, 2, 64); ss += __shfl_xor(ss, 4, 64);
                const float rs = cg < 64 ? rsqrtf(ss + 1e-6f) : 1.0f;
                uint4 o; o.x = cvt_pk_bf16_(y[0] * rs, y[1] * rs); o.y = cvt_pk_bf16_(y[2] * rs, y[3] * rs); o.z = cvt_pk_bf16_(y[4] * rs, y[5] * rs); o.w = cvt_pk_bf16_(y[6] * rs, y[7] * rs);
                *(uint4*)(p.QKVN + ((size_t)b * TJ + tlo + 4 * pg + e2) * 768 + cg * 8) = o;
            }
        }
        {
            const int lane = tid_ & 63, wq = tid_ >> 6, hh = wq >> 1, dd = wq & 1;
            bf16_t* prow = p.P + ((size_t)b * TJ + tlo + lane) * DINP;
            const float av = bf2f(prow[C_DNA + dd * 4 + hh]), bv = bf2f(prow[C_DNB + dd * 4 + hh]);
            const float g = -expf(p.dn_a_log[layer * 8 + dd * 4 + hh]) * softplusf_(av + p.dn_dt_bias[layer * 8 + dd * 4 + hh]);
            float pre = g;
#pragma unroll
            for (int o = 1; o < 64; o <<= 1) { const float t = __shfl_up(pre, o, 64); if (lane >= o) pre += t; }
            const float tot = rdlane(pre, 63);
            float2 gb; gb.x = dd == 0 ? pre : tot - pre + g; gb.y = sigmoidf_(bv);
            *(float2*)((float*)(prow + DIN) + (dd * 4 + hh) * 2) = gb;
        }
    }
}

#define DN_SB 72
#define DN_QN 0
#define DN_QD (DN_QN + 9216)
#define DN_KN (DN_QD + 9216)
#define DN_KB (DN_KN + 9216)
#define DN_V (DN_KB + 9216)
#define DN_NL (DN_V + 9216)
#define DN_AI (DN_NL + 9216)
#define DN_NW (DN_AI + 9216)
#define DN_KDT (DN_NW + 9216)
#define DN_U (DN_KDT + 9216)
#define DN_TD (DN_U + 17408)
#define DN_GAM (DN_TD + 4096)
#define DN_TX (DN_GAM + 1024)
typedef float f32x4_ __attribute__((ext_vector_type(4)));
__device__ __forceinline__ bfx8 pack8(const f32x4_& x, const f32x4_& y) {
    unsigned u[4]; u[0] = cvt_pk_bf16_(x[0], x[1]); u[1] = cvt_pk_bf16_(x[2], x[3]); u[2] = cvt_pk_bf16_(y[0], y[1]); u[3] = cvt_pk_bf16_(y[2], y[3]);
    return *(const bfx8*)u;
}
__device__ __forceinline__ bfx8 ld_split(const unsigned char* base, int row, int k0, int q4) {
    const unsigned char* a = base + (row * DN_SB + k0 + 4 * q4) * 2;
    uint2 lo = *(const uint2*)a, hi = *(const uint2*)(a + 32);
    unsigned u[4] = {lo.x, lo.y, hi.x, hi.y}; return *(const bfx8*)u;
}
__device__ __forceinline__ bfx8 ld_half(const unsigned char* base, int rowstride, int row, int k0, int q4) {
    uint2 lo = *(const uint2*)(base + (row * rowstride + k0 + 4 * q4) * 2);
    unsigned u[4] = {lo.x, lo.y, 0u, 0u}; return *(const bfx8*)u;
}
#define MFMA16(a, b, c) __builtin_amdgcn_mfma_f32_16x16x32_bf16(a, b, c, 0, 0, 0)

__device__ __forceinline__ void dn_tdiag(unsigned char* L, int a, int cc, int q4) {
    float xs[16];
#pragma unroll
    for (int r = 0; r < 16; ++r) {
        const unsigned char* rowp = L + DN_NL + ((16 * a + r) * DN_SB + 16 * a) * 2;
        const uint4 v0 = *(const uint4*)rowp, v1 = *(const uint4*)(rowp + 16);
        const unsigned vv[8] = {v0.x, v0.y, v0.z, v0.w, v1.x, v1.y, v1.z, v1.w};
        float sx = (r == cc) ? 1.f : 0.f;
#pragma unroll
        for (int j2 = 0; j2 < 16; ++j2) if (j2 < r) { const float lij = (j2 & 1) ? __uint_as_float(vv[j2 >> 1] & 0xffff0000u) : __uint_as_float(vv[j2 >> 1] << 16); sx += lij * xs[j2]; }
        xs[r] = sx;
        if (q4 == 0) *(bf16_t*)(L + DN_TD + ((a * 16 + r) * 16 + cc) * 2) = f2bf(sx);
    }
}
__device__ __forceinline__ void dn_tdiag_ahead(const Params& p, unsigned char* L, unsigned char* TDdst, int b, int h, int d, int tlo, int a, int l15, int q4) {
    unsigned char* blk = L + DN_TX + a * 640; float* gsc = (float*)(blk + 512);
    const int i = 16 * a + l15, tau = d ? tlo + 63 - i : tlo + i;
    const bf16_t* krow = p.QKVN + ((size_t)b * TJ + tau) * 768 + 256 + h * 64;
    const bfx8 k0 = *(const bfx8*)(krow + 8 * q4), k1 = *(const bfx8*)(krow + 32 + 8 * q4);
    const float2 gb = *(const float2*)((const float*)(p.P + ((size_t)b * TJ + tau) * DINP + DIN) + (d * 4 + h) * 2);
    if (q4 == 0) { gsc[l15] = gb.x; gsc[16 + l15] = gb.y; }
    f32x4_ kk = {0.f, 0.f, 0.f, 0.f};
    kk = MFMA16(k0, k0, kk); kk = MFMA16(k1, k1, kk);
    WAVE_LDS_FENCE();
    const float gj = gsc[l15];
#pragma unroll
    for (int r = 0; r < 4; ++r) {
        const int il = 4 * q4 + r;
        const float lv = (l15 < il) ? -gsc[16 + il] * kk[r] * __expf(gsc[il] - gj) : 0.f;
        *(bf16_t*)(blk + (il * 16 + l15) * 2) = f2bf(lv);
    }
    WAVE_LDS_FENCE();
    float xs[16];
#pragma unroll
    for (int r = 0; r < 16; ++r) {
        const uint4 v0 = *(const uint4*)(blk + r * 32), v1 = *(const uint4*)(blk + r * 32 + 16);
        const unsigned vv[8] = {v0.x, v0.y, v0.z, v0.w, v1.x, v1.y, v1.z, v1.w};
        float sx = (r == l15) ? 1.f : 0.f;
#pragma unroll
        for (int j2 = 0; j2 < 16; ++j2) if (j2 < r) { const float lij = (j2 & 1) ? __uint_as_float(vv[j2 >> 1] & 0xffff0000u) : __uint_as_float(vv[j2 >> 1] << 16); sx += lij * xs[j2]; }
        xs[r] = sx;
        if (q4 == 0) *(bf16_t*)(TDdst + ((a * 16 + r) * 16 + l15) * 2) = f2bf(sx);
    }
    WAVE_LDS_FENCE();
}
__device__ __forceinline__ void dn_chain(unsigned char* smem, const Params& p, int layer, int chain, int tid_) {
    unsigned char* L = smem + 1024;
    const int b = chain >> 3, h = (chain >> 1) & 3, d = chain & 1;
    const int w0_ = tid_ >> 6, lane0_ = tid_ & 63;
#define DN_IDS() int tt_ = tid_; OPQV(tt_); const int lane = tt_ & 63, w = __builtin_amdgcn_readfirstlane(tt_ >> 6), l15 = lane & 15, q4 = lane >> 4; (void)l15; (void)q4; (void)w
    const float nalog = -expf(p.dn_a_log[layer * 8 + d * 4 + h]), dtb = p.dn_dt_bias[layer * 8 + d * 4 + h];
    float* gam = (float*)(L + DN_GAM);
    f32x4_ Sst[4];
#pragma unroll
    for (int mt = 0; mt < 4; ++mt) Sst[mt] = (f32x4_){0.f, 0.f, 0.f, 0.f};
    bf16_t* Oout = d == 0 ? p.Y : p.ODN; const int ldo = d == 0 ? DM : 256;
    uint4 pre0, pre1, pre2; float2 gb_n = make_float2(0.f, 0.f); float gl_n = 0.f;
    auto chunk_lo = [&](int c) { return d == 0 ? c * 64 : (c < 4 ? 192 - c * 64 : (TJ + NCTX - 64) - c * 64); };
    auto issue = [&](int c) {
        const int tlo = chunk_lo(c);
        {
            const int i = tid_ >> 3, c8 = (tid_ & 7) * 8, tau = d ? tlo + 63 - i : tlo + i;
            const bf16_t* src = p.QKVN + ((size_t)b * TJ + tau) * 768 + h * 64 + c8;
            pre0 = *(const uint4*)src; pre1 = *(const uint4*)(src + 256); pre2 = *(const uint4*)(src + 512);
            gb_n = *(const float2*)((const float*)(p.P + ((size_t)b * TJ + tau) * DINP + DIN) + (d * 4 + h) * 2);
            gl_n = *((const float*)(p.P + ((size_t)b * TJ + (d ? tlo : tlo + 63)) * DINP + DIN) + (d * 4 + h) * 2);
        }
    };
    issue(0);
    if (w0_ >= 4) dn_tdiag_ahead(p, L, L + DN_TD, b, h, d, chunk_lo(0), w0_ - 4, lane0_ & 15, lane0_ >> 4);
    for (int c = 0; c < TJ / 64; ++c) {
        const int tlo = chunk_lo(c);
        __syncthreads();
        {
            const int i = tid_ >> 3, c8 = (tid_ & 7) * 8;
            const float gmi = gb_n.x, bti = gb_n.y, egi = __expf(gmi), eki = __expf(gl_n - gmi);
            if ((tid_ & 7) == 0) { gam[i] = gmi; gam[64 + i] = bti; gam[128 + i] = egi; gam[192 + i] = eki; }
            *(uint4*)(L + DN_QN + (i * DN_SB + c8) * 2) = pre0; *(uint4*)(L + DN_KN + (i * DN_SB + c8) * 2) = pre1;
            const unsigned* qq = (const unsigned*)&pre0; const unsigned* kq = (const unsigned*)&pre1; const unsigned* vq = (const unsigned*)&pre2;
            uint4 qd, kb, vb; unsigned* qdp = (unsigned*)&qd; unsigned* kbp = (unsigned*)&kb; unsigned* vbp = (unsigned*)&vb;
            const float sq = 0.125f * egi, skb = bti * egi;
#pragma unroll
            for (int e = 0; e < 4; ++e) {
                const float k0 = __uint_as_float(kq[e] << 16), k1 = __uint_as_float(kq[e] & 0xffff0000u);
                qdp[e] = cvt_pk_bf16_(__uint_as_float(qq[e] << 16) * sq, __uint_as_float(qq[e] & 0xffff0000u) * sq);
                kbp[e] = cvt_pk_bf16_(k0 * skb, k1 * skb);
                vbp[e] = cvt_pk_bf16_(__uint_as_float(vq[e] << 16) * bti, __uint_as_float(vq[e] & 0xffff0000u) * bti);
                *(bf16_t*)(L + DN_KDT + ((c8 + 2 * e) * DN_SB + i) * 2) = f2bf(k0 * eki);
                *(bf16_t*)(L + DN_KDT + ((c8 + 2 * e + 1) * DN_SB + i) * 2) = f2bf(k1 * eki);
            }
            *(uint4*)(L + DN_QD + (i * DN_SB + c8) * 2) = qd; *(uint4*)(L + DN_KB + (i * DN_SB + c8) * 2) = kb; *(uint4*)(L + DN_V + (i * DN_SB + c8) * 2) = vb;
        }
        if (c + 1 < TJ / 64) issue(c + 1);
        __syncthreads();
        { DN_IDS();
#pragma unroll
        for (int tt = 0; tt < 2; ++tt) {
            const int t = 2 * w + tt, it = t >> 2, jt = t & 3;
            f32x4_ kk = {0.f, 0.f, 0.f, 0.f}, qk = {0.f, 0.f, 0.f, 0.f};
            if (jt <= it) {
#pragma unroll
                for (int ks = 0; ks < 2; ++ks) {
                    const bfx8 bk = *(const bfx8*)(L + DN_KN + ((jt * 16 + l15) * DN_SB + ks * 32 + q4 * 8) * 2);
                    const bfx8 ak = *(const bfx8*)(L + DN_KN + ((it * 16 + l15) * DN_SB + ks * 32 + q4 * 8) * 2);
                    const bfx8 aq = *(const bfx8*)(L + DN_QN + ((it * 16 + l15) * DN_SB + ks * 32 + q4 * 8) * 2);
                    kk = MFMA16(ak, bk, kk); qk = MFMA16(aq, bk, qk);
                }
            }
            const int j = jt * 16 + l15; const float gj = gam[j];
#pragma unroll
            for (int r = 0; r < 4; ++r) {
                const int i = it * 16 + q4 * 4 + r;
                const float dec = (j <= i) ? __expf(gam[i] - gj) : 0.f;
                const float lv = (j < i) ? -gam[64 + i] * kk[r] * dec : 0.f;
                *(bf16_t*)(L + DN_NL + (i * DN_SB + j) * 2) = f2bf(lv);
                *(bf16_t*)(L + DN_AI + (i * DN_SB + j) * 2) = f2bf(0.125f * qk[r] * dec);
            }
        }
        }
        __syncthreads();
        { DN_IDS();
            const f32x4_ z4 = {0.f, 0.f, 0.f, 0.f};
            f32x4_ R[4];
#pragma unroll
            for (int a = 0; a < 4; ++a)
#pragma unroll
                for (int r = 0; r < 4; ++r) {
                    const int i = 16 * a + 4 * q4 + r;
                    R[a][r] = w < 4 ? bf2f(*(const bf16_t*)(L + DN_V + (i * DN_SB + 16 * w + l15) * 2)) : bf2f(*(const bf16_t*)(L + DN_KB + (i * DN_SB + 16 * (w - 4) + l15) * 2));
                }
            f32x4_ X[4];
#pragma unroll
            for (int a = 0; a < 4; ++a) {
                f32x4_ acc = R[a];
                if (a == 1) acc = MFMA16(ld_half(L + DN_NL, DN_SB, 16 + l15, 0, q4), pack8(X[0], z4), acc);
                if (a >= 2) acc = MFMA16(ld_split(L + DN_NL, 16 * a + l15, 0, q4), pack8(X[0], X[1]), acc);
                if (a == 3) acc = MFMA16(ld_half(L + DN_NL, DN_SB, 48 + l15, 32, q4), pack8(X[2], z4), acc);
                X[a] = MFMA16(ld_half(L + DN_TD + (c & 1) * 2048, 16, a * 16 + l15, 0, q4), pack8(acc, z4), z4);
            }
#pragma unroll
            for (int a = 0; a < 4; ++a)
#pragma unroll
                for (int r = 0; r < 4; ++r) {
                    const int i = 16 * a + 4 * q4 + r;
                    if (w < 4) *(float*)(L + DN_U + (i * 68 + 16 * w + l15) * 4) = X[a][r];
                    else *(bf16_t*)(L + DN_NW + (i * DN_SB + 16 * (w - 4) + l15) * 2) = f2bf(-X[a][r]);
                }
        }
        __syncthreads();
        { DN_IDS();
        if (w < 4) {
            const f32x4_ z4 = {0.f, 0.f, 0.f, 0.f};
            bfx8 sb[2]; sb[0] = pack8(Sst[0], Sst[1]); sb[1] = pack8(Sst[2], Sst[3]);
            f32x4_ vn[4];
#pragma unroll
            for (int mt = 0; mt < 4; ++mt) {
                f32x4_ acc;
#pragma unroll
                for (int r = 0; r < 4; ++r) acc[r] = *(const float*)(L + DN_U + ((16 * mt + 4 * q4 + r) * 68 + 16 * w + l15) * 4);
                acc = MFMA16(ld_split(L + DN_NW, 16 * mt + l15, 0, q4), sb[0], acc);
                acc = MFMA16(ld_split(L + DN_NW, 16 * mt + l15, 32, q4), sb[1], acc);
                vn[mt] = acc;
            }
            bfx8 vb[2]; vb[0] = pack8(vn[0], vn[1]); vb[1] = pack8(vn[2], vn[3]);
#pragma unroll
            for (int mt = 0; mt < 4; ++mt) {
                f32x4_ acc = z4;
                acc = MFMA16(ld_split(L + DN_QD, 16 * mt + l15, 0, q4), sb[0], acc);
                acc = MFMA16(ld_split(L + DN_QD, 16 * mt + l15, 32, q4), sb[1], acc);
                acc = MFMA16(ld_split(L + DN_AI, 16 * mt + l15, 0, q4), vb[0], acc);
                acc = MFMA16(ld_split(L + DN_AI, 16 * mt + l15, 32, q4), vb[1], acc);
#pragma unroll
                for (int r = 0; r < 4; ++r) {
                    const int i = 16 * mt + 4 * q4 + r, tau = d ? tlo + 63 - i : tlo + i;
                    Oout[((size_t)b * TJ + tau) * ldo + h * 64 + 16 * w + l15] = f2bf(acc[r]);
                }
            }
            const float glast = gam[128 + 63];
#pragma unroll
            for (int mt = 0; mt < 4; ++mt) {
                f32x4_ acc = Sst[mt] * glast;
                acc = MFMA16(ld_split(L + DN_KDT, 16 * mt + l15, 0, q4), vb[0], acc);
                acc = MFMA16(ld_split(L + DN_KDT, 16 * mt + l15, 32, q4), vb[1], acc);
                Sst[mt] = acc;
            }
        } else if (c + 1 < TJ / 64) {
            dn_tdiag_ahead(p, L, L + DN_TD + ((c + 1) & 1) * 2048, b, h, d, chunk_lo(c + 1), w - 4, l15, q4);
        }
        }
    }
    __syncthreads();
}

__device__ __forceinline__ int gla_scan_chunk(int d, int tc) { return d == 0 ? tc : (tc < 4 ? 3 - tc : (TJ / 64 + 3) - tc); }
__device__ __forceinline__ void gla_low(const bf16_t* prow, int d, float (&low)[16]) {
    const uint4 v0 = *(const uint4*)(prow + C_GLG + d * 16), v1 = *(const uint4*)(prow + C_GLG + d * 16 + 8);
    const unsigned vv[8] = {v0.x, v0.y, v0.z, v0.w, v1.x, v1.y, v1.z, v1.w};
#pragma unroll
    for (int e = 0; e < 8; ++e) { low[2 * e] = __uint_as_float(vv[e] << 16); low[2 * e + 1] = __uint_as_float(vv[e] & 0xffff0000u); }
}
__device__ __forceinline__ void gla_gate4(const Params& p, int layer, int h, int d, const float (&low)[16], int c4, int lane, float (&bb)[4], float (&tot)[4]) {
    const float* w2 = p.gla_w_gate + (size_t)(layer * 2 + d) * 16 * 128 + h * 32 + c4 * 4;
    const float* b2 = p.gla_b_gate + (size_t)(layer * 2 + d) * 128 + h * 32 + c4 * 4;
#pragma unroll
    for (int e = 0; e < 4; ++e) {
        float z = b2[e];
#pragma unroll
        for (int r = 0; r < 16; ++r) z += low[r] * w2[r * 128 + e];
        const float x = logsigmoidf_(z) * (1.0f / 16.0f);
        float pre = x;
#pragma unroll
        for (int o = 1; o < 64; o <<= 1) { const float t = __shfl_up(pre, o, 64); if (lane >= o) pre += t; }
        const float tt = rdlane(pre, 63);
        tot[e] = tt; bb[e] = d == 0 ? pre : tt - pre + x;
    }
}
#define GLA_VS 68
#define GLA_WAVE_LDS 17408
__device__ __forceinline__ bfx8 ld_split_s(const unsigned char* base, int strideB, int row, int k0, int q4) {
    const unsigned char* a = base + row * strideB + (k0 + 4 * q4) * 2;
    const uint2 lo = *(const uint2*)a, hi = *(const uint2*)(a + 32);
    unsigned u[4] = {lo.x, lo.y, hi.x, hi.y}; return *(const bfx8*)u;
}
__device__ __forceinline__ void gla_load_row32(const bf16_t* src, float (&x)[32]) {
#pragma unroll
    for (int c = 0; c < 4; ++c) { const uint4 v = *(const uint4*)(src + c * 8); const unsigned vv[4] = {v.x, v.y, v.z, v.w};
#pragma unroll
        for (int e = 0; e < 4; ++e) { x[c * 8 + 2 * e] = __uint_as_float(vv[e] << 16); x[c * 8 + 2 * e + 1] = __uint_as_float(vv[e] & 0xffff0000u); } }
}
__device__ __forceinline__ void gla_store_vT(unsigned char* vT, const bf16_t* vsrc, int lane) {
#pragma unroll
    for (int c = 0; c < 8; ++c) { const uint4 v = *(const uint4*)(vsrc + c * 8); const unsigned vv[4] = {v.x, v.y, v.z, v.w};
#pragma unroll
        for (int e = 0; e < 4; ++e) { *(bf16_t*)(vT + ((c * 8 + 2 * e) * GLA_VS + lane) * 2) = (bf16_t)(vv[e] & 0xffffu); *(bf16_t*)(vT + ((c * 8 + 2 * e + 1) * GLA_VS + lane) * 2) = (bf16_t)(vv[e] >> 16); } }
}
__device__ __forceinline__ void ph_gla1(const int wv_, unsigned char* smem, const Params& p, int layer) {
    PH_IDS();
    const int lane = tid_ & 63, w = tid_ >> 6, l15 = lane & 15, q4 = lane >> 4;
    unsigned char* vT = smem + 1024 + w * GLA_WAVE_LDS; unsigned char* khT = vT + 8704 + 4096;
    for (int item = bid_ * NWV + w; item < NB * 4 * 2 * (TJ / 64); item += nblk_ * NWV) {
        const int tc = item % (TJ / 64), bhd = item / (TJ / 64), d = bhd & 1, h = (bhd >> 1) & 3, b = bhd >> 3;
        const bf16_t* prow = p.P + ((size_t)b * TJ + tc * 64 + lane) * DINP;
        const int cs = gla_scan_chunk(d, tc);
        float low[16]; gla_low(prow, d, low);
#pragma unroll 1
        for (int c4 = 0; c4 < 8; ++c4) {
            float bb[4], tot[4];
            gla_gate4(p, layer, h, d, low, c4, lane, bb, tot);
            const uint2 kv = *(const uint2*)(prow + C_GLK + h * 32 + c4 * 4);
            const float k0 = __uint_as_float(kv.x << 16), k1 = __uint_as_float(kv.x & 0xffff0000u), k2 = __uint_as_float(kv.y << 16), k3 = __uint_as_float(kv.y & 0xffff0000u);
            *(bf16_t*)(khT + ((c4 * 4 + 0) * GLA_VS + lane) * 2) = f2bf(k0 * __expf(tot[0] - bb[0]));
            *(bf16_t*)(khT + ((c4 * 4 + 1) * GLA_VS + lane) * 2) = f2bf(k1 * __expf(tot[1] - bb[1]));
            *(bf16_t*)(khT + ((c4 * 4 + 2) * GLA_VS + lane) * 2) = f2bf(k2 * __expf(tot[2] - bb[2]));
            *(bf16_t*)(khT + ((c4 * 4 + 3) * GLA_VS + lane) * 2) = f2bf(k3 * __expf(tot[3] - bb[3]));
            if (lane < 4) { const float tl = lane == 0 ? tot[0] : lane == 1 ? tot[1] : lane == 2 ? tot[2] : tot[3];
                p.DCY[((size_t)bhd * (TJ / 64) + cs) * 32 + c4 * 4 + lane] = __expf(tl); }
        }
        gla_store_vT(vT, prow + C_GLV + h * 64, lane);
        WAVE_LDS_FENCE();
        bf16_t* gout = p.GST + ((size_t)bhd * (TJ / 64) + cs) * 2048;
#pragma unroll
        for (int dt = 0; dt < 4; ++dt)
#pragma unroll
            for (int nt = 0; nt < 2; ++nt) {
                f32x4_ acc = {0.f, 0.f, 0.f, 0.f};
#pragma unroll
                for (int ks = 0; ks < 2; ++ks) acc = MFMA16(ld_split_s(vT, GLA_VS * 2, 16 * dt + l15, 32 * ks, q4), ld_split_s(khT, GLA_VS * 2, 16 * nt + l15, 32 * ks, q4), acc);
#pragma unroll
                for (int r = 0; r < 4; ++r) gout[(16 * dt + 4 * q4 + r) * 32 + 16 * nt + l15] = f2bf(acc[r]);
            }
        WAVE_LDS_FENCE();
    }
}
__device__ __forceinline__ void gla2_scan(const Params& p, int wg, int tid_) {
    const int chain = wg >> 1, pr = (wg & 1) * 512 + tid_, dk0 = (2 * pr) & 31;
    unsigned* g = (unsigned*)(p.GST + (size_t)chain * (TJ / 64) * 2048) + pr;
    const float* dc = p.DCY + (size_t)chain * (TJ / 64) * 32 + dk0;
    float s0 = 0.f, s1 = 0.f;
    unsigned gv = g[0]; float d0 = dc[0], d1 = dc[1];
    for (int c = 0; c < TJ / 64; ++c) {
        const unsigned cur = gv; const float c0 = d0, c1 = d1;
        if (c + 1 < TJ / 64) { gv = g[(size_t)(c + 1) * 1024]; d0 = dc[(c + 1) * 32]; d1 = dc[(c + 1) * 32 + 1]; }
        g[(size_t)c * 1024] = cvt_pk_bf16_(s0, s1);
        s0 = c0 * s0 + __uint_as_float(cur << 16); s1 = c1 * s1 + __uint_as_float(cur & 0xffff0000u);
    }
}
__device__ __forceinline__ void ph_gla3(const int wv_, unsigned char* smem, const Params& p, int layer) {
    PH_IDS();
    const int lane = tid_ & 63, w = tid_ >> 6, l15 = lane & 15, q4 = lane >> 4;
    unsigned char* vT = smem + 1024 + w * GLA_WAVE_LDS; unsigned char* Qt = vT + 8704; unsigned char* Kt = Qt + 4096;
    for (;;) {
#ifdef EMU
        const int item = g_emu_q++ ;
#else
        int item = 0; if (lane == 0) item = atomicAdd(p.cnt + 130, 1); item = __builtin_amdgcn_readfirstlane(item);
#endif
        if (item >= NB * 4 * (TJ / 64)) break;
        const int tc = item % (TJ / 64), bh = item / (TJ / 64), h = bh & 3, b = bh >> 2;
        if (layer == NLAYER - 1 && tc < 4) continue;
        const bf16_t* prow = p.P + ((size_t)b * TJ + tc * 64 + lane) * DINP;
        gla_store_vT(vT, prow + C_GLV + h * 64, lane);
        f32x4_ o[4][4];
#pragma unroll
        for (int dt = 0; dt < 4; ++dt)
#pragma unroll
            for (int nt = 0; nt < 4; ++nt) o[dt][nt] = (f32x4_){0.f, 0.f, 0.f, 0.f};
#pragma unroll 1
        for (int d = 0; d < 2; ++d) {
#ifdef EMU
            if (g_dbg_dir >= 0 && d != g_dbg_dir) continue;
#endif
            {
                float low[16]; gla_low(prow, d, low);
#pragma unroll 1
                for (int c4 = 0; c4 < 8; ++c4) {
                    float bb[4], tot[4];
                    gla_gate4(p, layer, h, d, low, c4, lane, bb, tot);
                    const uint2 qv = *(const uint2*)(prow + C_GLQ + h * 32 + c4 * 4), kv = *(const uint2*)(prow + C_GLK + h * 32 + c4 * 4);
                    const float sc = 0.17677669529663687f;
                    const float e0 = __expf(bb[0]), e1 = __expf(bb[1]), e2 = __expf(bb[2]), e3 = __expf(bb[3]);
                    uint2 qo, ko;
                    qo.x = cvt_pk_bf16_(__uint_as_float(qv.x << 16) * sc * e0, __uint_as_float(qv.x & 0xffff0000u) * sc * e1);
                    qo.y = cvt_pk_bf16_(__uint_as_float(qv.y << 16) * sc * e2, __uint_as_float(qv.y & 0xffff0000u) * sc * e3);
                    ko.x = cvt_pk_bf16_(__uint_as_float(kv.x << 16) / e0, __uint_as_float(kv.x & 0xffff0000u) / e1);
                    ko.y = cvt_pk_bf16_(__uint_as_float(kv.y << 16) / e2, __uint_as_float(kv.y & 0xffff0000u) / e3);
                    *(uint2*)(Qt + lane * 64 + c4 * 8) = qo; *(uint2*)(Kt + lane * 64 + c4 * 8) = ko;
                }
            }
            WAVE_LDS_FENCE();
            const bf16_t* sst = p.GST + ((size_t)((bh * 2 + d) * (TJ / 64)) + gla_scan_chunk(d, tc)) * 2048;
            bfx8 qb[4];
#pragma unroll
            for (int nt = 0; nt < 4; ++nt) qb[nt] = *(const bfx8*)(Qt + (16 * nt + l15) * 64 + q4 * 16);
#pragma unroll
            for (int nt = 0; nt < 4; ++nt) {
                f32x4_ at[4];
#pragma unroll
                for (int mt = 0; mt < 4; ++mt) {
                    const bfx8 ka = *(const bfx8*)(Kt + (16 * mt + l15) * 64 + q4 * 16);
                    f32x4_ a = MFMA16(ka, qb[nt], ((f32x4_){0.f, 0.f, 0.f, 0.f}));
                    const int t = 16 * nt + l15;
#pragma unroll
                    for (int r = 0; r < 4; ++r) { const int sidx = 16 * mt + 4 * q4 + r; const bool keep = d == 0 ? sidx <= t : sidx >= t; a[r] = keep ? a[r] : 0.f; }
                    at[mt] = a;
                }
                const bfx8 ab0 = pack8(at[0], at[1]), ab1 = pack8(at[2], at[3]);
#pragma unroll
                for (int dt = 0; dt < 4; ++dt) {
                    f32x4_ acc = o[dt][nt];
                    acc = MFMA16(ld_split_s(vT, GLA_VS * 2, 16 * dt + l15, 0, q4), ab0, acc);
                    acc = MFMA16(ld_split_s(vT, GLA_VS * 2, 16 * dt + l15, 32, q4), ab1, acc);
                    acc = MFMA16(*(const bfx8*)(sst + (16 * dt + l15) * 32 + q4 * 8), qb[nt], acc);
                    o[dt][nt] = acc;
                }
            }
            WAVE_LDS_FENCE();
        }
        const float* g = p.gla_norm_g + layer * 64;
#pragma unroll
        for (int nt = 0; nt < 4; ++nt) {
            float ss = 0.f;
#pragma unroll
            for (int dt = 0; dt < 4; ++dt)
#pragma unroll
                for (int r = 0; r < 4; ++r) ss += o[dt][nt][r] * o[dt][nt][r];
            ss += __shfl_xor(ss, 16, 64); ss += __shfl_xor(ss, 32, 64);
            const float rs = rsqrtf(ss * (1.0f / 64.0f) + 1e-6f);
            const size_t row = (size_t)b * TJ + tc * 64 + 16 * nt + l15;
#ifdef EMU
            if (g_dbg_dir >= 0) { for (int dt = 0; dt < 4; ++dt) for (int r = 0; r < 4; ++r) g_dbg[row * 256 + h * 64 + 16 * dt + 4 * q4 + r] = o[dt][nt][r]; }
#endif
#pragma unroll
            for (int dt = 0; dt < 4; ++dt) {
                const int dv0 = 16 * dt + 4 * q4;
                const uint2 rg = *(const uint2*)(p.P + row * DINP + C_GLR + h * 64 + dv0);
                const float r0 = __uint_as_float(rg.x << 16), r1 = __uint_as_float(rg.x & 0xffff0000u), r2 = __uint_as_float(rg.y << 16), r3 = __uint_as_float(rg.y & 0xffff0000u);
                uint2 w2;
                w2.x = cvt_pk_bf16_(o[dt][nt][0] * rs * g[dv0] * siluf_(r0), o[dt][nt][1] * rs * g[dv0 + 1] * siluf_(r1));
                w2.y = cvt_pk_bf16_(o[dt][nt][2] * rs * g[dv0 + 2] * siluf_(r2), o[dt][nt][3] * rs * g[dv0 + 3] * siluf_(r3));
                *(uint2*)(p.Y + row * DM + 768 + h * 64 + dv0) = w2;
            }
        }
    }
}

#define S5NS (TJ / 16)
#define S5NT (TJ / 256)
__device__ __forceinline__ void ph_s5_prep(const int wv_, unsigned char* smem, const Params& p, int layer) {
    PH_IDS();
    if (bid_ >= 64) {
        if (bid_ < 80) for (int idx = (bid_ - 64) * NTHR + tid_; idx < 65536; idx += 16 * NTHR) { const int co = idx >> 8, ch = idx & 255; p.GLUt[idx] = f2bf(p.s5_glu_w[(size_t)layer * 65536 + ch * 256 + co]); }
        return;
    }
    const int g = bid_ >> 2, qd = bid_ & 3;
    float2* APOW = (float2*)(smem + 1024);
    float2* BBAR = APOW + 2 * 64 * 17;
    float2* CC = BBAR + 2 * 64 * 16;
    float* KC = (float*)(CC + 2 * 16 * 64);
    __syncthreads();
    if (tid_ < 128) {
        const int d = tid_ >> 6, pp = tid_ & 63;
        const float lre = p.s5_a_re[((layer * 2 + d) * 16 + g) * 64 + pp], lim = p.s5_a_im[((layer * 2 + d) * 16 + g) * 64 + pp];
        const float dt = expf(p.s5_log_dt[(layer * 2 + d) * 16 + g]);
        for (int m = 0; m <= 16; ++m) { const float mag = expf(lre * dt * (float)m), ang = lim * dt * (float)m; APOW[(d * 64 + pp) * 17 + m] = make_float2(mag * cosf(ang), mag * sinf(ang)); }
        const float2 a1 = APOW[(d * 64 + pp) * 17 + 1]; const float den = lre * lre + lim * lim;
        const float fre = ((a1.x - 1.f) * lre + a1.y * lim) / den, fim = (a1.y * lre - (a1.x - 1.f) * lim) / den;
        for (int c = 0; c < 16; ++c) {
            const float br = p.s5_b_re[((layer * 16 + g) * 64 + pp) * 16 + c], bi = p.s5_b_im[((layer * 16 + g) * 64 + pp) * 16 + c];
            BBAR[(d * 64 + pp) * 16 + c] = make_float2(fre * br - fim * bi, fre * bi + fim * br);
            CC[(d * 16 + c) * 64 + pp] = make_float2(p.s5_c_re[(((layer * 2 + d) * 16 + g) * 16 + c) * 64 + pp], p.s5_c_im[(((layer * 2 + d) * 16 + g) * 16 + c) * 64 + pp]);
        }
        if (qd == 0) { const float2 a16 = APOW[(d * 64 + pp) * 17 + 16]; p.A16[((d * 16 + g) * 64 + pp) * 2] = a16.x; p.A16[((d * 16 + g) * 64 + pp) * 2 + 1] = a16.y; }
    }
    __syncthreads();
    for (int idx = tid_; idx < 2048; idx += NTHR) {
        const int d = idx >> 10, tau = (idx >> 6) & 15, cl = (idx >> 4) & 3, c2 = idx & 15, c = 4 * qd + cl;
        float acc = 0.f;
        for (int pp = 0; pp < 64; ++pp) {
            const float2 cc = CC[(d * 16 + c) * 64 + pp], ap = APOW[(d * 64 + pp) * 17 + tau], bbv = BBAR[(d * 64 + pp) * 16 + c2];
            const float tr = cc.x * ap.x - cc.y * ap.y, ti = cc.x * ap.y + cc.y * ap.x;
            acc += tr * bbv.x - ti * bbv.y;
        }
        KC[idx] = acc;
    }
    __syncthreads();
    for (int idx = tid_; idx < 64 * 512; idx += NTHR) {
        const int nl = idx >> 9, k = idx & 511, i = nl >> 2, cl = nl & 3, c = 4 * qd + cl, n = i * 16 + c;
        float v;
        if (k < 256) { const int j = k >> 4, c2 = k & 15;
            v = (i >= j ? KC[((0 * 16 + (i - j)) * 4 + cl) * 16 + c2] : 0.f) + (j >= i ? KC[((1 * 16 + (j - i)) * 4 + cl) * 16 + c2] : 0.f);
        } else { const int kk = k - 256, d = kk >> 7, im = (kk >> 6) & 1, pp = kk & 63, m = d == 0 ? i + 1 : 16 - i;
            const float2 cc = CC[(d * 16 + c) * 64 + pp], ap = APOW[(d * 64 + pp) * 17 + m];
            v = im == 0 ? (cc.x * ap.x - cc.y * ap.y) : -(cc.x * ap.y + cc.y * ap.x); }
        p.SB[((size_t)g * 256 + n) * 512 + k] = f2bf(v);
    }
    for (int idx = tid_; idx < 64 * 256; idx += NTHR) {
        const int n = 64 * qd + (idx >> 8), k = idx & 255, j = k >> 4, c2 = k & 15, d = n >> 7, im = (n >> 6) & 1, pp = n & 63, m = d == 0 ? 15 - j : j;
        const float2 ap = APOW[(d * 64 + pp) * 17 + m], bbv = BBAR[(d * 64 + pp) * 16 + c2];
        p.SE[((size_t)g * 256 + n) * 256 + k] = f2bf(im == 0 ? ap.x * bbv.x - ap.y * bbv.y : ap.x * bbv.y + ap.y * bbv.x);
    }
}
__device__ __forceinline__ void ph_s5_1(const int wv_, const Params& p, int layer) {
    PH_IDS();
    const int lane = tid_ & 63, w = tid_ >> 6, l15 = lane & 15, q4 = lane >> 4;
    for (int item = bid_ * NWV + w; item < NB * S5NT * 16; item += nblk_ * NWV) {
        const int g = item & 15, st = (item >> 4) % S5NT, b = item / (16 * S5NT), s0 = st * 16;
        bfx8 ua[8];
#pragma unroll
        for (int ks = 0; ks < 8; ++ks) ua[ks] = *(const bfx8*)(p.P + ((size_t)b * TJ + 16 * (s0 + l15) + 2 * ks + (q4 >> 1)) * DINP + C_S5U + 16 * g + 8 * (q4 & 1));
        const bf16_t* se = p.SE + (size_t)g * 65536;
#pragma unroll 2
        for (int nt = 0; nt < 16; ++nt) {
            f32x4_ acc = {0.f, 0.f, 0.f, 0.f};
#pragma unroll
            for (int ks = 0; ks < 8; ++ks) acc = MFMA16(ua[ks], *(const bfx8*)(se + (16 * nt + l15) * 256 + 32 * ks + 8 * q4), acc);
#pragma unroll
            for (int r = 0; r < 4; ++r) p.XS[(((size_t)b * S5NS + s0 + 4 * q4 + r) * 16 + g) * 256 + 16 * nt + l15] = f2bf(acc[r]);
        }
    }
}
__device__ __forceinline__ void s5_2_scan(const Params& p, int wg, int tid_) {
    const int idx = wg * NTHR + tid_, pp = idx & 63, d = (idx >> 6) & 1, g = (idx >> 7) & 15, b = idx >> 11;
    const float ar = p.A16[((d * 16 + g) * 64 + pp) * 2], ai = p.A16[((d * 16 + g) * 64 + pp) * 2 + 1];
    bf16_t* base = p.XS + ((size_t)b * S5NS * 16 + g) * 256 + d * 128 + pp;
    float xr = 0.f, xi = 0.f;
    for (int q0 = 0; q0 < S5NS; q0 += 8) {
        float er[8], ei[8]; int sidx[8];
#pragma unroll
        for (int u = 0; u < 8; ++u) { const int q = q0 + u; const int sq = d == 0 ? q : (q < NCTX / 16 ? NCTX / 16 - 1 - q : S5NS + NCTX / 16 - 1 - q); sidx[u] = sq;
            er[u] = bf2f(base[(size_t)sq * 4096]); ei[u] = bf2f(base[(size_t)sq * 4096 + 64]); }
#pragma unroll
        for (int u = 0; u < 8; ++u) {
            base[(size_t)sidx[u] * 4096] = f2bf(xr); base[(size_t)sidx[u] * 4096 + 64] = f2bf(xi);
            const float nr = ar * xr - ai * xi + er[u], ni = ar * xi + ai * xr + ei[u]; xr = nr; xi = ni;
        }
    }
}
#define S5_ZS 264
__device__ __forceinline__ void ph_s5_3(const int wv_, unsigned char* smem, const Params& p, int layer) {
    PH_IDS();
    const int lane = tid_ & 63, w = tid_ >> 6, l15 = lane & 15, q4 = lane >> 4;
    bf16_t* Z = (bf16_t*)(smem + 1024);
    int* sitem = (int*)(smem + 64);
    for (;;) {
        __syncthreads();
#ifdef EMU
        if (tid_ == 0) sitem[0] = g_emu_q2++;
#else
        if (tid_ == 0) sitem[0] = atomicAdd(p.cnt + 131, 1);
#endif
        __syncthreads();
        const int item = sitem[0];
        if (item >= NB * S5NT) break;
        const int b = item / S5NT, st = item - b * S5NT, s0 = st * 16;
        if (layer == NLAYER - 1 && st == 0) continue;
        __syncthreads();
#pragma unroll 1
        for (int gi = 0; gi < 2; ++gi) {
            const int g = 2 * w + gi;
            bfx8 ua[8], xa[8];
#pragma unroll
            for (int ks = 0; ks < 8; ++ks) {
                ua[ks] = *(const bfx8*)(p.P + ((size_t)b * TJ + 16 * (s0 + l15) + 2 * ks + (q4 >> 1)) * DINP + C_S5U + 16 * g + 8 * (q4 & 1));
                xa[ks] = *(const bfx8*)(p.XS + (((size_t)b * S5NS + s0 + l15) * 16 + g) * 256 + 32 * ks + 8 * q4);
            }
            const bf16_t* sb = p.SB + (size_t)g * 131072;
            const float dsk = p.s5_d[layer * 256 + 16 * g + l15];
#pragma unroll 2
            for (int nt = 0; nt < 16; ++nt) {
                f32x4_ acc = {0.f, 0.f, 0.f, 0.f};
#pragma unroll
                for (int ks = 0; ks < 8; ++ks) acc = MFMA16(ua[ks], *(const bfx8*)(sb + (16 * nt + l15) * 512 + 32 * ks + 8 * q4), acc);
#pragma unroll
                for (int ks = 0; ks < 8; ++ks) acc = MFMA16(xa[ks], *(const bfx8*)(sb + (16 * nt + l15) * 512 + 256 + 32 * ks + 8 * q4), acc);
#pragma unroll
                for (int r = 0; r < 4; ++r) {
                    const int tl = 16 * (4 * q4 + r) + nt;
                    const float u = bf2f(p.P[((size_t)b * TJ + 16 * s0 + tl) * DINP + C_S5U + 16 * g + l15]);
                    Z[tl * S5_ZS + 16 * g + l15] = f2bf(gelu_tanh(acc[r] + dsk * u));
                }
            }
        }
        __syncthreads();
#pragma unroll 1
        for (int m2 = 0; m2 < 2; ++m2) {
            const int mt = 2 * w + m2;
            bfx8 za[8];
#pragma unroll
            for (int ks = 0; ks < 8; ++ks) za[ks] = *(const bfx8*)(Z + (16 * mt + l15) * S5_ZS + 32 * ks + 8 * q4);
#pragma unroll 2
            for (int nt = 0; nt < 16; ++nt) {
                f32x4_ acc = {0.f, 0.f, 0.f, 0.f};
#pragma unroll
                for (int ks = 0; ks < 8; ++ks) acc = MFMA16(za[ks], *(const bfx8*)(p.GLUt + (16 * nt + l15) * 256 + 32 * ks + 8 * q4), acc);
                const int co = 16 * nt + l15; const float gb = p.s5_glu_b[layer * 256 + co];
#pragma unroll
                for (int r = 0; r < 4; ++r) {
                    const int tl = 16 * mt + 4 * q4 + r;
                    const float z = bf2f(Z[tl * S5_ZS + co]);
                    p.Y[((size_t)b * TJ + 16 * s0 + tl) * DM + 256 + co] = f2bf(z * sigmoidf_(acc[r] + gb));
                }
            }
        }
    }
}

__device__ __forceinline__ void ph_scans_dn_only(const int wv_, unsigned char* smem, const Params& p, int layer) {
    PH_IDS();
    if (bid_ < 32) dn_chain(smem, p, layer, bid_, tid_);
}
__device__ __forceinline__ void ph_scans(const int wv_, unsigned char* smem, const Params& p, int layer) {
    PH_IDS();
    if (bid_ < 32) { dn_chain(smem, p, layer, bid_, tid_); return; }
    if (bid_ < 112) {
        if (bid_ < 96) gla2_scan(p, bid_ - 32, tid_); else s5_2_scan(p, bid_ - 96, tid_);
#ifndef EMU
        asm volatile("s_waitcnt vmcnt(0)" ::: "memory");
        __syncthreads();
        if (tid_ == 0) { __builtin_amdgcn_fence(__ATOMIC_RELEASE, "agent"); asm volatile("s_waitcnt vmcnt(0)" ::: "memory"); (void)xb_add((unsigned*)p.cnt + 129, 1u); }
#endif
    }
}
#ifndef EMU
__device__ __forceinline__ void ph_wait_scans(const int wv_, const Params& p) {
    PH_IDS();
    if (tid_ == 0) {
        unsigned sp = 0;
        while (xb_ld((unsigned*)p.cnt + 129) < 80u) { __builtin_amdgcn_s_sleep(2); if (++sp > (1u << 22)) break; }
        __builtin_amdgcn_fence(__ATOMIC_ACQUIRE, "agent");
        asm volatile("s_waitcnt vmcnt(0)" ::: "memory");
    }
    __syncthreads();
}
#endif

__device__ __forceinline__ void ph_attn_prep(const int wv_, unsigned char* smem, const Params& p, int layer) {
    PH_IDS();
    float2 (*sCS)[16] = (float2 (*)[16])(smem + 1024);
    bf16_t* sVt = (bf16_t*)(smem + 1024 + 8192);
    unsigned* sMax = (unsigned*)(smem + 64);
    const float qscale = 0.17677669529663687f * 1.4426950408889634f;
    for (int item = bid_; item < NB * 132; item += nblk_) {
        const int b = item / 132, kt = item - b * 132, tau0 = kt * 64; const bool lat = tau0 >= NCTX;
        __syncthreads();
        if (tid_ < 8) sMax[tid_] = 0u;
        for (int idx = tid_; idx < 1024; idx += NTHR) {
            const int tk = idx >> 4, i = idx & 15; float cs = 1.f, sn = 0.f;
            if (lat) { const int t = tau0 + tk - NCTX; const float base = (i < 8) ? (float)(t >> 6) : (float)(t & 63);
                const float inv = exp2f(-(float)(i & 7) * (13.287712379549449f / 8.0f)); sincosf(base * inv, &sn, &cs); }
            sCS[tk][i] = make_float2(cs, sn);
        }
        __syncthreads();
        const int tk = tid_ >> 3, hm = tid_ & 7, h = hm >> 1, m = hm & 1, tau = tau0 + tk, bh = b * 4 + h;
        const size_t r = (size_t)b * TJ + tau;
#pragma unroll
        for (int which = 0; which < 2; ++which) {
            const uint4* src = (const uint4*)(p.P + r * DINP + (which ? C_DAQ : C_DAK) + h * 64 + m * 32);
            uint4 raw[4]; raw[0] = src[0]; raw[1] = src[1]; raw[2] = src[2]; raw[3] = src[3];
            const unsigned* rw = (const unsigned*)raw; float x[32], o[32];
#pragma unroll
            for (int i = 0; i < 16; ++i) { x[2 * i] = __uint_as_float(rw[i] << 16); x[2 * i + 1] = __uint_as_float(rw[i] & 0xffff0000u); }
            float n2 = 0.f; const float sc = which ? qscale : 1.0f;
#pragma unroll
            for (int i = 0; i < 16; ++i) { const float2 c = sCS[tk][i]; o[i] = (x[i] * c.x - x[16 + i] * c.y) * sc; o[16 + i] = (x[i] * c.y + x[16 + i] * c.x) * sc; n2 += o[i] * o[i] + o[16 + i] * o[16 + i]; }
            uint4 w[4]; unsigned* ww = (unsigned*)w;
#pragma unroll
            for (int i = 0; i < 16; ++i) ww[i] = cvt_pk_bf16_(o[2 * i], o[2 * i + 1]);
            uint4* dst = (uint4*)((which ? p.Qr : p.Kr) + ((size_t)bh * TJ + tau) * 64 + m * 32);
            dst[0] = w[0]; dst[1] = w[1]; dst[2] = w[2]; dst[3] = w[3];
            if (which) p.Qn[((size_t)bh * TJ + tau) * 2 + m] = sqrtf(n2);
            else atomicMax(&sMax[hm], __float_as_uint(n2 * 1.02f));
        }
        {
            const uint4* src = (const uint4*)(p.P + r * DINP + C_DAV + h * 64 + m * 32);
            uint4 raw[4]; raw[0] = src[0]; raw[1] = src[1]; raw[2] = src[2]; raw[3] = src[3];
            const bf16_t* rv = (const bf16_t*)raw;
            const int pos = (tk & ~15) | ((tk & 4) << 1) | ((tk & 8) >> 1) | (tk & 3);
#pragma unroll
            for (int i = 0; i < 32; ++i) sVt[(h * 64 + m * 32 + i) * 64 + pos] = rv[i];
        }
        __syncthreads();
        if (tid_ < 8) atomicMax(&p.kmax[(b * 4 + (tid_ >> 1)) * 2 + (tid_ & 1)], sMax[tid_]);
        for (int c = tid_; c < 2048; c += NTHR) {
            const int row = c >> 3, ch = c & 7, hq = row >> 6, dv = row & 63;
            *(uint4*)(p.Vt + ((((size_t)(b * 4 + hq) * 132 + kt) * 64 + dv) * 64 + ch * 8)) = *(const uint4*)(sVt + row * 64 + ch * 8);
        }
    }
}

__device__ __forceinline__ void ph_attn(const int wv_, unsigned char* smem, const Params& p, int layer) {
    PH_IDS();
    const int lane = tid_ & 63, w = tid_ >> 6, ql = lane & 31, hh = lane >> 5;
    unsigned char* sK0 = smem + 1024;
    const int nitem = 512 + (layer < NLAYER - 1 ? 16 : 0);
    const float* lf = p.da_lambda + layer * 128;
    float d01 = 0.f, d23 = 0.f;
    for (int i = 0; i < 32; ++i) { d01 += lf[i] * lf[32 + i]; d23 += lf[64 + i] * lf[96 + i]; }
    const float lam_init = 0.8f - 0.6f * expf(-0.3f * (float)layer);
    const float lam = expf(d01) - expf(d23) + lam_init;
    const int skey = tid_ >> 3, sc = tid_ & 7;
    const unsigned sdst = (unsigned)(skey * 128 + ((sc ^ ((skey >> 1) & 7)) << 4));
    int* qctr = p.cnt + 128;
    int* sitem = (int*)(smem + 64);
    for (;;) {
        __syncthreads();
        if (tid_ == 0) sitem[0] = atomicAdd(qctr, 1);
        __syncthreads();
        const int item = sitem[0];
        if (item >= nitem) break;
        const int is_ctx = item >= 512;
        const int bh = is_ctx ? item - 512 : item >> 5, b = bh >> 2, h = bh & 3;
        const int qtau = is_ctx ? w * 32 + ql : NCTX + (item & 31) * 256 + w * 32 + ql;
        const int ntile = is_ctx ? 4 : TJ / 64;
        bfx8 qf[2][2];
        const bf16_t* qp = p.Qr + ((size_t)bh * TJ + qtau) * 64 + hh * 8;
#pragma unroll
        for (int m = 0; m < 2; ++m)
#pragma unroll
            for (int ks = 0; ks < 2; ++ks) qf[m][ks] = *(const bfx8*)(qp + m * 32 + ks * 16);
        float negm[2];
#pragma unroll
        for (int m = 0; m < 2; ++m) negm[m] = -p.Qn[((size_t)bh * TJ + qtau) * 2 + m] * sqrtf(__uint_as_float(p.kmax[bh * 2 + m]));
        f32x16 O[2][2];
#pragma unroll
        for (int m = 0; m < 2; ++m)
#pragma unroll
            for (int t = 0; t < 2; ++t)
#pragma unroll
                for (int i = 0; i < 16; ++i) O[m][t][i] = 0.f;
        float l[2] = {0.f, 0.f};
        const char* kbase = (const char*)(p.Kr + (size_t)bh * TJ * 64) + tid_ * 16;
        const char* vbase = (const char*)(p.Vt + (size_t)bh * 132 * 4096) + tid_ * 16;
        __syncthreads();
        {
            uint4 k0 = *(const uint4*)kbase, v0 = *(const uint4*)vbase;
            *(uint4*)(sK0 + sdst) = k0; *(uint4*)(sK0 + 8192 + sdst) = v0;
        }
        __syncthreads();
        for (int kt = 0; kt < ntile; ++kt) {
            unsigned char* sK = sK0 + (kt & 1) * 16384; unsigned char* sV = sK + 8192;
            uint4 kn = make_uint4(0, 0, 0, 0), vn = make_uint4(0, 0, 0, 0);
            if (kt + 1 < ntile) { kn = *(const uint4*)(kbase + (size_t)(kt + 1) * 8192); vn = *(const uint4*)(vbase + (size_t)(kt + 1) * 8192); }
#pragma unroll
            for (int sb = 0; sb < 2; ++sb) {
                bfx8 pf[2][2];
#pragma unroll
                for (int m = 0; m < 2; ++m) {
                    f32x16 S;
#pragma unroll
                    for (int i = 0; i < 16; ++i) S[i] = negm[m];
                    const int key = sb * 32 + ql;
#pragma unroll
                    for (int ks = 0; ks < 2; ++ks) {
                        const int c = m * 4 + ks * 2 + hh;
                        const bfx8 kf = *(const bfx8*)(sK + key * 128 + ((c ^ ((key >> 1) & 7)) << 4));
                        S = __builtin_amdgcn_mfma_f32_32x32x16_bf16(kf, qf[m][ks], S, 0, 0, 0);
                    }
                    float ls = 0.f;
#pragma unroll
                    for (int i = 0; i < 16; ++i) { S[i] = __builtin_amdgcn_exp2f(S[i]); ls += S[i]; }
                    l[m] += ls;
#pragma unroll
                    for (int s2 = 0; s2 < 2; ++s2) {
                        unsigned u[4];
#pragma unroll
                        for (int j = 0; j < 4; ++j) u[j] = cvt_pk_bf16_(S[8 * s2 + 2 * j], S[8 * s2 + 2 * j + 1]);
                        pf[m][s2] = *(const bfx8*)u;
                    }
                }
#pragma unroll
                for (int t = 0; t < 2; ++t)
#pragma unroll
                    for (int s2 = 0; s2 < 2; ++s2) {
                        const int dv = t * 32 + ql, c = (sb * 2 + s2) * 2 + hh;
                        const bfx8 vf = *(const bfx8*)(sV + dv * 128 + ((c ^ ((dv >> 1) & 7)) << 4));
                        O[0][t] = __builtin_amdgcn_mfma_f32_32x32x16_bf16(vf, pf[0][s2], O[0][t], 0, 0, 0);
                        O[1][t] = __builtin_amdgcn_mfma_f32_32x32x16_bf16(vf, pf[1][s2], O[1][t], 0, 0, 0);
                    }
            }
            if (kt + 1 < ntile) { unsigned char* dK = sK0 + ((kt + 1) & 1) * 16384; *(uint4*)(dK + sdst) = kn; *(uint4*)(dK + 8192 + sdst) = vn; }
            __syncthreads();
        }
        const float l0 = l[0] + __shfl_xor(l[0], 32, 64), l1 = l[1] + __shfl_xor(l[1], 32, 64);
        const float i0 = 1.0f / l0, i1 = lam / l1;
        float ss = 0.f;
#pragma unroll
        for (int t = 0; t < 2; ++t)
#pragma unroll
            for (int i = 0; i < 16; ++i) { const float o = O[0][t][i] * i0 - O[1][t][i] * i1; O[0][t][i] = o; ss += o * o; }
        ss += __shfl_xor(ss, 32, 64);
        const float rs = rsqrtf(ss * (1.0f / 64.0f) + 1e-5f) * (1.0f - lam_init);
        const float* g = p.da_norm_g + layer * 64;
        bf16_t* yo = p.Y + ((size_t)b * TJ + qtau) * DM + 512 + h * 64;
#pragma unroll
        for (int t = 0; t < 2; ++t)
#pragma unroll
            for (int gq = 0; gq < 4; ++gq) {
                const int dv0 = 32 * t + 8 * gq + 4 * hh;
                uint2 w2;
                w2.x = cvt_pk_bf16_(O[0][t][4 * gq] * rs * g[dv0], O[0][t][4 * gq + 1] * rs * g[dv0 + 1]);
                w2.y = cvt_pk_bf16_(O[0][t][4 * gq + 2] * rs * g[dv0 + 2], O[0][t][4 * gq + 3] * rs * g[dv0 + 3]);
                *(uint2*)(yo + dv0) = w2;
            }
    }
}

__device__ __forceinline__ void ph_finish(const int wv_, unsigned char* smem, const Params& p, int layer) {
    PH_IDS();
    const int lane = tid_ & 63;
    for (int it = WID; it < NTOK * 4; it += GWV) {
        const int r = it >> 2, h = it & 3;
        if (layer == NLAYER - 1 && (r % TJ) < NCTX) continue;
        const float o = bf2f(p.Y[(size_t)r * DM + h * 64 + lane]) + bf2f(p.ODN[(size_t)r * 256 + h * 64 + lane]);
        const float ss = wave_sum(o * o), rs = rsqrtf(ss * (1.f / 64.f) + 1e-6f);
        const float z = bf2f(p.P[(size_t)r * DINP + C_DNZ + h * 64 + lane]);
        p.Y[(size_t)r * DM + h * 64 + lane] = f2bf(o * rs * p.dn_norm_g[layer * 64 + lane] * siluf_(z));
    }
}

__device__ __forceinline__ void ph_norm2_route(const int wv_, unsigned char* smem, const Params& p, int layer) {
    PH_IDS();
    int lane = tid_ & 63;
    float* swr = (float*)(smem + 1024);
    __syncthreads();
    for (int i = tid_; i < DM * 16; i += NTHR) { const int k = i >> 4, e = i & 15; swr[e * DM + k] = p.w_router[i]; }
    __syncthreads();
    for (int r = WID; r < NTOK; r += GWV) {
        if (layer == NLAYER - 1 && (r % TJ) < NCTX) continue;
        const float* h = hrow(p, r); const float* md = modrow(p, layer, r);
        float f[16]; float ss = 0.f;
#pragma unroll
        for (int i = 0; i < 4; ++i) { float4 v = *(const float4*)(h + i * 256 + lane * 4); f[i * 4] = v.x; f[i * 4 + 1] = v.y; f[i * 4 + 2] = v.z; f[i * 4 + 3] = v.w; ss += v.x * v.x + v.y * v.y + v.z * v.z + v.w * v.w; }
        ss = wave_sum(ss);
        float rs = rsqrtf(ss * (1.0f / DM) + 1e-6f);
        const float* g = p.norm2_g + layer * DM;
        float sc[16];
#pragma unroll
        for (int e = 0; e < 16; ++e) sc[e] = 0.f;
#pragma unroll
        for (int i = 0; i < 4; ++i) {
            int c0 = i * 256 + lane * 4; ushort4 ob; bf16_t* obp = (bf16_t*)&ob;
            float vq[4];
#pragma unroll
            for (int j = 0; j < 4; ++j) { vq[j] = f[i * 4 + j] * rs * g[c0 + j] * (1.f + md[4 * DM + c0 + j]) + md[3 * DM + c0 + j]; obp[j] = f2bf(vq[j]); }
#pragma unroll
            for (int e = 0; e < 16; ++e) { const float4 w = *(const float4*)(swr + e * DM + c0); sc[e] += vq[0] * w.x + vq[1] * w.y + vq[2] * w.z + vq[3] * w.w; }
            *(ushort4*)(p.A + (size_t)r * DM + c0) = ob;
        }
#pragma unroll
        for (int e = 0; e < 16; ++e) sc[e] = wave_sum(sc[e]);
        if (lane == 0) {
            float s[16], gb[16];
#pragma unroll
            for (int e = 0; e < 16; ++e) { s[e] = sigmoidf_(sc[e]); gb[e] = s[e] + p.b_router[e]; }
            int best = 0; float bestv = -1e30f;
#pragma unroll
            for (int gI = 0; gI < 4; ++gI) {
                float a0 = -1e30f, a1 = -1e30f;
#pragma unroll
                for (int j = 0; j < 4; ++j) { float v = gb[gI * 4 + j]; if (v > a0) { a1 = a0; a0 = v; } else if (v > a1) a1 = v; }
                float gs = a0 + a1; if (gs > bestv) { bestv = gs; best = gI; }
            }
            int i0 = 0, i1 = 0; float v0 = -1e30f, v1 = -1e30f;
#pragma unroll
            for (int j = 0; j < 4; ++j) {
                float v = 0.f;
#pragma unroll
                for (int gI = 0; gI < 4; ++gI) if (gI == best) v = gb[gI * 4 + j];
                if (v > v0) { v1 = v0; i1 = i0; v0 = v; i0 = j; } else if (v > v1) { v1 = v; i1 = j; }
            }
            int e0 = best * 4 + i0, e1 = best * 4 + i1;
            float w0 = 0.f, w1 = 0.f;
#pragma unroll
            for (int e = 0; e < 16; ++e) { if (e == e0) w0 = s[e]; if (e == e1) w1 = s[e]; }
            float inv = 1.f / (w0 + w1);
            p.tok_e[r * 2] = e0; p.tok_e[r * 2 + 1] = e1; p.tok_w[r * 2] = w0 * inv; p.tok_w[r * 2 + 1] = w1 * inv;
            p.tok_pos[r * 2] = atomicAdd(&p.cnt[e0], 1); p.tok_pos[r * 2 + 1] = atomicAdd(&p.cnt[e1], 1);
        }
    }
}

__device__ __forceinline__ void ph_moe_gather(const int wv_, unsigned char* smem, const Params& p, int layer) {
    PH_IDS();
    int* sstart = (int*)(smem + 64);
    __syncthreads();
    if (tid_ == 0) {
        int acc = 0;
        for (int e = 0; e < 16; ++e) { sstart[e] = acc; acc += (p.cnt[e] + 255) / 256 * 256; if (bid_ == 0) p.cnt[16 + e] = acc; }
        if (bid_ == 0) p.cnt[32] = acc;
    }
    __syncthreads();
    int lane = tid_ & 63;
    for (int pr = WID; pr < NTOK * 2; pr += GWV) {
        int r = pr >> 1;
        if (layer == NLAYER - 1 && (r % TJ) < NCTX) continue;
        int slot = sstart[p.tok_e[pr]] + p.tok_pos[pr];
        if (lane == 0) p.tok_slot[pr] = slot;
        const uint4* src = (const uint4*)(p.A + (size_t)r * DM); uint4* dst = (uint4*)(p.BUF + (size_t)slot * DM);
        dst[lane] = src[lane]; dst[lane + 64] = src[lane + 64];
    }
}

__device__ __forceinline__ void ph_moe_combine(const int wv_, const Params& p, int layer) {
    PH_IDS();
    int lane = tid_ & 63;
    for (int r = WID; r < NTOK; r += GWV) {
        if (layer == NLAYER - 1 && (r % TJ) < NCTX) continue;
        float* h = hrow(p, r); const float* md = modrow(p, layer, r) + 5 * DM;
        int s0 = p.tok_slot[r * 2], s1 = p.tok_slot[r * 2 + 1]; float w0 = p.tok_w[r * 2], w1 = p.tok_w[r * 2 + 1];
        const bf16_t* p0 = p.PO + (size_t)s0 * DM; const bf16_t* p1 = p.PO + (size_t)s1 * DM;
        float v[16]; float ss = 0.f;
#pragma unroll
        for (int i = 0; i < 4; ++i) {
            int c0 = i * 256 + lane * 4;
            float4 hv = *(const float4*)(h + c0); ushort4 a = *(const ushort4*)(p0 + c0), bq = *(const ushort4*)(p1 + c0); float4 m = *(const float4*)(md + c0);
            hv.x += m.x * (w0 * bf2f(a.x) + w1 * bf2f(bq.x)); hv.y += m.y * (w0 * bf2f(a.y) + w1 * bf2f(bq.y));
            hv.z += m.z * (w0 * bf2f(a.z) + w1 * bf2f(bq.z)); hv.w += m.w * (w0 * bf2f(a.w) + w1 * bf2f(bq.w));
            v[i * 4] = hv.x; v[i * 4 + 1] = hv.y; v[i * 4 + 2] = hv.z; v[i * 4 + 3] = hv.w;
            ss += hv.x * hv.x + hv.y * hv.y + hv.z * hv.z + hv.w * hv.w;
        }
        if (layer == NLAYER - 1) {
            ss = wave_sum(ss); float rs = rsqrtf(ss * (1.0f / DM) + 1e-6f);
#pragma unroll
            for (int i = 0; i < 4; ++i) { int c0 = i * 256 + lane * 4; float4 g = *(const float4*)(p.final_g + c0);
                float4 o; o.x = v[i * 4] * rs * g.x; o.y = v[i * 4 + 1] * rs * g.y; o.z = v[i * 4 + 2] * rs * g.z; o.w = v[i * 4 + 3] * rs * g.w; *(float4*)(h + c0) = o; }
        } else {
#pragma unroll
            for (int i = 0; i < 4; ++i) { int c0 = i * 256 + lane * 4; float4 o; o.x = v[i * 4]; o.y = v[i * 4 + 1]; o.z = v[i * 4 + 2]; o.w = v[i * 4 + 3]; *(float4*)(h + c0) = o; }
        }
    }
}


#ifndef EMU
struct CvtTask { const float* src; bf16_t* dst; int lds, K, N, Nsrc, ldd; };
__device__ __forceinline__ void cvt_tiles(unsigned char* smem, const CvtTask& t, int& base, int tid_, int bid_, int nblk_) {
    float (*sT)[65] = (float (*)[65])(smem + 1024);
    const int nkt = t.K / 64, nnt = t.N / 64, ntile = nkt * nnt;
    int first = (bid_ - base % nblk_ + nblk_) % nblk_;
    for (int it = first; it < ntile; it += nblk_) {
        const int kt = it % nkt, ntl = it / nkt, k0 = kt * 64, n0 = ntl * 64;
        __syncthreads();
#pragma unroll
        for (int j = 0; j < 2; ++j) {
            int k = (tid_ >> 4) + 32 * j, n4 = (tid_ & 15) * 4;
            float4 v = make_float4(0.f, 0.f, 0.f, 0.f);
            if (n0 + n4 < t.Nsrc) v = *(const float4*)(t.src + (size_t)(k0 + k) * t.lds + n0 + n4);
            sT[k][n4] = v.x; sT[k][n4 + 1] = v.y; sT[k][n4 + 2] = v.z; sT[k][n4 + 3] = v.w;
        }
        __syncthreads();
        {
            int n = tid_ >> 3, k8 = (tid_ & 7) * 8;
            ushort4 a, b;
            a.x = f2bf(sT[k8 + 0][n]); a.y = f2bf(sT[k8 + 1][n]); a.z = f2bf(sT[k8 + 2][n]); a.w = f2bf(sT[k8 + 3][n]);
            b.x = f2bf(sT[k8 + 4][n]); b.y = f2bf(sT[k8 + 5][n]); b.z = f2bf(sT[k8 + 6][n]); b.w = f2bf(sT[k8 + 7][n]);
            bf16_t* d = t.dst + (size_t)(n0 + n) * t.ldd + k0 + k8;
            *(ushort4*)d = a; *(ushort4*)(d + 4) = b;
        }
    }
    base += ntile;
}
__device__ __forceinline__ void ph_convert(const int wv_, unsigned char* smem, const Params& p, int layer) {
    PH_IDS();
    int base = 0;
    cvt_tiles(smem, CvtTask{p.w_in + (size_t)layer * DM * DIN, p.WinT, DIN, DM, DINP, DIN, DM}, base, tid_, bid_, nblk_);
    cvt_tiles(smem, CvtTask{p.w_gate + (size_t)layer * DM * 4096, p.WgT, 4096, DM, 4096, 4096, DM}, base, tid_, bid_, nblk_);
    for (int i = 0; i < 4; ++i)
        cvt_tiles(smem, CvtTask{p.w_branch + ((size_t)layer * 4 + i) * 256 * DM, p.WbrT + i * 256, DM, 256, DM, DM, DM}, base, tid_, bid_, nblk_);
    cvt_tiles(smem, CvtTask{p.w_out + (size_t)layer * DM * DM, p.WoT, DM, DM, DM, DM, DM}, base, tid_, bid_, nblk_);
}
__device__ __forceinline__ void ph_convert_experts(const int wv_, unsigned char* smem, const Params& p, int layer) {
    PH_IDS();
    int base = 0;
    for (int e = 0; e < NEXP; ++e) {
        for (int u = 0; u < 4; ++u) {
            cvt_tiles(smem, CvtTask{p.w_e_gate + ((size_t)layer * NEXP + e) * DM * DEXP + u * 128, p.WguT + ((size_t)e * 1024 + u * 256) * DM, DEXP, DM, 128, 128, DM}, base, tid_, bid_, nblk_);
            cvt_tiles(smem, CvtTask{p.w_e_up + ((size_t)layer * NEXP + e) * DM * DEXP + u * 128, p.WguT + ((size_t)e * 1024 + u * 256 + 128) * DM, DEXP, DM, 128, 128, DM}, base, tid_, bid_, nblk_);
        }
        cvt_tiles(smem, CvtTask{p.w_e_down + ((size_t)layer * NEXP + e) * DEXP * DM, p.WdT + (size_t)e * DM * DEXP, DM, DEXP, DM, DM, DEXP}, base, tid_, bid_, nblk_);
    }
}

namespace pg8 {
#define PG8_LAS __attribute__((address_space(3)))
typedef short bf16x8 __attribute__((ext_vector_type(8)));
typedef float f32x4 __attribute__((ext_vector_type(4)));
typedef unsigned u32x4 __attribute__((ext_vector_type(4)));
constexpr int BM = 256, BK = 64, HALF = 128, HTB = HALF * BK * 2, STAGE_BYTES = 8 * HTB, NXCD = 8, WGM = 8;
__host__ __device__ __forceinline__ int lds_byte(int r, int c) { const int st = (r >> 4) * 2 + (c >> 5), rr = r & 15, cc = c & 31, ob = rr * 64 + cc * 2; return st * 1024 + (ob ^ (((ob >> 9) & 1) << 5)); }
__host__ __device__ __forceinline__ void stage_rc(int b, int& R, int& C) { const int st = b / 1024, sb = b % 1024, swz = sb ^ (((sb >> 9) & 1) << 5); R = (st >> 1) * 16 + swz / 64; C = (st & 1) * 32 + (swz % 64) / 2; }
__host__ __device__ __forceinline__ int perm32(int rho) { const int n = rho >> 4, i = rho & 15; return 8 * (i >> 2) + 4 * n + (i & 3); }
struct Unit { int pm, pn, nt, kind; const char* a; const char* b; };
__device__ __forceinline__ void static_map(int L, int nM, int nN, int& pm, int& pn) {
    const int nwg = nM * nN; int wgid = L; { const int q = nwg / NXCD, r = nwg % NXCD, xcd = wgid % NXCD, off = wgid / NXCD; wgid = (xcd < r ? xcd * (q + 1) : r * (q + 1) + (xcd - r) * q) + off; }
    const int nig = WGM * nN, gid = wgid / nig, fm = gid * WGM, gsz = (nM - fm) < WGM ? (nM - fm) : WGM;
    pm = fm + ((wgid % nig) % gsz); pn = (wgid % nig) / gsz;
}
__device__ __forceinline__ unsigned cvt_pk_bf16(float lo, float hi) { return cvt_pk_bf16_(lo, hi); }

template <class Epi, class Sched>
__device__ __forceinline__ void gemm_phase(PG8_LAS unsigned char* lds, const int lda, const int ldb, const Sched& S, const Epi& E, int tid) {
    asm volatile("" : "+v"(tid));
    const int wid = __builtin_amdgcn_readfirstlane(tid >> 6), lane = tid & 63, wr = wid >> 2, wc = wid & 3, fr = lane & 15, fq = lane >> 4;
    unsigned voffA[2], voffB[2];
#pragma unroll
    for (int i = 0; i < 2; ++i) { int R, C; stage_rc(tid * 16 + i * 8192, R, C); const int Rb = Epi::PERM ? ((R & ~31) + perm32(R & 31)) : R;
        voffA[i] = (unsigned)(R * lda + C) * 2u; voffB[i] = (unsigned)(Rb * ldb + C) * 2u; }
    const size_t kstep = (size_t)(BK * 2);
    const size_t hstepA = (size_t)HALF * lda * 2, hstepB = (size_t)HALF * ldb * 2;
    const unsigned ldsw = (unsigned)wid * 1024u;
    const int aoff = lds_byte(wr * 64 + fr, fq * 8), boff = lds_byte(wc * 32 + fr, fq * 8);
#define PG8_SA(b, h) (((b) * 2 + (h)) * HTB)
#define PG8_SB(b, h) ((4 + (b) * 2 + (h)) * HTB)
#define PG8_STAGE(bufoff, gbase, voff) do { _Pragma("unroll") for (int _i = 0; _i < 2; ++_i) \
        __builtin_amdgcn_global_load_lds((const unsigned*)((const char*)(gbase) + (voff)[_i]), (PG8_LAS unsigned*)(lds + (bufoff) + ldsw + _i * 8192), 16, 0, 0); } while (0)
#define PG8_LDA(dst, b, h) do { _Pragma("unroll") for (int m = 0; m < 4; ++m) _Pragma("unroll") for (int k = 0; k < 2; ++k) dst[m][k] = *(const PG8_LAS bf16x8*)(lds + PG8_SA(b, h) + aoff + m * 2048 + k * 1024); } while (0)
#define PG8_LDB(dst, b, h) do { _Pragma("unroll") for (int n = 0; n < 2; ++n) _Pragma("unroll") for (int k = 0; k < 2; ++k) dst[n][k] = *(const PG8_LAS bf16x8*)(lds + PG8_SB(b, h) + boff + n * 2048 + k * 1024); } while (0)
#define PG8_MMA(ai, bj, At, Bt) do { __builtin_amdgcn_s_setprio(1); _Pragma("unroll") for (int m = 0; m < 4; ++m) _Pragma("unroll") for (int n = 0; n < 2; ++n) _Pragma("unroll") for (int k = 0; k < 2; ++k) \
        acc[ai][bj][m][n] = __builtin_amdgcn_mfma_f32_16x16x32_bf16(Bt[n][k], At[m][k], acc[ai][bj][m][n], 0, 0, 0); __builtin_amdgcn_s_setprio(0); } while (0)
#define PG8_WAIT_V(n) asm volatile("s_waitcnt vmcnt(" #n ")" ::: "memory")
#define PG8_WAIT_L(n) asm volatile("s_waitcnt lgkmcnt(" #n ")" ::: "memory")
#define PG8_BAR __builtin_amdgcn_s_barrier()
#define PG8_SCHED __builtin_amdgcn_sched_barrier(0)
    Unit cur, nxt; int ui = 0;
    if (!S.next(0, cur)) return;
    f32x4 acc[2][2][4][2];
#pragma unroll
    for (int a = 0; a < 2; ++a)
#pragma unroll
        for (int b = 0; b < 2; ++b)
#pragma unroll
            for (int m = 0; m < 4; ++m)
#pragma unroll
                for (int n = 0; n < 2; ++n) acc[a][b][m][n] = (f32x4){0.f, 0.f, 0.f, 0.f};
    bf16x8 At[4][2], B0[2][2], B1[2][2];
    const char* cA = cur.a; const char* cB = cur.b;
    PG8_STAGE(PG8_SB(0, 0), cB, voffB); PG8_STAGE(PG8_SA(0, 0), cA, voffA); PG8_STAGE(PG8_SB(0, 1), cB + hstepB, voffB); PG8_STAGE(PG8_SA(0, 1), cA + hstepA, voffA);
    if (wr == 1) PG8_BAR;
    PG8_WAIT_V(4); PG8_BAR;
    PG8_STAGE(PG8_SB(1, 0), cB + kstep, voffB); PG8_STAGE(PG8_SA(1, 0), cA + kstep, voffA); PG8_STAGE(PG8_SB(1, 1), cB + hstepB + kstep, voffB);
    PG8_WAIT_V(6); PG8_BAR;
    for (;;) {
        const bool has_next = S.next(ui + 1, nxt);
        const char* nA = has_next ? nxt.a : cA; const char* nB = has_next ? nxt.b : cB;
        const int nt = cur.nt;
        for (int t = 0; t < nt; t += 2) {
            const bool last = (t == nt - 2);
            const char* a1 = cA + (size_t)(t + 1) * kstep;
            const char* a2 = last ? nA : cA + (size_t)(t + 2) * kstep; const char* b2 = last ? nB : cB + (size_t)(t + 2) * kstep;
            const char* a3 = a2 + kstep; const char* b3 = b2 + kstep;
            PG8_LDB(B0, 0, 0); PG8_SCHED; PG8_LDA(At, 0, 0); PG8_STAGE(PG8_SA(1, 1), a1 + hstepA, voffA);
            PG8_WAIT_L(8); PG8_BAR; PG8_WAIT_L(0); PG8_MMA(0, 0, At, B0); PG8_BAR; PG8_SCHED;
            PG8_LDB(B1, 0, 1); PG8_STAGE(PG8_SB(0, 0), b2, voffB);
            PG8_BAR; PG8_WAIT_L(0); PG8_MMA(0, 1, At, B1); PG8_BAR;
            PG8_LDA(At, 0, 1); PG8_STAGE(PG8_SA(0, 0), a2, voffA);
            PG8_BAR; PG8_WAIT_L(0); PG8_MMA(1, 0, At, B0); PG8_BAR; PG8_SCHED;
            PG8_STAGE(PG8_SB(0, 1), b2 + hstepB, voffB);
            PG8_WAIT_V(6); PG8_BAR; PG8_MMA(1, 1, At, B1); PG8_BAR;
            PG8_LDB(B0, 1, 0); PG8_SCHED; PG8_LDA(At, 1, 0); PG8_STAGE(PG8_SA(0, 1), a2 + hstepA, voffA);
            PG8_WAIT_L(8); PG8_BAR; PG8_WAIT_L(0); PG8_MMA(0, 0, At, B0); PG8_BAR; PG8_SCHED;
            PG8_LDB(B1, 1, 1); PG8_STAGE(PG8_SB(1, 0), b3, voffB);
            PG8_BAR; PG8_WAIT_L(0); PG8_MMA(0, 1, At, B1); PG8_BAR;
            PG8_LDA(At, 1, 1); PG8_STAGE(PG8_SA(1, 0), a3, voffA);
            PG8_BAR; PG8_WAIT_L(0); PG8_MMA(1, 0, At, B0); PG8_BAR; PG8_SCHED;
            PG8_STAGE(PG8_SB(1, 1), b3 + hstepB, voffB);
            PG8_WAIT_V(6); PG8_BAR; PG8_MMA(1, 1, At, B1); PG8_BAR;
        }
        E(acc, cur, wr, wc, fr, fq, tid);
        if (!has_next) break;
#pragma unroll
        for (int a = 0; a < 2; ++a)
#pragma unroll
            for (int b = 0; b < 2; ++b)
#pragma unroll
                for (int m = 0; m < 4; ++m)
#pragma unroll
                    for (int n = 0; n < 2; ++n) acc[a][b][m][n] = (f32x4){0.f, 0.f, 0.f, 0.f};
        cur = nxt; cA = nA; cB = nB; ++ui;
    }
    PG8_WAIT_V(0);
    if (wr == 0) PG8_BAR;
    PG8_BAR;
#undef PG8_SA
#undef PG8_SB
#undef PG8_STAGE
#undef PG8_LDA
#undef PG8_LDB
#undef PG8_MMA
#undef PG8_WAIT_V
#undef PG8_WAIT_L
#undef PG8_BAR
#undef PG8_SCHED
}

struct SchedRows {
    const char* A; const char* Bt; int lda, ldb, nt, nN, nM, skip_ctx, G, c;
    __device__ __forceinline__ bool next(int i, Unit& u) const {
        const int L = i * G + c; if (L >= nM * nN) return false;
        int pmi, pn; static_map(L, nM, nN, pmi, pn);
        const int pm = skip_ctx ? (pmi >> 5) * 33 + 1 + (pmi & 31) : pmi;
        u.pm = pm; u.pn = pn; u.nt = nt; u.kind = 0;
        u.a = A + (size_t)pm * 256 * lda * 2; u.b = Bt + (size_t)pn * 256 * ldb * 2; return true;
    }
};
struct SchedMerge {
    const char* A; const char* Y; const char* WgT; const char* WbrT; int nM, skip_ctx, G, c;
    __device__ __forceinline__ bool next(int i, Unit& u) const {
        const int ch = (i >> 3) * G + c, sub = i & 7; if (ch >= nM * 4) return false;
        int pmi, pn; static_map(ch, nM, 4, pmi, pn);
        const int pm = skip_ctx ? (pmi >> 5) * 33 + 1 + (pmi & 31) : pmi, br = sub >> 1;
        u.pm = pm; u.pn = pn; u.kind = sub;
        if (sub & 1) { u.nt = 4;  u.a = Y + ((size_t)pm * 256 * DM + br * 256) * 2; u.b = WbrT + ((size_t)pn * 256 * DM + br * 256) * 2; }
        else         { u.nt = 16; u.a = A + (size_t)pm * 256 * DM * 2;              u.b = WgT + ((size_t)br * DM + pn * 256) * DM * 2; }
        return true;
    }
};
struct SchedMoe {
    const char* A; const char* Bt; const int* pe  ; int lda, ldb, nt, nN, G, c;
    __device__ __forceinline__ bool next(int i, Unit& u) const {
        const int nM = pe[16] >> 8; const int L = i * G + c; if (L >= nM * nN) return false;
        int pm, pn; static_map(L, nM, nN, pm, pn);
        int e = 0;
#pragma unroll
        for (int j = 0; j < 16; ++j) e += (pe[j] <= pm * 256) ? 1 : 0;
        if (e > 15) e = 15;
        u.pm = pm; u.pn = pn; u.nt = nt; u.kind = e;
        u.a = A + (size_t)pm * 256 * lda * 2; u.b = Bt + ((size_t)e * nN + pn) * 256 * ldb * 2; return true;
    }
};

struct EpiBf16 {
    static constexpr bool PERM = true;
    bf16_t* O; int ldc;
    __device__ __forceinline__ void operator()(const f32x4 (&acc)[2][2][4][2], const Unit& u, int wr, int wc, int fr, int fq, int tid) const {
        const int row0 = u.pm * BM + wr * 64 + fr, col0 = u.pn * BM + wc * 32 + 8 * fq;
#pragma unroll
        for (int ai = 0; ai < 2; ++ai)
#pragma unroll
            for (int m = 0; m < 4; ++m) { bf16_t* rowp = O + (size_t)(row0 + ai * HALF + m * 16) * ldc + col0;
#pragma unroll
                for (int bj = 0; bj < 2; ++bj) { const f32x4 v0 = acc[ai][bj][m][0], v1 = acc[ai][bj][m][1];
                    u32x4 w; w.x = cvt_pk_bf16(v0[0], v0[1]); w.y = cvt_pk_bf16(v0[2], v0[3]); w.z = cvt_pk_bf16(v1[0], v1[1]); w.w = cvt_pk_bf16(v1[2], v1[3]);
                    *(u32x4*)(rowp + bj * HALF) = w; } }
    }
};
struct EpiResidual {
    static constexpr bool PERM = false;
    float* hctx; float* out; const float* mod; int layer, modoff;
    __device__ __forceinline__ void operator()(const f32x4 (&acc)[2][2][4][2], const Unit& u, int wr, int wc, int fr, int fq, int tid) const {
        const int row0 = u.pm * BM + wr * 64 + fr, col0 = u.pn * BM + wc * 32 + 4 * fq;
        const int b = (u.pm * BM) / TJ; const bool isctx = (u.pm * BM - b * TJ) < NCTX;
        const float* md = mod + ((size_t)layer * 5 + (isctx ? 4 : b)) * (6 * DM) + modoff * DM + col0;
        f32x4 mv[2][2];
#pragma unroll
        for (int bj = 0; bj < 2; ++bj)
#pragma unroll
            for (int n = 0; n < 2; ++n) mv[bj][n] = *(const f32x4*)(md + bj * HALF + n * 16);
#pragma unroll
        for (int ai = 0; ai < 2; ++ai)
#pragma unroll
            for (int m = 0; m < 4; ++m) {
                const int r = row0 + ai * HALF + m * 16, tau = r - b * TJ;
                float* rowp = (isctx ? hctx + ((size_t)b * NCTX + tau) * DM : out + ((size_t)b * SEQ + (tau - NCTX)) * DM) + col0;
#pragma unroll
                for (int bj = 0; bj < 2; ++bj)
#pragma unroll
                    for (int n = 0; n < 2; ++n) { f32x4* q = (f32x4*)(rowp + bj * HALF + n * 16); *q = *q + mv[bj][n] * acc[ai][bj][m][n]; }
            }
    }
};
struct EpiMerge {
    static constexpr bool PERM = true;
    bf16_t* T; bf16_t* stash  ; const float* bgate;
    __device__ __forceinline__ void operator()(const f32x4 (&acc)[2][2][4][2], const Unit& u, int wr, int wc, int fr, int fq, int tid) const {
        const int br = u.kind >> 1;
        asm volatile("" : "+v"(tid));
        const unsigned soff = (unsigned)tid * 16u;
        if ((u.kind & 1) == 0) {
            const float* bg = bgate + br * DM + u.pn * BM + wc * 32 + 8 * fq;
            f32x4 bv[2][2];
#pragma unroll
            for (int bj = 0; bj < 2; ++bj)
#pragma unroll
                for (int n = 0; n < 2; ++n) bv[bj][n] = *(const f32x4*)(bg + bj * HALF + 4 * n);
#pragma unroll
            for (int ai = 0; ai < 2; ++ai)
#pragma unroll
                for (int m = 0; m < 4; ++m)
#pragma unroll
                    for (int bj = 0; bj < 2; ++bj) { f32x4 v0 = acc[ai][bj][m][0] + bv[bj][0], v1 = acc[ai][bj][m][1] + bv[bj][1];
#pragma unroll
                        for (int j = 0; j < 4; ++j) { v0[j] = sigmoidf_(v0[j]); v1[j] = sigmoidf_(v1[j]); }
                        u32x4 w; w.x = cvt_pk_bf16(v0[0], v0[1]); w.y = cvt_pk_bf16(v0[2], v0[3]); w.z = cvt_pk_bf16(v1[0], v1[1]); w.w = cvt_pk_bf16(v1[2], v1[3]);
                        *(u32x4*)((char*)stash + (soff + (unsigned)(((ai * 4 + m) * 2 + bj) * NTHR * 16))) = w; }
        } else {
            const int row0 = u.pm * BM + wr * 64 + fr, col0 = u.pn * BM + wc * 32 + 8 * fq;
#pragma unroll
            for (int ai = 0; ai < 2; ++ai)
#pragma unroll
                for (int m = 0; m < 4; ++m) { bf16_t* rowp = T + (size_t)(row0 + ai * HALF + m * 16) * DM + col0;
#pragma unroll
                    for (int bj = 0; bj < 2; ++bj) {
                        const u32x4 g = *(const u32x4*)((const char*)stash + (soff + (unsigned)(((ai * 4 + m) * 2 + bj) * NTHR * 16)));
                        f32x4 v0 = acc[ai][bj][m][0], v1 = acc[ai][bj][m][1];
                        v0[0] *= __uint_as_float(g.x << 16); v0[1] *= __uint_as_float(g.x & 0xffff0000u); v0[2] *= __uint_as_float(g.y << 16); v0[3] *= __uint_as_float(g.y & 0xffff0000u);
                        v1[0] *= __uint_as_float(g.z << 16); v1[1] *= __uint_as_float(g.z & 0xffff0000u); v1[2] *= __uint_as_float(g.w << 16); v1[3] *= __uint_as_float(g.w & 0xffff0000u);
                        if (br > 0) { const u32x4 o = *(const u32x4*)(rowp + bj * HALF);
                            v0[0] += __uint_as_float(o.x << 16); v0[1] += __uint_as_float(o.x & 0xffff0000u); v0[2] += __uint_as_float(o.y << 16); v0[3] += __uint_as_float(o.y & 0xffff0000u);
                            v1[0] += __uint_as_float(o.z << 16); v1[1] += __uint_as_float(o.z & 0xffff0000u); v1[2] += __uint_as_float(o.w << 16); v1[3] += __uint_as_float(o.w & 0xffff0000u); }
                        u32x4 w; w.x = cvt_pk_bf16(v0[0], v0[1]); w.y = cvt_pk_bf16(v0[2], v0[3]); w.z = cvt_pk_bf16(v1[0], v1[1]); w.w = cvt_pk_bf16(v1[2], v1[3]);
                        *(u32x4*)(rowp + bj * HALF) = w; } }
        }
    }
};
struct EpiSwiGlu {
    static constexpr bool PERM = true;
    bf16_t* H;
    __device__ __forceinline__ void operator()(const f32x4 (&acc)[2][2][4][2], const Unit& u, int wr, int wc, int fr, int fq, int tid) const {
        const int row0 = u.pm * BM + wr * 64 + fr, col0 = u.pn * HALF + wc * 32 + 8 * fq;
#pragma unroll
        for (int ai = 0; ai < 2; ++ai)
#pragma unroll
            for (int m = 0; m < 4; ++m) {
                f32x4 v0 = acc[ai][0][m][0], v1 = acc[ai][0][m][1]; const f32x4 u0 = acc[ai][1][m][0], u1 = acc[ai][1][m][1];
#pragma unroll
                for (int j = 0; j < 4; ++j) { v0[j] = siluf_(v0[j]) * u0[j]; v1[j] = siluf_(v1[j]) * u1[j]; }
                u32x4 w; w.x = cvt_pk_bf16(v0[0], v0[1]); w.y = cvt_pk_bf16(v0[2], v0[3]); w.z = cvt_pk_bf16(v1[0], v1[1]); w.w = cvt_pk_bf16(v1[2], v1[3]);
                *(u32x4*)(H + (size_t)(row0 + ai * HALF + m * 16) * DEXP + col0) = w;
            }
    }
};
}

#define STAGE_OFF 1024
__device__ __forceinline__ void ph_gemm_inproj(const int wv_, unsigned char* smem, const Params& p) {
    PH_IDS();
    pg8::SchedRows S{(const char*)p.A, (const char*)p.WinT, DM, DM, DM / 64, DINP / 256, NTOK / 256, 0, nblk_, bid_};
    pg8::gemm_phase((PG8_LAS unsigned char*)(smem + STAGE_OFF), DM, DM, S, pg8::EpiBf16{p.P, DINP}, tid_);
}
__device__ __forceinline__ void ph_gemm_merge(const int wv_, unsigned char* smem, const Params& p, int layer, int last) {
    PH_IDS();
    pg8::SchedMerge S{(const char*)p.A, (const char*)p.Y, (const char*)p.WgT, (const char*)p.WbrT, last ? NB * 32 : NTOK / 256, last, nblk_, bid_};
    pg8::gemm_phase((PG8_LAS unsigned char*)(smem + STAGE_OFF), DM, DM, S, pg8::EpiMerge{p.T, p.STASH + (size_t)bid_ * 65536, p.b_gate + layer * 4096}, tid_);
}
__device__ __forceinline__ void ph_gemm_wout(const int wv_, unsigned char* smem, const Params& p, int layer, int last) {
    PH_IDS();
    pg8::SchedRows S{(const char*)p.T, (const char*)p.WoT, DM, DM, DM / 64, DM / 256, last ? NB * 32 : NTOK / 256, last, nblk_, bid_};
    pg8::gemm_phase((PG8_LAS unsigned char*)(smem + STAGE_OFF), DM, DM, S, pg8::EpiResidual{p.hctx, p.out, p.mod, layer, 2}, tid_);
}
__device__ __forceinline__ void moe_pad_to_lds(unsigned char* smem, const Params& p, int tid_) {
    __syncthreads();
    if (tid_ < 17) ((int*)(smem + 64))[tid_] = p.cnt[16 + tid_];
    __syncthreads();
}
__device__ __forceinline__ void ph_gemm_moe_up(const int wv_, unsigned char* smem, const Params& p) {
    PH_IDS();
    moe_pad_to_lds(smem, p, tid_);
    pg8::SchedMoe S{(const char*)p.BUF, (const char*)p.WguT, (const int*)(smem + 64), DM, DM, DM / 64, 4, nblk_, bid_};
    pg8::gemm_phase((PG8_LAS unsigned char*)(smem + STAGE_OFF), DM, DM, S, pg8::EpiSwiGlu{p.HID}, tid_);
}
__device__ __forceinline__ void ph_gemm_moe_down(const int wv_, unsigned char* smem, const Params& p) {
    PH_IDS();
    moe_pad_to_lds(smem, p, tid_);
    pg8::SchedMoe S{(const char*)p.HID, (const char*)p.WdT, (const int*)(smem + 64), DEXP, DEXP, DEXP / 64, 4, nblk_, bid_};
    pg8::gemm_phase((PG8_LAS unsigned char*)(smem + STAGE_OFF), DEXP, DEXP, S, pg8::EpiBf16{p.PO, DM}, tid_);
}

#define LDS_BYTES (152 * 1024)
typedef const __attribute__((address_space(4))) unsigned long long* KArgPtr;
__device__ __forceinline__ Params ldparams() {
    KArgPtr q = (KArgPtr)__builtin_amdgcn_kernarg_segment_ptr(); asm volatile("" : "+s"(q));
    Params r; unsigned long long* d = (unsigned long long*)&r;
#pragma unroll
    for (int i = 0; i < (int)(sizeof(Params) / 8); ++i) d[i] = q[i];
    return r;
}
#define PHASE(call) do { const Params p = ldparams(); call; } while (0)

#define GRID_SYNC() do { int t0_ = wv * 64 + (int)__builtin_amdgcn_mbcnt_hi(~0u, __builtin_amdgcn_mbcnt_lo(~0u, 0u)); asm volatile("" : "+v"(t0_)); \
    XcdBarrier b_; b_.bar = ldparams().bar; b_.x = xb_xcc_id(); b_.st = (volatile LAS unsigned*)smem; xcd_barrier_(b_, t0_); } while (0)
__global__ __launch_bounds__(NTHR, 2) void k_mega(Params p_unused) {
    extern __shared__ __attribute__((aligned(16))) unsigned char smem[];
    int wv = __builtin_amdgcn_readfirstlane(threadIdx.x >> 6); asm volatile("" : "+s"(wv));
    if (threadIdx.x == 0) *(uint4*)smem = make_uint4(0u, 0u, 0u, 0u);
    __syncthreads();
    (void)xcd_barrier_post(ldparams().bar, (volatile LAS unsigned*)smem);
    PHASE(ph_mod(wv, smem, p));
    PHASE(ph_convert(wv, smem, p, 0));
    PHASE(ph_s5_prep(wv, smem, p, 0));
    GRID_SYNC();
    for (int l = 0; l < NLAYER; ++l) {
        const int last = (l == NLAYER - 1);
        PHASE(ph_norm1(wv, p, l));
        if (l > 0) { PHASE(ph_convert(wv, smem, p, l)); PHASE(ph_s5_prep(wv, smem, p, l)); }
        GRID_SYNC();
        PHASE(ph_gemm_inproj(wv, smem, p));
        GRID_SYNC();
#if PROBE_DUP == 4
        PHASE(ph_gemm_inproj(wv, smem, p));
        GRID_SYNC();
#endif
        PHASE(ph_attn_prep(wv, smem, p, l));
        PHASE(ph_gla1(wv, smem, p, l));
        PHASE(ph_s5_1(wv, p, l));
        PHASE(ph_dn_prep(wv, smem, p, l));
        GRID_SYNC();
#if PROBE_DUP == 7
        PHASE(ph_gla1(wv, smem, p, l));
        PHASE(ph_s5_1(wv, p, l));
        GRID_SYNC();
#endif
        PHASE(ph_scans(wv, smem, p, l));
        PHASE(ph_attn(wv, smem, p, l));
        PHASE(ph_wait_scans(wv, p));
        PHASE(ph_s5_3(wv, smem, p, l));
        PHASE(ph_gla3(wv, smem, p, l));
        GRID_SYNC();
#if PROBE_DUP == 1
        PHASE(ph_scans_dn_only(wv, smem, p, l));
        PHASE(ph_attn(wv, smem, p, l));
        GRID_SYNC();
#elif PROBE_DUP == 2
        PHASE(ph_attn(wv, smem, p, l));
        GRID_SYNC();
#elif PROBE_DUP == 3
        PHASE(ph_scans_dn_only(wv, smem, p, l));
        GRID_SYNC();
#endif
        PHASE(ph_finish(wv, smem, p, l));
        GRID_SYNC();
        PHASE(ph_gemm_merge(wv, smem, p, l, last));
        GRID_SYNC();
#if PROBE_DUP == 5
        PHASE(ph_gemm_merge(wv, smem, p, l, last));
        GRID_SYNC();
#endif
        PHASE(ph_gemm_wout(wv, smem, p, l, last));
        GRID_SYNC();
        PHASE(ph_convert_experts(wv, smem, p, l));
        PHASE(ph_norm2_route(wv, smem, p, l));
        GRID_SYNC();
        PHASE(ph_moe_gather(wv, smem, p, l));
        GRID_SYNC();
#if PROBE_DUP == 8
        PHASE(ph_moe_gather(wv, smem, p, l));
        GRID_SYNC();
#endif
        PHASE(ph_gemm_moe_up(wv, smem, p));
        GRID_SYNC();
#if PROBE_DUP == 6
        PHASE(ph_gemm_moe_up(wv, smem, p));
        GRID_SYNC();
#endif
        PHASE(ph_gemm_moe_down(wv, smem, p));
        GRID_SYNC();
#if PROBE_DUP == 6
        PHASE(ph_gemm_moe_down(wv, smem, p));
        GRID_SYNC();
#endif
        PHASE(ph_moe_combine(wv, p, l));
        GRID_SYNC();
    }
}

static inline size_t al(size_t x) { return (x + 255) & ~(size_t)255; }

extern "C" void kernel_launch(void* const* d_in, const int* in_sizes, int n_in, void* d_out, int out_size, void* d_ws, size_t ws_size, hipStream_t stream) {
    Params p{};
    const float** ins = (const float**)d_in;
    p.x = ins[0]; p.c = ins[1]; p.ctx = ins[2]; p.c_ctx = ins[3]; p.w_mod = ins[4]; p.b_mod = ins[5]; p.norm1_g = ins[6]; p.norm2_g = ins[7]; p.w_in = ins[8];
    p.dn_conv = ins[9]; p.dn_a_log = ins[10]; p.dn_dt_bias = ins[11]; p.dn_norm_g = ins[12];
    p.s5_a_re = ins[13]; p.s5_a_im = ins[14]; p.s5_log_dt = ins[15]; p.s5_b_re = ins[16]; p.s5_b_im = ins[17]; p.s5_c_re = ins[18]; p.s5_c_im = ins[19]; p.s5_d = ins[20]; p.s5_glu_w = ins[21]; p.s5_glu_b = ins[22];
    p.da_lambda = ins[23]; p.da_norm_g = ins[24]; p.gla_w_gate = ins[25]; p.gla_b_gate = ins[26]; p.gla_norm_g = ins[27];
    p.w_branch = ins[28]; p.w_gate = ins[29]; p.b_gate = ins[30]; p.w_out = ins[31]; p.w_router = ins[32]; p.b_router = ins[33];
    p.w_e_gate = ins[34]; p.w_e_up = ins[35]; p.w_e_down = ins[36]; p.final_g = ins[37];
    p.out = (float*)d_out;
    char* ws = (char*)d_ws; size_t off = 0;
    auto take = [&](size_t bytes) { char* q = ws + off; off += al(bytes); return q; };
    p.bar = (unsigned*)take((size_t)XCD_BAR_WORDS * 4);
    p.cnt = (int*)take(256 * 4);
    p.kmax = (unsigned*)take(256);
    p.mod = (float*)take((size_t)NLAYER * 5 * 6 * DM * 4);
    p.hctx = (float*)take((size_t)NB * NCTX * DM * 4);
    p.tok_e = (int*)take((size_t)NTOK * 2 * 4); p.tok_w = (float*)take((size_t)NTOK * 2 * 4); p.tok_pos = (int*)take((size_t)NTOK * 2 * 4); p.tok_slot = (int*)take((size_t)NTOK * 2 * 4);
    p.WinT = (bf16_t*)take((size_t)DINP * DM * 2); p.WgT = (bf16_t*)take((size_t)4096 * DM * 2); p.WbrT = (bf16_t*)take((size_t)DM * DM * 2); p.WoT = (bf16_t*)take((size_t)DM * DM * 2);
    p.SB = (bf16_t*)take((size_t)16 * 256 * 512 * 2); p.SE = (bf16_t*)take((size_t)16 * 256 * 256 * 2); p.GLUt = (bf16_t*)take((size_t)65536 * 2); p.A16 = (float*)take((size_t)2 * 16 * 64 * 2 * 4);
    p.A = (bf16_t*)take((size_t)NTOK * DM * 2);
    p.Y = (bf16_t*)take((size_t)NTOK * DM * 2);
    char* big = ws + off;
    p.P = (bf16_t*)take((size_t)NTOK * DINP * 2);
    char* ms = ws + off;
    p.WguT = (bf16_t*)(ms + ((size_t)16 << 20)); p.WdT = (bf16_t*)(ms + ((size_t)16 << 20) + (size_t)NEXP * 1024 * DM * 2);
    p.Qr = (bf16_t*)take((size_t)16 * TJ * 64 * 2); p.Kr = (bf16_t*)take((size_t)16 * TJ * 64 * 2); p.Vt = (bf16_t*)take((size_t)16 * 132 * 4096 * 2); p.Qn = (float*)take((size_t)16 * TJ * 2 * 4);
    p.ODN = (bf16_t*)take((size_t)NTOK * 256 * 2);
    p.QKVN = (bf16_t*)take((size_t)NTOK * 768 * 2);
    p.XS = (bf16_t*)take((size_t)NB * S5NS * 16 * 256 * 2);
    p.GST = (bf16_t*)take((size_t)32 * (TJ / 64) * 2048 * 2); p.DCY = (float*)take((size_t)32 * (TJ / 64) * 32 * 4);
    p.T = (bf16_t*)big;
    p.STASH = (bf16_t*)(big + al((size_t)NTOK * DM * 2));
    p.BUF = (bf16_t*)big; p.PO = (bf16_t*)big;
    p.HID = (bf16_t*)(big + al((size_t)MAXSLOT * DM * 2));
    if (off > ws_size) return;

    static int grid = 0;
    if (!grid) {
        int dev = 0, cus = 0, per_cu = 0;
        (void)hipGetDevice(&dev);
        (void)hipDeviceGetAttribute(&cus, hipDeviceAttributeMultiprocessorCount, dev);
        (void)hipFuncSetAttribute((const void*)k_mega, hipFuncAttributeMaxDynamicSharedMemorySize, LDS_BYTES);
        (void)hipOccupancyMaxActiveBlocksPerMultiprocessor(&per_cu, (const void*)k_mega, NTHR, LDS_BYTES);
        grid = per_cu >= 1 ? cus : 0;
    }
    if (!grid) return;
    (void)hipMemsetAsync(p.bar, 0, (size_t)XCD_BAR_WORDS * 4, stream);
    k_mega<<<grid, NTHR, LDS_BYTES, stream>>>(p);
}

#endif
```

```cpp
#ifndef EMU
#include <hip/hip_runtime.h>
#include <stdint.h>
#define OPQV(x) asm volatile("" : "+v"(x))
#define OPQS(x) asm volatile("" : "+s"(x))
#define WAVE_LDS_FENCE() asm volatile("s_waitcnt lgkmcnt(0)" ::: "memory")
#endif

typedef unsigned short bf16_t;

#define DM 1024
#define NB 4
#ifndef SEQ
#define SEQ 8192
#endif
#define NCTX 256
#define TJ (SEQ + NCTX)
#define NTOK (NB * TJ)
#define DIN 2864
#define DINP 3072
#define NEXP 16
#define DEXP 512
#define NLAYER 2
#define C_DNQ 0
#define C_DNK 256
#define C_DNV 512
#define C_DNZ 768
#define C_DNA 1024
#define C_DNB 1032
#define C_S5U 1040
#define C_DAQ 1296
#define C_DAK 1552
#define C_DAV 1808
#define C_GLQ 2064
#define C_GLK 2192
#define C_GLV 2320
#define C_GLR 2576
#define C_GLG 2832

#define MAXSLOT (2 * NTOK + NEXP * 256)

__device__ __forceinline__ float bf2f(bf16_t v) { return __uint_as_float(((unsigned)v) << 16); }
__device__ __forceinline__ bf16_t f2bf(float f) { unsigned u = __float_as_uint(f); u += 0x7FFFu + ((u >> 16) & 1u); return (bf16_t)(u >> 16); }
#ifdef EMU
__device__ __forceinline__ float frcp_(float x) { return 1.0f / x; }
#else
__device__ __forceinline__ float frcp_(float x) { return __builtin_amdgcn_rcpf(x); }
#endif
__device__ __forceinline__ float sigmoidf_(float x) { return frcp_(1.0f + __expf(-x)); }
__device__ __forceinline__ float siluf_(float x) { return x * frcp_(1.0f + __expf(-x)); }
__device__ __forceinline__ float softplusf_(float x) { return x > 20.f ? x : log1pf(expf(x)); }
__device__ __forceinline__ float logsigmoidf_(float x) { return fminf(x, 0.f) - __logf(1.0f + __expf(-fabsf(x))); }
__device__ __forceinline__ float gelu_tanh(float x) { const float k = 0.7978845608028654f; float u = k * (x + 0.044715f * x * x * x); return x * frcp_(1.0f + __expf(-2.0f * u)); }
__device__ __forceinline__ float wave_sum(float v) {
#pragma unroll
    for (int o = 32; o >= 1; o >>= 1) v += __shfl_xor(v, o, 64);
    return v;
}
__device__ __forceinline__ float rdlane(float v, int l) { return __int_as_float(__builtin_amdgcn_readlane(__float_as_int(v), l)); }

typedef float f32x16 __attribute__((ext_vector_type(16)));
#ifndef EMU
typedef __bf16 bfx8 __attribute__((ext_vector_type(8)));
typedef __bf16 bf16x2_t_ __attribute__((ext_vector_type(2)));
typedef float f32x2_t_ __attribute__((ext_vector_type(2)));
__device__ __forceinline__ unsigned cvt_pk_bf16_(float lo, float hi) { f32x2_t_ f = {lo, hi}; bf16x2_t_ b = __builtin_convertvector(f, bf16x2_t_); return *(unsigned*)&b; }
#endif

struct Params {
    const float *x, *c, *ctx, *c_ctx, *w_mod, *b_mod, *norm1_g, *norm2_g, *w_in, *dn_conv, *dn_a_log, *dn_dt_bias, *dn_norm_g;
    const float *s5_a_re, *s5_a_im, *s5_log_dt, *s5_b_re, *s5_b_im, *s5_c_re, *s5_c_im, *s5_d, *s5_glu_w, *s5_glu_b;
    const float *da_lambda, *da_norm_g, *gla_w_gate, *gla_b_gate, *gla_norm_g, *w_branch, *w_gate, *b_gate, *w_out;
    const float *w_router, *b_router, *w_e_gate, *w_e_up, *w_e_down, *final_g;
    float* out;
    float* mod;
    float* hctx;
    bf16_t* A;
    bf16_t* P;
    bf16_t* Y;
    bf16_t* Qr;
    bf16_t* Kr;
    bf16_t* Vt;
    float* Qn;
    unsigned* kmax;
    bf16_t* QKVN;
    bf16_t* ODN;
    bf16_t* OS5;
    bf16_t* XS;
    bf16_t* SB;
    bf16_t* SE;
    bf16_t* GLUt;
    float* A16;
    bf16_t* OGLA;
    bf16_t* GST;
    float* DCY;
    bf16_t* T;
    bf16_t* TP;
    bf16_t* STASH;
    bf16_t *WinT, *WgT, *WbrT, *WoT, *WguT, *WdT;
    bf16_t* BUF;
    bf16_t* HID;
    bf16_t* PO;
    unsigned* bar;
    int* cnt;
    int* tok_e;
    float* tok_w;
    int* tok_pos;
    int* tok_slot;
};

__device__ __forceinline__ float* hrow(const Params& p, int r) {
    int b = r / TJ, tau = r - b * TJ;
    return tau < NCTX ? p.hctx + ((size_t)b * NCTX + tau) * DM : p.out + ((size_t)b * SEQ + (tau - NCTX)) * DM;
}
__device__ __forceinline__ const float* modrow(const Params& p, int layer, int r) {
    int b = r / TJ, tau = r - b * TJ;
    return p.mod + ((size_t)layer * 5 + (tau < NCTX ? 4 : b)) * (6 * DM);
}


#ifndef EMU
#define XB_TMO      128
#define XB_XCNT(j)  (256  + 64 * (j))
#define XB_XSUB(j)  (1280 + 64 * (j))
#define XB_XGEN(j)  (2304 + 64 * (j))
#define XB_TOP      3328
#define XB_TOPGEN   3392
#define XCD_BAR_WORDS 3456
#define XB_SPIN_CAP (1u << 18)
#define LAS __attribute__((address_space(3)))
__device__ __forceinline__ unsigned xb_ld(unsigned* p)              { return __hip_atomic_load(p, __ATOMIC_RELAXED, __HIP_MEMORY_SCOPE_AGENT); }
__device__ __forceinline__ unsigned xb_add(unsigned* p, unsigned v) { return __hip_atomic_fetch_add(p, v, __ATOMIC_RELAXED, __HIP_MEMORY_SCOPE_AGENT); }
__device__ __forceinline__ unsigned xb_xcc_id() { return (unsigned)__builtin_amdgcn_s_getreg((3 << 11) | 20) & 0xFu; }
#define XB_SPIN(cond, bar) do { unsigned _sp = 0; while (cond) { __builtin_amdgcn_s_sleep(1); \
    if ((++_sp & 255u) == 0u) { if (xb_ld(&(bar)[XB_TMO])) break; if (_sp > XB_SPIN_CAP) { atomicAdd(&(bar)[XB_TMO], 1u); break; } } } } while (0)
struct XcdBarrier { unsigned* bar; unsigned x; volatile LAS unsigned* st; };
__device__ __forceinline__ XcdBarrier xcd_barrier_post(unsigned* bar, volatile LAS unsigned* st) {
    XcdBarrier b; b.bar = bar; b.x = xb_xcc_id(); b.st = st;
    if (threadIdx.x == 0) (void)xb_add(&bar[XB_XCNT(b.x)], 1u);
    return b;
}
__device__ __forceinline__ void xcd_barrier_complete(unsigned* bar, unsigned x, unsigned& nloc, unsigned& nx) {
    const unsigned G = gridDim.x * gridDim.y * gridDim.z;
    unsigned sum, cnt, mine, sp = 0u;
    for (;;) {
        sum = 0u; cnt = 0u; mine = 0u;
#pragma unroll
        for (unsigned j = 0; j < 16; ++j) { const unsigned c = xb_ld(&bar[XB_XCNT(j)]); sum += c; cnt += (c > 0u) ? 1u : 0u; mine = (j == x) ? c : mine; }
        if (sum == G) break;
        __builtin_amdgcn_s_sleep(1);
        if ((++sp & 255u) == 0u) { if (xb_ld(&bar[XB_TMO])) break; if (sp > XB_SPIN_CAP) { atomicAdd(&bar[XB_TMO], 1u); break; } }
    }
    nloc = mine > 0u ? mine : 1u; nx = cnt > 0u ? cnt : 1u;
}
__device__ __forceinline__ void xcd_barrier_(const XcdBarrier& b, const int tid0) {
    asm volatile("s_waitcnt vmcnt(0)" ::: "memory");
    __syncthreads();
    if (tid0 == 0) {
        unsigned* bar = b.bar;
        __builtin_amdgcn_s_waitcnt(0);
        unsigned nloc = b.st[0], nx = b.st[1];
        if (nloc == 0u) { xcd_barrier_complete(bar, b.x, nloc, nx); b.st[0] = nloc; b.st[1] = nx; }
        const unsigned old = xb_add(&bar[XB_XSUB(b.x)], 1u);
        const unsigned gen = old / nloc;
        if (old + 1u == (gen + 1u) * nloc) {
            __builtin_amdgcn_fence(__ATOMIC_RELEASE, "agent");
            asm volatile("s_waitcnt vmcnt(0)" ::: "memory");
            const unsigned og = xb_add(&bar[XB_TOP], 1u);
            const unsigned tg = og / nx;
            if (og + 1u == (tg + 1u) * nx) xb_add(&bar[XB_TOPGEN], 1u);
            else XB_SPIN(xb_ld(&bar[XB_TOPGEN]) == tg, bar);
            __builtin_amdgcn_fence(__ATOMIC_ACQUIRE, "agent");
            xb_add(&bar[XB_XGEN(b.x)], 1u);
            asm volatile("s_waitcnt vmcnt(0)" ::: "memory");
        } else {
            XB_SPIN(xb_ld(&bar[XB_XGEN(b.x)]) == gen, bar);
            __builtin_amdgcn_fence(__ATOMIC_ACQUIRE, "agent");
            asm volatile("s_waitcnt vmcnt(0)" ::: "memory");
        }
    }
    __syncthreads();
}

#endif
#ifndef PROBE_DUP
#define PROBE_DUP 0
#endif
#define NTHR 512
#define NWV 8
#define PH_IDS() int tid_ = wv_ * 64 + (int)__builtin_amdgcn_mbcnt_hi(~0u, __builtin_amdgcn_mbcnt_lo(~0u, 0u)); OPQV(tid_); int bid_ = blockIdx.x; OPQS(bid_); int nblk_ = gridDim.x; OPQS(nblk_); (void)tid_; (void)bid_; (void)nblk_
#define GWV (nblk_ * NWV)
#define WID (bid_ * NWV + (tid_ >> 6))

__device__ __forceinline__ void ph_mod(const int wv_, unsigned char* smem, const Params& p) {
    PH_IDS();
    float* sc = (float*)(smem + 1024);
    float* part = sc + 5 * DM;
    for (int i = tid_; i < 5 * DM; i += NTHR) { const int v = i >> 10, k = i & (DM - 1); sc[i] = siluf_(v < 4 ? p.c[v * DM + k] : p.c_ctx[k]); }
    __syncthreads();
    const int ksl = tid_ >> 6, cl = tid_ & 63;
    for (int item = bid_; item < NLAYER * 6 * DM / 64; item += nblk_) {
        const int l = item / (6 * DM / 64), col = (item - l * (6 * DM / 64)) * 64 + cl;
        const float* w = p.w_mod + (size_t)l * DM * 6 * DM + (size_t)ksl * 128 * 6 * DM + col;
        float a0 = 0.f, a1 = 0.f, a2 = 0.f, a3 = 0.f, a4 = 0.f;
#pragma unroll 8
        for (int k = 0; k < 128; ++k) { const float wv2 = w[(size_t)k * 6 * DM]; const int kk = ksl * 128 + k; a0 += sc[kk] * wv2; a1 += sc[DM + kk] * wv2; a2 += sc[2 * DM + kk] * wv2; a3 += sc[3 * DM + kk] * wv2; a4 += sc[4 * DM + kk] * wv2; }
        __syncthreads();
        part[(ksl * 5 + 0) * 64 + cl] = a0; part[(ksl * 5 + 1) * 64 + cl] = a1; part[(ksl * 5 + 2) * 64 + cl] = a2; part[(ksl * 5 + 3) * 64 + cl] = a3; part[(ksl * 5 + 4) * 64 + cl] = a4;
        __syncthreads();
        if (tid_ < 320) { const int v = tid_ >> 6; float acc = p.b_mod[l * 6 * DM + col];
#pragma unroll
            for (int q = 0; q < 8; ++q) acc += part[(q * 5 + v) * 64 + cl];
            p.mod[((size_t)l * 5 + v) * 6 * DM + col] = acc; }
    }
}

__device__ __forceinline__ void ph_zero_counters(const int wv_, const Params& p) {
    PH_IDS();
    if (bid_ == 0 && tid_ < 64) { p.cnt[tid_] = 0; if (tid_ < 32) p.kmax[tid_] = 0u; p.cnt[128 + tid_] = 0; p.cnt[192 + tid_] = 0; p.cnt[512 + tid_] = 0; p.cnt[576 + tid_] = 0; p.cnt[640 + tid_] = 0; p.cnt[704 + tid_] = 0; }
}
__device__ __forceinline__ void ph_norm1(const int wv_, const Params& p, int layer) {
    PH_IDS();
    int lane = tid_ & 63;
    if (bid_ == 0 && tid_ < 64) { p.cnt[tid_] = 0; if (tid_ < 32) p.kmax[tid_] = 0u; p.cnt[128 + tid_] = 0; p.cnt[192 + tid_] = 0; p.cnt[512 + tid_] = 0; p.cnt[576 + tid_] = 0; p.cnt[640 + tid_] = 0; p.cnt[704 + tid_] = 0; }
    for (int r = WID; r < NTOK; r += GWV) {
        int b = r / TJ, tau = r - b * TJ;
        float* h = hrow(p, r);
        const float* src = h;
        if (layer == 0) src = tau < NCTX ? p.ctx + ((size_t)b * NCTX + tau) * DM : p.x + ((size_t)b * SEQ + (tau - NCTX)) * DM;
        const float* md = modrow(p, layer, r);
        float4 v[4]; float ss = 0.f;
#pragma unroll
        for (int i = 0; i < 4; ++i) { v[i] = *(const float4*)(src + i * 256 + lane * 4); ss += v[i].x * v[i].x + v[i].y * v[i].y + v[i].z * v[i].z + v[i].w * v[i].w; }
        ss = wave_sum(ss);
        float rs = rsqrtf(ss * (1.0f / DM) + 1e-6f);
        const float* g = p.norm1_g + layer * DM;
#pragma unroll
        for (int i = 0; i < 4; ++i) {
            int c0 = i * 256 + lane * 4;
            if (layer == 0) *(float4*)(h + c0) = v[i];
            float4 gg = *(const float4*)(g + c0), sh = *(const float4*)(md + c0), sc = *(const float4*)(md + DM + c0);
            float o0 = v[i].x * rs * gg.x * (1.f + sc.x) + sh.x, o1 = v[i].y * rs * gg.y * (1.f + sc.y) + sh.y;
            float o2 = v[i].z * rs * gg.z * (1.f + sc.z) + sh.z, o3 = v[i].w * rs * gg.w * (1.f + sc.w) + sh.w;
            ushort4 ob; ob.x = f2bf(o0); ob.y = f2bf(o1); ob.z = f2bf(o2); ob.w = f2bf(o3);
            *(ushort4*)(p.A + (size_t)r * DM + c0) = ob;
        }
    }
}

struct EpiStoreBf16 { bf16_t* C; int ldc; __device__ void operator()(int r, int c, float v) const { C[(size_t)r * ldc + c] = f2bf(v); } };
struct EpiSigmoidBias { bf16_t* C; const float* bias; int ldc; __device__ void operator()(int r, int c, float v) const { C[(size_t)r * ldc + c] = f2bf(sigmoidf_(v + bias[c])); } };
struct EpiGateAcc { bf16_t* T; const bf16_t* G; int i; __device__ void operator()(int r, int c, float v) const {
    float g = bf2f(G[(size_t)r * 4096 + i * DM + c]); float t = g * v; if (i > 0) t += bf2f(T[(size_t)r * DM + c]); T[(size_t)r * DM + c] = f2bf(t); } };
struct EpiResid { float* hctx; float* out; const float* mod; int layer; int modoff; __device__ void operator()(int r, int c, float v) const {
    int b = r / TJ, tau = r - b * TJ;
    float* h = tau < NCTX ? hctx + ((size_t)b * NCTX + tau) * DM : out + ((size_t)b * SEQ + (tau - NCTX)) * DM;
    const float* md = mod + ((size_t)layer * 5 + (tau < NCTX ? 4 : b)) * (6 * DM);
    h[c] += md[modoff * DM + c] * v; } };
struct EpiSiluMul { bf16_t* H; __device__ void operator()(int r, int c, float v) const { float g = bf2f(H[(size_t)r * DEXP + c]); H[(size_t)r * DEXP + c] = f2bf(siluf_(g) * v); } };

template <class Epi>
__device__ __forceinline__ void ph_gemm_naive(const int wv_, unsigned char* smem, const bf16_t* A, int lda, const float* W0, int ldw, int M, int N, int K, const Epi& epi, const int* grp, size_t wstride, int skip_ctx) {
    PH_IDS();
    const int half = tid_ >> 8, tid = tid_ & 255, tx = tid & 15, ty = tid >> 4;
    float (*sA)[68] = (float (*)[68])(smem + 64 + half * 8704);
    float (*sB)[68] = (float (*)[68])(smem + 64 + half * 8704 + 4352);
    const int ntn = (N + 63) / 64, ntiles = (M / 64) * ntn;
    for (int t0 = bid_ * 2; t0 < ntiles; t0 += nblk_ * 2) {
        const int t = t0 + half;
        bool active = t < ntiles;
        int bm = active ? (t / ntn) * 64 : 0, bn = active ? (t % ntn) * 64 : 0;
        const float* W = W0;
        if (grp && active) {
            if (bm >= grp[32]) active = false;
            int e = 0;
            for (int i = 0; i < 16; ++i) e += (grp[16 + i] <= bm) ? 1 : 0;
            if (e > 15) e = 15;
            W += (size_t)e * wstride;
        }
        if (skip_ctx && (bm % TJ) < NCTX) active = false;
        float acc[4][4] = {};
        for (int k0 = 0; k0 < K; k0 += 16) {
            if (active) {
                int r = tid >> 2, kk = (tid & 3) * 4;
                ushort4 a = *(const ushort4*)(A + (size_t)(bm + r) * lda + k0 + kk);
                sA[kk + 0][r] = bf2f(a.x); sA[kk + 1][r] = bf2f(a.y); sA[kk + 2][r] = bf2f(a.z); sA[kk + 3][r] = bf2f(a.w);
                int kr = tid >> 4, cc = (tid & 15) * 4;
#pragma unroll
                for (int j = 0; j < 4; ++j) { int col = bn + cc + j; sB[kr][cc + j] = col < N ? W[(size_t)(k0 + kr) * ldw + col] : 0.f; }
            }
            __syncthreads();
            if (active) {
#pragma unroll
                for (int kk = 0; kk < 16; ++kk) {
                    float a[4], b[4];
#pragma unroll
                    for (int i = 0; i < 4; ++i) { a[i] = sA[kk][ty * 4 + i]; b[i] = sB[kk][tx * 4 + i]; }
#pragma unroll
                    for (int i = 0; i < 4; ++i)
#pragma unroll
                        for (int j = 0; j < 4; ++j) acc[i][j] += a[i] * b[j];
                }
            }
            __syncthreads();
        }
        if (active) {
#pragma unroll
            for (int i = 0; i < 4; ++i)
#pragma unroll
                for (int j = 0; j < 4; ++j) { int col = bn + tx * 4 + j; if (col < N) epi(bm + ty * 4 + i, col, acc[i][j]); }
        }
    }
}

__device__ __forceinline__ int pos2tau(int d, int pos) { return d == 0 ? pos : (pos < NCTX ? NCTX - 1 - pos : (TJ + NCTX - 1) - pos); }

__device__ __forceinline__ void dn_load_raw(const Params& p, int b, int tau, int h, int lane, float (&q)[5], float (&k)[5], float (&v)[5]) {
    const int lo = tau < NCTX ? 0 : NCTX, hi = tau < NCTX ? NCTX : TJ;
#pragma unroll
    for (int j = 0; j < 5; ++j) {
        const int t2 = tau + j - 2; const bool ok = t2 >= lo && t2 < hi;
        const bf16_t* pr = p.P + ((size_t)b * TJ + (ok ? t2 : tau)) * DINP + h * 64 + lane;
        q[j] = ok ? bf2f(pr[0]) : 0.f; k[j] = ok ? bf2f(pr[256]) : 0.f; v[j] = ok ? bf2f(pr[512]) : 0.f;
    }
}
__device__ __forceinline__ void dn_chain_naive(const Params& p, int layer, int chain, int lane) {
    int b = chain >> 3, h = (chain >> 1) & 3, d = chain & 1;
    float S[64];
#pragma unroll
    for (int i = 0; i < 64; ++i) S[i] = 0.f;
    const float nalog = -expf(p.dn_a_log[layer * 8 + d * 4 + h]), dtb = p.dn_dt_bias[layer * 8 + d * 4 + h];
    float cq[5], ck[5], cv[5];
#pragma unroll
    for (int j = 0; j < 5; ++j) { const float* cw = p.dn_conv + ((size_t)layer * 5 + j) * 768 + h * 64 + lane; cq[j] = cw[0]; ck[j] = cw[256]; cv[j] = cw[512]; }
    bf16_t* O = d == 0 ? p.Y : p.ODN; const int ldo = d == 0 ? DM : 256;
    int tau = pos2tau(d, 0);
    size_t r = (size_t)b * TJ + tau;
    float a_n = bf2f(p.P[r * DINP + C_DNA + d * 4 + h]), b_n = bf2f(p.P[r * DINP + C_DNB + d * 4 + h]);
    float qn[5], kn[5], vn[5];
    dn_load_raw(p, b, tau, h, lane, qn, kn, vn);
    for (int pos = 0; pos < TJ; ++pos) {
        float a_in = a_n, b_in = b_n; size_t rc = r;
        float qa = 0.f, ka = 0.f, va = 0.f;
#pragma unroll
        for (int j = 0; j < 5; ++j) { qa += qn[j] * cq[j]; ka += kn[j] * ck[j]; va += vn[j] * cv[j]; }
        if (pos + 1 < TJ) {
            tau = pos2tau(d, pos + 1); r = (size_t)b * TJ + tau;
            a_n = bf2f(p.P[r * DINP + C_DNA + d * 4 + h]); b_n = bf2f(p.P[r * DINP + C_DNB + d * 4 + h]);
            dn_load_raw(p, b, tau, h, lane, qn, kn, vn);
        }
        float qv = siluf_(qa), kv = siluf_(ka), vv = siluf_(va);
        qv *= rsqrtf(wave_sum(qv * qv) + 1e-6f); kv *= rsqrtf(wave_sum(kv * kv) + 1e-6f);
        float decay = expf(nalog * softplusf_(a_in + dtb)), beta = sigmoidf_(b_in);
        float kS = 0.f;
#pragma unroll
        for (int i = 0; i < 64; ++i) { S[i] *= decay; kS += rdlane(kv, i) * S[i]; }
        float vnew = beta * (vv - kS), o = 0.f;
#pragma unroll
        for (int i = 0; i < 64; ++i) { S[i] += rdlane(kv, i) * vnew; o += rdlane(qv, i) * S[i]; }
        O[rc * ldo + h * 64 + lane] = f2bf(o * 0.125f);
    }
}

__device__ __forceinline__ void s5_chain_naive(const Params& p, int layer, int chain, int lane) {
    int b = chain >> 5, g = (chain >> 1) & 15, d = chain & 1;
    float lre = p.s5_a_re[((layer * 2 + d) * 16 + g) * 64 + lane], lim = p.s5_a_im[((layer * 2 + d) * 16 + g) * 64 + lane];
    float dt = expf(p.s5_log_dt[(layer * 2 + d) * 16 + g]);
    float mag = expf(lre * dt), are = mag * cosf(lim * dt), aim = mag * sinf(lim * dt);
    float den = lre * lre + lim * lim;
    float fre = ((are - 1.f) * lre + aim * lim) / den, fim = (aim * lre - (are - 1.f) * lim) / den;
    float bbr[16], bbi[16], cr[16], ci[16];
#pragma unroll
    for (int c = 0; c < 16; ++c) {
        float br = p.s5_b_re[((layer * 16 + g) * 64 + lane) * 16 + c], bi = p.s5_b_im[((layer * 16 + g) * 64 + lane) * 16 + c];
        bbr[c] = fre * br - fim * bi; bbi[c] = fre * bi + fim * br;
        cr[c] = p.s5_c_re[(((layer * 2 + d) * 16 + g) * 16 + c) * 64 + lane]; ci[c] = p.s5_c_im[(((layer * 2 + d) * 16 + g) * 16 + c) * 64 + lane];
    }
    bf16_t* O = d == 0 ? p.Y + 256 : p.OS5; const int ldo = d == 0 ? DM : 256;
    float xr = 0.f, xi = 0.f;
    size_t r = (size_t)b * TJ + pos2tau(d, 0);
    float u_n = bf2f(p.P[r * DINP + C_S5U + g * 16 + (lane & 15)]);
    for (int pos = 0; pos < TJ; ++pos) {
        float u = u_n; size_t rc = r;
        if (pos + 1 < TJ) { r = (size_t)b * TJ + pos2tau(d, pos + 1); u_n = bf2f(p.P[r * DINP + C_S5U + g * 16 + (lane & 15)]); }
        float nr = are * xr - aim * xi, ni = are * xi + aim * xr;
#pragma unroll
        for (int c = 0; c < 16; ++c) { float uc = rdlane(u, c); nr += bbr[c] * uc; ni += bbi[c] * uc; }
        xr = nr; xi = ni;
        float my = 0.f;
#pragma unroll
        for (int c = 0; c < 16; ++c) { float t = wave_sum(cr[c] * xr - ci[c] * xi); if (lane == c) my = t; }
        if (lane < 16) O[rc * ldo + g * 16 + lane] = f2bf(my);
    }
}

__device__ __forceinline__ void gla_chain_naive(const Params& p, int layer, int chain, int lane) {
    int b = chain >> 3, h = (chain >> 1) & 3, d = chain & 1;
    float S[32];
#pragma unroll
    for (int i = 0; i < 32; ++i) S[i] = 0.f;
    float w2[16];
#pragma unroll
    for (int rr = 0; rr < 16; ++rr) w2[rr] = p.gla_w_gate[((layer * 2 + d) * 16 + rr) * 128 + h * 32 + (lane & 31)];
    float b2 = p.gla_b_gate[(layer * 2 + d) * 128 + h * 32 + (lane & 31)];
    bf16_t* O = d == 0 ? p.Y + 768 : p.OGLA; const int ldo = d == 0 ? DM : 256;
    size_t r = (size_t)b * TJ + pos2tau(d, 0);
    float low_n = bf2f(p.P[r * DINP + C_GLG + d * 16 + (lane & 15)]), q_n = bf2f(p.P[r * DINP + C_GLQ + h * 32 + (lane & 31)]);
    float k_n = bf2f(p.P[r * DINP + C_GLK + h * 32 + (lane & 31)]), v_n = bf2f(p.P[r * DINP + C_GLV + h * 64 + lane]);
    for (int pos = 0; pos < TJ; ++pos) {
        float low = low_n, qv = q_n, kv = k_n, vv = v_n; size_t rc = r;
        if (pos + 1 < TJ) {
            r = (size_t)b * TJ + pos2tau(d, pos + 1);
            low_n = bf2f(p.P[r * DINP + C_GLG + d * 16 + (lane & 15)]); q_n = bf2f(p.P[r * DINP + C_GLQ + h * 32 + (lane & 31)]);
            k_n = bf2f(p.P[r * DINP + C_GLK + h * 32 + (lane & 31)]); v_n = bf2f(p.P[r * DINP + C_GLV + h * 64 + lane]);
        }
        float z = b2;
#pragma unroll
        for (int rr = 0; rr < 16; ++rr) z += rdlane(low, rr) * w2[rr];
        float a = expf(logsigmoidf_(z) * (1.0f / 16.0f));
        float o = 0.f;
#pragma unroll
        for (int i = 0; i < 32; ++i) { S[i] = rdlane(a, i) * S[i] + rdlane(kv, i) * vv; o += rdlane(qv, i) * S[i]; }
        O[rc * ldo + h * 64 + lane] = f2bf(o * 0.17677669529663687f);
    }
}

__device__ __forceinline__ void ph_dn_prep(const int wv_, unsigned char* smem, const Params& p, int layer) {
    PH_IDS();
    unsigned char* RAW = smem + 1024;
    const float* cwl = p.dn_conv + (size_t)layer * 5 * 768;
    for (int item = (bid_ + 64) % nblk_; item < NB * (TJ / 64); item += nblk_) {
        const int b = item / (TJ / 64), tc = item - b * (TJ / 64), tlo = tc * 64;
        const int slo = tlo < NCTX ? 0 : NCTX, shi = tlo < NCTX ? NCTX : TJ;
        __syncthreads();
        for (int e = tid_; e < 68 * 96; e += NTHR) {
            const int row = e / 96, ch = e - row * 96, tau = tlo - 2 + row;
            uint4 v = make_uint4(0u, 0u, 0u, 0u);
            if (tau >= slo && tau < shi) v = *(const uint4*)(p.P + ((size_t)b * TJ + tau) * DINP + ch * 8);
            *(uint4*)(RAW + e * 16) = v;
        }
        __syncthreads();
#pragma unroll 1
        for (int k3 = 0; k3 < 3; ++k3) {
            const int id = tid_ + NTHR * k3, pg = id / 96, cg = id - pg * 96;
            float cw[5][8];
#pragma unroll
            for (int j = 0; j < 5; ++j) { const float4 w0 = *(const float4*)(cwl + j * 768 + cg * 8), w1 = *(const float4*)(cwl + j * 768 + cg * 8 + 4);
                cw[j][0] = w0.x; cw[j][1] = w0.y; cw[j][2] = w0.z; cw[j][3] = w0.w; cw[j][4] = w1.x; cw[j][5] = w1.y; cw[j][6] = w1.z; cw[j][7] = w1.w; }
            float x[8][8];
#pragma unroll
            for (int rr = 0; rr < 8; ++rr) {
                const uint4 v = *(const uint4*)(RAW + ((4 * pg + rr) * 96 + cg) * 16);
                const unsigned vv[4] = {v.x, v.y, v.z, v.w};
#pragma unroll
                for (int e = 0; e < 4; ++e) { x[rr][2 * e] = __uint_as_float(vv[e] << 16); x[rr][2 * e + 1] = __uint_as_float(vv[e] & 0xffff0000u); }
            }
#pragma unroll
            for (int e2 = 0; e2 < 4; ++e2) {
                float y[8]; float ss = 0.f;
#pragma unroll
                for (int e = 0; e < 8; ++e) { float acc = 0.f;
#pragma unroll
                    for (int j = 0; j < 5; ++j) acc += x[e2 + j][e] * cw[j][e];
                    y[e] = siluf_(acc); ss += y[e] * y[e]; }
                ss += __shfl_xor(ss, 1, 64); ss += __shfl_xor(ss, 2, 64); ss += __shfl_xor(ss, 4, 64);
                const float rs = cg < 64 ? rsqrtf(ss + 1e-6f) : 1.0f;
                uint4 o; o.x = cvt_pk_bf16_(y[0] * rs, y[1] * rs); o.y = cvt_pk_bf16_(y[2] * rs, y[3] * rs); o.z = cvt_pk_bf16_(y[4] * rs, y[5] * rs); o.w = cvt_pk_bf16_(y[6] * rs, y[7] * rs);
                *(uint4*)(p.QKVN + ((size_t)b * TJ + tlo + 4 * pg + e2) * 768 + cg * 8) = o;
            }
        }
        {
            const int lane = tid_ & 63, wq = tid_ >> 6, hh = wq >> 1, dd = wq & 1;
            bf16_t* prow = p.P + ((size_t)b * TJ + tlo + lane) * DINP;
            const float av = bf2f(prow[C_DNA + dd * 4 + hh]), bv = bf2f(prow[C_DNB + dd * 4 + hh]);
            const float g = -expf(p.dn_a_log[layer * 8 + dd * 4 + hh]) * softplusf_(av + p.dn_dt_bias[layer * 8 + dd * 4 + hh]);
            float pre = g;
#pragma unroll
            for (int o = 1; o < 64; o <<= 1) { const float t = __shfl_up(pre, o, 64); if (lane >= o) pre += t; }
            const float tot = rdlane(pre, 63);
            float2 gb; gb.x = dd == 0 ? pre : tot - pre + g; gb.y = sigmoidf_(bv);
            *(float2*)((float*)(prow + DIN) + (dd * 4 + hh) * 2) = gb;
        }
    }
}

#define DN_B1 (DN_TX + 2560)
#define DN_SB 72
#define DN_QN 0
#define DN_QD (DN_QN + 9216)
#define DN_KN (DN_QD + 9216)
#define DN_KB (DN_KN + 9216)
#define DN_V (DN_KB + 9216)
#define DN_NL (DN_V + 9216)
#define DN_AI (DN_NL + 9216)
#define DN_NW (DN_AI + 9216)
#define DN_KDT (DN_NW + 9216)
#define DN_TD (DN_KDT + 9216)
#define DN_GAM (DN_TD + 4096)
#define DN_TX (DN_GAM + 2048)
typedef float f32x4_ __attribute__((ext_vector_type(4)));
__device__ __forceinline__ bfx8 pack8(const f32x4_& x, const f32x4_& y) {
    unsigned u[4]; u[0] = cvt_pk_bf16_(x[0], x[1]); u[1] = cvt_pk_bf16_(x[2], x[3]); u[2] = cvt_pk_bf16_(y[0], y[1]); u[3] = cvt_pk_bf16_(y[2], y[3]);
    return *(const bfx8*)u;
}
__device__ __forceinline__ bfx8 ld_split(const unsigned char* base, int row, int k0, int q4) {
    const unsigned char* a = base + (row * DN_SB + k0 + 4 * q4) * 2;
    uint2 lo = *(const uint2*)a, hi = *(const uint2*)(a + 32);
    unsigned u[4] = {lo.x, lo.y, hi.x, hi.y}; return *(const bfx8*)u;
}
__device__ __forceinline__ bfx8 ld_half(const unsigned char* base, int rowstride, int row, int k0, int q4) {
    uint2 lo = *(const uint2*)(base + (row * rowstride + k0 + 4 * q4) * 2);
    unsigned u[4] = {lo.x, lo.y, 0u, 0u}; return *(const bfx8*)u;
}
#define MFMA16(a, b, c) __builtin_amdgcn_mfma_f32_16x16x32_bf16(a, b, c, 0, 0, 0)

__device__ __forceinline__ void dn_tdiag(unsigned char* L, int a, int cc, int q4) {
    float xs[16];
#pragma unroll
    for (int r = 0; r < 16; ++r) {
        const unsigned char* rowp = L + DN_NL + ((16 * a + r) * DN_SB + 16 * a) * 2;
        const uint4 v0 = *(const uint4*)rowp, v1 = *(const uint4*)(rowp + 16);
        const unsigned vv[8] = {v0.x, v0.y, v0.z, v0.w, v1.x, v1.y, v1.z, v1.w};
        float sx = (r == cc) ? 1.f : 0.f;
#pragma unroll
        for (int j2 = 0; j2 < 16; ++j2) if (j2 < r) { const float lij = (j2 & 1) ? __uint_as_float(vv[j2 >> 1] & 0xffff0000u) : __uint_as_float(vv[j2 >> 1] << 16); sx += lij * xs[j2]; }
        xs[r] = sx;
        if (q4 == 0) *(bf16_t*)(L + DN_TD + ((a * 16 + r) * 16 + cc) * 2) = f2bf(sx);
    }
}
__device__ __forceinline__ void dn_tdiag_ahead(const Params& p, unsigned char* L, unsigned char* TDdst, int b, int h, int d, int tlo, int a, int l15, int q4) {
    unsigned char* blk = L + DN_TX + a * 640; float* gsc = (float*)(blk + 512);
    const int i = 16 * a + l15, tau = d ? tlo + 63 - i : tlo + i;
    const bf16_t* krow = p.QKVN + ((size_t)b * TJ + tau) * 768 + 256 + h * 64;
    const bfx8 k0 = *(const bfx8*)(krow + 8 * q4), k1 = *(const bfx8*)(krow + 32 + 8 * q4);
    const float2 gb = *(const float2*)((const float*)(p.P + ((size_t)b * TJ + tau) * DINP + DIN) + (d * 4 + h) * 2);
    if (q4 == 0) { gsc[l15] = gb.x; gsc[16 + l15] = gb.y; }
    f32x4_ kk = {0.f, 0.f, 0.f, 0.f};
    kk = MFMA16(k0, k0, kk); kk = MFMA16(k1, k1, kk);
    WAVE_LDS_FENCE();
    const float gj = gsc[l15];
#pragma unroll
    for (int r = 0; r < 4; ++r) {
        const int il = 4 * q4 + r;
        const float lv = (l15 < il) ? -gsc[16 + il] * kk[r] * __expf(gsc[il] - gj) : 0.f;
        *(bf16_t*)(blk + (il * 16 + l15) * 2) = f2bf(lv);
    }
    WAVE_LDS_FENCE();
    float xs[16];
#pragma unroll
    for (int r = 0; r < 16; ++r) {
        const uint4 v0 = *(const uint4*)(blk + r * 32), v1 = *(const uint4*)(blk + r * 32 + 16);
        const unsigned vv[8] = {v0.x, v0.y, v0.z, v0.w, v1.x, v1.y, v1.z, v1.w};
        float sx = (r == l15) ? 1.f : 0.f;
#pragma unroll
        for (int j2 = 0; j2 < 16; ++j2) if (j2 < r) { const float lij = (j2 & 1) ? __uint_as_float(vv[j2 >> 1] & 0xffff0000u) : __uint_as_float(vv[j2 >> 1] << 16); sx += lij * xs[j2]; }
        xs[r] = sx;
        if (q4 == 0) *(bf16_t*)(TDdst + ((a * 16 + r) * 16 + l15) * 2) = f2bf(sx);
    }
    WAVE_LDS_FENCE();
}
__device__ __forceinline__ void dn_chain(unsigned char* smem, const Params& p, int layer, int chain, int tid_) {
    unsigned char* L = smem + 1024;
    const int b = chain >> 3, h = (chain >> 1) & 3, d = chain & 1;
    const int w0_ = tid_ >> 6, lane0_ = tid_ & 63;
#define DN_IDS() int tt_ = tid_; OPQV(tt_); const int lane = tt_ & 63, w = __builtin_amdgcn_readfirstlane(tt_ >> 6), l15 = lane & 15, q4 = lane >> 4; (void)l15; (void)q4; (void)w
    const float nalog = -expf(p.dn_a_log[layer * 8 + d * 4 + h]), dtb = p.dn_dt_bias[layer * 8 + d * 4 + h];
    f32x4_ Sst[4], Uk[4];
#pragma unroll
    for (int mt = 0; mt < 4; ++mt) { Sst[mt] = (f32x4_){0.f, 0.f, 0.f, 0.f}; Uk[mt] = (f32x4_){0.f, 0.f, 0.f, 0.f}; }
    bf16_t* Oout = d == 0 ? p.Y : p.ODN; const int ldo = d == 0 ? DM : 256;
    uint4 pa0 = make_uint4(0, 0, 0, 0), pa1 = pa0, pa2 = pa0; float2 gba = make_float2(0.f, 0.f); float gl_n = 0.f;
    auto chunk_lo = [&](int c) { return d == 0 ? c * 64 : (c < 4 ? 192 - c * 64 : (TJ + NCTX - 64) - c * 64); };
#define DN_ISSUE(c_) do { const int tlo_ = chunk_lo(c_); const int i_ = tid_ >> 3, c8_ = (tid_ & 7) * 8; \
        { const int tau_ = d ? tlo_ + 63 - i_ : tlo_ + i_; const bf16_t* s_ = p.QKVN + ((size_t)b * TJ + tau_) * 768 + h * 64 + c8_; \
          pa0 = *(const uint4*)s_; pa1 = *(const uint4*)(s_ + 256); pa2 = *(const uint4*)(s_ + 512); \
          gba = *(const float2*)((const float*)(p.P + ((size_t)b * TJ + tau_) * DINP + DIN) + (d * 4 + h) * 2); } \
        gl_n = *((const float*)(p.P + ((size_t)b * TJ + (d ? tlo_ : tlo_ + 63)) * DINP + DIN) + (d * 4 + h) * 2); } while (0)
#define DN_COMMIT1(i_, q_, k_, v_, gb_, io_, ko_, gm_) do { \
        const float gmi = (gb_).x, bti = (gb_).y, egi = __expf(gmi), eki = __expf(gl_n - gmi); \
        if ((tid_ & 7) == 0) { (gm_)[i_] = gmi; (gm_)[64 + (i_)] = bti; (gm_)[128 + (i_)] = egi; (gm_)[192 + (i_)] = eki; } \
        *(uint4*)(L + DN_QN + (io_) + ((i_) * DN_SB + c8) * 2) = (q_); *(uint4*)(L + DN_KN + (io_) + ((i_) * DN_SB + c8) * 2) = (k_); \
        const unsigned* qq = (const unsigned*)&(q_); const unsigned* kq = (const unsigned*)&(k_); const unsigned* vq = (const unsigned*)&(v_); \
        uint4 qd, kb, vb; unsigned* qdp = (unsigned*)&qd; unsigned* kbp = (unsigned*)&kb; unsigned* vbp = (unsigned*)&vb; \
        const float sq = 0.125f * egi, skb = bti * egi; \
        _Pragma("unroll") for (int e = 0; e < 4; ++e) { \
            const float k0 = __uint_as_float(kq[e] << 16), k1 = __uint_as_float(kq[e] & 0xffff0000u); \
            qdp[e] = cvt_pk_bf16_(__uint_as_float(qq[e] << 16) * sq, __uint_as_float(qq[e] & 0xffff0000u) * sq); \
            kbp[e] = cvt_pk_bf16_(k0 * skb, k1 * skb); \
            vbp[e] = cvt_pk_bf16_(__uint_as_float(vq[e] << 16) * bti, __uint_as_float(vq[e] & 0xffff0000u) * bti); \
            *(bf16_t*)(L + DN_KDT + (ko_) + ((c8 + 2 * e) * DN_SB + (i_)) * 2) = f2bf(k0 * eki); \
            *(bf16_t*)(L + DN_KDT + (ko_) + ((c8 + 2 * e + 1) * DN_SB + (i_)) * 2) = f2bf(k1 * eki); } \
        *(uint4*)(L + DN_QD + (io_) + ((i_) * DN_SB + c8) * 2) = qd; *(uint4*)(L + DN_KB + (io_) + ((i_) * DN_SB + c8) * 2) = kb; *(uint4*)(L + DN_V + (io_) + ((i_) * DN_SB + c8) * 2) = vb; } while (0)
#define DN_COMMIT(c_) do { const int par_ = (c_) & 1, io2 = par_ ? DN_B1 : 0, ko2 = par_ ? (DN_B1 + 46080 - DN_KDT) : 0; float* gm2 = (float*)(L + DN_GAM + par_ * 1024); \
        const int i0 = tid_ >> 3, c8 = (tid_ & 7) * 8; \
        DN_COMMIT1(i0, pa0, pa1, pa2, gba, io2, ko2, gm2); } while (0)
    DN_ISSUE(0);
    if (w0_ >= 4) dn_tdiag_ahead(p, L, L + DN_TD, b, h, d, chunk_lo(0), w0_ - 4, lane0_ & 15, lane0_ >> 4);
    DN_COMMIT(0);
    DN_ISSUE(1);
    __syncthreads();
    for (int c = 0; c < TJ / 64; ++c) {
        const int tlo = chunk_lo(c);
        const int io = (c & 1) ? DN_B1 : 0, ko = (c & 1) ? (DN_B1 + 46080 - DN_KDT) : 0;
        const float* gam = (const float*)(L + DN_GAM + (c & 1) * 1024);
        { DN_IDS();
#pragma unroll
        for (int tt = 0; tt < 2; ++tt) {
            const int t = 2 * w + tt, it = t >> 2, jt = t & 3;
            f32x4_ kk = {0.f, 0.f, 0.f, 0.f}, qk = {0.f, 0.f, 0.f, 0.f};
            if (jt <= it) {
#pragma unroll
                for (int ks = 0; ks < 2; ++ks) {
                    const bfx8 bk = *(const bfx8*)(L + DN_KN + io + ((jt * 16 + l15) * DN_SB + ks * 32 + q4 * 8) * 2);
                    const bfx8 ak = *(const bfx8*)(L + DN_KN + io + ((it * 16 + l15) * DN_SB + ks * 32 + q4 * 8) * 2);
                    const bfx8 aq = *(const bfx8*)(L + DN_QN + io + ((it * 16 + l15) * DN_SB + ks * 32 + q4 * 8) * 2);
                    kk = MFMA16(ak, bk, kk); qk = MFMA16(aq, bk, qk);
                }
            }
            const int j = jt * 16 + l15; const float gj = gam[j];
#pragma unroll
            for (int r = 0; r < 4; ++r) {
                const int i = it * 16 + q4 * 4 + r;
                const float dec = (j <= i) ? __expf(gam[i] - gj) : 0.f;
                const float lv = (j < i) ? -gam[64 + i] * kk[r] * dec : 0.f;
                *(bf16_t*)(L + DN_NL + (i * DN_SB + j) * 2) = f2bf(lv);
                *(bf16_t*)(L + DN_AI + (i * DN_SB + j) * 2) = f2bf(0.125f * qk[r] * dec);
            }
        }
        }
        __syncthreads();
        if (c + 1 < TJ / 64) { DN_COMMIT(c + 1); if (c + 2 < TJ / 64) DN_ISSUE(c + 2); }
        { DN_IDS();
            const f32x4_ z4 = {0.f, 0.f, 0.f, 0.f};
            f32x4_ R[4];
#pragma unroll
            for (int a = 0; a < 4; ++a)
#pragma unroll
                for (int r = 0; r < 4; ++r) {
                    const int i = 16 * a + 4 * q4 + r;
                    R[a][r] = w < 4 ? bf2f(*(const bf16_t*)(L + DN_V + io + (i * DN_SB + 16 * w + l15) * 2)) : bf2f(*(const bf16_t*)(L + DN_KB + io + (i * DN_SB + 16 * (w - 4) + l15) * 2));
                }
            f32x4_ X[4];
#pragma unroll
            for (int a = 0; a < 4; ++a) {
                f32x4_ acc = R[a];
                if (a == 1) acc = MFMA16(ld_half(L + DN_NL, DN_SB, 16 + l15, 0, q4), pack8(X[0], z4), acc);
                if (a >= 2) acc = MFMA16(ld_split(L + DN_NL, 16 * a + l15, 0, q4), pack8(X[0], X[1]), acc);
                if (a == 3) acc = MFMA16(ld_half(L + DN_NL, DN_SB, 48 + l15, 32, q4), pack8(X[2], z4), acc);
                X[a] = MFMA16(ld_half(L + DN_TD + (c & 1) * 2048, 16, a * 16 + l15, 0, q4), pack8(acc, z4), z4);
            }
            if (w < 4) {
#pragma unroll
                for (int a = 0; a < 4; ++a) Uk[a] = X[a];
            } else {
#pragma unroll
                for (int a = 0; a < 4; ++a)
#pragma unroll
                    for (int r = 0; r < 4; ++r) {
                        const int i = 16 * a + 4 * q4 + r;
                        *(bf16_t*)(L + DN_NW + (i * DN_SB + 16 * (w - 4) + l15) * 2) = f2bf(-X[a][r]);
                    }
            }
        }
        __syncthreads();
        { DN_IDS();
        if (w < 4) {
            const f32x4_ z4 = {0.f, 0.f, 0.f, 0.f};
            bfx8 sb[2]; sb[0] = pack8(Sst[0], Sst[1]); sb[1] = pack8(Sst[2], Sst[3]);
            f32x4_ vn[4];
#pragma unroll
            for (int mt = 0; mt < 4; ++mt) {
                f32x4_ acc = Uk[mt];
                acc = MFMA16(ld_split(L + DN_NW, 16 * mt + l15, 0, q4), sb[0], acc);
                acc = MFMA16(ld_split(L + DN_NW, 16 * mt + l15, 32, q4), sb[1], acc);
                vn[mt] = acc;
            }
            bfx8 vb[2]; vb[0] = pack8(vn[0], vn[1]); vb[1] = pack8(vn[2], vn[3]);
#pragma unroll
            for (int mt = 0; mt < 4; ++mt) {
                f32x4_ acc = z4;
                acc = MFMA16(ld_split(L + DN_QD + io, 16 * mt + l15, 0, q4), sb[0], acc);
                acc = MFMA16(ld_split(L + DN_QD + io, 16 * mt + l15, 32, q4), sb[1], acc);
                acc = MFMA16(ld_split(L + DN_AI, 16 * mt + l15, 0, q4), vb[0], acc);
                acc = MFMA16(ld_split(L + DN_AI, 16 * mt + l15, 32, q4), vb[1], acc);
#pragma unroll
                for (int r = 0; r < 4; ++r) {
                    const int i = 16 * mt + 4 * q4 + r, tau = d ? tlo + 63 - i : tlo + i;
                    Oout[((size_t)b * TJ + tau) * ldo + h * 64 + 16 * w + l15] = f2bf(acc[r]);
                }
            }
            const float glast = gam[128 + 63];
#pragma unroll
            for (int mt = 0; mt < 4; ++mt) {
                f32x4_ acc = Sst[mt] * glast;
                acc = MFMA16(ld_split(L + DN_KDT + ko, 16 * mt + l15, 0, q4), vb[0], acc);
                acc = MFMA16(ld_split(L + DN_KDT + ko, 16 * mt + l15, 32, q4), vb[1], acc);
                Sst[mt] = acc;
            }
        } else if (c + 1 < TJ / 64) {
            dn_tdiag_ahead(p, L, L + DN_TD + ((c + 1) & 1) * 2048, b, h, d, chunk_lo(c + 1), w - 4, l15, q4);
        }
        }
        __syncthreads();
    }
#undef DN_ISSUE
#undef DN_COMMIT1
#undef DN_COMMIT
    __syncthreads();
}

__device__ __forceinline__ int gla_scan_chunk(int d, int tc) { return d == 0 ? tc : (tc < 4 ? 3 - tc : (TJ / 64 + 3) - tc); }
__device__ __forceinline__ void gla_low(const bf16_t* prow, int d, float (&low)[16]) {
    const uint4 v0 = *(const uint4*)(prow + C_GLG + d * 16), v1 = *(const uint4*)(prow + C_GLG + d * 16 + 8);
    const unsigned vv[8] = {v0.x, v0.y, v0.z, v0.w, v1.x, v1.y, v1.z, v1.w};
#pragma unroll
    for (int e = 0; e < 8; ++e) { low[2 * e] = __uint_as_float(vv[e] << 16); low[2 * e + 1] = __uint_as_float(vv[e] & 0xffff0000u); }
}
__device__ __forceinline__ void gla_gate4(const Params& p, int layer, int h, int d, const float (&low)[16], int c4, int lane, float (&bb)[4], float (&tot)[4]) {
    const float* w2 = p.gla_w_gate + (size_t)(layer * 2 + d) * 16 * 128 + h * 32 + c4 * 4;
    const float* b2 = p.gla_b_gate + (size_t)(layer * 2 + d) * 128 + h * 32 + c4 * 4;
#pragma unroll
    for (int e = 0; e < 4; ++e) {
        float z = b2[e];
#pragma unroll
        for (int r = 0; r < 16; ++r) z += low[r] * w2[r * 128 + e];
        const float x = logsigmoidf_(z) * (1.0f / 16.0f);
        float pre = x;
#pragma unroll
        for (int o = 1; o < 64; o <<= 1) { const float t = __shfl_up(pre, o, 64); if (lane >= o) pre += t; }
        const float tt = rdlane(pre, 63);
        tot[e] = tt; bb[e] = d == 0 ? pre : tt - pre + x;
    }
}
#define GLA_VS 68
#define GLA_WAVE_LDS 17408
__device__ __forceinline__ bfx8 ld_split_s(const unsigned char* base, int strideB, int row, int k0, int q4) {
    const unsigned char* a = base + row * strideB + (k0 + 4 * q4) * 2;
    const uint2 lo = *(const uint2*)a, hi = *(const uint2*)(a + 32);
    unsigned u[4] = {lo.x, lo.y, hi.x, hi.y}; return *(const bfx8*)u;
}
__device__ __forceinline__ void gla_load_row32(const bf16_t* src, float (&x)[32]) {
#pragma unroll
    for (int c = 0; c < 4; ++c) { const uint4 v = *(const uint4*)(src + c * 8); const unsigned vv[4] = {v.x, v.y, v.z, v.w};
#pragma unroll
        for (int e = 0; e < 4; ++e) { x[c * 8 + 2 * e] = __uint_as_float(vv[e] << 16); x[c * 8 + 2 * e + 1] = __uint_as_float(vv[e] & 0xffff0000u); } }
}
__device__ __forceinline__ void gla_store_vT(unsigned char* vT, const bf16_t* vsrc, int lane) {
#pragma unroll
    for (int c = 0; c < 8; ++c) { const uint4 v = *(const uint4*)(vsrc + c * 8); const unsigned vv[4] = {v.x, v.y, v.z, v.w};
#pragma unroll
        for (int e = 0; e < 4; ++e) { *(bf16_t*)(vT + ((c * 8 + 2 * e) * GLA_VS + lane) * 2) = (bf16_t)(vv[e] & 0xffffu); *(bf16_t*)(vT + ((c * 8 + 2 * e + 1) * GLA_VS + lane) * 2) = (bf16_t)(vv[e] >> 16); } }
}
__device__ __forceinline__ void ph_gla1(const int wv_, unsigned char* smem, const Params& p, int layer) {
    PH_IDS();
    const int lane = tid_ & 63, w = tid_ >> 6, l15 = lane & 15, q4 = lane >> 4;
    unsigned char* vT = smem + 1024 + w * GLA_WAVE_LDS; unsigned char* khT = vT + 8704 + 4096;
    const int vb = bid_ - 32, vn = nblk_ - 32;
    if (vb < 0) return;
    for (int item = ((vb + 128) % vn) * NWV + w; item < NB * 4 * 2 * (TJ / 64); item += vn * NWV) {
        const int tc = item % (TJ / 64), bhd = item / (TJ / 64), d = bhd & 1, h = (bhd >> 1) & 3, b = bhd >> 3;
        const bf16_t* prow = p.P + ((size_t)b * TJ + tc * 64 + lane) * DINP;
        const int cs = gla_scan_chunk(d, tc);
        float low[16]; gla_low(prow, d, low);
        {
            const uint4* ks = (const uint4*)(prow + C_GLK + h * 32); const uint4 k0 = ks[0], k1 = ks[1], k2 = ks[2], k3 = ks[3];
            uint4* kd = (uint4*)(vT + lane * 64); kd[0] = k0; kd[1] = k1; kd[2] = k2; kd[3] = k3;
        }
#pragma unroll 1
        for (int c4 = 0; c4 < 8; ++c4) {
            float bb[4], tot[4];
            gla_gate4(p, layer, h, d, low, c4, lane, bb, tot);
            const uint2 kv = *(const uint2*)(vT + lane * 64 + c4 * 8);
            const float k0 = __uint_as_float(kv.x << 16), k1 = __uint_as_float(kv.x & 0xffff0000u), k2 = __uint_as_float(kv.y << 16), k3 = __uint_as_float(kv.y & 0xffff0000u);
            *(bf16_t*)(khT + ((c4 * 4 + 0) * GLA_VS + lane) * 2) = f2bf(k0 * __expf(tot[0] - bb[0]));
            *(bf16_t*)(khT + ((c4 * 4 + 1) * GLA_VS + lane) * 2) = f2bf(k1 * __expf(tot[1] - bb[1]));
            *(bf16_t*)(khT + ((c4 * 4 + 2) * GLA_VS + lane) * 2) = f2bf(k2 * __expf(tot[2] - bb[2]));
            *(bf16_t*)(khT + ((c4 * 4 + 3) * GLA_VS + lane) * 2) = f2bf(k3 * __expf(tot[3] - bb[3]));
            if (lane < 4) { const float tl = lane == 0 ? tot[0] : lane == 1 ? tot[1] : lane == 2 ? tot[2] : tot[3];
                p.DCY[((size_t)bhd * (TJ / 64) + cs) * 32 + c4 * 4 + lane] = __expf(tl); }
        }
        WAVE_LDS_FENCE();
        gla_store_vT(vT, prow + C_GLV + h * 64, lane);
        WAVE_LDS_FENCE();
        bf16_t* gout = p.GST + ((size_t)bhd * (TJ / 64) + cs) * 2048;
#pragma unroll
        for (int dt = 0; dt < 4; ++dt)
#pragma unroll
            for (int nt = 0; nt < 2; ++nt) {
                f32x4_ acc = {0.f, 0.f, 0.f, 0.f};
#pragma unroll
                for (int ks = 0; ks < 2; ++ks) acc = MFMA16(ld_split_s(vT, GLA_VS * 2, 16 * dt + l15, 32 * ks, q4), ld_split_s(khT, GLA_VS * 2, 16 * nt + l15, 32 * ks, q4), acc);
#pragma unroll
                for (int r = 0; r < 4; ++r) gout[(16 * dt + 4 * q4 + r) * 32 + 16 * nt + l15] = f2bf(acc[r]);
            }
        WAVE_LDS_FENCE();
    }
}
__device__ __forceinline__ void gla2_scan(const Params& p, int wg, int tid_) {
    const int chain = wg >> 1, pr = (wg & 1) * 512 + tid_, dk0 = (2 * pr) & 31;
    unsigned* g = (unsigned*)(p.GST + (size_t)chain * (TJ / 64) * 2048) + pr;
    const float* dc = p.DCY + (size_t)chain * (TJ / 64) * 32 + dk0;
    float s0 = 0.f, s1 = 0.f;
    for (int c0 = 0; c0 < TJ / 64; c0 += 4) {
        unsigned gv[4]; float2 dv[4];
#pragma unroll
        for (int u = 0; u < 4; ++u) if (c0 + u < TJ / 64) { gv[u] = g[(size_t)(c0 + u) * 1024]; dv[u] = *(const float2*)(dc + (c0 + u) * 32); }
#pragma unroll
        for (int u = 0; u < 4; ++u) if (c0 + u < TJ / 64) {
            g[(size_t)(c0 + u) * 1024] = cvt_pk_bf16_(s0, s1);
            s0 = dv[u].x * s0 + __uint_as_float(gv[u] << 16); s1 = dv[u].y * s1 + __uint_as_float(gv[u] & 0xffff0000u);
        }
    }
}
__device__ __forceinline__ void ph_gla3(const int wv_, unsigned char* smem, const Params& p, int layer) {
    PH_IDS();
    const int lane = tid_ & 63, w = tid_ >> 6, l15 = lane & 15, q4 = lane >> 4;
    unsigned char* vT = smem + 1024 + w * GLA_WAVE_LDS; unsigned char* Qt = vT + 8704; unsigned char* Kt = Qt + 4096;
    for (;;) {
#ifdef EMU
        int item = 0; if (lane == 0) item = g_emu_q++; item = __builtin_amdgcn_readlane(item, 0);
#else
        int item = 0; if (lane == 0) item = atomicAdd(p.cnt + 130, 1); item = __builtin_amdgcn_readfirstlane(item);
#endif
        if (item >= NB * 4 * (TJ / 64)) break;
        const int tc = item % (TJ / 64), bh = item / (TJ / 64), h = bh & 3, b = bh >> 2;
        if (layer == NLAYER - 1 && tc < 4) continue;
        const bf16_t* prow = p.P + ((size_t)b * TJ + tc * 64 + lane) * DINP;
        gla_store_vT(vT, prow + C_GLV + h * 64, lane);
        f32x4_ o[4][4];
#pragma unroll
        for (int dt = 0; dt < 4; ++dt)
#pragma unroll
            for (int nt = 0; nt < 4; ++nt) o[dt][nt] = (f32x4_){0.f, 0.f, 0.f, 0.f};
#pragma unroll 1
        for (int d = 0; d < 2; ++d) {
#ifdef EMU
            if (g_dbg_dir >= 0 && d != g_dbg_dir) continue;
#endif
            {
                float low[16]; gla_low(prow, d, low);
                {
                    const uint4* qs = (const uint4*)(prow + C_GLQ + h * 32); const uint4* ks = (const uint4*)(prow + C_GLK + h * 32);
                    const uint4 q0 = qs[0], q1 = qs[1], q2 = qs[2], q3 = qs[3], k0 = ks[0], k1 = ks[1], k2 = ks[2], k3 = ks[3];
                    uint4* qd = (uint4*)(Qt + lane * 64); uint4* kd = (uint4*)(Kt + lane * 64);
                    qd[0] = q0; qd[1] = q1; qd[2] = q2; qd[3] = q3; kd[0] = k0; kd[1] = k1; kd[2] = k2; kd[3] = k3;
                }
#pragma unroll 1
                for (int c4 = 0; c4 < 8; ++c4) {
                    float bb[4], tot[4];
                    gla_gate4(p, layer, h, d, low, c4, lane, bb, tot);
                    const uint2 qv = *(const uint2*)(Qt + lane * 64 + c4 * 8), kv = *(const uint2*)(Kt + lane * 64 + c4 * 8);
                    const float sc = 0.17677669529663687f;
                    const float e0 = __expf(bb[0]), e1 = __expf(bb[1]), e2 = __expf(bb[2]), e3 = __expf(bb[3]);
                    uint2 qo, ko;
                    qo.x = cvt_pk_bf16_(__uint_as_float(qv.x << 16) * sc * e0, __uint_as_float(qv.x & 0xffff0000u) * sc * e1);
                    qo.y = cvt_pk_bf16_(__uint_as_float(qv.y << 16) * sc * e2, __uint_as_float(qv.y & 0xffff0000u) * sc * e3);
                    ko.x = cvt_pk_bf16_(__uint_as_float(kv.x << 16) / e0, __uint_as_float(kv.x & 0xffff0000u) / e1);
                    ko.y = cvt_pk_bf16_(__uint_as_float(kv.y << 16) / e2, __uint_as_float(kv.y & 0xffff0000u) / e3);
                    *(uint2*)(Qt + lane * 64 + c4 * 8) = qo; *(uint2*)(Kt + lane * 64 + c4 * 8) = ko;
                }
            }
            WAVE_LDS_FENCE();
            const bf16_t* sst = p.GST + ((size_t)((bh * 2 + d) * (TJ / 64)) + gla_scan_chunk(d, tc)) * 2048;
            bfx8 qb[4];
#pragma unroll
            for (int nt = 0; nt < 4; ++nt) qb[nt] = *(const bfx8*)(Qt + (16 * nt + l15) * 64 + q4 * 16);
#pragma unroll
            for (int nt = 0; nt < 4; ++nt) {
                f32x4_ at[4];
#pragma unroll
                for (int mt = 0; mt < 4; ++mt) {
                    const bfx8 ka = *(const bfx8*)(Kt + (16 * mt + l15) * 64 + q4 * 16);
                    f32x4_ a = MFMA16(ka, qb[nt], ((f32x4_){0.f, 0.f, 0.f, 0.f}));
                    const int t = 16 * nt + l15;
#pragma unroll
                    for (int r = 0; r < 4; ++r) { const int sidx = 16 * mt + 4 * q4 + r; const bool keep = d == 0 ? sidx <= t : sidx >= t; a[r] = keep ? a[r] : 0.f; }
                    at[mt] = a;
                }
                const bfx8 ab0 = pack8(at[0], at[1]), ab1 = pack8(at[2], at[3]);
#pragma unroll
                for (int dt = 0; dt < 4; ++dt) {
                    f32x4_ acc = o[dt][nt];
                    acc = MFMA16(ld_split_s(vT, GLA_VS * 2, 16 * dt + l15, 0, q4), ab0, acc);
                    acc = MFMA16(ld_split_s(vT, GLA_VS * 2, 16 * dt + l15, 32, q4), ab1, acc);
                    acc = MFMA16(*(const bfx8*)(sst + (16 * dt + l15) * 32 + q4 * 8), qb[nt], acc);
                    o[dt][nt] = acc;
                }
            }
            WAVE_LDS_FENCE();
        }
        const float* g = p.gla_norm_g + layer * 64;
#pragma unroll
        for (int nt = 0; nt < 4; ++nt) {
            float ss = 0.f;
#pragma unroll
            for (int dt = 0; dt < 4; ++dt)
#pragma unroll
                for (int r = 0; r < 4; ++r) ss += o[dt][nt][r] * o[dt][nt][r];
            ss += __shfl_xor(ss, 16, 64); ss += __shfl_xor(ss, 32, 64);
            const float rs = rsqrtf(ss * (1.0f / 64.0f) + 1e-6f);
            const size_t row = (size_t)b * TJ + tc * 64 + 16 * nt + l15;
#ifdef EMU
            if (g_dbg_dir >= 0) { for (int dt = 0; dt < 4; ++dt) for (int r = 0; r < 4; ++r) g_dbg[row * 256 + h * 64 + 16 * dt + 4 * q4 + r] = o[dt][nt][r]; }
#endif
#pragma unroll
            for (int dt = 0; dt < 4; ++dt) {
                const int dv0 = 16 * dt + 4 * q4;
                const uint2 rg = *(const uint2*)(p.P + row * DINP + C_GLR + h * 64 + dv0);
                const float r0 = __uint_as_float(rg.x << 16), r1 = __uint_as_float(rg.x & 0xffff0000u), r2 = __uint_as_float(rg.y << 16), r3 = __uint_as_float(rg.y & 0xffff0000u);
                uint2 w2;
                w2.x = cvt_pk_bf16_(o[dt][nt][0] * rs * g[dv0] * siluf_(r0), o[dt][nt][1] * rs * g[dv0 + 1] * siluf_(r1));
                w2.y = cvt_pk_bf16_(o[dt][nt][2] * rs * g[dv0 + 2] * siluf_(r2), o[dt][nt][3] * rs * g[dv0 + 3] * siluf_(r3));
                *(uint2*)(p.Y + row * DM + 768 + h * 64 + dv0) = w2;
            }
        }
    }
}

#define S5NS (TJ / 16)
#define S5NT (TJ / 256)
__device__ __forceinline__ void s5_prep_item(unsigned char* smem, const Params& p, int layer, const int bid_, const int tid_) {
    if (bid_ >= 64) {
        if (bid_ < 80) for (int idx = (bid_ - 64) * NTHR + tid_; idx < 65536; idx += 16 * NTHR) { const int co = idx >> 8, ch = idx & 255; p.GLUt[idx] = f2bf(p.s5_glu_w[(size_t)layer * 65536 + ch * 256 + co]); }
        return;
    }
    const int g = bid_ >> 2, qd = bid_ & 3;
    float2* APOW = (float2*)(smem + 1024);
    float2* BBAR = APOW + 2 * 64 * 17;
    float2* CC = BBAR + 2 * 64 * 16;
    float* KC = (float*)(CC + 2 * 16 * 64);
    __syncthreads();
    if (tid_ < 128) {
        const int d = tid_ >> 6, pp = tid_ & 63;
        const float lre = p.s5_a_re[((layer * 2 + d) * 16 + g) * 64 + pp], lim = p.s5_a_im[((layer * 2 + d) * 16 + g) * 64 + pp];
        const float dt = expf(p.s5_log_dt[(layer * 2 + d) * 16 + g]);
        for (int m = 0; m <= 16; ++m) { const float mag = expf(lre * dt * (float)m), ang = lim * dt * (float)m; APOW[(d * 64 + pp) * 17 + m] = make_float2(mag * cosf(ang), mag * sinf(ang)); }
        const float2 a1 = APOW[(d * 64 + pp) * 17 + 1]; const float den = lre * lre + lim * lim;
        const float fre = ((a1.x - 1.f) * lre + a1.y * lim) / den, fim = (a1.y * lre - (a1.x - 1.f) * lim) / den;
        for (int c = 0; c < 16; ++c) {
            const float br = p.s5_b_re[((layer * 16 + g) * 64 + pp) * 16 + c], bi = p.s5_b_im[((layer * 16 + g) * 64 + pp) * 16 + c];
            BBAR[(d * 64 + pp) * 16 + c] = make_float2(fre * br - fim * bi, fre * bi + fim * br);
            CC[(d * 16 + c) * 64 + pp] = make_float2(p.s5_c_re[(((layer * 2 + d) * 16 + g) * 16 + c) * 64 + pp], p.s5_c_im[(((layer * 2 + d) * 16 + g) * 16 + c) * 64 + pp]);
        }
        if (qd == 0) { const float2 a16 = APOW[(d * 64 + pp) * 17 + 16]; p.A16[((d * 16 + g) * 64 + pp) * 2] = a16.x; p.A16[((d * 16 + g) * 64 + pp) * 2 + 1] = a16.y; }
    }
    __syncthreads();
    for (int idx = tid_; idx < 2048; idx += NTHR) {
        const int d = idx >> 10, tau = (idx >> 6) & 15, cl = (idx >> 4) & 3, c2 = idx & 15, c = 4 * qd + cl;
        float acc = 0.f;
        for (int pp = 0; pp < 64; ++pp) {
            const float2 cc = CC[(d * 16 + c) * 64 + pp], ap = APOW[(d * 64 + pp) * 17 + tau], bbv = BBAR[(d * 64 + pp) * 16 + c2];
            const float tr = cc.x * ap.x - cc.y * ap.y, ti = cc.x * ap.y + cc.y * ap.x;
            acc += tr * bbv.x - ti * bbv.y;
        }
        KC[idx] = acc;
    }
    __syncthreads();
    for (int idx = tid_; idx < 64 * 512; idx += NTHR) {
        const int nl = idx >> 9, k = idx & 511, i = nl >> 2, cl = nl & 3, c = 4 * qd + cl, n = i * 16 + c;
        float v;
        if (k < 256) { const int j = k >> 4, c2 = k & 15;
            v = (i >= j ? KC[((0 * 16 + (i - j)) * 4 + cl) * 16 + c2] : 0.f) + (j >= i ? KC[((1 * 16 + (j - i)) * 4 + cl) * 16 + c2] : 0.f);
        } else { const int kk = k - 256, d = kk >> 7, im = (kk >> 6) & 1, pp = kk & 63, m = d == 0 ? i + 1 : 16 - i;
            const float2 cc = CC[(d * 16 + c) * 64 + pp], ap = APOW[(d * 64 + pp) * 17 + m];
            v = im == 0 ? (cc.x * ap.x - cc.y * ap.y) : -(cc.x * ap.y + cc.y * ap.x); }
        p.SB[((size_t)g * 256 + n) * 512 + k] = f2bf(v);
    }
    for (int idx = tid_; idx < 64 * 256; idx += NTHR) {
        const int n = 64 * qd + (idx >> 8), k = idx & 255, j = k >> 4, c2 = k & 15, d = n >> 7, im = (n >> 6) & 1, pp = n & 63, m = d == 0 ? 15 - j : j;
        const float2 ap = APOW[(d * 64 + pp) * 17 + m], bbv = BBAR[(d * 64 + pp) * 16 + c2];
        p.SE[((size_t)g * 256 + n) * 256 + k] = f2bf(im == 0 ? ap.x * bbv.x - ap.y * bbv.y : ap.x * bbv.y + ap.y * bbv.x);
    }
}
__device__ __forceinline__ void ph_s5_1(const int wv_, const Params& p, int layer) {
    PH_IDS();
    const int lane = tid_ & 63, w = tid_ >> 6, l15 = lane & 15, q4 = lane >> 4;
    const int vb = bid_ - 32, vn = nblk_ - 32;
    if (vb < 0) return;
    for (int item = ((vb + 192) % vn) * NWV + w; item < NB * S5NT * 16; item += vn * NWV) {
        const int g = item & 15, st = (item >> 4) % S5NT, b = item / (16 * S5NT), s0 = st * 16;
        bfx8 ua[8];
#pragma unroll
        for (int ks = 0; ks < 8; ++ks) ua[ks] = *(const bfx8*)(p.P + ((size_t)b * TJ + 16 * (s0 + l15) + 2 * ks + (q4 >> 1)) * DINP + C_S5U + 16 * g + 8 * (q4 & 1));
        const bf16_t* se = p.SE + (size_t)g * 65536;
#pragma unroll 2
        for (int nt = 0; nt < 16; ++nt) {
            f32x4_ acc = {0.f, 0.f, 0.f, 0.f};
#pragma unroll
            for (int ks = 0; ks < 8; ++ks) acc = MFMA16(ua[ks], *(const bfx8*)(se + (16 * nt + l15) * 256 + 32 * ks + 8 * q4), acc);
#pragma unroll
            for (int r = 0; r < 4; ++r) p.XS[(((size_t)b * S5NS + s0 + 4 * q4 + r) * 16 + g) * 256 + 16 * nt + l15] = f2bf(acc[r]);
        }
    }
}
__device__ __forceinline__ void s5_2_scan(const Params& p, int wg, int tid_) {
    const int idx = wg * NTHR + tid_, pp = idx & 63, d = (idx >> 6) & 1, g = (idx >> 7) & 15, b = idx >> 11;
    const float ar = p.A16[((d * 16 + g) * 64 + pp) * 2], ai = p.A16[((d * 16 + g) * 64 + pp) * 2 + 1];
    bf16_t* base = p.XS + ((size_t)b * S5NS * 16 + g) * 256 + d * 128 + pp;
    float xr = 0.f, xi = 0.f;
    for (int q0 = 0; q0 < S5NS; q0 += 8) {
        float er[8], ei[8]; int sidx[8];
#pragma unroll
        for (int u = 0; u < 8; ++u) { const int q = q0 + u; const int sq = d == 0 ? q : (q < NCTX / 16 ? NCTX / 16 - 1 - q : S5NS + NCTX / 16 - 1 - q); sidx[u] = sq;
            er[u] = bf2f(base[(size_t)sq * 4096]); ei[u] = bf2f(base[(size_t)sq * 4096 + 64]); }
#pragma unroll
        for (int u = 0; u < 8; ++u) {
            base[(size_t)sidx[u] * 4096] = f2bf(xr); base[(size_t)sidx[u] * 4096 + 64] = f2bf(xi);
            const float nr = ar * xr - ai * xi + er[u], ni = ar * xi + ai * xr + ei[u]; xr = nr; xi = ni;
        }
    }
}
#define S5_ZS 264
__device__ __forceinline__ void ph_s5_3(const int wv_, unsigned char* smem, const Params& p, int layer) {
    PH_IDS();
    const int lane = tid_ & 63, w = tid_ >> 6, l15 = lane & 15, q4 = lane >> 4;
    bf16_t* Z = (bf16_t*)(smem + 1024);
    int* sitem = (int*)(smem + 64);
    for (;;) {
        __syncthreads();
#ifdef EMU
        if (tid_ == 0) sitem[0] = g_emu_q2++;
#else
        if (tid_ == 0) sitem[0] = atomicAdd(p.cnt + 131, 1);
#endif
        __syncthreads();
        const int item = sitem[0];
        if (item >= NB * S5NT) break;
        const int b = item / S5NT, st = item - b * S5NT, s0 = st * 16;
        if (layer == NLAYER - 1 && st == 0) continue;
        __syncthreads();
#pragma unroll 1
        for (int gi = 0; gi < 2; ++gi) {
            const int g = 2 * w + gi;
            bfx8 ua[8], xa[8];
#pragma unroll
            for (int ks = 0; ks < 8; ++ks) {
                ua[ks] = *(const bfx8*)(p.P + ((size_t)b * TJ + 16 * (s0 + l15) + 2 * ks + (q4 >> 1)) * DINP + C_S5U + 16 * g + 8 * (q4 & 1));
                xa[ks] = *(const bfx8*)(p.XS + (((size_t)b * S5NS + s0 + l15) * 16 + g) * 256 + 32 * ks + 8 * q4);
            }
            const bf16_t* sb = p.SB + (size_t)g * 131072;
            const float dsk = p.s5_d[layer * 256 + 16 * g + l15];
#pragma unroll 2
            for (int nt = 0; nt < 16; ++nt) {
                f32x4_ acc = {0.f, 0.f, 0.f, 0.f};
#pragma unroll
                for (int ks = 0; ks < 8; ++ks) acc = MFMA16(ua[ks], *(const bfx8*)(sb + (16 * nt + l15) * 512 + 32 * ks + 8 * q4), acc);
#pragma unroll
                for (int ks = 0; ks < 8; ++ks) acc = MFMA16(xa[ks], *(const bfx8*)(sb + (16 * nt + l15) * 512 + 256 + 32 * ks + 8 * q4), acc);
#pragma unroll
                for (int r = 0; r < 4; ++r) {
                    const int tl = 16 * (4 * q4 + r) + nt;
                    const float u = bf2f(p.P[((size_t)b * TJ + 16 * s0 + tl) * DINP + C_S5U + 16 * g + l15]);
                    Z[tl * S5_ZS + 16 * g + l15] = f2bf(gelu_tanh(acc[r] + dsk * u));
                }
            }
        }
        __syncthreads();
#pragma unroll 1
        for (int m2 = 0; m2 < 2; ++m2) {
            const int mt = 2 * w + m2;
            bfx8 za[8];
#pragma unroll
            for (int ks = 0; ks < 8; ++ks) za[ks] = *(const bfx8*)(Z + (16 * mt + l15) * S5_ZS + 32 * ks + 8 * q4);
#pragma unroll 2
            for (int nt = 0; nt < 16; ++nt) {
                f32x4_ acc = {0.f, 0.f, 0.f, 0.f};
#pragma unroll
                for (int ks = 0; ks < 8; ++ks) acc = MFMA16(za[ks], *(const bfx8*)(p.GLUt + (16 * nt + l15) * 256 + 32 * ks + 8 * q4), acc);
                const int co = 16 * nt + l15; const float gb = p.s5_glu_b[layer * 256 + co];
#pragma unroll
                for (int r = 0; r < 4; ++r) {
                    const int tl = 16 * mt + 4 * q4 + r;
                    const float z = bf2f(Z[tl * S5_ZS + co]);
                    p.Y[((size_t)b * TJ + 16 * s0 + tl) * DM + 256 + co] = f2bf(z * sigmoidf_(acc[r] + gb));
                }
            }
        }
    }
}

__device__ __forceinline__ void ph_scans(const int wv_, unsigned char* smem, const Params& p, int layer) {
    PH_IDS();
    if (bid_ < 32) { dn_chain(smem, p, layer, bid_, tid_); return; }
    if (bid_ < 112) {
        if (bid_ < 96) gla2_scan(p, bid_ - 32, tid_); else s5_2_scan(p, bid_ - 96, tid_);
#ifndef EMU
        asm volatile("s_waitcnt vmcnt(0)" ::: "memory");
        __syncthreads();
        if (tid_ == 0) { __builtin_amdgcn_fence(__ATOMIC_RELEASE, "agent"); asm volatile("s_waitcnt vmcnt(0)" ::: "memory"); (void)xb_add((unsigned*)p.cnt + 129, 1u); }
#endif
    }
}
#ifndef EMU
__device__ __forceinline__ void ph_sub_barrier(const int wv_, const Params& p) {
    PH_IDS();
    const unsigned need = (unsigned)(nblk_ - 32);
    if (bid_ >= 32) { asm volatile("s_waitcnt vmcnt(0)" ::: "memory"); __syncthreads(); }
    if (tid_ == 0) {
        if (bid_ >= 32) { __builtin_amdgcn_fence(__ATOMIC_RELEASE, "agent"); asm volatile("s_waitcnt vmcnt(0)" ::: "memory"); (void)xb_add((unsigned*)p.cnt + 134, 1u); }
        unsigned sp = 0;
        while (xb_ld((unsigned*)p.cnt + 134) < need) { __builtin_amdgcn_s_sleep(2); if (++sp > (1u << 22)) break; }
        __builtin_amdgcn_fence(__ATOMIC_ACQUIRE, "agent");
        asm volatile("s_waitcnt vmcnt(0)" ::: "memory");
    }
    __syncthreads();
}
#endif
#ifndef EMU
__device__ __forceinline__ void ph_wait_scans(const int wv_, const Params& p) {
    PH_IDS();
    if (tid_ == 0) {
        unsigned sp = 0;
        while (xb_ld((unsigned*)p.cnt + 129) < 80u) { __builtin_amdgcn_s_sleep(2); if (++sp > (1u << 22)) break; }
        __builtin_amdgcn_fence(__ATOMIC_ACQUIRE, "agent");
        asm volatile("s_waitcnt vmcnt(0)" ::: "memory");
    }
    __syncthreads();
}
#endif

__device__ __forceinline__ void ph_attn_prep(const int wv_, unsigned char* smem, const Params& p, int layer) {
    PH_IDS();
    float2 (*sCS)[16] = (float2 (*)[16])(smem + 1024);
    bf16_t* sVt = (bf16_t*)(smem + 1024 + 8192);
    unsigned* sMax = (unsigned*)(smem + 64);
    const float qscale = 0.17677669529663687f * 1.4426950408889634f;
    const int vb = bid_ - 32, vn = nblk_ - 32;
    if (vb < 0) return;
    for (int item = vb; item < NB * 132; item += vn) {
        const int b = item / 132, kt = item - b * 132, tau0 = kt * 64; const bool lat = tau0 >= NCTX;
        __syncthreads();
        if (tid_ < 8) sMax[tid_] = 0u;
        for (int idx = tid_; idx < 1024; idx += NTHR) {
            const int tk = idx >> 4, i = idx & 15; float cs = 1.f, sn = 0.f;
            if (lat) { const int t = tau0 + tk - NCTX; const float base = (i < 8) ? (float)(t >> 6) : (float)(t & 63);
                const float inv = exp2f(-(float)(i & 7) * (13.287712379549449f / 8.0f)); sincosf(base * inv, &sn, &cs); }
            sCS[tk][i] = make_float2(cs, sn);
        }
        __syncthreads();
        const int tk = tid_ >> 3, hm = tid_ & 7, h = hm >> 1, m = hm & 1, tau = tau0 + tk, bh = b * 4 + h;
        const size_t r = (size_t)b * TJ + tau;
#pragma unroll
        for (int which = 0; which < 2; ++which) {
            const uint4* src = (const uint4*)(p.P + r * DINP + (which ? C_DAQ : C_DAK) + h * 64 + m * 32);
            uint4 raw[4]; raw[0] = src[0]; raw[1] = src[1]; raw[2] = src[2]; raw[3] = src[3];
            const unsigned* rw = (const unsigned*)raw; float x[32], o[32];
#pragma unroll
            for (int i = 0; i < 16; ++i) { x[2 * i] = __uint_as_float(rw[i] << 16); x[2 * i + 1] = __uint_as_float(rw[i] & 0xffff0000u); }
            float n2 = 0.f; const float sc = which ? qscale : 1.0f;
#pragma unroll
            for (int i = 0; i < 16; ++i) { const float2 c = sCS[tk][i]; o[i] = (x[i] * c.x - x[16 + i] * c.y) * sc; o[16 + i] = (x[i] * c.y + x[16 + i] * c.x) * sc; n2 += o[i] * o[i] + o[16 + i] * o[16 + i]; }
            uint4 w[4]; unsigned* ww = (unsigned*)w;
#pragma unroll
            for (int i = 0; i < 16; ++i) ww[i] = cvt_pk_bf16_(o[2 * i], o[2 * i + 1]);
            uint4* dst = (uint4*)((which ? p.Qr : p.Kr) + ((size_t)bh * TJ + tau) * 64 + m * 32);
            dst[0] = w[0]; dst[1] = w[1]; dst[2] = w[2]; dst[3] = w[3];
            if (which) p.Qn[((size_t)bh * TJ + tau) * 2 + m] = sqrtf(n2);
            else atomicMax(&sMax[hm], __float_as_uint(n2 * 1.02f));
        }
        {
            const uint4* src = (const uint4*)(p.P + r * DINP + C_DAV + h * 64 + m * 32);
            uint4 raw[4]; raw[0] = src[0]; raw[1] = src[1]; raw[2] = src[2]; raw[3] = src[3];
            const bf16_t* rv = (const bf16_t*)raw;
            const int pos = (tk & ~15) | ((tk & 4) << 1) | ((tk & 8) >> 1) | (tk & 3);
#pragma unroll
            for (int i = 0; i < 32; ++i) sVt[(h * 64 + m * 32 + i) * 64 + pos] = rv[i];
        }
        __syncthreads();
        if (tid_ < 8) atomicMax(&p.kmax[(b * 4 + (tid_ >> 1)) * 2 + (tid_ & 1)], sMax[tid_]);
        for (int c = tid_; c < 2048; c += NTHR) {
            const int row = c >> 3, ch = c & 7, hq = row >> 6, dv = row & 63;
            *(uint4*)(p.Vt + ((((size_t)(b * 4 + hq) * 132 + kt) * 64 + dv) * 64 + ch * 8)) = *(const uint4*)(sVt + row * 64 + ch * 8);
        }
    }
}

#ifdef EMU
#define ATT_BAR() __syncthreads()
#define ATT_DMA(g, l) do { *(uint4*)((l) + (tid_ & 63) * 16) = *(const uint4*)(g); } while (0)
#define ATT_DMA_WAIT() do {} while (0)
#define ATT_PIN_P() do {} while (0)
#define ATT_LD_FENCE() do {} while (0)
#define ATT_PIN_S() do {} while (0)
#define ATT_PIN_O() do {} while (0)
#else
#define ATT_DMA(g, l) __builtin_amdgcn_global_load_lds((const unsigned*)(g), (LAS unsigned*)(l), 16, 0, 0)
#define ATT_DMA_WAIT() asm volatile("s_waitcnt vmcnt(0)" ::: "memory")
#define ATT_BAR() do { __builtin_amdgcn_sched_barrier(0); asm volatile("s_waitcnt lgkmcnt(0)" ::: "memory"); __builtin_amdgcn_s_barrier(); asm volatile("" ::: "memory"); __builtin_amdgcn_sched_barrier(0); } while (0)
#define ATT_LD_FENCE() __builtin_amdgcn_sched_barrier(0)
#define ATT_PIN_P() asm volatile("" : "+v"(pf[0][0]), "+v"(pf[0][1]), "+v"(pf[1][0]), "+v"(pf[1][1]), "+v"(l[0]), "+v"(l[1]))
#define ATT_PIN_S() asm volatile("" : "+v"(S[0]), "+v"(S[1]))
#define ATT_PIN_O() asm volatile("" : "+v"(O[0][0]), "+v"(O[0][1]), "+v"(O[1][0]), "+v"(O[1][1]))
#endif
__device__ __forceinline__ void ph_attn(const int wv_, unsigned char* smem, const Params& p, int layer) {
    PH_IDS();
    const int lane = tid_ & 63, w = tid_ >> 6, ql = lane & 31, hh = lane >> 5;
    const int grp = wv_ >> 2;
    unsigned char* sK0 = smem + 1024;
    constexpr int QB = (TJ - NCTX) / 256;
    const int nitem = 16 * QB + (layer < NLAYER - 1 ? 16 : 0);
    const float* lf = p.da_lambda + layer * 128;
    float d01 = 0.f, d23 = 0.f;
    for (int i = 0; i < 32; ++i) { d01 += lf[i] * lf[32 + i]; d23 += lf[64 + i] * lf[96 + i]; }
    const float lam_init = 0.8f - 0.6f * expf(-0.3f * (float)layer);
    const float lam = expf(d01) - expf(d23) + lam_init;
    int* qctr = p.cnt + 128;
    int* sitem = (int*)(smem + 64);
    for (;;) {
        __syncthreads();
        if (tid_ == 0) sitem[0] = atomicAdd(qctr, 1);
        __syncthreads();
        const int item = sitem[0];
        if (item >= nitem) break;
        const int is_ctx = item >= 16 * QB;
        const int bh = is_ctx ? item - 16 * QB : item / QB, b = bh >> 2, h = bh & 3;
        const int qtau = is_ctx ? w * 32 + ql : NCTX + (item % QB) * 256 + w * 32 + ql;
        const int ntile = is_ctx ? 4 : TJ / 64;
        bfx8 qf[2][2];
        const bf16_t* qp = p.Qr + ((size_t)bh * TJ + qtau) * 64 + hh * 8;
#pragma unroll
        for (int m = 0; m < 2; ++m)
#pragma unroll
            for (int ks = 0; ks < 2; ++ks) qf[m][ks] = *(const bfx8*)(qp + m * 32 + ks * 16);
        float negm[2];
#pragma unroll
        for (int m = 0; m < 2; ++m) negm[m] = -p.Qn[((size_t)bh * TJ + qtau) * 2 + m] * sqrtf(__uint_as_float(p.kmax[bh * 2 + m]));
        f32x16 O[2][2];
#pragma unroll
        for (int m = 0; m < 2; ++m)
#pragma unroll
            for (int t = 0; t < 2; ++t)
#pragma unroll
                for (int i = 0; i < 16; ++i) O[m][t][i] = 0.f;
        float l[2] = {0.f, 0.f};
        const int srow = tid_ >> 3, schk = (tid_ & 7) ^ ((tid_ >> 4) & 7);
        const char* kbase = (const char*)(p.Kr + (size_t)bh * TJ * 64) + srow * 128 + schk * 16;
        const char* vbase = (const char*)(p.Vt + (size_t)bh * 132 * 4096) + srow * 128 + schk * 16;
        __syncthreads();
        ATT_DMA(kbase, sK0 + wv_ * 1024); ATT_DMA(vbase, sK0 + 8192 + wv_ * 1024);
        if (ntile > 1) { ATT_DMA(kbase + 8192, sK0 + 16384 + wv_ * 1024); ATT_DMA(vbase + 8192, sK0 + 16384 + 8192 + wv_ * 1024); }
        if (ntile > 2) { ATT_DMA(kbase + 16384, sK0 + 32768 + wv_ * 1024); ATT_DMA(vbase + 16384, sK0 + 32768 + 8192 + wv_ * 1024); }
        ATT_DMA_WAIT();
        __syncthreads();
        if (grp) ATT_BAR();
        f32x16 S[2], NM[2];
        bfx8 pf[2][2];
#pragma unroll
        for (int m = 0; m < 2; ++m)
#pragma unroll
            for (int i = 0; i < 16; ++i) NM[m][i] = negm[m];
#ifndef EMU
        asm volatile("" : "+v"(NM[0]), "+v"(NM[1]));
#endif
#define ATT_LDK(sKp, sb) do { const int key = (sb) * 32 + ql; \
            _Pragma("unroll") for (int m = 0; m < 2; ++m) { _Pragma("unroll") for (int ks = 0; ks < 2; ++ks) { const int c = m * 4 + ks * 2 + hh; \
                kf[m][ks] = *(const bfx8*)((sKp) + key * 128 + ((c ^ ((key >> 1) & 7)) << 4)); } } } while (0)
#define ATT_LDV(sVp, sb) do { \
            _Pragma("unroll") for (int s2 = 0; s2 < 2; ++s2) { _Pragma("unroll") for (int t = 0; t < 2; ++t) { const int dv = t * 32 + ql, c = ((sb) * 2 + s2) * 2 + hh; \
                vf[s2][t] = *(const bfx8*)((sVp) + dv * 128 + ((c ^ ((dv >> 1) & 7)) << 4)); } } } while (0)
#define ATT_QK() do { \
            _Pragma("unroll") for (int m = 0; m < 2; ++m) { \
                S[m] = __builtin_amdgcn_mfma_f32_32x32x16_bf16(kf[m][0], qf[m][0], NM[m], 0, 0, 0); \
                S[m] = __builtin_amdgcn_mfma_f32_32x32x16_bf16(kf[m][1], qf[m][1], S[m], 0, 0, 0); } \
            ATT_PIN_S(); } while (0)
#define ATT_PV() do { \
            _Pragma("unroll") for (int s2 = 0; s2 < 2; ++s2) { _Pragma("unroll") for (int t = 0; t < 2; ++t) { \
                O[0][t] = __builtin_amdgcn_mfma_f32_32x32x16_bf16(vf[s2][t], pf[0][s2], O[0][t], 0, 0, 0); \
                O[1][t] = __builtin_amdgcn_mfma_f32_32x32x16_bf16(vf[s2][t], pf[1][s2], O[1][t], 0, 0, 0); } } \
            ATT_PIN_O(); } while (0)
#define ATT_SOFTMAX() do { \
            _Pragma("unroll") for (int m = 0; m < 2; ++m) { float ls = 0.f; \
                _Pragma("unroll") for (int i = 0; i < 16; ++i) { S[m][i] = __builtin_amdgcn_exp2f(S[m][i]); ls += S[m][i]; } \
                l[m] += ls; \
                _Pragma("unroll") for (int s2 = 0; s2 < 2; ++s2) { unsigned u[4]; \
                    _Pragma("unroll") for (int j = 0; j < 4; ++j) u[j] = cvt_pk_bf16_(S[m][8 * s2 + 2 * j], S[m][8 * s2 + 2 * j + 1]); \
                    pf[m][s2] = *(const bfx8*)u; } } \
            ATT_PIN_P(); } while (0)
        bfx8 kf[2][2], vf[2][2];
        ATT_LDK(sK0, 0);
        ATT_QK();
        ATT_BAR();
        ATT_LDK(sK0, 1); ATT_LDV(sK0 + 8192, 0);
        ATT_LD_FENCE();
        ATT_SOFTMAX();
        ATT_BAR();
        int r0 = 0, r1 = 16384, r2 = 32768;
#pragma unroll 1
        for (int j = 0; j + 1 < ntile; ++j) {
            ATT_QK();
            ATT_PV();
            ATT_BAR();
            ATT_LDK(sK0 + r1, 0); ATT_LDV(sK0 + r0 + 8192, 1);
            ATT_LD_FENCE();
            ATT_SOFTMAX();
            ATT_BAR();
            ATT_QK();
            ATT_PV();
            ATT_BAR();
            ATT_LDK(sK0 + r1, 1); ATT_LDV(sK0 + r1 + 8192, 0);
            ATT_LD_FENCE();
            ATT_SOFTMAX();
            ATT_DMA_WAIT();
            if (j + 3 < ntile) { ATT_DMA(kbase + (size_t)(j + 3) * 8192, sK0 + r0 + wv_ * 1024); ATT_DMA(vbase + (size_t)(j + 3) * 8192, sK0 + r0 + 8192 + wv_ * 1024); }
            ATT_BAR();
            { const int t = r0; r0 = r1; r1 = r2; r2 = t; }
        }
        {
            ATT_QK();
            ATT_PV();
            ATT_BAR();
            ATT_LDV(sK0 + r0 + 8192, 1);
            ATT_LD_FENCE();
            ATT_SOFTMAX();
            ATT_BAR();
            ATT_PV();
            ATT_BAR();
            ATT_BAR();
        }
        if (!grp) ATT_BAR();
#undef ATT_LDK
#undef ATT_LDV
#undef ATT_QK
#undef ATT_PV
#undef ATT_SOFTMAX
        const float l0 = l[0] + __shfl_xor(l[0], 32, 64), l1 = l[1] + __shfl_xor(l[1], 32, 64);
        const float i0 = 1.0f / l0, i1 = lam / l1;
        float ss = 0.f;
#pragma unroll
        for (int t = 0; t < 2; ++t)
#pragma unroll
            for (int i = 0; i < 16; ++i) { const float o = O[0][t][i] * i0 - O[1][t][i] * i1; O[0][t][i] = o; ss += o * o; }
        ss += __shfl_xor(ss, 32, 64);
        const float rs = rsqrtf(ss * (1.0f / 64.0f) + 1e-5f) * (1.0f - lam_init);
        const float* g = p.da_norm_g + layer * 64;
        bf16_t* yo = p.Y + ((size_t)b * TJ + qtau) * DM + 512 + h * 64;
#pragma unroll
        for (int t = 0; t < 2; ++t)
#pragma unroll
            for (int gq = 0; gq < 4; ++gq) {
                const int dv0 = 32 * t + 8 * gq + 4 * hh;
                uint2 w2;
                w2.x = cvt_pk_bf16_(O[0][t][4 * gq] * rs * g[dv0], O[0][t][4 * gq + 1] * rs * g[dv0 + 1]);
                w2.y = cvt_pk_bf16_(O[0][t][4 * gq + 2] * rs * g[dv0 + 2], O[0][t][4 * gq + 3] * rs * g[dv0 + 3]);
                *(uint2*)(yo + dv0) = w2;
            }
    }
}

__device__ __forceinline__ void ph_finish(const int wv_, unsigned char* smem, const Params& p, int layer) {
    PH_IDS();
    const int lane = tid_ & 63, c4 = lane * 4;
    const float4 g = *(const float4*)(p.dn_norm_g + layer * 64 + (c4 & 63));
    for (int r0 = WID * 2; r0 < NTOK; r0 += GWV * 2) {
        if (layer == NLAYER - 1 && (r0 % TJ) < NCTX) continue;
        uint2 ya[2], yb[2], zz[2];
#pragma unroll
        for (int u = 0; u < 2; ++u) { const size_t r = (size_t)(r0 + u);
            ya[u] = *(const uint2*)(p.Y + r * DM + c4); yb[u] = *(const uint2*)(p.ODN + r * 256 + c4); zz[u] = *(const uint2*)(p.P + r * DINP + C_DNZ + c4); }
#pragma unroll
        for (int u = 0; u < 2; ++u) {
            float o0 = __uint_as_float(ya[u].x << 16) + __uint_as_float(yb[u].x << 16), o1 = __uint_as_float(ya[u].x & 0xffff0000u) + __uint_as_float(yb[u].x & 0xffff0000u);
            float o2 = __uint_as_float(ya[u].y << 16) + __uint_as_float(yb[u].y << 16), o3 = __uint_as_float(ya[u].y & 0xffff0000u) + __uint_as_float(yb[u].y & 0xffff0000u);
            float ss = o0 * o0 + o1 * o1 + o2 * o2 + o3 * o3;
            ss += __shfl_xor(ss, 1, 64); ss += __shfl_xor(ss, 2, 64); ss += __shfl_xor(ss, 4, 64); ss += __shfl_xor(ss, 8, 64);
            const float rs = rsqrtf(ss * (1.f / 64.f) + 1e-6f);
            const float z0 = __uint_as_float(zz[u].x << 16), z1 = __uint_as_float(zz[u].x & 0xffff0000u), z2 = __uint_as_float(zz[u].y << 16), z3 = __uint_as_float(zz[u].y & 0xffff0000u);
            uint2 w; w.x = cvt_pk_bf16_(o0 * rs * g.x * siluf_(z0), o1 * rs * g.y * siluf_(z1)); w.y = cvt_pk_bf16_(o2 * rs * g.z * siluf_(z2), o3 * rs * g.w * siluf_(z3));
            *(uint2*)(p.Y + (size_t)(r0 + u) * DM + c4) = w;
        }
    }
}

__device__ __forceinline__ void ph_norm2_route(const int wv_, unsigned char* smem, const Params& p, int layer) {
    PH_IDS();
    int lane = tid_ & 63;
    float* swr = (float*)(smem + 1024);
    int* lcnt = (int*)(smem + 64);
    __syncthreads();
    for (int i = tid_; i < DM * 16; i += NTHR) { const int k = i >> 4, e = i & 15; swr[e * DM + k] = p.w_router[i]; }
    if (tid_ < 16) lcnt[tid_] = 0;
    __syncthreads();
    const int rpb = (NTOK + nblk_ - 1) / nblk_;
    for (int rr = (tid_ >> 6); rr < rpb; rr += NWV) {
        const int r = bid_ * rpb + rr;
        if (r >= NTOK) continue;
        if (layer == NLAYER - 1 && (r % TJ) < NCTX) continue;
        const float* h = hrow(p, r); const float* md = modrow(p, layer, r);
        float f[16]; float ss = 0.f;
#pragma unroll
        for (int i = 0; i < 4; ++i) { float4 v = *(const float4*)(h + i * 256 + lane * 4); f[i * 4] = v.x; f[i * 4 + 1] = v.y; f[i * 4 + 2] = v.z; f[i * 4 + 3] = v.w; ss += v.x * v.x + v.y * v.y + v.z * v.z + v.w * v.w; }
        ss = wave_sum(ss);
        float rs = rsqrtf(ss * (1.0f / DM) + 1e-6f);
        const float* g = p.norm2_g + layer * DM;
        float sc[16];
#pragma unroll
        for (int e = 0; e < 16; ++e) sc[e] = 0.f;
#pragma unroll
        for (int i = 0; i < 4; ++i) {
            int c0 = i * 256 + lane * 4; ushort4 ob; bf16_t* obp = (bf16_t*)&ob;
            float vq[4];
#pragma unroll
            for (int j = 0; j < 4; ++j) { vq[j] = f[i * 4 + j] * rs * g[c0 + j] * (1.f + md[4 * DM + c0 + j]) + md[3 * DM + c0 + j]; obp[j] = f2bf(vq[j]); }
#pragma unroll
            for (int e = 0; e < 16; ++e) { const float4 w = *(const float4*)(swr + e * DM + c0); sc[e] += vq[0] * w.x + vq[1] * w.y + vq[2] * w.z + vq[3] * w.w; }
            *(ushort4*)(p.A + (size_t)r * DM + c0) = ob;
        }
        {
            float t8[8], t4[4], t2[2], t1;
#pragma unroll
            for (int i = 0; i < 8; ++i) { const float keep = (lane & 1) ? sc[i + 8] : sc[i], send = (lane & 1) ? sc[i] : sc[i + 8]; t8[i] = keep + __shfl_xor(send, 1, 64); }
#pragma unroll
            for (int i = 0; i < 4; ++i) { const float keep = (lane & 2) ? t8[i + 4] : t8[i], send = (lane & 2) ? t8[i] : t8[i + 4]; t4[i] = keep + __shfl_xor(send, 2, 64); }
#pragma unroll
            for (int i = 0; i < 2; ++i) { const float keep = (lane & 4) ? t4[i + 2] : t4[i], send = (lane & 4) ? t4[i] : t4[i + 2]; t2[i] = keep + __shfl_xor(send, 4, 64); }
            { const float keep = (lane & 8) ? t2[1] : t2[0], send = (lane & 8) ? t2[0] : t2[1]; t1 = keep + __shfl_xor(send, 8, 64); }
            t1 += __shfl_xor(t1, 16, 64); t1 += __shfl_xor(t1, 32, 64);
#pragma unroll
            for (int e = 0; e < 16; ++e) sc[e] = rdlane(t1, ((e >> 3) & 1) | (((e >> 2) & 1) << 1) | (((e >> 1) & 1) << 2) | ((e & 1) << 3));
        }
        if (lane == 0) {
            float s[16], gb[16];
#pragma unroll
            for (int e = 0; e < 16; ++e) { s[e] = sigmoidf_(sc[e]); gb[e] = s[e] + p.b_router[e]; }
            int best = 0; float bestv = -1e30f;
#pragma unroll
            for (int gI = 0; gI < 4; ++gI) {
                float a0 = -1e30f, a1 = -1e30f;
#pragma unroll
                for (int j = 0; j < 4; ++j) { float v = gb[gI * 4 + j]; if (v > a0) { a1 = a0; a0 = v; } else if (v > a1) a1 = v; }
                float gs = a0 + a1; if (gs > bestv) { bestv = gs; best = gI; }
            }
            int i0 = 0, i1 = 0; float v0 = -1e30f, v1 = -1e30f;
#pragma unroll
            for (int j = 0; j < 4; ++j) {
                float v = 0.f;
#pragma unroll
                for (int gI = 0; gI < 4; ++gI) if (gI == best) v = gb[gI * 4 + j];
                if (v > v0) { v1 = v0; i1 = i0; v0 = v; i0 = j; } else if (v > v1) { v1 = v; i1 = j; }
            }
            int e0 = best * 4 + i0, e1 = best * 4 + i1;
            float w0 = 0.f, w1 = 0.f;
#pragma unroll
            for (int e = 0; e < 16; ++e) { if (e == e0) w0 = s[e]; if (e == e1) w1 = s[e]; }
            float inv = 1.f / (w0 + w1);
            p.tok_e[r * 2] = e0; p.tok_e[r * 2 + 1] = e1; p.tok_w[r * 2] = w0 * inv; p.tok_w[r * 2 + 1] = w1 * inv;
            p.tok_pos[r * 2] = atomicAdd(&lcnt[e0], 1); p.tok_pos[r * 2 + 1] = atomicAdd(&lcnt[e1], 1);
        }
    }
    __syncthreads();
    if (tid_ < 16) p.cnt[1024 + bid_ * 16 + tid_] = atomicAdd(&p.cnt[512 + tid_ * 16], lcnt[tid_]);
}

__device__ __forceinline__ void ph_moe_gather(const int wv_, unsigned char* smem, const Params& p, int layer) {
    PH_IDS();
    int* sstart = (int*)(smem + 64);
    __syncthreads();
    if (tid_ == 0) {
        int acc = 0;
        for (int e = 0; e < 16; ++e) { sstart[e] = acc; acc += (p.cnt[512 + e * 16] + 255) / 256 * 256; if (bid_ == 0) p.cnt[16 + e] = acc; }
        if (bid_ == 0) p.cnt[32] = acc;
    }
    __syncthreads();
    int lane = tid_ & 63;
    const int rpb = (NTOK + nblk_ - 1) / nblk_;
    for (int pr = WID; pr < NTOK * 2; pr += GWV) {
        int r = pr >> 1;
        if (layer == NLAYER - 1 && (r % TJ) < NCTX) continue;
        const int ee = p.tok_e[pr];
        int slot = sstart[ee] + p.cnt[1024 + (r / rpb) * 16 + ee] + p.tok_pos[pr];
        if (lane == 0) p.tok_slot[pr] = slot;
        const uint4* src = (const uint4*)(p.A + (size_t)r * DM); uint4* dst = (uint4*)(p.BUF + (size_t)slot * DM);
        dst[lane] = src[lane]; dst[lane + 64] = src[lane + 64];
    }
}

__device__ __forceinline__ void ph_moe_combine(const int wv_, const Params& p, int layer) {
    PH_IDS();
    int lane = tid_ & 63;
    int rn = WID;
    while (rn < NTOK && layer == NLAYER - 1 && (rn % TJ) < NCTX) rn += GWV;
    int s0n = 0, s1n = 0; float w0n = 0.f, w1n = 0.f;
    if (rn < NTOK) { s0n = p.tok_slot[rn * 2]; s1n = p.tok_slot[rn * 2 + 1]; w0n = p.tok_w[rn * 2]; w1n = p.tok_w[rn * 2 + 1]; }
    while (rn < NTOK) {
        const int r = rn; const int s0 = s0n, s1 = s1n; const float w0 = w0n, w1 = w1n;
        rn += GWV;
        while (rn < NTOK && layer == NLAYER - 1 && (rn % TJ) < NCTX) rn += GWV;
        if (rn < NTOK) { s0n = p.tok_slot[rn * 2]; s1n = p.tok_slot[rn * 2 + 1]; w0n = p.tok_w[rn * 2]; w1n = p.tok_w[rn * 2 + 1]; }
        float* h = hrow(p, r); const float* md = modrow(p, layer, r) + 5 * DM;
        const bf16_t* p0 = p.PO + (size_t)s0 * DM; const bf16_t* p1 = p.PO + (size_t)s1 * DM;
        float v[16]; float ss = 0.f;
#pragma unroll
        for (int i = 0; i < 4; ++i) {
            int c0 = i * 256 + lane * 4;
            float4 hv = *(const float4*)(h + c0); ushort4 a = *(const ushort4*)(p0 + c0), bq = *(const ushort4*)(p1 + c0); float4 m = *(const float4*)(md + c0);
            hv.x += m.x * (w0 * bf2f(a.x) + w1 * bf2f(bq.x)); hv.y += m.y * (w0 * bf2f(a.y) + w1 * bf2f(bq.y));
            hv.z += m.z * (w0 * bf2f(a.z) + w1 * bf2f(bq.z)); hv.w += m.w * (w0 * bf2f(a.w) + w1 * bf2f(bq.w));
            v[i * 4] = hv.x; v[i * 4 + 1] = hv.y; v[i * 4 + 2] = hv.z; v[i * 4 + 3] = hv.w;
            ss += hv.x * hv.x + hv.y * hv.y + hv.z * hv.z + hv.w * hv.w;
        }
        ss = wave_sum(ss); const float rs = rsqrtf(ss * (1.0f / DM) + 1e-6f);
        if (layer == NLAYER - 1) {
#pragma unroll
            for (int i = 0; i < 4; ++i) { int c0 = i * 256 + lane * 4; float4 g = *(const float4*)(p.final_g + c0);
                float4 o; o.x = v[i * 4] * rs * g.x; o.y = v[i * 4 + 1] * rs * g.y; o.z = v[i * 4 + 2] * rs * g.z; o.w = v[i * 4 + 3] * rs * g.w; *(float4*)(h + c0) = o; }
        } else {
            const float* g1 = p.norm1_g + (layer + 1) * DM; const float* mdn = modrow(p, layer + 1, r);
#pragma unroll
            for (int i = 0; i < 4; ++i) { int c0 = i * 256 + lane * 4; float4 o; o.x = v[i * 4]; o.y = v[i * 4 + 1]; o.z = v[i * 4 + 2]; o.w = v[i * 4 + 3]; *(float4*)(h + c0) = o;
                const float4 gg = *(const float4*)(g1 + c0), sh = *(const float4*)(mdn + c0), sc = *(const float4*)(mdn + DM + c0);
                ushort4 ob; ob.x = f2bf(o.x * rs * gg.x * (1.f + sc.x) + sh.x); ob.y = f2bf(o.y * rs * gg.y * (1.f + sc.y) + sh.y); ob.z = f2bf(o.z * rs * gg.z * (1.f + sc.z) + sh.z); ob.w = f2bf(o.w * rs * gg.w * (1.f + sc.w) + sh.w);
                *(ushort4*)(p.A + (size_t)r * DM + c0) = ob; }
        }
    }
}


#ifndef EMU
struct CvtTask { const float* src; bf16_t* dst; int lds, K, N, Nsrc, ldd; };
__device__ __forceinline__ void cvt_tiles(unsigned char* smem, const CvtTask& t, int& base, int tid_, int bid_, int nblk_) {
    float (*sT)[65] = (float (*)[65])(smem + 1024);
    const int nkt = t.K / 64, nnt = t.N / 64, ntile = nkt * nnt;
    int first = (bid_ - base % nblk_ + nblk_) % nblk_;
    for (int it = first; it < ntile; it += nblk_) {
        const int kt = it % nkt, ntl = it / nkt, k0 = kt * 64, n0 = ntl * 64;
        __syncthreads();
#pragma unroll
        for (int j = 0; j < 2; ++j) {
            int k = (tid_ >> 4) + 32 * j, n4 = (tid_ & 15) * 4;
            float4 v = make_float4(0.f, 0.f, 0.f, 0.f);
            if (n0 + n4 < t.Nsrc) v = *(const float4*)(t.src + (size_t)(k0 + k) * t.lds + n0 + n4);
            sT[k][n4] = v.x; sT[k][n4 + 1] = v.y; sT[k][n4 + 2] = v.z; sT[k][n4 + 3] = v.w;
        }
        __syncthreads();
        {
            int n = tid_ >> 3, k8 = (tid_ & 7) * 8;
            ushort4 a, b;
            a.x = f2bf(sT[k8 + 0][n]); a.y = f2bf(sT[k8 + 1][n]); a.z = f2bf(sT[k8 + 2][n]); a.w = f2bf(sT[k8 + 3][n]);
            b.x = f2bf(sT[k8 + 4][n]); b.y = f2bf(sT[k8 + 5][n]); b.z = f2bf(sT[k8 + 6][n]); b.w = f2bf(sT[k8 + 7][n]);
            bf16_t* d = t.dst + (size_t)(n0 + n) * t.ldd + k0 + k8;
            *(ushort4*)d = a; *(ushort4*)(d + 4) = b;
        }
    }
    base += ntile;
}
__device__ __forceinline__ void ph_convert(const int wv_, unsigned char* smem, const Params& p, int layer) {
    PH_IDS();
    int base = 0;
    cvt_tiles(smem, CvtTask{p.w_in + (size_t)layer * DM * DIN, p.WinT, DIN, DM, DINP, DIN, DM}, base, tid_, bid_, nblk_);
}
__device__ __forceinline__ void convert_merge_vb(unsigned char* smem, const Params& p, int layer, const int bid_, const int nblk_, const int tid_) {
    int base = 0;
    cvt_tiles(smem, CvtTask{p.w_gate + (size_t)layer * DM * 4096, p.WgT, 4096, DM, 4096, 4096, DM}, base, tid_, bid_, nblk_);
    for (int i = 0; i < 4; ++i)
        cvt_tiles(smem, CvtTask{p.w_branch + ((size_t)layer * 4 + i) * 256 * DM, p.WbrT + i * 256, DM, 256, DM, DM, DM}, base, tid_, bid_, nblk_);
    cvt_tiles(smem, CvtTask{p.w_out + (size_t)layer * DM * DM, p.WoT, DM, DM, DM, DM, DM}, base, tid_, bid_, nblk_);
}
__device__ __forceinline__ void ph_convert_experts(const int wv_, unsigned char* smem, const Params& p, int layer) {
    PH_IDS();
    int base = 0;
    for (int e = 0; e < NEXP; ++e) {
        for (int u = 0; u < 4; ++u) {
            cvt_tiles(smem, CvtTask{p.w_e_gate + ((size_t)layer * NEXP + e) * DM * DEXP + u * 128, p.WguT + ((size_t)e * 1024 + u * 256) * DM, DEXP, DM, 128, 128, DM}, base, tid_, bid_, nblk_);
            cvt_tiles(smem, CvtTask{p.w_e_up + ((size_t)layer * NEXP + e) * DM * DEXP + u * 128, p.WguT + ((size_t)e * 1024 + u * 256 + 128) * DM, DEXP, DM, 128, 128, DM}, base, tid_, bid_, nblk_);
        }
        cvt_tiles(smem, CvtTask{p.w_e_down + ((size_t)layer * NEXP + e) * DEXP * DM, p.WdT + (size_t)e * DM * DEXP, DM, DEXP, DM, DM, DEXP}, base, tid_, bid_, nblk_);
    }
}

namespace pg8 {
#define PG8_LAS __attribute__((address_space(3)))
typedef short bf16x8 __attribute__((ext_vector_type(8)));
typedef float f32x4 __attribute__((ext_vector_type(4)));
typedef unsigned u32x4 __attribute__((ext_vector_type(4)));
constexpr int BM = 256, BK = 64, HALF = 128, HTB = HALF * BK * 2, STAGE_BYTES = 8 * HTB, NXCD = 8, WGM = 8;
__host__ __device__ __forceinline__ int lds_byte(int r, int c) { const int st = (r >> 4) * 2 + (c >> 5), rr = r & 15, cc = c & 31, ob = rr * 64 + cc * 2; return st * 1024 + (ob ^ (((ob >> 9) & 1) << 5)); }
__host__ __device__ __forceinline__ void stage_rc(int b, int& R, int& C) { const int st = b / 1024, sb = b % 1024, swz = sb ^ (((sb >> 9) & 1) << 5); R = (st >> 1) * 16 + swz / 64; C = (st & 1) * 32 + (swz % 64) / 2; }
__host__ __device__ __forceinline__ int perm32(int rho) { const int n = rho >> 4, i = rho & 15; return 8 * (i >> 2) + 4 * n + (i & 3); }
struct Unit { int pm, pn, nt, kind; const char* a; const char* b; };
__device__ __forceinline__ void static_map(int L, int nM, int nN, int& pm, int& pn) {
    const int nwg = nM * nN; int wgid = L; { const int q = nwg / NXCD, r = nwg % NXCD, xcd = wgid % NXCD, off = wgid / NXCD; wgid = (xcd < r ? xcd * (q + 1) : r * (q + 1) + (xcd - r) * q) + off; }
    const int nig = WGM * nN, gid = wgid / nig, fm = gid * WGM, gsz = (nM - fm) < WGM ? (nM - fm) : WGM;
    pm = fm + ((wgid % nig) % gsz); pn = (wgid % nig) / gsz;
}
__device__ __forceinline__ unsigned cvt_pk_bf16(float lo, float hi) { return cvt_pk_bf16_(lo, hi); }

template <class Epi, class Sched>
__device__ __forceinline__ void gemm_phase(PG8_LAS unsigned char* lds, const int lda, const int ldb, const Sched& S, const Epi& E, int tid) {
    asm volatile("" : "+v"(tid));
    const int wid = __builtin_amdgcn_readfirstlane(tid >> 6), lane = tid & 63, wr = wid >> 2, wc = wid & 3, fr = lane & 15, fq = lane >> 4;
    unsigned voffA[2], voffB[2];
#pragma unroll
    for (int i = 0; i < 2; ++i) { int R, C; stage_rc(tid * 16 + i * 8192, R, C); const int Rb = Epi::PERM ? ((R & ~31) + perm32(R & 31)) : R;
        voffA[i] = (unsigned)(R * lda + C) * 2u; voffB[i] = (unsigned)(Rb * ldb + C) * 2u; }
    const size_t kstep = (size_t)(BK * 2);
    const size_t hstepA = (size_t)HALF * lda * 2, hstepB = (size_t)HALF * ldb * 2;
    const unsigned ldsw = (unsigned)wid * 1024u;
    const int aoff = lds_byte(wr * 64 + fr, fq * 8), boff = lds_byte(wc * 32 + fr, fq * 8);
#define PG8_SA(b, h) (((b) * 2 + (h)) * HTB)
#define PG8_SB(b, h) ((4 + (b) * 2 + (h)) * HTB)
#define PG8_STAGE(bufoff, gbase, voff) do { _Pragma("unroll") for (int _i = 0; _i < 2; ++_i) \
        __builtin_amdgcn_global_load_lds((const unsigned*)((const char*)(gbase) + (voff)[_i]), (PG8_LAS unsigned*)(lds + (bufoff) + ldsw + _i * 8192), 16, 0, 0); } while (0)
#define PG8_LDA(dst, b, h) do { _Pragma("unroll") for (int m = 0; m < 4; ++m) _Pragma("unroll") for (int k = 0; k < 2; ++k) dst[m][k] = *(const PG8_LAS bf16x8*)(lds + PG8_SA(b, h) + aoff + m * 2048 + k * 1024); } while (0)
#define PG8_LDB(dst, b, h) do { _Pragma("unroll") for (int n = 0; n < 2; ++n) _Pragma("unroll") for (int k = 0; k < 2; ++k) dst[n][k] = *(const PG8_LAS bf16x8*)(lds + PG8_SB(b, h) + boff + n * 2048 + k * 1024); } while (0)
#define PG8_MMA(ai, bj, At, Bt) do { __builtin_amdgcn_s_setprio(1); _Pragma("unroll") for (int m = 0; m < 4; ++m) _Pragma("unroll") for (int n = 0; n < 2; ++n) _Pragma("unroll") for (int k = 0; k < 2; ++k) \
        acc[ai][bj][m][n] = __builtin_amdgcn_mfma_f32_16x16x32_bf16(Bt[n][k], At[m][k], acc[ai][bj][m][n], 0, 0, 0); __builtin_amdgcn_s_setprio(0); } while (0)
#define PG8_WAIT_V(n) asm volatile("s_waitcnt vmcnt(" #n ")" ::: "memory")
#define PG8_WAIT_L(n) asm volatile("s_waitcnt lgkmcnt(" #n ")" ::: "memory")
#define PG8_BAR __builtin_amdgcn_s_barrier()
#define PG8_SCHED __builtin_amdgcn_sched_barrier(0)
    Unit cur, nxt; int ui = 0;
    if (!S.next(0, cur)) return;
    f32x4 acc[2][2][4][2];
#pragma unroll
    for (int a = 0; a < 2; ++a)
#pragma unroll
        for (int b = 0; b < 2; ++b)
#pragma unroll
            for (int m = 0; m < 4; ++m)
#pragma unroll
                for (int n = 0; n < 2; ++n) acc[a][b][m][n] = (f32x4){0.f, 0.f, 0.f, 0.f};
    bf16x8 At[4][2], B0[2][2], B1[2][2];
    const char* cA = cur.a; const char* cB = cur.b;
    PG8_STAGE(PG8_SB(0, 0), cB, voffB); PG8_STAGE(PG8_SA(0, 0), cA, voffA); PG8_STAGE(PG8_SB(0, 1), cB + hstepB, voffB); PG8_STAGE(PG8_SA(0, 1), cA + hstepA, voffA);
    if (wr == 1) PG8_BAR;
    PG8_WAIT_V(4); PG8_BAR;
    PG8_STAGE(PG8_SB(1, 0), cB + kstep, voffB); PG8_STAGE(PG8_SA(1, 0), cA + kstep, voffA); PG8_STAGE(PG8_SB(1, 1), cB + hstepB + kstep, voffB);
    PG8_WAIT_V(6); PG8_BAR;
    for (;;) {
        const bool has_next = S.next(ui + 1, nxt);
        const char* nA = has_next ? nxt.a : cA; const char* nB = has_next ? nxt.b : cB;
        const int nt = cur.nt;
        for (int t = 0; t < nt; t += 2) {
            const bool last = (t == nt - 2);
            const char* a1 = cA + (size_t)(t + 1) * kstep;
            const char* a2 = last ? nA : cA + (size_t)(t + 2) * kstep; const char* b2 = last ? nB : cB + (size_t)(t + 2) * kstep;
            const char* a3 = a2 + kstep; const char* b3 = b2 + kstep;
            PG8_LDB(B0, 0, 0); PG8_SCHED; PG8_LDA(At, 0, 0); PG8_STAGE(PG8_SA(1, 1), a1 + hstepA, voffA);
            PG8_WAIT_L(8); PG8_BAR; PG8_WAIT_L(0); PG8_MMA(0, 0, At, B0); PG8_BAR; PG8_SCHED;
            PG8_LDB(B1, 0, 1); PG8_STAGE(PG8_SB(0, 0), b2, voffB);
            PG8_BAR; PG8_WAIT_L(0); PG8_MMA(0, 1, At, B1); PG8_BAR;
            PG8_LDA(At, 0, 1); PG8_STAGE(PG8_SA(0, 0), a2, voffA);
            PG8_BAR; PG8_WAIT_L(0); PG8_MMA(1, 0, At, B0); PG8_BAR; PG8_SCHED;
            PG8_STAGE(PG8_SB(0, 1), b2 + hstepB, voffB);
            PG8_WAIT_V(6); PG8_BAR; PG8_MMA(1, 1, At, B1); PG8_BAR;
            PG8_LDB(B0, 1, 0); PG8_SCHED; PG8_LDA(At, 1, 0); PG8_STAGE(PG8_SA(0, 1), a2 + hstepA, voffA);
            PG8_WAIT_L(8); PG8_BAR; PG8_WAIT_L(0); PG8_MMA(0, 0, At, B0); PG8_BAR; PG8_SCHED;
            PG8_LDB(B1, 1, 1); PG8_STAGE(PG8_SB(1, 0), b3, voffB);
            PG8_BAR; PG8_WAIT_L(0); PG8_MMA(0, 1, At, B1); PG8_BAR;
            PG8_LDA(At, 1, 1); PG8_STAGE(PG8_SA(1, 0), a3, voffA);
            PG8_BAR; PG8_WAIT_L(0); PG8_MMA(1, 0, At, B0); PG8_BAR; PG8_SCHED;
            PG8_STAGE(PG8_SB(1, 1), b3 + hstepB, voffB);
            PG8_WAIT_V(6); PG8_BAR; PG8_MMA(1, 1, At, B1); PG8_BAR;
        }
        E(acc, cur, wr, wc, fr, fq, tid);
        if (!has_next) break;
#pragma unroll
        for (int a = 0; a < 2; ++a)
#pragma unroll
            for (int b = 0; b < 2; ++b)
#pragma unroll
                for (int m = 0; m < 4; ++m)
#pragma unroll
                    for (int n = 0; n < 2; ++n) acc[a][b][m][n] = (f32x4){0.f, 0.f, 0.f, 0.f};
        cur = nxt; cA = nA; cB = nB; ++ui;
    }
    PG8_WAIT_V(0);
    if (wr == 0) PG8_BAR;
    PG8_BAR;
#undef PG8_SA
#undef PG8_SB
#undef PG8_STAGE
#undef PG8_LDA
#undef PG8_LDB
#undef PG8_MMA
#undef PG8_WAIT_V
#undef PG8_WAIT_L
#undef PG8_BAR
#undef PG8_SCHED
}

struct SchedRows {
    const char* A; const char* Bt; int lda, ldb, nt, nN, nM, skip_ctx, G, c;
    __device__ __forceinline__ bool next(int i, Unit& u) const {
        const int L = i * G + c; if (L >= nM * nN) return false;
        int pmi, pn; static_map(L, nM, nN, pmi, pn);
        const int pm = skip_ctx ? (pmi >> 5) * 33 + 1 + (pmi & 31) : pmi;
        u.pm = pm; u.pn = pn; u.nt = nt; u.kind = 0;
        u.a = A + (size_t)pm * 256 * lda * 2; u.b = Bt + (size_t)pn * 256 * ldb * 2; return true;
    }
};
struct SchedMerge {
    const char* A; const char* Y; const char* WgT; const char* WbrT; int with_ctx, G, c;
    __device__ __forceinline__ bool next(int i, Unit& u) const {
        const int nlat = (NB * 32 * 4) / G;
        if (i < nlat * 8) {
            const int ch = (i >> 3) * G + c, sub = i & 7;
            int pmi, pn; static_map(ch, NB * 32, 4, pmi, pn);
            const int pm = (pmi >> 5) * 33 + 1 + (pmi & 31), br = sub >> 1;
            u.pm = pm; u.pn = pn; u.kind = sub;
            if (sub & 1) { u.nt = 4;  u.a = Y + ((size_t)pm * 256 * DM + br * 256) * 2; u.b = WbrT + ((size_t)pn * 256 * DM + br * 256) * 2; }
            else         { u.nt = 16; u.a = A + (size_t)pm * 256 * DM * 2;              u.b = WgT + ((size_t)br * DM + pn * 256) * DM * 2; }
            return true;
        }
        const int j = i - nlat * 8;
        if (!with_ctx || c >= 64 || j >= 2) return false;
        const int tile = c >> 2, br = c & 3, pm = (tile >> 2) * 33, pn = tile & 3;
        u.pm = pm; u.pn = pn; u.kind = 16 + (br << 1) + j;
        if (j) { u.nt = 4;  u.a = Y + ((size_t)pm * 256 * DM + br * 256) * 2; u.b = WbrT + ((size_t)pn * 256 * DM + br * 256) * 2; }
        else   { u.nt = 16; u.a = A + (size_t)pm * 256 * DM * 2;              u.b = WgT + ((size_t)br * DM + pn * 256) * DM * 2; }
        return true;
    }
};
struct SchedMoe {
    const char* A; const char* Bt; const int* pe  ; int lda, ldb, nt, nN, G, c;
    __device__ __forceinline__ bool next(int i, Unit& u) const {
        const int nM = pe[16] >> 8; const int L = i * G + c; if (L >= nM * nN) return false;
        int pm, pn; static_map(L, nM, nN, pm, pn);
        int e = 0;
#pragma unroll
        for (int j = 0; j < 16; ++j) e += (pe[j] <= pm * 256) ? 1 : 0;
        if (e > 15) e = 15;
        u.pm = pm; u.pn = pn; u.nt = nt; u.kind = e;
        u.a = A + (size_t)pm * 256 * lda * 2; u.b = Bt + ((size_t)e * nN + pn) * 256 * ldb * 2; return true;
    }
};

struct EpiBf16 {
    static constexpr bool PERM = true;
    bf16_t* O; int ldc;
    __device__ __forceinline__ void operator()(const f32x4 (&acc)[2][2][4][2], const Unit& u, int wr, int wc, int fr, int fq, int tid) const {
        const int row0 = u.pm * BM + wr * 64 + fr, col0 = u.pn * BM + wc * 32 + 8 * fq;
#pragma unroll
        for (int ai = 0; ai < 2; ++ai)
#pragma unroll
            for (int m = 0; m < 4; ++m) { bf16_t* rowp = O + (size_t)(row0 + ai * HALF + m * 16) * ldc + col0;
#pragma unroll
                for (int bj = 0; bj < 2; ++bj) { const f32x4 v0 = acc[ai][bj][m][0], v1 = acc[ai][bj][m][1];
                    u32x4 w; w.x = cvt_pk_bf16(v0[0], v0[1]); w.y = cvt_pk_bf16(v0[2], v0[3]); w.z = cvt_pk_bf16(v1[0], v1[1]); w.w = cvt_pk_bf16(v1[2], v1[3]);
                    *(u32x4*)(rowp + bj * HALF) = w; } }
    }
};
struct EpiResidual {
    static constexpr bool PERM = false;
    float* hctx; float* out; const float* mod; int layer, modoff;
    __device__ __forceinline__ void operator()(const f32x4 (&acc)[2][2][4][2], const Unit& u, int wr, int wc, int fr, int fq, int tid) const {
        const int row0 = u.pm * BM + wr * 64 + fr, col0 = u.pn * BM + wc * 32 + 4 * fq;
        const int b = (u.pm * BM) / TJ; const bool isctx = (u.pm * BM - b * TJ) < NCTX;
        const float* md = mod + ((size_t)layer * 5 + (isctx ? 4 : b)) * (6 * DM) + modoff * DM + col0;
        f32x4 mv[2][2];
#pragma unroll
        for (int bj = 0; bj < 2; ++bj)
#pragma unroll
            for (int n = 0; n < 2; ++n) mv[bj][n] = *(const f32x4*)(md + bj * HALF + n * 16);
#pragma unroll
        for (int ai = 0; ai < 2; ++ai)
#pragma unroll
            for (int m = 0; m < 4; ++m) {
                const int r = row0 + ai * HALF + m * 16, tau = r - b * TJ;
                float* rowp = (isctx ? hctx + ((size_t)b * NCTX + tau) * DM : out + ((size_t)b * SEQ + (tau - NCTX)) * DM) + col0;
#pragma unroll
                for (int bj = 0; bj < 2; ++bj)
#pragma unroll
                    for (int n = 0; n < 2; ++n) { f32x4* q = (f32x4*)(rowp + bj * HALF + n * 16); *q = *q + mv[bj][n] * acc[ai][bj][m][n]; }
            }
    }
};
struct EpiMerge {
    static constexpr bool PERM = true;
    bf16_t* T; bf16_t* stash  ; const float* bgate; bf16_t* TP;
    __device__ __forceinline__ void operator()(const f32x4 (&acc)[2][2][4][2], const Unit& u, int wr, int wc, int fr, int fq, int tid) const {
        const bool part = u.kind >= 16;
        const int br = (u.kind & 15) >> 1;
        asm volatile("" : "+v"(tid));
        const unsigned soff = (unsigned)tid * 16u;
        if ((u.kind & 1) == 0) {
            const float* bg = bgate + br * DM + u.pn * BM + wc * 32 + 8 * fq;
            f32x4 bv[2][2];
#pragma unroll
            for (int bj = 0; bj < 2; ++bj)
#pragma unroll
                for (int n = 0; n < 2; ++n) bv[bj][n] = *(const f32x4*)(bg + bj * HALF + 4 * n);
#pragma unroll
            for (int ai = 0; ai < 2; ++ai)
#pragma unroll
                for (int m = 0; m < 4; ++m)
#pragma unroll
                    for (int bj = 0; bj < 2; ++bj) { f32x4 v0 = acc[ai][bj][m][0] + bv[bj][0], v1 = acc[ai][bj][m][1] + bv[bj][1];
#pragma unroll
                        for (int j = 0; j < 4; ++j) { v0[j] = sigmoidf_(v0[j]); v1[j] = sigmoidf_(v1[j]); }
                        u32x4 w; w.x = cvt_pk_bf16(v0[0], v0[1]); w.y = cvt_pk_bf16(v0[2], v0[3]); w.z = cvt_pk_bf16(v1[0], v1[1]); w.w = cvt_pk_bf16(v1[2], v1[3]);
                        *(u32x4*)((char*)stash + (soff + (unsigned)(((ai * 4 + m) * 2 + bj) * NTHR * 16))) = w; }
        } else {
            const int row0 = (part ? (u.pm / 33) * BM : u.pm * BM) + wr * 64 + fr, col0 = u.pn * BM + wc * 32 + 8 * fq;
            bf16_t* Tb = part ? TP + (size_t)br * (NB * NCTX) * DM : T;
#pragma unroll
            for (int ai = 0; ai < 2; ++ai)
#pragma unroll
                for (int m = 0; m < 4; ++m) { bf16_t* rowp = Tb + (size_t)(row0 + ai * HALF + m * 16) * DM + col0;
#pragma unroll
                    for (int bj = 0; bj < 2; ++bj) {
                        const u32x4 g = *(const u32x4*)((const char*)stash + (soff + (unsigned)(((ai * 4 + m) * 2 + bj) * NTHR * 16)));
                        f32x4 v0 = acc[ai][bj][m][0], v1 = acc[ai][bj][m][1];
                        v0[0] *= __uint_as_float(g.x << 16); v0[1] *= __uint_as_float(g.x & 0xffff0000u); v0[2] *= __uint_as_float(g.y << 16); v0[3] *= __uint_as_float(g.y & 0xffff0000u);
                        v1[0] *= __uint_as_float(g.z << 16); v1[1] *= __uint_as_float(g.z & 0xffff0000u); v1[2] *= __uint_as_float(g.w << 16); v1[3] *= __uint_as_float(g.w & 0xffff0000u);
                        if (br > 0 && !part) { const u32x4 o = *(const u32x4*)(rowp + bj * HALF);
                            v0[0] += __uint_as_float(o.x << 16); v0[1] += __uint_as_float(o.x & 0xffff0000u); v0[2] += __uint_as_float(o.y << 16); v0[3] += __uint_as_float(o.y & 0xffff0000u);
                            v1[0] += __uint_as_float(o.z << 16); v1[1] += __uint_as_float(o.z & 0xffff0000u); v1[2] += __uint_as_float(o.w << 16); v1[3] += __uint_as_float(o.w & 0xffff0000u); }
                        u32x4 w; w.x = cvt_pk_bf16(v0[0], v0[1]); w.y = cvt_pk_bf16(v0[2], v0[3]); w.z = cvt_pk_bf16(v1[0], v1[1]); w.w = cvt_pk_bf16(v1[2], v1[3]);
                        *(u32x4*)(rowp + bj * HALF) = w; } }
        }
    }
};
struct EpiSwiGlu {
    static constexpr bool PERM = true;
    bf16_t* H;
    __device__ __forceinline__ void operator()(const f32x4 (&acc)[2][2][4][2], const Unit& u, int wr, int wc, int fr, int fq, int tid) const {
        const int row0 = u.pm * BM + wr * 64 + fr, col0 = u.pn * HALF + wc * 32 + 8 * fq;
#pragma unroll
        for (int ai = 0; ai < 2; ++ai)
#pragma unroll
            for (int m = 0; m < 4; ++m) {
                f32x4 v0 = acc[ai][0][m][0], v1 = acc[ai][0][m][1]; const f32x4 u0 = acc[ai][1][m][0], u1 = acc[ai][1][m][1];
#pragma unroll
                for (int j = 0; j < 4; ++j) { v0[j] = siluf_(v0[j]) * u0[j]; v1[j] = siluf_(v1[j]) * u1[j]; }
                u32x4 w; w.x = cvt_pk_bf16(v0[0], v0[1]); w.y = cvt_pk_bf16(v0[2], v0[3]); w.z = cvt_pk_bf16(v1[0], v1[1]); w.w = cvt_pk_bf16(v1[2], v1[3]);
                *(u32x4*)(H + (size_t)(row0 + ai * HALF + m * 16) * DEXP + col0) = w;
            }
    }
};
}

#define STAGE_OFF 1024
__device__ __forceinline__ void ph_gemm_inproj(const int wv_, unsigned char* smem, const Params& p) {
    PH_IDS();
    pg8::SchedRows S{(const char*)p.A, (const char*)p.WinT, DM, DM, DM / 64, DINP / 256, NTOK / 256, 0, nblk_, bid_};
    pg8::gemm_phase((PG8_LAS unsigned char*)(smem + STAGE_OFF), DM, DM, S, pg8::EpiBf16{p.P, DINP}, tid_);
}
__device__ __forceinline__ void ph_gemm_merge(const int wv_, unsigned char* smem, const Params& p, int layer, int last) {
    PH_IDS();
    pg8::SchedMerge S{(const char*)p.A, (const char*)p.Y, (const char*)p.WgT, (const char*)p.WbrT, !last, nblk_, bid_};
    pg8::gemm_phase((PG8_LAS unsigned char*)(smem + STAGE_OFF), DM, DM, S, pg8::EpiMerge{p.T, p.STASH + (size_t)bid_ * 65536, p.b_gate + layer * 4096, p.TP}, tid_);
}
__device__ __forceinline__ void ph_ctx_sum(const int wv_, const Params& p) {
    PH_IDS();
    for (int idx = bid_ * NTHR + tid_; idx < NB * NCTX * DM / 8; idx += nblk_ * NTHR) {
        const int row = idx / (DM / 8), c8 = (idx - row * (DM / 8)) * 8, b = row / NCTX, t = row - b * NCTX;
        float a[8];
#pragma unroll
        for (int e = 0; e < 8; ++e) a[e] = 0.f;
#pragma unroll
        for (int br = 0; br < 4; ++br) {
            const uint4 v = *(const uint4*)(p.TP + ((size_t)br * (NB * NCTX) + row) * DM + c8); const unsigned vv[4] = {v.x, v.y, v.z, v.w};
#pragma unroll
            for (int e = 0; e < 4; ++e) { a[2 * e] += __uint_as_float(vv[e] << 16); a[2 * e + 1] += __uint_as_float(vv[e] & 0xffff0000u); }
        }
        uint4 o; o.x = cvt_pk_bf16_(a[0], a[1]); o.y = cvt_pk_bf16_(a[2], a[3]); o.z = cvt_pk_bf16_(a[4], a[5]); o.w = cvt_pk_bf16_(a[6], a[7]);
        *(uint4*)(p.T + ((size_t)b * TJ + t) * DM + c8) = o;
    }
}
__device__ __forceinline__ void ph_gemm_wout(const int wv_, unsigned char* smem, const Params& p, int layer, int last) {
    PH_IDS();
    pg8::SchedRows S{(const char*)p.T, (const char*)p.WoT, DM, DM, DM / 64, DM / 256, last ? NB * 32 : NTOK / 256, last, nblk_, bid_};
    pg8::gemm_phase((PG8_LAS unsigned char*)(smem + STAGE_OFF), DM, DM, S, pg8::EpiResidual{p.hctx, p.out, p.mod, layer, 2}, tid_);
}
__device__ __forceinline__ void moe_pad_to_lds(unsigned char* smem, const Params& p, int tid_) {
    __syncthreads();
    if (tid_ < 17) ((int*)(smem + 64))[tid_] = p.cnt[16 + tid_];
    __syncthreads();
}
__device__ __forceinline__ void ph_gemm_moe_up(const int wv_, unsigned char* smem, const Params& p) {
    PH_IDS();
    moe_pad_to_lds(smem, p, tid_);
    pg8::SchedMoe S{(const char*)p.BUF, (const char*)p.WguT, (const int*)(smem + 64), DM, DM, DM / 64, 4, nblk_, bid_};
    pg8::gemm_phase((PG8_LAS unsigned char*)(smem + STAGE_OFF), DM, DM, S, pg8::EpiSwiGlu{p.HID}, tid_);
}
__device__ __forceinline__ void ph_gemm_moe_down(const int wv_, unsigned char* smem, const Params& p) {
    PH_IDS();
    moe_pad_to_lds(smem, p, tid_);
    pg8::SchedMoe S{(const char*)p.HID, (const char*)p.WdT, (const int*)(smem + 64), DEXP, DEXP, DEXP / 64, 4, nblk_, bid_};
    pg8::gemm_phase((PG8_LAS unsigned char*)(smem + STAGE_OFF), DEXP, DEXP, S, pg8::EpiBf16{p.PO, DM}, tid_);
}

__device__ __forceinline__ void ph_tail_work(const int wv_, unsigned char* smem, const Params& p, int layer) {
    PH_IDS();
    int* sitem = (int*)(smem + 64);
    for (;;) {
        __syncthreads();
        if (tid_ == 0) sitem[0] = atomicAdd(p.cnt + 133, 1);
        __syncthreads();
        const int item = sitem[0];
        if (item >= 80 + 256) break;
        if (item < 80) s5_prep_item(smem, p, layer, item, tid_);
        else convert_merge_vb(smem, p, layer, item - 80, 256, tid_);
    }
}

#define LDS_BYTES (152 * 1024)
typedef const __attribute__((address_space(4))) unsigned long long* KArgPtr;
__device__ __forceinline__ Params ldparams() {
    KArgPtr q = (KArgPtr)__builtin_amdgcn_kernarg_segment_ptr(); asm volatile("" : "+s"(q));
    Params r; unsigned long long* d = (unsigned long long*)&r;
#pragma unroll
    for (int i = 0; i < (int)(sizeof(Params) / 8); ++i) d[i] = q[i];
    return r;
}
#define PHASE(call) do { const Params p = ldparams(); call; } while (0)
#ifndef PROBE_T
#define PROBE_T 0
#endif
#if PROBE_T
#define TMARK(id) do { if ((id) == PROBE_T && blockIdx.x == 0 && threadIdx.x == 0) *(unsigned long long*)(smem + 96) = __builtin_amdgcn_s_memrealtime(); } while (0)
#define TSTOP(id) do { if ((id) == PROBE_T && blockIdx.x == 0 && threadIdx.x == 0) *(unsigned long long*)(smem + 104) += __builtin_amdgcn_s_memrealtime() - *(unsigned long long*)(smem + 96); } while (0)
#else
#define TMARK(id) do {} while (0)
#define TSTOP(id) do {} while (0)
#endif

#define GRID_SYNC() do { int t0_ = wv * 64 + (int)__builtin_amdgcn_mbcnt_hi(~0u, __builtin_amdgcn_mbcnt_lo(~0u, 0u)); asm volatile("" : "+v"(t0_)); \
    XcdBarrier b_; b_.bar = ldparams().bar; b_.x = xb_xcc_id(); b_.st = (volatile LAS unsigned*)smem; xcd_barrier_(b_, t0_); } while (0)
__device__ __forceinline__ void layer_body(const int l, const int wv, unsigned char* smem) {
    const int last = (l == NLAYER - 1);
    if (l == 0) {
        TMARK(2);
        PHASE(ph_norm1(wv, p, l));
        GRID_SYNC(); TSTOP(2);
    }
    TMARK(3);
    PHASE(ph_gemm_inproj(wv, smem, p));
    PHASE(ph_tail_work(wv, smem, p, l));
    GRID_SYNC(); TSTOP(3);
    TMARK(4);
    PHASE(ph_dn_prep(wv, smem, p, l));
    GRID_SYNC(); TSTOP(4);
    TMARK(5);
    PHASE(ph_attn_prep(wv, smem, p, l));
    PHASE(ph_gla1(wv, smem, p, l));
    PHASE(ph_s5_1(wv, p, l));
    if (blockIdx.x >= 32) { PHASE(ph_sub_barrier(wv, p)); }
    PHASE(ph_scans(wv, smem, p, l));
    if (blockIdx.x < 32) { PHASE(ph_sub_barrier(wv, p)); }
    PHASE(ph_attn(wv, smem, p, l));
    PHASE(ph_wait_scans(wv, p));
    PHASE(ph_s5_3(wv, smem, p, l));
    PHASE(ph_gla3(wv, smem, p, l));
    GRID_SYNC(); TSTOP(5);
    TMARK(6);
    PHASE(ph_finish(wv, smem, p, l));
    GRID_SYNC(); TSTOP(6);
    TMARK(7);
    PHASE(ph_gemm_merge(wv, smem, p, l, last));
    GRID_SYNC();
    if (!last) { PHASE(ph_ctx_sum(wv, p)); GRID_SYNC(); }
    TSTOP(7);
    TMARK(8);
    PHASE(ph_gemm_wout(wv, smem, p, l, last));
    GRID_SYNC(); TSTOP(8);
    TMARK(9);
    PHASE(ph_convert_experts(wv, smem, p, l));
    PHASE(ph_norm2_route(wv, smem, p, l));
    GRID_SYNC(); TSTOP(9);
    TMARK(10);
    PHASE(ph_moe_gather(wv, smem, p, l));
    GRID_SYNC(); TSTOP(10);
    TMARK(11);
    PHASE(ph_gemm_moe_up(wv, smem, p));
    GRID_SYNC(); TSTOP(11);
    TMARK(12);
    PHASE(ph_gemm_moe_down(wv, smem, p));
    GRID_SYNC(); TSTOP(12);
    TMARK(13);
    PHASE(ph_moe_combine(wv, p, l));
    if (!last) { PHASE(ph_zero_counters(wv, p)); PHASE(ph_convert(wv, smem, p, l + 1)); }
    GRID_SYNC(); TSTOP(13);
}
__global__ __launch_bounds__(NTHR, 2) void k_mega(Params p_unused) {
    extern __shared__ __attribute__((aligned(16))) unsigned char smem[];
    int wv = __builtin_amdgcn_readfirstlane(threadIdx.x >> 6); asm volatile("" : "+s"(wv));
    if (threadIdx.x == 0) *(uint4*)smem = make_uint4(0u, 0u, 0u, 0u);
    __syncthreads();
    (void)xcd_barrier_post(ldparams().bar, (volatile LAS unsigned*)smem);
#if PROBE_T
    if (threadIdx.x == 0) *(unsigned long long*)(smem + 104) = 0ull;
#endif
    TMARK(1);
    PHASE(ph_mod(wv, smem, p));
    PHASE(ph_convert(wv, smem, p, 0));
    GRID_SYNC(); TSTOP(1);
    static_assert(NLAYER == 2, "layers are instantiated explicitly");
    layer_body(0, wv, smem);
    layer_body(1, wv, smem);
#if PROBE_T
    if (blockIdx.x == 0 && threadIdx.x == 0) {
        const unsigned long long acc = *(unsigned long long*)(smem + 104), t0 = __builtin_amdgcn_s_memrealtime();
        while (__builtin_amdgcn_s_memrealtime() - t0 < 4ull * acc) __builtin_amdgcn_s_sleep(8);
    }
#endif
}

static inline size_t al(size_t x) { return (x + 255) & ~(size_t)255; }

extern "C" void kernel_launch(void* const* d_in, const int* in_sizes, int n_in, void* d_out, int out_size, void* d_ws, size_t ws_size, hipStream_t stream) {
    Params p{};
    const float** ins = (const float**)d_in;
    p.x = ins[0]; p.c = ins[1]; p.ctx = ins[2]; p.c_ctx = ins[3]; p.w_mod = ins[4]; p.b_mod = ins[5]; p.norm1_g = ins[6]; p.norm2_g = ins[7]; p.w_in = ins[8];
    p.dn_conv = ins[9]; p.dn_a_log = ins[10]; p.dn_dt_bias = ins[11]; p.dn_norm_g = ins[12];
    p.s5_a_re = ins[13]; p.s5_a_im = ins[14]; p.s5_log_dt = ins[15]; p.s5_b_re = ins[16]; p.s5_b_im = ins[17]; p.s5_c_re = ins[18]; p.s5_c_im = ins[19]; p.s5_d = ins[20]; p.s5_glu_w = ins[21]; p.s5_glu_b = ins[22];
    p.da_lambda = ins[23]; p.da_norm_g = ins[24]; p.gla_w_gate = ins[25]; p.gla_b_gate = ins[26]; p.gla_norm_g = ins[27];
    p.w_branch = ins[28]; p.w_gate = ins[29]; p.b_gate = ins[30]; p.w_out = ins[31]; p.w_router = ins[32]; p.b_router = ins[33];
    p.w_e_gate = ins[34]; p.w_e_up = ins[35]; p.w_e_down = ins[36]; p.final_g = ins[37];
    p.out = (float*)d_out;
    char* ws = (char*)d_ws; size_t off = 0;
    auto take = [&](size_t bytes) { char* q = ws + off; off += al(bytes); return q; };
    p.bar = (unsigned*)take((size_t)XCD_BAR_WORDS * 4);
    p.cnt = (int*)take(8192 * 4);
    p.kmax = (unsigned*)take(256);
    p.mod = (float*)take((size_t)NLAYER * 5 * 6 * DM * 4);
    p.hctx = (float*)take((size_t)NB * NCTX * DM * 4);
    p.tok_e = (int*)take((size_t)NTOK * 2 * 4); p.tok_w = (float*)take((size_t)NTOK * 2 * 4); p.tok_pos = (int*)take((size_t)NTOK * 2 * 4); p.tok_slot = (int*)take((size_t)NTOK * 2 * 4);
    p.WinT = (bf16_t*)take((size_t)DINP * DM * 2); p.WgT = (bf16_t*)take((size_t)4096 * DM * 2); p.WbrT = (bf16_t*)take((size_t)DM * DM * 2); p.WoT = (bf16_t*)take((size_t)DM * DM * 2);
    p.SB = (bf16_t*)take((size_t)16 * 256 * 512 * 2); p.SE = (bf16_t*)take((size_t)16 * 256 * 256 * 2); p.GLUt = (bf16_t*)take((size_t)65536 * 2); p.A16 = (float*)take((size_t)2 * 16 * 64 * 2 * 4);
    p.A = (bf16_t*)take((size_t)NTOK * DM * 2);
    p.Y = (bf16_t*)take((size_t)NTOK * DM * 2);
    char* big = ws + off;
    p.P = (bf16_t*)take((size_t)NTOK * DINP * 2);
    char* ms = ws + off;
    p.WguT = (bf16_t*)(ms + ((size_t)16 << 20)); p.WdT = (bf16_t*)(ms + ((size_t)16 << 20) + (size_t)NEXP * 1024 * DM * 2);
    p.Qr = (bf16_t*)take((size_t)16 * TJ * 64 * 2); p.Kr = (bf16_t*)take((size_t)16 * TJ * 64 * 2); p.Vt = (bf16_t*)take((size_t)16 * 132 * 4096 * 2); p.Qn = (float*)take((size_t)16 * TJ * 2 * 4);
    p.ODN = (bf16_t*)take((size_t)NTOK * 256 * 2);
    p.QKVN = (bf16_t*)take((size_t)NTOK * 768 * 2);
    p.XS = (bf16_t*)take((size_t)NB * S5NS * 16 * 256 * 2);
    p.GST = (bf16_t*)take((size_t)32 * (TJ / 64) * 2048 * 2); p.DCY = (float*)take((size_t)32 * (TJ / 64) * 32 * 4);
    p.T = (bf16_t*)big;
    p.STASH = (bf16_t*)(big + al((size_t)NTOK * DM * 2));
    p.TP = (bf16_t*)(big + al((size_t)NTOK * DM * 2) + al((size_t)256 * 65536 * 2));
    p.BUF = (bf16_t*)big; p.PO = (bf16_t*)big;
    p.HID = (bf16_t*)(big + al((size_t)MAXSLOT * DM * 2));
    if (off > ws_size) return;

    static int grid = 0;
    if (!grid) {
        int dev = 0, cus = 0, per_cu = 0;
        (void)hipGetDevice(&dev);
        (void)hipDeviceGetAttribute(&cus, hipDeviceAttributeMultiprocessorCount, dev);
        (void)hipFuncSetAttribute((const void*)k_mega, hipFuncAttributeMaxDynamicSharedMemorySize, LDS_BYTES);
        (void)hipOccupancyMaxActiveBlocksPerMultiprocessor(&per_cu, (const void*)k_mega, NTHR, LDS_BYTES);
        grid = per_cu >= 1 ? cus : 0;
    }
    if (!grid) return;
    (void)hipMemsetAsync(p.bar, 0, (size_t)XCD_BAR_WORDS * 4, stream);
    k_mega<<<grid, NTHR, LDS_BYTES, stream>>>(p);
}

#endif
```

```cpp
#ifndef EMU
#include <hip/hip_runtime.h>
#include <stdint.h>
#define OPQV(x) asm volatile("" : "+v"(x))
#define OPQS(x) asm volatile("" : "+s"(x))
#define WAVE_LDS_FENCE() asm volatile("s_waitcnt lgkmcnt(0)" ::: "memory")
#endif

typedef unsigned short bf16_t;

#define DM 1024
#define NB 4
#ifndef SEQ
#define SEQ 8192
#endif
#define NCTX 256
#define TJ (SEQ + NCTX)
#define NTOK (NB * TJ)
#define DIN 2864
#define DINP 3072
#define NEXP 16
#define DEXP 512
#define NLAYER 2
#define C_DNQ 0
#define C_DNK 256
#define C_DNV 512
#define C_DNZ 768
#define C_DNA 1024
#define C_DNB 1032
#define C_S5U 1040
#define C_DAQ 1296
#define C_DAK 1552
#define C_DAV 1808
#define C_GLQ 2064
#define C_GLK 2192
#define C_GLV 2320
#define C_GLR 2576
#define C_GLG 2832

#define MAXSLOT (2 * NTOK + NEXP * 256)

__device__ __forceinline__ float bf2f(bf16_t v) { return __uint_as_float(((unsigned)v) << 16); }
__device__ __forceinline__ bf16_t f2bf(float f) { unsigned u = __float_as_uint(f); u += 0x7FFFu + ((u >> 16) & 1u); return (bf16_t)(u >> 16); }
#ifdef EMU
__device__ __forceinline__ float frcp_(float x) { return 1.0f / x; }
#else
__device__ __forceinline__ float frcp_(float x) { return __builtin_amdgcn_rcpf(x); }
#endif
__device__ __forceinline__ float sigmoidf_(float x) { return frcp_(1.0f + __expf(-x)); }
__device__ __forceinline__ float siluf_(float x) { return x * frcp_(1.0f + __expf(-x)); }
__device__ __forceinline__ float softplusf_(float x) { return x > 20.f ? x : log1pf(expf(x)); }
__device__ __forceinline__ float logsigmoidf_(float x) { return fminf(x, 0.f) - __logf(1.0f + __expf(-fabsf(x))); }
__device__ __forceinline__ float gelu_tanh(float x) { const float k = 0.7978845608028654f; float u = k * (x + 0.044715f * x * x * x); return x * frcp_(1.0f + __expf(-2.0f * u)); }
__device__ __forceinline__ float wave_sum(float v) {
#pragma unroll
    for (int o = 32; o >= 1; o >>= 1) v += __shfl_xor(v, o, 64);
    return v;
}
__device__ __forceinline__ float rdlane(float v, int l) { return __int_as_float(__builtin_amdgcn_readlane(__float_as_int(v), l)); }

typedef float f32x16 __attribute__((ext_vector_type(16)));
#ifndef EMU
typedef __bf16 bfx8 __attribute__((ext_vector_type(8)));
typedef __bf16 bf16x2_t_ __attribute__((ext_vector_type(2)));
typedef float f32x2_t_ __attribute__((ext_vector_type(2)));
__device__ __forceinline__ unsigned cvt_pk_bf16_(float lo, float hi) { f32x2_t_ f = {lo, hi}; bf16x2_t_ b = __builtin_convertvector(f, bf16x2_t_); return *(unsigned*)&b; }
#endif

struct Params {
    const float *x, *c, *ctx, *c_ctx, *w_mod, *b_mod, *norm1_g, *norm2_g, *w_in, *dn_conv, *dn_a_log, *dn_dt_bias, *dn_norm_g;
    const float *s5_a_re, *s5_a_im, *s5_log_dt, *s5_b_re, *s5_b_im, *s5_c_re, *s5_c_im, *s5_d, *s5_glu_w, *s5_glu_b;
    const float *da_lambda, *da_norm_g, *gla_w_gate, *gla_b_gate, *gla_norm_g, *w_branch, *w_gate, *b_gate, *w_out;
    const float *w_router, *b_router, *w_e_gate, *w_e_up, *w_e_down, *final_g;
    float* out;
    float* mod;
    float* hctx;
    bf16_t* A;
    bf16_t* P;
    bf16_t* Y;
    bf16_t* Qr;
    bf16_t* Kr;
    bf16_t* Vt;
    float* Qn;
    unsigned* kmax;
    bf16_t* QKVN;
    bf16_t* ODN;
    bf16_t* OS5;
    bf16_t* XS;
    bf16_t* SB;
    bf16_t* SE;
    bf16_t* GLUt;
    float* A16;
    bf16_t* OGLA;
    bf16_t* GST;
    float* DCY;
    bf16_t* T;
    bf16_t* TP;
    bf16_t* STASH;
    bf16_t *WinT, *WgT, *WbrT, *WoT, *WguT, *WdT;
    bf16_t* BUF;
    bf16_t* HID;
    bf16_t* PO;
    unsigned* bar;
    int* cnt;
    int* tok_e;
    float* tok_w;
    int* tok_pos;
    int* tok_slot;
};

__device__ __forceinline__ float* hrow(const Params& p, int r) {
    int b = r / TJ, tau = r - b * TJ;
    return tau < NCTX ? p.hctx + ((size_t)b * NCTX + tau) * DM : p.out + ((size_t)b * SEQ + (tau - NCTX)) * DM;
}
__device__ __forceinline__ const float* modrow(const Params& p, int layer, int r) {
    int b = r / TJ, tau = r - b * TJ;
    return p.mod + ((size_t)layer * 5 + (tau < NCTX ? 4 : b)) * (6 * DM);
}


#ifndef EMU
#define XB_TMO      128
#define XB_XCNT(j)  (256  + 64 * (j))
#define XB_XSUB(j)  (1280 + 64 * (j))
#define XB_XGEN(j)  (2304 + 64 * (j))
#define XB_TOP      3328
#define XB_TOPGEN   3392
#define XCD_BAR_WORDS 3456
#define XB_SPIN_CAP (1u << 18)
#define LAS __attribute__((address_space(3)))
__device__ __forceinline__ unsigned xb_ld(unsigned* p)              { return __hip_atomic_load(p, __ATOMIC_RELAXED, __HIP_MEMORY_SCOPE_AGENT); }
__device__ __forceinline__ unsigned xb_add(unsigned* p, unsigned v) { return __hip_atomic_fetch_add(p, v, __ATOMIC_RELAXED, __HIP_MEMORY_SCOPE_AGENT); }
__device__ __forceinline__ unsigned xb_xcc_id() { return (unsigned)__builtin_amdgcn_s_getreg((3 << 11) | 20) & 0xFu; }
#define XB_SPIN(cond, bar) do { unsigned _sp = 0; while (cond) { __builtin_amdgcn_s_sleep(1); \
    if ((++_sp & 255u) == 0u) { if (xb_ld(&(bar)[XB_TMO])) break; if (_sp > XB_SPIN_CAP) { atomicAdd(&(bar)[XB_TMO], 1u); break; } } } } while (0)
struct XcdBarrier { unsigned* bar; unsigned x; volatile LAS unsigned* st; };
__device__ __forceinline__ XcdBarrier xcd_barrier_post(unsigned* bar, volatile LAS unsigned* st) {
    XcdBarrier b; b.bar = bar; b.x = xb_xcc_id(); b.st = st;
    if (threadIdx.x == 0) (void)xb_add(&bar[XB_XCNT(b.x)], 1u);
    return b;
}
__device__ __forceinline__ void xcd_barrier_complete(unsigned* bar, unsigned x, unsigned& nloc, unsigned& nx) {
    const unsigned G = gridDim.x * gridDim.y * gridDim.z;
    unsigned sum, cnt, mine, sp = 0u;
    for (;;) {
        sum = 0u; cnt = 0u; mine = 0u;
#pragma unroll
        for (unsigned j = 0; j < 16; ++j) { const unsigned c = xb_ld(&bar[XB_XCNT(j)]); sum += c; cnt += (c > 0u) ? 1u : 0u; mine = (j == x) ? c : mine; }
        if (sum == G) break;
        __builtin_amdgcn_s_sleep(1);
        if ((++sp & 255u) == 0u) { if (xb_ld(&bar[XB_TMO])) break; if (sp > XB_SPIN_CAP) { atomicAdd(&bar[XB_TMO], 1u); break; } }
    }
    nloc = mine > 0u ? mine : 1u; nx = cnt > 0u ? cnt : 1u;
}
__device__ __forceinline__ void xcd_barrier_(const XcdBarrier& b, const int tid0) {
    asm volatile("s_waitcnt vmcnt(0)" ::: "memory");
    __syncthreads();
    if (tid0 == 0) {
        unsigned* bar = b.bar;
        __builtin_amdgcn_s_waitcnt(0);
        unsigned nloc = b.st[0], nx = b.st[1];
        if (nloc == 0u) { xcd_barrier_complete(bar, b.x, nloc, nx); b.st[0] = nloc; b.st[1] = nx; }
        const unsigned old = xb_add(&bar[XB_XSUB(b.x)], 1u);
        const unsigned gen = old / nloc;
        if (old + 1u == (gen + 1u) * nloc) {
            __builtin_amdgcn_fence(__ATOMIC_RELEASE, "agent");
            asm volatile("s_waitcnt vmcnt(0)" ::: "memory");
            const unsigned og = xb_add(&bar[XB_TOP], 1u);
            const unsigned tg = og / nx;
            if (og + 1u == (tg + 1u) * nx) xb_add(&bar[XB_TOPGEN], 1u);
            else XB_SPIN(xb_ld(&bar[XB_TOPGEN]) == tg, bar);
            __builtin_amdgcn_fence(__ATOMIC_ACQUIRE, "agent");
            xb_add(&bar[XB_XGEN(b.x)], 1u);
            asm volatile("s_waitcnt vmcnt(0)" ::: "memory");
        } else {
            XB_SPIN(xb_ld(&bar[XB_XGEN(b.x)]) == gen, bar);
            __builtin_amdgcn_fence(__ATOMIC_ACQUIRE, "agent");
            asm volatile("s_waitcnt vmcnt(0)" ::: "memory");
        }
    }
    __syncthreads();
}

#endif
#ifndef PROBE_DUP
#define PROBE_DUP 0
#endif
#define NTHR 512
#define NWV 8
#define PH_IDS() int tid_ = wv_ * 64 + (int)__builtin_amdgcn_mbcnt_hi(~0u, __builtin_amdgcn_mbcnt_lo(~0u, 0u)); OPQV(tid_); int bid_ = blockIdx.x; OPQS(bid_); int nblk_ = gridDim.x; OPQS(nblk_); (void)tid_; (void)bid_; (void)nblk_
#define GWV (nblk_ * NWV)
#define WID (bid_ * NWV + (tid_ >> 6))

__device__ __forceinline__ void ph_mod(const int wv_, unsigned char* smem, const Params& p) {
    PH_IDS();
    float* sc = (float*)(smem + 1024);
    float* part = sc + 5 * DM;
    for (int i = tid_; i < 5 * DM; i += NTHR) { const int v = i >> 10, k = i & (DM - 1); sc[i] = siluf_(v < 4 ? p.c[v * DM + k] : p.c_ctx[k]); }
    __syncthreads();
    const int ksl = tid_ >> 6, cl = tid_ & 63;
    for (int item = bid_; item < NLAYER * 6 * DM / 64; item += nblk_) {
        const int l = item / (6 * DM / 64), col = (item - l * (6 * DM / 64)) * 64 + cl;
        const float* w = p.w_mod + (size_t)l * DM * 6 * DM + (size_t)ksl * 128 * 6 * DM + col;
        float a0 = 0.f, a1 = 0.f, a2 = 0.f, a3 = 0.f, a4 = 0.f;
#pragma unroll 8
        for (int k = 0; k < 128; ++k) { const float wv2 = w[(size_t)k * 6 * DM]; const int kk = ksl * 128 + k; a0 += sc[kk] * wv2; a1 += sc[DM + kk] * wv2; a2 += sc[2 * DM + kk] * wv2; a3 += sc[3 * DM + kk] * wv2; a4 += sc[4 * DM + kk] * wv2; }
        __syncthreads();
        part[(ksl * 5 + 0) * 64 + cl] = a0; part[(ksl * 5 + 1) * 64 + cl] = a1; part[(ksl * 5 + 2) * 64 + cl] = a2; part[(ksl * 5 + 3) * 64 + cl] = a3; part[(ksl * 5 + 4) * 64 + cl] = a4;
        __syncthreads();
        if (tid_ < 320) { const int v = tid_ >> 6; float acc = p.b_mod[l * 6 * DM + col];
#pragma unroll
            for (int q = 0; q < 8; ++q) acc += part[(q * 5 + v) * 64 + cl];
            p.mod[((size_t)l * 5 + v) * 6 * DM + col] = acc; }
    }
}

__device__ __forceinline__ void ph_zero_counters(const int wv_, const Params& p) {
    PH_IDS();
    if (bid_ == 0 && tid_ < 64) { p.cnt[tid_] = 0; if (tid_ < 32) p.kmax[tid_] = 0u; p.cnt[128 + tid_] = 0; p.cnt[192 + tid_] = 0; p.cnt[512 + tid_] = 0; p.cnt[576 + tid_] = 0; p.cnt[640 + tid_] = 0; p.cnt[704 + tid_] = 0; }
}
__device__ __forceinline__ void ph_norm1(const int wv_, const Params& p, int layer) {
    PH_IDS();
    int lane = tid_ & 63;
    if (bid_ == 0 && tid_ < 64) { p.cnt[tid_] = 0; if (tid_ < 32) p.kmax[tid_] = 0u; p.cnt[128 + tid_] = 0; p.cnt[192 + tid_] = 0; p.cnt[512 + tid_] = 0; p.cnt[576 + tid_] = 0; p.cnt[640 + tid_] = 0; p.cnt[704 + tid_] = 0; }
    for (int r = WID; r < NTOK; r += GWV) {
        int b = r / TJ, tau = r - b * TJ;
        float* h = hrow(p, r);
        const float* src = h;
        if (layer == 0) src = tau < NCTX ? p.ctx + ((size_t)b * NCTX + tau) * DM : p.x + ((size_t)b * SEQ + (tau - NCTX)) * DM;
        const float* md = modrow(p, layer, r);
        float4 v[4]; float ss = 0.f;
#pragma unroll
        for (int i = 0; i < 4; ++i) { v[i] = *(const float4*)(src + i * 256 + lane * 4); ss += v[i].x * v[i].x + v[i].y * v[i].y + v[i].z * v[i].z + v[i].w * v[i].w; }
        ss = wave_sum(ss);
        float rs = rsqrtf(ss * (1.0f / DM) + 1e-6f);
        const float* g = p.norm1_g + layer * DM;
#pragma unroll
        for (int i = 0; i < 4; ++i) {
            int c0 = i * 256 + lane * 4;
            float4 gg = *(const float4*)(g + c0), sh = *(const float4*)(md + c0), sc = *(const float4*)(md + DM + c0);
            float o0 = v[i].x * rs * gg.x * (1.f + sc.x) + sh.x, o1 = v[i].y * rs * gg.y * (1.f + sc.y) + sh.y;
            float o2 = v[i].z * rs * gg.z * (1.f + sc.z) + sh.z, o3 = v[i].w * rs * gg.w * (1.f + sc.w) + sh.w;
            ushort4 ob; ob.x = f2bf(o0); ob.y = f2bf(o1); ob.z = f2bf(o2); ob.w = f2bf(o3);
            *(ushort4*)(p.A + (size_t)r * DM + c0) = ob;
        }
    }
}

struct EpiStoreBf16 { bf16_t* C; int ldc; __device__ void operator()(int r, int c, float v) const { C[(size_t)r * ldc + c] = f2bf(v); } };
struct EpiSigmoidBias { bf16_t* C; const float* bias; int ldc; __device__ void operator()(int r, int c, float v) const { C[(size_t)r * ldc + c] = f2bf(sigmoidf_(v + bias[c])); } };
struct EpiGateAcc { bf16_t* T; const bf16_t* G; int i; __device__ void operator()(int r, int c, float v) const {
    float g = bf2f(G[(size_t)r * 4096 + i * DM + c]); float t = g * v; if (i > 0) t += bf2f(T[(size_t)r * DM + c]); T[(size_t)r * DM + c] = f2bf(t); } };
struct EpiResid { float* hctx; float* out; const float* mod; int layer; int modoff; __device__ void operator()(int r, int c, float v) const {
    int b = r / TJ, tau = r - b * TJ;
    float* h = tau < NCTX ? hctx + ((size_t)b * NCTX + tau) * DM : out + ((size_t)b * SEQ + (tau - NCTX)) * DM;
    const float* md = mod + ((size_t)layer * 5 + (tau < NCTX ? 4 : b)) * (6 * DM);
    h[c] += md[modoff * DM + c] * v; } };
struct EpiSiluMul { bf16_t* H; __device__ void operator()(int r, int c, float v) const { float g = bf2f(H[(size_t)r * DEXP + c]); H[(size_t)r * DEXP + c] = f2bf(siluf_(g) * v); } };

template <class Epi>
__device__ __forceinline__ void ph_gemm_naive(const int wv_, unsigned char* smem, const bf16_t* A, int lda, const float* W0, int ldw, int M, int N, int K, const Epi& epi, const int* grp, size_t wstride, int skip_ctx) {
    PH_IDS();
    const int half = tid_ >> 8, tid = tid_ & 255, tx = tid & 15, ty = tid >> 4;
    float (*sA)[68] = (float (*)[68])(smem + 64 + half * 8704);
    float (*sB)[68] = (float (*)[68])(smem + 64 + half * 8704 + 4352);
    const int ntn = (N + 63) / 64, ntiles = (M / 64) * ntn;
    for (int t0 = bid_ * 2; t0 < ntiles; t0 += nblk_ * 2) {
        const int t = t0 + half;
        bool active = t < ntiles;
        int bm = active ? (t / ntn) * 64 : 0, bn = active ? (t % ntn) * 64 : 0;
        const float* W = W0;
        if (grp && active) {
            if (bm >= grp[32]) active = false;
            int e = 0;
            for (int i = 0; i < 16; ++i) e += (grp[16 + i] <= bm) ? 1 : 0;
            if (e > 15) e = 15;
            W += (size_t)e * wstride;
        }
        if (skip_ctx && (bm % TJ) < NCTX) active = false;
        float acc[4][4] = {};
        for (int k0 = 0; k0 < K; k0 += 16) {
            if (active) {
                int r = tid >> 2, kk = (tid & 3) * 4;
                ushort4 a = *(const ushort4*)(A + (size_t)(bm + r) * lda + k0 + kk);
                sA[kk + 0][r] = bf2f(a.x); sA[kk + 1][r] = bf2f(a.y); sA[kk + 2][r] = bf2f(a.z); sA[kk + 3][r] = bf2f(a.w);
                int kr = tid >> 4, cc = (tid & 15) * 4;
#pragma unroll
                for (int j = 0; j < 4; ++j) { int col = bn + cc + j; sB[kr][cc + j] = col < N ? W[(size_t)(k0 + kr) * ldw + col] : 0.f; }
            }
            __syncthreads();
            if (active) {
#pragma unroll
                for (int kk = 0; kk < 16; ++kk) {
                    float a[4], b[4];
#pragma unroll
                    for (int i = 0; i < 4; ++i) { a[i] = sA[kk][ty * 4 + i]; b[i] = sB[kk][tx * 4 + i]; }
#pragma unroll
                    for (int i = 0; i < 4; ++i)
#pragma unroll
                        for (int j = 0; j < 4; ++j) acc[i][j] += a[i] * b[j];
                }
            }
            __syncthreads();
        }
        if (active) {
#pragma unroll
            for (int i = 0; i < 4; ++i)
#pragma unroll
                for (int j = 0; j < 4; ++j) { int col = bn + tx * 4 + j; if (col < N) epi(bm + ty * 4 + i, col, acc[i][j]); }
        }
    }
}

__device__ __forceinline__ int pos2tau(int d, int pos) { return d == 0 ? pos : (pos < NCTX ? NCTX - 1 - pos : (TJ + NCTX - 1) - pos); }

__device__ __forceinline__ void dn_load_raw(const Params& p, int b, int tau, int h, int lane, float (&q)[5], float (&k)[5], float (&v)[5]) {
    const int lo = tau < NCTX ? 0 : NCTX, hi = tau < NCTX ? NCTX : TJ;
#pragma unroll
    for (int j = 0; j < 5; ++j) {
        const int t2 = tau + j - 2; const bool ok = t2 >= lo && t2 < hi;
        const bf16_t* pr = p.P + ((size_t)b * TJ + (ok ? t2 : tau)) * DINP + h * 64 + lane;
        q[j] = ok ? bf2f(pr[0]) : 0.f; k[j] = ok ? bf2f(pr[256]) : 0.f; v[j] = ok ? bf2f(pr[512]) : 0.f;
    }
}
__device__ __forceinline__ void dn_chain_naive(const Params& p, int layer, int chain, int lane) {
    int b = chain >> 3, h = (chain >> 1) & 3, d = chain & 1;
    float S[64];
#pragma unroll
    for (int i = 0; i < 64; ++i) S[i] = 0.f;
    const float nalog = -expf(p.dn_a_log[layer * 8 + d * 4 + h]), dtb = p.dn_dt_bias[layer * 8 + d * 4 + h];
    float cq[5], ck[5], cv[5];
#pragma unroll
    for (int j = 0; j < 5; ++j) { const float* cw = p.dn_conv + ((size_t)layer * 5 + j) * 768 + h * 64 + lane; cq[j] = cw[0]; ck[j] = cw[256]; cv[j] = cw[512]; }
    bf16_t* O = d == 0 ? p.Y : p.ODN; const int ldo = d == 0 ? DM : 256;
    int tau = pos2tau(d, 0);
    size_t r = (size_t)b * TJ + tau;
    float a_n = bf2f(p.P[r * DINP + C_DNA + d * 4 + h]), b_n = bf2f(p.P[r * DINP + C_DNB + d * 4 + h]);
    float qn[5], kn[5], vn[5];
    dn_load_raw(p, b, tau, h, lane, qn, kn, vn);
    for (int pos = 0; pos < TJ; ++pos) {
        float a_in = a_n, b_in = b_n; size_t rc = r;
        float qa = 0.f, ka = 0.f, va = 0.f;
#pragma unroll
        for (int j = 0; j < 5; ++j) { qa += qn[j] * cq[j]; ka += kn[j] * ck[j]; va += vn[j] * cv[j]; }
        if (pos + 1 < TJ) {
            tau = pos2tau(d, pos + 1); r = (size_t)b * TJ + tau;
            a_n = bf2f(p.P[r * DINP + C_DNA + d * 4 + h]); b_n = bf2f(p.P[r * DINP + C_DNB + d * 4 + h]);
            dn_load_raw(p, b, tau, h, lane, qn, kn, vn);
        }
        float qv = siluf_(qa), kv = siluf_(ka), vv = siluf_(va);
        qv *= rsqrtf(wave_sum(qv * qv) + 1e-6f); kv *= rsqrtf(wave_sum(kv * kv) + 1e-6f);
        float decay = expf(nalog * softplusf_(a_in + dtb)), beta = sigmoidf_(b_in);
        float kS = 0.f;
#pragma unroll
        for (int i = 0; i < 64; ++i) { S[i] *= decay; kS += rdlane(kv, i) * S[i]; }
        float vnew = beta * (vv - kS), o = 0.f;
#pragma unroll
        for (int i = 0; i < 64; ++i) { S[i] += rdlane(kv, i) * vnew; o += rdlane(qv, i) * S[i]; }
        O[rc * ldo + h * 64 + lane] = f2bf(o * 0.125f);
    }
}

__device__ __forceinline__ void s5_chain_naive(const Params& p, int layer, int chain, int lane) {
    int b = chain >> 5, g = (chain >> 1) & 15, d = chain & 1;
    float lre = p.s5_a_re[((layer * 2 + d) * 16 + g) * 64 + lane], lim = p.s5_a_im[((layer * 2 + d) * 16 + g) * 64 + lane];
    float dt = expf(p.s5_log_dt[(layer * 2 + d) * 16 + g]);
    float mag = expf(lre * dt), are = mag * cosf(lim * dt), aim = mag * sinf(lim * dt);
    float den = lre * lre + lim * lim;
    float fre = ((are - 1.f) * lre + aim * lim) / den, fim = (aim * lre - (are - 1.f) * lim) / den;
    float bbr[16], bbi[16], cr[16], ci[16];
#pragma unroll
    for (int c = 0; c < 16; ++c) {
        float br = p.s5_b_re[((layer * 16 + g) * 64 + lane) * 16 + c], bi = p.s5_b_im[((layer * 16 + g) * 64 + lane) * 16 + c];
        bbr[c] = fre * br - fim * bi; bbi[c] = fre * bi + fim * br;
        cr[c] = p.s5_c_re[(((layer * 2 + d) * 16 + g) * 16 + c) * 64 + lane]; ci[c] = p.s5_c_im[(((layer * 2 + d) * 16 + g) * 16 + c) * 64 + lane];
    }
    bf16_t* O = d == 0 ? p.Y + 256 : p.OS5; const int ldo = d == 0 ? DM : 256;
    float xr = 0.f, xi = 0.f;
    size_t r = (size_t)b * TJ + pos2tau(d, 0);
    float u_n = bf2f(p.P[r * DINP + C_S5U + g * 16 + (lane & 15)]);
    for (int pos = 0; pos < TJ; ++pos) {
        float u = u_n; size_t rc = r;
        if (pos + 1 < TJ) { r = (size_t)b * TJ + pos2tau(d, pos + 1); u_n = bf2f(p.P[r * DINP + C_S5U + g * 16 + (lane & 15)]); }
        float nr = are * xr - aim * xi, ni = are * xi + aim * xr;
#pragma unroll
        for (int c = 0; c < 16; ++c) { float uc = rdlane(u, c); nr += bbr[c] * uc; ni += bbi[c] * uc; }
        xr = nr; xi = ni;
        float my = 0.f;
#pragma unroll
        for (int c = 0; c < 16; ++c) { float t = wave_sum(cr[c] * xr - ci[c] * xi); if (lane == c) my = t; }
        if (lane < 16) O[rc * ldo + g * 16 + lane] = f2bf(my);
    }
}

__device__ __forceinline__ void gla_chain_naive(const Params& p, int layer, int chain, int lane) {
    int b = chain >> 3, h = (chain >> 1) & 3, d = chain & 1;
    float S[32];
#pragma unroll
    for (int i = 0; i < 32; ++i) S[i] = 0.f;
    float w2[16];
#pragma unroll
    for (int rr = 0; rr < 16; ++rr) w2[rr] = p.gla_w_gate[((layer * 2 + d) * 16 + rr) * 128 + h * 32 + (lane & 31)];
    float b2 = p.gla_b_gate[(layer * 2 + d) * 128 + h * 32 + (lane & 31)];
    bf16_t* O = d == 0 ? p.Y + 768 : p.OGLA; const int ldo = d == 0 ? DM : 256;
    size_t r = (size_t)b * TJ + pos2tau(d, 0);
    float low_n = bf2f(p.P[r * DINP + C_GLG + d * 16 + (lane & 15)]), q_n = bf2f(p.P[r * DINP + C_GLQ + h * 32 + (lane & 31)]);
    float k_n = bf2f(p.P[r * DINP + C_GLK + h * 32 + (lane & 31)]), v_n = bf2f(p.P[r * DINP + C_GLV + h * 64 + lane]);
    for (int pos = 0; pos < TJ; ++pos) {
        float low = low_n, qv = q_n, kv = k_n, vv = v_n; size_t rc = r;
        if (pos + 1 < TJ) {
            r = (size_t)b * TJ + pos2tau(d, pos + 1);
            low_n = bf2f(p.P[r * DINP + C_GLG + d * 16 + (lane & 15)]); q_n = bf2f(p.P[r * DINP + C_GLQ + h * 32 + (lane & 31)]);
            k_n = bf2f(p.P[r * DINP + C_GLK + h * 32 + (lane & 31)]); v_n = bf2f(p.P[r * DINP + C_GLV + h * 64 + lane]);
        }
        float z = b2;
#pragma unroll
        for (int rr = 0; rr < 16; ++rr) z += rdlane(low, rr) * w2[rr];
        float a = expf(logsigmoidf_(z) * (1.0f / 16.0f));
        float o = 0.f;
#pragma unroll
        for (int i = 0; i < 32; ++i) { S[i] = rdlane(a, i) * S[i] + rdlane(kv, i) * vv; o += rdlane(qv, i) * S[i]; }
        O[rc * ldo + h * 64 + lane] = f2bf(o * 0.17677669529663687f);
    }
}

#define DN_DEF0 32
#define DN_NDEF 68
#define DN_DEFC 20
__device__ __forceinline__ void ph_dn_prep(const int wv_, unsigned char* smem, const Params& p, int layer, const int part) {
    PH_IDS();
    unsigned char* RAW = smem + 1024;
    const float* cwl = p.dn_conv + (size_t)layer * 5 * 768;
    constexpr bool DEFER = (TJ / 64) == 132;
    const int nfirst = DEFER ? NB * (TJ / 64 - DN_NDEF) : NB * (TJ / 64), nall = NB * (TJ / 64);
    if (part == 1 && (!DEFER || bid_ < 32)) return;
    for (int v = part ? nfirst + (bid_ - 32) : (bid_ + 64) % nblk_; v < (part ? nall : nfirst); v += (part ? nblk_ - 32 : nblk_)) {
        int b, tc;
        if (!DEFER) { b = v / (TJ / 64); tc = v - b * (TJ / 64); }
        else if (v < nfirst) { b = v / (TJ / 64 - DN_NDEF); const int j = v - b * (TJ / 64 - DN_NDEF); tc = j < DN_DEF0 ? j : j + DN_NDEF; }
        else { b = (v - nfirst) / DN_NDEF; tc = DN_DEF0 + (v - nfirst) - b * DN_NDEF; }
        const int tlo = tc * 64;
        const int slo = tlo < NCTX ? 0 : NCTX, shi = tlo < NCTX ? NCTX : TJ;
        __syncthreads();
        for (int e = tid_; e < 68 * 96; e += NTHR) {
            const int row = e / 96, ch = e - row * 96, tau = tlo - 2 + row;
            uint4 v = make_uint4(0u, 0u, 0u, 0u);
            if (tau >= slo && tau < shi) v = *(const uint4*)(p.P + ((size_t)b * TJ + tau) * DINP + ch * 8);
            *(uint4*)(RAW + e * 16) = v;
        }
        __syncthreads();
#pragma unroll 1
        for (int k3 = 0; k3 < 3; ++k3) {
            const int id = tid_ + NTHR * k3, pg = id / 96, cg = id - pg * 96;
            float cw[5][8];
#pragma unroll
            for (int j = 0; j < 5; ++j) { const float4 w0 = *(const float4*)(cwl + j * 768 + cg * 8), w1 = *(const float4*)(cwl + j * 768 + cg * 8 + 4);
                cw[j][0] = w0.x; cw[j][1] = w0.y; cw[j][2] = w0.z; cw[j][3] = w0.w; cw[j][4] = w1.x; cw[j][5] = w1.y; cw[j][6] = w1.z; cw[j][7] = w1.w; }
            float x[8][8];
#pragma unroll
            for (int rr = 0; rr < 8; ++rr) {
                const uint4 v = *(const uint4*)(RAW + ((4 * pg + rr) * 96 + cg) * 16);
                const unsigned vv[4] = {v.x, v.y, v.z, v.w};
#pragma unroll
                for (int e = 0; e < 4; ++e) { x[rr][2 * e] = __uint_as_float(vv[e] << 16); x[rr][2 * e + 1] = __uint_as_float(vv[e] & 0xffff0000u); }
            }
#pragma unroll
            for (int e2 = 0; e2 < 4; ++e2) {
                float y[8]; float ss = 0.f;
#pragma unroll
                for (int e = 0; e < 8; ++e) { float acc = 0.f;
#pragma unroll
                    for (int j = 0; j < 5; ++j) acc += x[e2 + j][e] * cw[j][e];
                    y[e] = siluf_(acc); ss += y[e] * y[e]; }
                ss += __shfl_xor(ss, 1, 64); ss += __shfl_xor(ss, 2, 64); ss += __shfl_xor(ss, 4, 64);
                const float rs = cg < 64 ? rsqrtf(ss + 1e-6f) : 1.0f;
                uint4 o; o.x = cvt_pk_bf16_(y[0] * rs, y[1] * rs); o.y = cvt_pk_bf16_(y[2] * rs, y[3] * rs); o.z = cvt_pk_bf16_(y[4] * rs, y[5] * rs); o.w = cvt_pk_bf16_(y[6] * rs, y[7] * rs);
                *(uint4*)(p.QKVN + ((size_t)b * TJ + tlo + 4 * pg + e2) * 768 + cg * 8) = o;
            }
        }
        {
            const int lane = tid_ & 63, wq = tid_ >> 6, hh = wq >> 1, dd = wq & 1;
            bf16_t* prow = p.P + ((size_t)b * TJ + tlo + lane) * DINP;
            const float av = bf2f(prow[C_DNA + dd * 4 + hh]), bv = bf2f(prow[C_DNB + dd * 4 + hh]);
            const float g = -expf(p.dn_a_log[layer * 8 + dd * 4 + hh]) * softplusf_(av + p.dn_dt_bias[layer * 8 + dd * 4 + hh]);
            float pre = g;
#pragma unroll
            for (int o = 1; o < 64; o <<= 1) { const float t = __shfl_up(pre, o, 64); if (lane >= o) pre += t; }
            const float tot = rdlane(pre, 63);
            float2 gb; gb.x = dd == 0 ? pre : tot - pre + g; gb.y = sigmoidf_(bv);
            *(float2*)((float*)(prow + DIN) + (dd * 4 + hh) * 2) = gb;
        }
    }
}

#define DN_B1 (DN_TX + 2560)
#define DN_SB 72
#define DN_QN 0
#define DN_QD (DN_QN + 9216)
#define DN_KN (DN_QD + 9216)
#define DN_KB (DN_KN + 9216)
#define DN_V (DN_KB + 9216)
#define DN_NL (DN_V + 9216)
#define DN_AI (DN_NL + 9216)
#define DN_NW (DN_AI + 9216)
#define DN_KDT (DN_NW + 9216)
#define DN_TD (DN_KDT + 9216)
#define DN_GAM (DN_TD + 4096)
#define DN_TX (DN_GAM + 2048)
typedef float f32x4_ __attribute__((ext_vector_type(4)));
__device__ __forceinline__ bfx8 pack8(const f32x4_& x, const f32x4_& y) {
    unsigned u[4]; u[0] = cvt_pk_bf16_(x[0], x[1]); u[1] = cvt_pk_bf16_(x[2], x[3]); u[2] = cvt_pk_bf16_(y[0], y[1]); u[3] = cvt_pk_bf16_(y[2], y[3]);
    return *(const bfx8*)u;
}
__device__ __forceinline__ bfx8 ld_split(const unsigned char* base, int row, int k0, int q4) {
    const unsigned char* a = base + (row * DN_SB + k0 + 4 * q4) * 2;
    uint2 lo = *(const uint2*)a, hi = *(const uint2*)(a + 32);
    unsigned u[4] = {lo.x, lo.y, hi.x, hi.y}; return *(const bfx8*)u;
}
__device__ __forceinline__ bfx8 ld_half(const unsigned char* base, int rowstride, int row, int k0, int q4) {
    uint2 lo = *(const uint2*)(base + (row * rowstride + k0 + 4 * q4) * 2);
    unsigned u[4] = {lo.x, lo.y, 0u, 0u}; return *(const bfx8*)u;
}
#define MFMA16(a, b, c) __builtin_amdgcn_mfma_f32_16x16x32_bf16(a, b, c, 0, 0, 0)

__device__ __forceinline__ void dn_tdiag(unsigned char* L, int a, int cc, int q4) {
    float xs[16];
#pragma unroll
    for (int r = 0; r < 16; ++r) {
        const unsigned char* rowp = L + DN_NL + ((16 * a + r) * DN_SB + 16 * a) * 2;
        const uint4 v0 = *(const uint4*)rowp, v1 = *(const uint4*)(rowp + 16);
        const unsigned vv[8] = {v0.x, v0.y, v0.z, v0.w, v1.x, v1.y, v1.z, v1.w};
        float sx = (r == cc) ? 1.f : 0.f;
#pragma unroll
        for (int j2 = 0; j2 < 16; ++j2) if (j2 < r) { const float lij = (j2 & 1) ? __uint_as_float(vv[j2 >> 1] & 0xffff0000u) : __uint_as_float(vv[j2 >> 1] << 16); sx += lij * xs[j2]; }
        xs[r] = sx;
        if (q4 == 0) *(bf16_t*)(L + DN_TD + ((a * 16 + r) * 16 + cc) * 2) = f2bf(sx);
    }
}
__device__ __forceinline__ void dn_tdiag_ahead(const Params& p, unsigned char* L, unsigned char* TDdst, int b, int h, int d, int tlo, int a, int l15, int q4) {
    unsigned char* blk = L + DN_TX + a * 640; float* gsc = (float*)(blk + 512);
    const int i = 16 * a + l15, tau = d ? tlo + 63 - i : tlo + i;
    const bf16_t* krow = p.QKVN + ((size_t)b * TJ + tau) * 768 + 256 + h * 64;
    const bfx8 k0 = *(const bfx8*)(krow + 8 * q4), k1 = *(const bfx8*)(krow + 32 + 8 * q4);
    const float2 gb = *(const float2*)((const float*)(p.P + ((size_t)b * TJ + tau) * DINP + DIN) + (d * 4 + h) * 2);
    if (q4 == 0) { gsc[l15] = gb.x; gsc[16 + l15] = gb.y; }
    f32x4_ kk = {0.f, 0.f, 0.f, 0.f};
    kk = MFMA16(k0, k0, kk); kk = MFMA16(k1, k1, kk);
    WAVE_LDS_FENCE();
    const float gj = gsc[l15];
#pragma unroll
    for (int r = 0; r < 4; ++r) {
        const int il = 4 * q4 + r;
        const float lv = (l15 < il) ? -gsc[16 + il] * kk[r] * __expf(gsc[il] - gj) : 0.f;
        *(bf16_t*)(blk + (il * 16 + l15) * 2) = f2bf(lv);
    }
    WAVE_LDS_FENCE();
    float xs[16];
#pragma unroll
    for (int r = 0; r < 16; ++r) {
        const uint4 v0 = *(const uint4*)(blk + r * 32), v1 = *(const uint4*)(blk + r * 32 + 16);
        const unsigned vv[8] = {v0.x, v0.y, v0.z, v0.w, v1.x, v1.y, v1.z, v1.w};
        float sx = (r == l15) ? 1.f : 0.f;
#pragma unroll
        for (int j2 = 0; j2 < 16; ++j2) if (j2 < r) { const float lij = (j2 & 1) ? __uint_as_float(vv[j2 >> 1] & 0xffff0000u) : __uint_as_float(vv[j2 >> 1] << 16); sx += lij * xs[j2]; }
        xs[r] = sx;
        if (q4 == 0) *(bf16_t*)(TDdst + ((a * 16 + r) * 16 + l15) * 2) = f2bf(sx);
    }
    WAVE_LDS_FENCE();
}
__device__ __forceinline__ void dn_chain(unsigned char* smem, const Params& p, int layer, int chain, int tid_) {
    unsigned char* L = smem + 1024;
    const int b = chain >> 3, h = (chain >> 1) & 3, d = chain & 1;
    const int w0_ = tid_ >> 6, lane0_ = tid_ & 63;
#define DN_IDS() int tt_ = tid_; OPQV(tt_); const int lane = tt_ & 63, w = __builtin_amdgcn_readfirstlane(tt_ >> 6), l15 = lane & 15, q4 = lane >> 4; (void)l15; (void)q4; (void)w
    const float nalog = -expf(p.dn_a_log[layer * 8 + d * 4 + h]), dtb = p.dn_dt_bias[layer * 8 + d * 4 + h];
    f32x4_ Sst[4], Uk[4];
#pragma unroll
    for (int mt = 0; mt < 4; ++mt) { Sst[mt] = (f32x4_){0.f, 0.f, 0.f, 0.f}; Uk[mt] = (f32x4_){0.f, 0.f, 0.f, 0.f}; }
    bf16_t* Oout = d == 0 ? p.Y : p.ODN; const int ldo = d == 0 ? DM : 256;
    uint4 pa0 = make_uint4(0, 0, 0, 0), pa1 = pa0, pa2 = pa0; float2 gba = make_float2(0.f, 0.f); float gl_n = 0.f;
    auto chunk_lo = [&](int c) { return d == 0 ? c * 64 : (c < 4 ? 192 - c * 64 : (TJ + NCTX - 64) - c * 64); };
#define DN_ISSUE(c_) do { const int tlo_ = chunk_lo(c_); const int i_ = tid_ >> 3, c8_ = (tid_ & 7) * 8; \
        { const int tau_ = d ? tlo_ + 63 - i_ : tlo_ + i_; const bf16_t* s_ = p.QKVN + ((size_t)b * TJ + tau_) * 768 + h * 64 + c8_; \
          pa0 = *(const uint4*)s_; pa1 = *(const uint4*)(s_ + 256); pa2 = *(const uint4*)(s_ + 512); \
          gba = *(const float2*)((const float*)(p.P + ((size_t)b * TJ + tau_) * DINP + DIN) + (d * 4 + h) * 2); } \
        gl_n = *((const float*)(p.P + ((size_t)b * TJ + (d ? tlo_ : tlo_ + 63)) * DINP + DIN) + (d * 4 + h) * 2); } while (0)
#define DN_COMMIT1(i_, q_, k_, v_, gb_, io_, ko_, gm_) do { \
        const float gmi = (gb_).x, bti = (gb_).y, egi = __expf(gmi), eki = __expf(gl_n - gmi); \
        if ((tid_ & 7) == 0) { (gm_)[i_] = gmi; (gm_)[64 + (i_)] = bti; (gm_)[128 + (i_)] = egi; (gm_)[192 + (i_)] = eki; } \
        *(uint4*)(L + DN_QN + (io_) + ((i_) * DN_SB + c8) * 2) = (q_); *(uint4*)(L + DN_KN + (io_) + ((i_) * DN_SB + c8) * 2) = (k_); \
        const unsigned* qq = (const unsigned*)&(q_); const unsigned* kq = (const unsigned*)&(k_); const unsigned* vq = (const unsigned*)&(v_); \
        uint4 qd, kb, vb; unsigned* qdp = (unsigned*)&qd; unsigned* kbp = (unsigned*)&kb; unsigned* vbp = (unsigned*)&vb; \
        const float sq = 0.125f * egi, skb = bti * egi; \
        _Pragma("unroll") for (int e = 0; e < 4; ++e) { \
            const float k0 = __uint_as_float(kq[e] << 16), k1 = __uint_as_float(kq[e] & 0xffff0000u); \
            qdp[e] = cvt_pk_bf16_(__uint_as_float(qq[e] << 16) * sq, __uint_as_float(qq[e] & 0xffff0000u) * sq); \
            kbp[e] = cvt_pk_bf16_(k0 * skb, k1 * skb); \
            vbp[e] = cvt_pk_bf16_(__uint_as_float(vq[e] << 16) * bti, __uint_as_float(vq[e] & 0xffff0000u) * bti); \
            *(bf16_t*)(L + DN_KDT + (ko_) + ((c8 + 2 * e) * DN_SB + (i_)) * 2) = f2bf(k0 * eki); \
            *(bf16_t*)(L + DN_KDT + (ko_) + ((c8 + 2 * e + 1) * DN_SB + (i_)) * 2) = f2bf(k1 * eki); } \
        *(uint4*)(L + DN_QD + (io_) + ((i_) * DN_SB + c8) * 2) = qd; *(uint4*)(L + DN_KB + (io_) + ((i_) * DN_SB + c8) * 2) = kb; *(uint4*)(L + DN_V + (io_) + ((i_) * DN_SB + c8) * 2) = vb; } while (0)
#define DN_COMMIT(c_) do { const int par_ = (c_) & 1, io2 = par_ ? DN_B1 : 0, ko2 = par_ ? (DN_B1 + 46080 - DN_KDT) : 0; float* gm2 = (float*)(L + DN_GAM + par_ * 1024); \
        const int i0 = tid_ >> 3, c8 = (tid_ & 7) * 8; \
        DN_COMMIT1(i0, pa0, pa1, pa2, gba, io2, ko2, gm2); } while (0)
    DN_ISSUE(0);
    if (w0_ >= 4) dn_tdiag_ahead(p, L, L + DN_TD, b, h, d, chunk_lo(0), w0_ - 4, lane0_ & 15, lane0_ >> 4);
    DN_COMMIT(0);
    DN_ISSUE(1);
    __syncthreads();
    for (int c = 0; c < TJ / 64; ++c) {
#ifndef EMU
        if ((TJ / 64) == 132 && c == DN_DEFC) {
            if (tid_ == 0) {
                unsigned sp = 0;
                while (xb_ld((unsigned*)p.cnt + 135) < (unsigned)(gridDim.x - 32)) { __builtin_amdgcn_s_sleep(2); if (++sp > (1u << 22)) break; }
                __builtin_amdgcn_fence(__ATOMIC_ACQUIRE, "agent");
                asm volatile("s_waitcnt vmcnt(0)" ::: "memory");
            }
            __syncthreads();
        }
#endif
        const int tlo = chunk_lo(c);
        const int io = (c & 1) ? DN_B1 : 0, ko = (c & 1) ? (DN_B1 + 46080 - DN_KDT) : 0;
        const float* gam = (const float*)(L + DN_GAM + (c & 1) * 1024);
        { DN_IDS();
#pragma unroll
        for (int tt = 0; tt < 2; ++tt) {
            const int t = 2 * w + tt, it = t >> 2, jt = t & 3;
            f32x4_ kk = {0.f, 0.f, 0.f, 0.f}, qk = {0.f, 0.f, 0.f, 0.f};
            if (jt <= it) {
#pragma unroll
                for (int ks = 0; ks < 2; ++ks) {
                    const bfx8 bk = *(const bfx8*)(L + DN_KN + io + ((jt * 16 + l15) * DN_SB + ks * 32 + q4 * 8) * 2);
                    const bfx8 ak = *(const bfx8*)(L + DN_KN + io + ((it * 16 + l15) * DN_SB + ks * 32 + q4 * 8) * 2);
                    const bfx8 aq = *(const bfx8*)(L + DN_QN + io + ((it * 16 + l15) * DN_SB + ks * 32 + q4 * 8) * 2);
                    kk = MFMA16(ak, bk, kk); qk = MFMA16(aq, bk, qk);
                }
            }
            const int j = jt * 16 + l15; const float gj = gam[j];
#pragma unroll
            for (int r = 0; r < 4; ++r) {
                const int i = it * 16 + q4 * 4 + r;
                const float dec = (j <= i) ? __expf(gam[i] - gj) : 0.f;
                const float lv = (j < i) ? -gam[64 + i] * kk[r] * dec : 0.f;
                *(bf16_t*)(L + DN_NL + (i * DN_SB + j) * 2) = f2bf(lv);
                *(bf16_t*)(L + DN_AI + (i * DN_SB + j) * 2) = f2bf(0.125f * qk[r] * dec);
            }
        }
        }
        __syncthreads();
        if (c + 1 < TJ / 64) { DN_COMMIT(c + 1); if (c + 2 < TJ / 64) DN_ISSUE(c + 2); }
        { DN_IDS();
            const f32x4_ z4 = {0.f, 0.f, 0.f, 0.f};
            f32x4_ R[4];
#pragma unroll
            for (int a = 0; a < 4; ++a)
#pragma unroll
                for (int r = 0; r < 4; ++r) {
                    const int i = 16 * a + 4 * q4 + r;
                    R[a][r] = w < 4 ? bf2f(*(const bf16_t*)(L + DN_V + io + (i * DN_SB + 16 * w + l15) * 2)) : bf2f(*(const bf16_t*)(L + DN_KB + io + (i * DN_SB + 16 * (w - 4) + l15) * 2));
                }
            f32x4_ X[4];
#pragma unroll
            for (int a = 0; a < 4; ++a) {
                f32x4_ acc = R[a];
                if (a == 1) acc = MFMA16(ld_half(L + DN_NL, DN_SB, 16 + l15, 0, q4), pack8(X[0], z4), acc);
                if (a >= 2) acc = MFMA16(ld_split(L + DN_NL, 16 * a + l15, 0, q4), pack8(X[0], X[1]), acc);
                if (a == 3) acc = MFMA16(ld_half(L + DN_NL, DN_SB, 48 + l15, 32, q4), pack8(X[2], z4), acc);
                X[a] = MFMA16(ld_half(L + DN_TD + (c & 1) * 2048, 16, a * 16 + l15, 0, q4), pack8(acc, z4), z4);
            }
            if (w < 4) {
#pragma unroll
                for (int a = 0; a < 4; ++a) Uk[a] = X[a];
            } else {
#pragma unroll
                for (int a = 0; a < 4; ++a)
#pragma unroll
                    for (int r = 0; r < 4; ++r) {
                        const int i = 16 * a + 4 * q4 + r;
                        *(bf16_t*)(L + DN_NW + (i * DN_SB + 16 * (w - 4) + l15) * 2) = f2bf(-X[a][r]);
                    }
            }
        }
        __syncthreads();
        { DN_IDS();
        if (w < 4) {
            const f32x4_ z4 = {0.f, 0.f, 0.f, 0.f};
            bfx8 sb[2]; sb[0] = pack8(Sst[0], Sst[1]); sb[1] = pack8(Sst[2], Sst[3]);
            f32x4_ vn[4];
#pragma unroll
            for (int mt = 0; mt < 4; ++mt) {
                f32x4_ acc = Uk[mt];
                acc = MFMA16(ld_split(L + DN_NW, 16 * mt + l15, 0, q4), sb[0], acc);
                acc = MFMA16(ld_split(L + DN_NW, 16 * mt + l15, 32, q4), sb[1], acc);
                vn[mt] = acc;
            }
            bfx8 vb[2]; vb[0] = pack8(vn[0], vn[1]); vb[1] = pack8(vn[2], vn[3]);
#pragma unroll
            for (int mt = 0; mt < 4; ++mt) {
                f32x4_ acc = z4;
                acc = MFMA16(ld_split(L + DN_QD + io, 16 * mt + l15, 0, q4), sb[0], acc);
                acc = MFMA16(ld_split(L + DN_QD + io, 16 * mt + l15, 32, q4), sb[1], acc);
                acc = MFMA16(ld_split(L + DN_AI, 16 * mt + l15, 0, q4), vb[0], acc);
                acc = MFMA16(ld_split(L + DN_AI, 16 * mt + l15, 32, q4), vb[1], acc);
#pragma unroll
                for (int r = 0; r < 4; ++r) {
                    const int i = 16 * mt + 4 * q4 + r, tau = d ? tlo + 63 - i : tlo + i;
                    Oout[((size_t)b * TJ + tau) * ldo + h * 64 + 16 * w + l15] = f2bf(acc[r]);
                }
            }
            const float glast = gam[128 + 63];
#pragma unroll
            for (int mt = 0; mt < 4; ++mt) {
                f32x4_ acc = Sst[mt] * glast;
                acc = MFMA16(ld_split(L + DN_KDT + ko, 16 * mt + l15, 0, q4), vb[0], acc);
                acc = MFMA16(ld_split(L + DN_KDT + ko, 16 * mt + l15, 32, q4), vb[1], acc);
                Sst[mt] = acc;
            }
        } else if (c + 1 < TJ / 64) {
            dn_tdiag_ahead(p, L, L + DN_TD + ((c + 1) & 1) * 2048, b, h, d, chunk_lo(c + 1), w - 4, l15, q4);
        }
        }
        __syncthreads();
    }
#undef DN_ISSUE
#undef DN_COMMIT1
#undef DN_COMMIT
    __syncthreads();
}

__device__ __forceinline__ int gla_scan_chunk(int d, int tc) { return d == 0 ? tc : (tc < 4 ? 3 - tc : (TJ / 64 + 3) - tc); }
__device__ __forceinline__ void gla_low(const bf16_t* prow, int d, float (&low)[16]) {
    const uint4 v0 = *(const uint4*)(prow + C_GLG + d * 16), v1 = *(const uint4*)(prow + C_GLG + d * 16 + 8);
    const unsigned vv[8] = {v0.x, v0.y, v0.z, v0.w, v1.x, v1.y, v1.z, v1.w};
#pragma unroll
    for (int e = 0; e < 8; ++e) { low[2 * e] = __uint_as_float(vv[e] << 16); low[2 * e + 1] = __uint_as_float(vv[e] & 0xffff0000u); }
}
__device__ __forceinline__ void gla_gate4(const Params& p, int layer, int h, int d, const float (&low)[16], int c4, int lane, float (&bb)[4], float (&tot)[4]) {
    const float* w2 = p.gla_w_gate + (size_t)(layer * 2 + d) * 16 * 128 + h * 32 + c4 * 4;
    const float* b2 = p.gla_b_gate + (size_t)(layer * 2 + d) * 128 + h * 32 + c4 * 4;
#pragma unroll
    for (int e = 0; e < 4; ++e) {
        float z = b2[e];
#pragma unroll
        for (int r = 0; r < 16; ++r) z += low[r] * w2[r * 128 + e];
        const float x = logsigmoidf_(z) * (1.0f / 16.0f);
        float pre = x;
#pragma unroll
        for (int o = 1; o < 64; o <<= 1) { const float t = __shfl_up(pre, o, 64); if (lane >= o) pre += t; }
        const float tt = rdlane(pre, 63);
        tot[e] = tt; bb[e] = d == 0 ? pre : tt - pre + x;
    }
}
#define GLA_VS 68
#define GLA_WAVE_LDS 17408
__device__ __forceinline__ bfx8 ld_split_s(const unsigned char* base, int strideB, int row, int k0, int q4) {
    const unsigned char* a = base + row * strideB + (k0 + 4 * q4) * 2;
    const uint2 lo = *(const uint2*)a, hi = *(const uint2*)(a + 32);
    unsigned u[4] = {lo.x, lo.y, hi.x, hi.y}; return *(const bfx8*)u;
}
__device__ __forceinline__ void gla_load_row32(const bf16_t* src, float (&x)[32]) {
#pragma unroll
    for (int c = 0; c < 4; ++c) { const uint4 v = *(const uint4*)(src + c * 8); const unsigned vv[4] = {v.x, v.y, v.z, v.w};
#pragma unroll
        for (int e = 0; e < 4; ++e) { x[c * 8 + 2 * e] = __uint_as_float(vv[e] << 16); x[c * 8 + 2 * e + 1] = __uint_as_float(vv[e] & 0xffff0000u); } }
}
__device__ __forceinline__ void gla_store_vT(unsigned char* vT, const bf16_t* vsrc, int lane) {
#pragma unroll
    for (int c = 0; c < 8; ++c) { const uint4 v = *(const uint4*)(vsrc + c * 8); const unsigned vv[4] = {v.x, v.y, v.z, v.w};
#pragma unroll
        for (int e = 0; e < 4; ++e) { *(bf16_t*)(vT + ((c * 8 + 2 * e) * GLA_VS + lane) * 2) = (bf16_t)(vv[e] & 0xffffu); *(bf16_t*)(vT + ((c * 8 + 2 * e + 1) * GLA_VS + lane) * 2) = (bf16_t)(vv[e] >> 16); } }
}
__device__ __forceinline__ void ph_gla1(const int wv_, unsigned char* smem, const Params& p, int layer) {
    PH_IDS();
    const int lane = tid_ & 63, w = tid_ >> 6, l15 = lane & 15, q4 = lane >> 4;
    unsigned char* vT = smem + 1024 + w * GLA_WAVE_LDS; unsigned char* khT = vT + 8704 + 4096;
    const int vb = bid_ - 32, vn = nblk_ - 32;
    if (vb < 0) return;
    for (int item = ((vb + 128) % vn) * NWV + w; item < NB * 4 * 2 * (TJ / 64); item += vn * NWV) {
        const int tc = item % (TJ / 64), bhd = item / (TJ / 64), d = bhd & 1, h = (bhd >> 1) & 3, b = bhd >> 3;
        const bf16_t* prow = p.P + ((size_t)b * TJ + tc * 64 + lane) * DINP;
        const int cs = gla_scan_chunk(d, tc);
        float low[16]; gla_low(prow, d, low);
        {
            const uint4* ks = (const uint4*)(prow + C_GLK + h * 32); const uint4 k0 = ks[0], k1 = ks[1], k2 = ks[2], k3 = ks[3];
            uint4* kd = (uint4*)(vT + lane * 64); kd[0] = k0; kd[1] = k1; kd[2] = k2; kd[3] = k3;
        }
#pragma unroll 1
        for (int c4 = 0; c4 < 8; ++c4) {
            float bb[4], tot[4];
            gla_gate4(p, layer, h, d, low, c4, lane, bb, tot);
            const uint2 kv = *(const uint2*)(vT + lane * 64 + c4 * 8);
            const float k0 = __uint_as_float(kv.x << 16), k1 = __uint_as_float(kv.x & 0xffff0000u), k2 = __uint_as_float(kv.y << 16), k3 = __uint_as_float(kv.y & 0xffff0000u);
            *(bf16_t*)(khT + ((c4 * 4 + 0) * GLA_VS + lane) * 2) = f2bf(k0 * __expf(tot[0] - bb[0]));
            *(bf16_t*)(khT + ((c4 * 4 + 1) * GLA_VS + lane) * 2) = f2bf(k1 * __expf(tot[1] - bb[1]));
            *(bf16_t*)(khT + ((c4 * 4 + 2) * GLA_VS + lane) * 2) = f2bf(k2 * __expf(tot[2] - bb[2]));
            *(bf16_t*)(khT + ((c4 * 4 + 3) * GLA_VS + lane) * 2) = f2bf(k3 * __expf(tot[3] - bb[3]));
            if (lane < 4) { const float tl = lane == 0 ? tot[0] : lane == 1 ? tot[1] : lane == 2 ? tot[2] : tot[3];
                p.DCY[((size_t)bhd * (TJ / 64) + cs) * 32 + c4 * 4 + lane] = __expf(tl); }
        }
        WAVE_LDS_FENCE();
        gla_store_vT(vT, prow + C_GLV + h * 64, lane);
        WAVE_LDS_FENCE();
        bf16_t* gout = p.GST + ((size_t)bhd * (TJ / 64) + cs) * 2048;
#pragma unroll
        for (int dt = 0; dt < 4; ++dt)
#pragma unroll
            for (int nt = 0; nt < 2; ++nt) {
                f32x4_ acc = {0.f, 0.f, 0.f, 0.f};
#pragma unroll
                for (int ks = 0; ks < 2; ++ks) acc = MFMA16(ld_split_s(vT, GLA_VS * 2, 16 * dt + l15, 32 * ks, q4), ld_split_s(khT, GLA_VS * 2, 16 * nt + l15, 32 * ks, q4), acc);
#pragma unroll
                for (int r = 0; r < 4; ++r) gout[(16 * dt + 4 * q4 + r) * 32 + 16 * nt + l15] = f2bf(acc[r]);
            }
        WAVE_LDS_FENCE();
    }
}
__device__ __forceinline__ void gla2_scan(const Params& p, int wg, int tid_) {
    const int chain = wg >> 1, pr = (wg & 1) * 512 + tid_, dk0 = (2 * pr) & 31;
    unsigned* g = (unsigned*)(p.GST + (size_t)chain * (TJ / 64) * 2048) + pr;
    const float* dc = p.DCY + (size_t)chain * (TJ / 64) * 32 + dk0;
    float s0 = 0.f, s1 = 0.f;
    for (int c0 = 0; c0 < TJ / 64; c0 += 4) {
        unsigned gv[4]; float2 dv[4];
#pragma unroll
        for (int u = 0; u < 4; ++u) if (c0 + u < TJ / 64) { gv[u] = g[(size_t)(c0 + u) * 1024]; dv[u] = *(const float2*)(dc + (c0 + u) * 32); }
#pragma unroll
        for (int u = 0; u < 4; ++u) if (c0 + u < TJ / 64) {
            g[(size_t)(c0 + u) * 1024] = cvt_pk_bf16_(s0, s1);
            s0 = dv[u].x * s0 + __uint_as_float(gv[u] << 16); s1 = dv[u].y * s1 + __uint_as_float(gv[u] & 0xffff0000u);
        }
    }
}
__device__ __forceinline__ void ph_gla3(const int wv_, unsigned char* smem, const Params& p, int layer) {
    PH_IDS();
    const int lane = tid_ & 63, w = tid_ >> 6, l15 = lane & 15, q4 = lane >> 4;
    unsigned char* vT = smem + 1024 + w * GLA_WAVE_LDS; unsigned char* Qt = vT + 8704; unsigned char* Kt = Qt + 4096;
    for (;;) {
#ifdef EMU
        int item = 0; if (lane == 0) item = g_emu_q++; item = __builtin_amdgcn_readlane(item, 0);
#else
        int item = 0; if (lane == 0) item = atomicAdd(p.cnt + 130, 1); item = __builtin_amdgcn_readfirstlane(item);
#endif
        if (item >= NB * 4 * (TJ / 64)) break;
        const int tc = item % (TJ / 64), bh = item / (TJ / 64), h = bh & 3, b = bh >> 2;
        if (layer == NLAYER - 1 && tc < 4) continue;
        const bf16_t* prow = p.P + ((size_t)b * TJ + tc * 64 + lane) * DINP;
        gla_store_vT(vT, prow + C_GLV + h * 64, lane);
        f32x4_ o[4][4];
#pragma unroll
        for (int dt = 0; dt < 4; ++dt)
#pragma unroll
            for (int nt = 0; nt < 4; ++nt) o[dt][nt] = (f32x4_){0.f, 0.f, 0.f, 0.f};
#pragma unroll 1
        for (int d = 0; d < 2; ++d) {
#ifdef EMU
            if (g_dbg_dir >= 0 && d != g_dbg_dir) continue;
#endif
            {
                float low[16]; gla_low(prow, d, low);
                {
                    const uint4* qs = (const uint4*)(prow + C_GLQ + h * 32); const uint4* ks = (const uint4*)(prow + C_GLK + h * 32);
                    const uint4 q0 = qs[0], q1 = qs[1], q2 = qs[2], q3 = qs[3], k0 = ks[0], k1 = ks[1], k2 = ks[2], k3 = ks[3];
                    uint4* qd = (uint4*)(Qt + lane * 64); uint4* kd = (uint4*)(Kt + lane * 64);
                    qd[0] = q0; qd[1] = q1; qd[2] = q2; qd[3] = q3; kd[0] = k0; kd[1] = k1; kd[2] = k2; kd[3] = k3;
                }
#pragma unroll 1
                for (int c4 = 0; c4 < 8; ++c4) {
                    float bb[4], tot[4];
                    gla_gate4(p, layer, h, d, low, c4, lane, bb, tot);
                    const uint2 qv = *(const uint2*)(Qt + lane * 64 + c4 * 8), kv = *(const uint2*)(Kt + lane * 64 + c4 * 8);
                    const float sc = 0.17677669529663687f;
                    const float e0 = __expf(bb[0]), e1 = __expf(bb[1]), e2 = __expf(bb[2]), e3 = __expf(bb[3]);
                    uint2 qo, ko;
                    qo.x = cvt_pk_bf16_(__uint_as_float(qv.x << 16) * sc * e0, __uint_as_float(qv.x & 0xffff0000u) * sc * e1);
                    qo.y = cvt_pk_bf16_(__uint_as_float(qv.y << 16) * sc * e2, __uint_as_float(qv.y & 0xffff0000u) * sc * e3);
                    ko.x = cvt_pk_bf16_(__uint_as_float(kv.x << 16) / e0, __uint_as_float(kv.x & 0xffff0000u) / e1);
                    ko.y = cvt_pk_bf16_(__uint_as_float(kv.y << 16) / e2, __uint_as_float(kv.y & 0xffff0000u) / e3);
                    *(uint2*)(Qt + lane * 64 + c4 * 8) = qo; *(uint2*)(Kt + lane * 64 + c4 * 8) = ko;
                }
            }
            WAVE_LDS_FENCE();
            const bf16_t* sst = p.GST + ((size_t)((bh * 2 + d) * (TJ / 64)) + gla_scan_chunk(d, tc)) * 2048;
            bfx8 qb[4];
#pragma unroll
            for (int nt = 0; nt < 4; ++nt) qb[nt] = *(const bfx8*)(Qt + (16 * nt + l15) * 64 + q4 * 16);
#pragma unroll
            for (int nt = 0; nt < 4; ++nt) {
                f32x4_ at[4];
#pragma unroll
                for (int mt = 0; mt < 4; ++mt) {
                    const bfx8 ka = *(const bfx8*)(Kt + (16 * mt + l15) * 64 + q4 * 16);
                    f32x4_ a = MFMA16(ka, qb[nt], ((f32x4_){0.f, 0.f, 0.f, 0.f}));
                    const int t = 16 * nt + l15;
#pragma unroll
                    for (int r = 0; r < 4; ++r) { const int sidx = 16 * mt + 4 * q4 + r; const bool keep = d == 0 ? sidx <= t : sidx >= t; a[r] = keep ? a[r] : 0.f; }
                    at[mt] = a;
                }
                const bfx8 ab0 = pack8(at[0], at[1]), ab1 = pack8(at[2], at[3]);
#pragma unroll
                for (int dt = 0; dt < 4; ++dt) {
                    f32x4_ acc = o[dt][nt];
                    acc = MFMA16(ld_split_s(vT, GLA_VS * 2, 16 * dt + l15, 0, q4), ab0, acc);
                    acc = MFMA16(ld_split_s(vT, GLA_VS * 2, 16 * dt + l15, 32, q4), ab1, acc);
                    acc = MFMA16(*(const bfx8*)(sst + (16 * dt + l15) * 32 + q4 * 8), qb[nt], acc);
                    o[dt][nt] = acc;
                }
            }
            WAVE_LDS_FENCE();
        }
        const float* g = p.gla_norm_g + layer * 64;
#pragma unroll
        for (int nt = 0; nt < 4; ++nt) {
            float ss = 0.f;
#pragma unroll
            for (int dt = 0; dt < 4; ++dt)
#pragma unroll
                for (int r = 0; r < 4; ++r) ss += o[dt][nt][r] * o[dt][nt][r];
            ss += __shfl_xor(ss, 16, 64); ss += __shfl_xor(ss, 32, 64);
            const float rs = rsqrtf(ss * (1.0f / 64.0f) + 1e-6f);
            const size_t row = (size_t)b * TJ + tc * 64 + 16 * nt + l15;
#ifdef EMU
            if (g_dbg_dir >= 0) { for (int dt = 0; dt < 4; ++dt) for (int r = 0; r < 4; ++r) g_dbg[row * 256 + h * 64 + 16 * dt + 4 * q4 + r] = o[dt][nt][r]; }
#endif
#pragma unroll
            for (int dt = 0; dt < 4; ++dt) {
                const int dv0 = 16 * dt + 4 * q4;
                const uint2 rg = *(const uint2*)(p.P + row * DINP + C_GLR + h * 64 + dv0);
                const float r0 = __uint_as_float(rg.x << 16), r1 = __uint_as_float(rg.x & 0xffff0000u), r2 = __uint_as_float(rg.y << 16), r3 = __uint_as_float(rg.y & 0xffff0000u);
                uint2 w2;
                w2.x = cvt_pk_bf16_(o[dt][nt][0] * rs * g[dv0] * siluf_(r0), o[dt][nt][1] * rs * g[dv0 + 1] * siluf_(r1));
                w2.y = cvt_pk_bf16_(o[dt][nt][2] * rs * g[dv0 + 2] * siluf_(r2), o[dt][nt][3] * rs * g[dv0 + 3] * siluf_(r3));
                *(uint2*)(p.Y + row * DM + 768 + h * 64 + dv0) = w2;
            }
        }
    }
}

#define S5NS (TJ / 16)
#define S5NT (TJ / 256)
__device__ __forceinline__ void s5_prep_item(unsigned char* smem, const Params& p, int layer, const int bid_, const int tid_) {
    if (bid_ >= 64) {
        if (bid_ < 80) for (int idx = (bid_ - 64) * NTHR + tid_; idx < 65536; idx += 16 * NTHR) { const int co = idx >> 8, ch = idx & 255; p.GLUt[idx] = f2bf(p.s5_glu_w[(size_t)layer * 65536 + ch * 256 + co]); }
        return;
    }
    const int g = bid_ >> 2, qd = bid_ & 3;
    float2* APOW = (float2*)(smem + 1024);
    float2* BBAR = APOW + 2 * 64 * 17;
    float2* CC = BBAR + 2 * 64 * 16;
    float* KC = (float*)(CC + 2 * 16 * 64);
    __syncthreads();
    if (tid_ < 128) {
        const int d = tid_ >> 6, pp = tid_ & 63;
        const float lre = p.s5_a_re[((layer * 2 + d) * 16 + g) * 64 + pp], lim = p.s5_a_im[((layer * 2 + d) * 16 + g) * 64 + pp];
        const float dt = expf(p.s5_log_dt[(layer * 2 + d) * 16 + g]);
        for (int m = 0; m <= 16; ++m) { const float mag = expf(lre * dt * (float)m), ang = lim * dt * (float)m; APOW[(d * 64 + pp) * 17 + m] = make_float2(mag * cosf(ang), mag * sinf(ang)); }
        const float2 a1 = APOW[(d * 64 + pp) * 17 + 1]; const float den = lre * lre + lim * lim;
        const float fre = ((a1.x - 1.f) * lre + a1.y * lim) / den, fim = (a1.y * lre - (a1.x - 1.f) * lim) / den;
        for (int c = 0; c < 16; ++c) {
            const float br = p.s5_b_re[((layer * 16 + g) * 64 + pp) * 16 + c], bi = p.s5_b_im[((layer * 16 + g) * 64 + pp) * 16 + c];
            BBAR[(d * 64 + pp) * 16 + c] = make_float2(fre * br - fim * bi, fre * bi + fim * br);
            CC[(d * 16 + c) * 64 + pp] = make_float2(p.s5_c_re[(((layer * 2 + d) * 16 + g) * 16 + c) * 64 + pp], p.s5_c_im[(((layer * 2 + d) * 16 + g) * 16 + c) * 64 + pp]);
        }
        if (qd == 0) { const float2 a16 = APOW[(d * 64 + pp) * 17 + 16]; p.A16[((d * 16 + g) * 64 + pp) * 2] = a16.x; p.A16[((d * 16 + g) * 64 + pp) * 2 + 1] = a16.y; }
    }
    __syncthreads();
    for (int idx = tid_; idx < 2048; idx += NTHR) {
        const int d = idx >> 10, tau = (idx >> 6) & 15, cl = (idx >> 4) & 3, c2 = idx & 15, c = 4 * qd + cl;
        float acc = 0.f;
        for (int pp = 0; pp < 64; ++pp) {
            const float2 cc = CC[(d * 16 + c) * 64 + pp], ap = APOW[(d * 64 + pp) * 17 + tau], bbv = BBAR[(d * 64 + pp) * 16 + c2];
            const float tr = cc.x * ap.x - cc.y * ap.y, ti = cc.x * ap.y + cc.y * ap.x;
            acc += tr * bbv.x - ti * bbv.y;
        }
        KC[idx] = acc;
    }
    __syncthreads();
    for (int idx = tid_; idx < 64 * 512; idx += NTHR) {
        const int nl = idx >> 9, k = idx & 511, i = nl >> 2, cl = nl & 3, c = 4 * qd + cl, n = i * 16 + c;
        float v;
        if (k < 256) { const int j = k >> 4, c2 = k & 15;
            v = (i >= j ? KC[((0 * 16 + (i - j)) * 4 + cl) * 16 + c2] : 0.f) + (j >= i ? KC[((1 * 16 + (j - i)) * 4 + cl) * 16 + c2] : 0.f);
        } else { const int kk = k - 256, d = kk >> 7, im = (kk >> 6) & 1, pp = kk & 63, m = d == 0 ? i + 1 : 16 - i;
            const float2 cc = CC[(d * 16 + c) * 64 + pp], ap = APOW[(d * 64 + pp) * 17 + m];
            v = im == 0 ? (cc.x * ap.x - cc.y * ap.y) : -(cc.x * ap.y + cc.y * ap.x); }
        p.SB[((size_t)g * 256 + n) * 512 + k] = f2bf(v);
    }
    for (int idx = tid_; idx < 64 * 256; idx += NTHR) {
        const int n = 64 * qd + (idx >> 8), k = idx & 255, j = k >> 4, c2 = k & 15, d = n >> 7, im = (n >> 6) & 1, pp = n & 63, m = d == 0 ? 15 - j : j;
        const float2 ap = APOW[(d * 64 + pp) * 17 + m], bbv = BBAR[(d * 64 + pp) * 16 + c2];
        p.SE[((size_t)g * 256 + n) * 256 + k] = f2bf(im == 0 ? ap.x * bbv.x - ap.y * bbv.y : ap.x * bbv.y + ap.y * bbv.x);
    }
}
__device__ __forceinline__ void ph_s5_1(const int wv_, unsigned char* smem, const Params& p, int layer) {
    PH_IDS();
    const int lane = tid_ & 63, w = tid_ >> 6, l15 = lane & 15, q4 = lane >> 4;
    const int vb = bid_ - 32, vn = nblk_ - 32;
    if (vb < 0) return;
    const int per_g = vn / 16, g = vb & 15, slice = vb >> 4;
    if (slice >= per_g) return;
    unsigned char* sSE = smem + 1024;
    __syncthreads();
    {
        const uint4* src = (const uint4*)(p.SE + (size_t)g * 65536);
#pragma unroll 4
        for (int i = 0; i < 16; ++i) { const int q = tid_ + NTHR * i, row = q >> 5, c = q & 31; *(uint4*)(sSE + row * 512 + ((c ^ (row & 15)) << 4)) = src[q]; }
    }
    __syncthreads();
    const int nitem = NB * S5NT, step = per_g * NWV;
    int item = slice * NWV + w;
    bfx8 ua[8];
    if (item < nitem) { const int st = item % S5NT, b = item / S5NT, s0 = st * 16;
#pragma unroll
        for (int ks = 0; ks < 8; ++ks) ua[ks] = *(const bfx8*)(p.P + ((size_t)b * TJ + 16 * (s0 + l15) + 2 * ks + (q4 >> 1)) * DINP + C_S5U + 16 * g + 8 * (q4 & 1)); }
    for (; item < nitem; item += step) {
        const int st = item % S5NT, b = item / S5NT, s0 = st * 16;
        bfx8 ub[8];
#pragma unroll
        for (int ks = 0; ks < 8; ++ks) ub[ks] = ua[ks];
        const int nx = item + step;
        if (nx < nitem) { const int stn = nx % S5NT, bn = nx / S5NT, s0n = stn * 16;
#pragma unroll
            for (int ks = 0; ks < 8; ++ks) ua[ks] = *(const bfx8*)(p.P + ((size_t)bn * TJ + 16 * (s0n + l15) + 2 * ks + (q4 >> 1)) * DINP + C_S5U + 16 * g + 8 * (q4 & 1)); }
#pragma unroll 2
        for (int nt = 0; nt < 16; ++nt) {
            f32x4_ acc = {0.f, 0.f, 0.f, 0.f};
            const int row = 16 * nt + l15;
#pragma unroll
            for (int ks = 0; ks < 8; ++ks) acc = MFMA16(ub[ks], *(const bfx8*)(sSE + row * 512 + (((4 * ks + q4) ^ l15) << 4)), acc);
#pragma unroll
            for (int r = 0; r < 4; ++r) p.XS[(((size_t)b * S5NS + s0 + 4 * q4 + r) * 16 + g) * 256 + 16 * nt + l15] = f2bf(acc[r]);
        }
    }
}
__device__ __forceinline__ void s5_2_scan(const Params& p, int wg, int tid_) {
    const int idx = wg * NTHR + tid_, pp = idx & 63, d = (idx >> 6) & 1, g = (idx >> 7) & 15, b = idx >> 11;
    const float ar = p.A16[((d * 16 + g) * 64 + pp) * 2], ai = p.A16[((d * 16 + g) * 64 + pp) * 2 + 1];
    bf16_t* base = p.XS + ((size_t)b * S5NS * 16 + g) * 256 + d * 128 + pp;
    float xr = 0.f, xi = 0.f;
    for (int q0 = 0; q0 < S5NS; q0 += 8) {
        float er[8], ei[8]; int sidx[8];
#pragma unroll
        for (int u = 0; u < 8; ++u) { const int q = q0 + u; const int sq = d == 0 ? q : (q < NCTX / 16 ? NCTX / 16 - 1 - q : S5NS + NCTX / 16 - 1 - q); sidx[u] = sq;
            er[u] = bf2f(base[(size_t)sq * 4096]); ei[u] = bf2f(base[(size_t)sq * 4096 + 64]); }
#pragma unroll
        for (int u = 0; u < 8; ++u) {
            base[(size_t)sidx[u] * 4096] = f2bf(xr); base[(size_t)sidx[u] * 4096 + 64] = f2bf(xi);
            const float nr = ar * xr - ai * xi + er[u], ni = ar * xi + ai * xr + ei[u]; xr = nr; xi = ni;
        }
    }
}
#define S5_ZS 264
__device__ __forceinline__ void ph_s5_3(const int wv_, unsigned char* smem, const Params& p, int layer) {
    PH_IDS();
    const int lane = tid_ & 63, w = tid_ >> 6, l15 = lane & 15, q4 = lane >> 4;
    bf16_t* Z = (bf16_t*)(smem + 1024);
    int* sitem = (int*)(smem + 64);
    for (;;) {
        __syncthreads();
#ifdef EMU
        if (tid_ == 0) sitem[0] = g_emu_q2++;
#else
        if (tid_ == 0) sitem[0] = atomicAdd(p.cnt + 131, 1);
#endif
        __syncthreads();
        const int item = sitem[0];
        if (item >= NB * S5NT) break;
        const int b = item / S5NT, st = item - b * S5NT, s0 = st * 16;
        if (layer == NLAYER - 1 && st == 0) continue;
        __syncthreads();
#pragma unroll 1
        for (int gi = 0; gi < 2; ++gi) {
            const int g = 2 * w + gi;
            bfx8 ua[8], xa[8];
#pragma unroll
            for (int ks = 0; ks < 8; ++ks) {
                ua[ks] = *(const bfx8*)(p.P + ((size_t)b * TJ + 16 * (s0 + l15) + 2 * ks + (q4 >> 1)) * DINP + C_S5U + 16 * g + 8 * (q4 & 1));
                xa[ks] = *(const bfx8*)(p.XS + (((size_t)b * S5NS + s0 + l15) * 16 + g) * 256 + 32 * ks + 8 * q4);
            }
            const bf16_t* sb = p.SB + (size_t)g * 131072;
            const float dsk = p.s5_d[layer * 256 + 16 * g + l15];
#pragma unroll 2
            for (int nt = 0; nt < 16; ++nt) {
                f32x4_ acc = {0.f, 0.f, 0.f, 0.f};
#pragma unroll
                for (int ks = 0; ks < 8; ++ks) acc = MFMA16(ua[ks], *(const bfx8*)(sb + (16 * nt + l15) * 512 + 32 * ks + 8 * q4), acc);
#pragma unroll
                for (int ks = 0; ks < 8; ++ks) acc = MFMA16(xa[ks], *(const bfx8*)(sb + (16 * nt + l15) * 512 + 256 + 32 * ks + 8 * q4), acc);
#pragma unroll
                for (int r = 0; r < 4; ++r) {
                    const int tl = 16 * (4 * q4 + r) + nt;
                    const float u = bf2f(p.P[((size_t)b * TJ + 16 * s0 + tl) * DINP + C_S5U + 16 * g + l15]);
                    Z[tl * S5_ZS + 16 * g + l15] = f2bf(gelu_tanh(acc[r] + dsk * u));
                }
            }
        }
        __syncthreads();
#pragma unroll 1
        for (int m2 = 0; m2 < 2; ++m2) {
            const int mt = 2 * w + m2;
            bfx8 za[8];
#pragma unroll
            for (int ks = 0; ks < 8; ++ks) za[ks] = *(const bfx8*)(Z + (16 * mt + l15) * S5_ZS + 32 * ks + 8 * q4);
#pragma unroll 2
            for (int nt = 0; nt < 16; ++nt) {
                f32x4_ acc = {0.f, 0.f, 0.f, 0.f};
#pragma unroll
                for (int ks = 0; ks < 8; ++ks) acc = MFMA16(za[ks], *(const bfx8*)(p.GLUt + (16 * nt + l15) * 256 + 32 * ks + 8 * q4), acc);
                const int co = 16 * nt + l15; const float gb = p.s5_glu_b[layer * 256 + co];
#pragma unroll
                for (int r = 0; r < 4; ++r) {
                    const int tl = 16 * mt + 4 * q4 + r;
                    const float z = bf2f(Z[tl * S5_ZS + co]);
                    p.Y[((size_t)b * TJ + 16 * s0 + tl) * DM + 256 + co] = f2bf(z * sigmoidf_(acc[r] + gb));
                }
            }
        }
    }
}

__device__ __forceinline__ void ph_scans(const int wv_, unsigned char* smem, const Params& p, int layer) {
    PH_IDS();
    if (bid_ < 32) { dn_chain(smem, p, layer, bid_, tid_); return; }
    if (bid_ < 112) {
        if (bid_ < 96) gla2_scan(p, bid_ - 32, tid_); else s5_2_scan(p, bid_ - 96, tid_);
#ifndef EMU
        asm volatile("s_waitcnt vmcnt(0)" ::: "memory");
        __syncthreads();
        if (tid_ == 0) { __builtin_amdgcn_fence(__ATOMIC_RELEASE, "agent"); asm volatile("s_waitcnt vmcnt(0)" ::: "memory"); (void)xb_add((unsigned*)p.cnt + 129, 1u); }
#endif
    }
}
#ifndef EMU
__device__ __forceinline__ void ph_dn_defer_publish(const int wv_, const Params& p) {
    PH_IDS();
    if (bid_ < 32) return;
    asm volatile("s_waitcnt vmcnt(0)" ::: "memory");
    __syncthreads();
    if (tid_ == 0) { __builtin_amdgcn_fence(__ATOMIC_RELEASE, "agent"); asm volatile("s_waitcnt vmcnt(0)" ::: "memory"); (void)xb_add((unsigned*)p.cnt + 135, 1u); }
}
#endif
#ifndef EMU
__device__ __forceinline__ void ph_sub_barrier(const int wv_, const Params& p) {
    PH_IDS();
    const unsigned need = (unsigned)(nblk_ - 32);
    if (bid_ >= 32) { asm volatile("s_waitcnt vmcnt(0)" ::: "memory"); __syncthreads(); }
    if (tid_ == 0) {
        if (bid_ >= 32) { __builtin_amdgcn_fence(__ATOMIC_RELEASE, "agent"); asm volatile("s_waitcnt vmcnt(0)" ::: "memory"); (void)xb_add((unsigned*)p.cnt + 134, 1u); }
        unsigned sp = 0;
        while (xb_ld((unsigned*)p.cnt + 134) < need) { __builtin_amdgcn_s_sleep(2); if (++sp > (1u << 22)) break; }
        __builtin_amdgcn_fence(__ATOMIC_ACQUIRE, "agent");
        asm volatile("s_waitcnt vmcnt(0)" ::: "memory");
    }
    __syncthreads();
}
#endif
#ifndef EMU
__device__ __forceinline__ void ph_wait_scans(const int wv_, const Params& p) {
    PH_IDS();
    if (tid_ == 0) {
        unsigned sp = 0;
        while (xb_ld((unsigned*)p.cnt + 129) < 80u) { __builtin_amdgcn_s_sleep(2); if (++sp > (1u << 22)) break; }
        __builtin_amdgcn_fence(__ATOMIC_ACQUIRE, "agent");
        asm volatile("s_waitcnt vmcnt(0)" ::: "memory");
    }
    __syncthreads();
}
#endif

__device__ __forceinline__ void ph_attn_prep(const int wv_, unsigned char* smem, const Params& p, int layer) {
    PH_IDS();
    float2 (*sCS)[16] = (float2 (*)[16])(smem + 1024);
    bf16_t* sVt = (bf16_t*)(smem + 1024 + 8192);
    unsigned* sMax = (unsigned*)(smem + 64);
    const float qscale = 0.17677669529663687f * 1.4426950408889634f;
    const int vb = bid_ - 32, vn = nblk_ - 32;
    if (vb < 0) return;
    for (int item = vb; item < NB * 132; item += vn) {
        const int b = item / 132, kt = item - b * 132, tau0 = kt * 64; const bool lat = tau0 >= NCTX;
        __syncthreads();
        if (tid_ < 8) sMax[tid_] = 0u;
        for (int idx = tid_; idx < 1024; idx += NTHR) {
            const int tk = idx >> 4, i = idx & 15; float cs = 1.f, sn = 0.f;
            if (lat) { const int t = tau0 + tk - NCTX; const float base = (i < 8) ? (float)(t >> 6) : (float)(t & 63);
                const float inv = exp2f(-(float)(i & 7) * (13.287712379549449f / 8.0f)); sincosf(base * inv, &sn, &cs); }
            sCS[tk][i] = make_float2(cs, sn);
        }
        __syncthreads();
        const int tk = tid_ >> 3, hm = tid_ & 7, h = hm >> 1, m = hm & 1, tau = tau0 + tk, bh = b * 4 + h;
        const size_t r = (size_t)b * TJ + tau;
#pragma unroll
        for (int which = 0; which < 2; ++which) {
            const uint4* src = (const uint4*)(p.P + r * DINP + (which ? C_DAQ : C_DAK) + h * 64 + m * 32);
            uint4 raw[4]; raw[0] = src[0]; raw[1] = src[1]; raw[2] = src[2]; raw[3] = src[3];
            const unsigned* rw = (const unsigned*)raw; float x[32], o[32];
#pragma unroll
            for (int i = 0; i < 16; ++i) { x[2 * i] = __uint_as_float(rw[i] << 16); x[2 * i + 1] = __uint_as_float(rw[i] & 0xffff0000u); }
            float n2 = 0.f; const float sc = which ? qscale : 1.0f;
#pragma unroll
            for (int i = 0; i < 16; ++i) { const float2 c = sCS[tk][i]; o[i] = (x[i] * c.x - x[16 + i] * c.y) * sc; o[16 + i] = (x[i] * c.y + x[16 + i] * c.x) * sc; n2 += o[i] * o[i] + o[16 + i] * o[16 + i]; }
            uint4 w[4]; unsigned* ww = (unsigned*)w;
#pragma unroll
            for (int i = 0; i < 16; ++i) ww[i] = cvt_pk_bf16_(o[2 * i], o[2 * i + 1]);
            uint4* dst = (uint4*)((which ? p.Qr : p.Kr) + ((size_t)bh * TJ + tau) * 64 + m * 32);
            dst[0] = w[0]; dst[1] = w[1]; dst[2] = w[2]; dst[3] = w[3];
            if (which) p.Qn[((size_t)bh * TJ + tau) * 2 + m] = sqrtf(n2);
            else atomicMax(&sMax[hm], __float_as_uint(n2 * 1.02f));
        }
        {
            const uint4* src = (const uint4*)(p.P + r * DINP + C_DAV + h * 64 + m * 32);
            uint4 raw[4]; raw[0] = src[0]; raw[1] = src[1]; raw[2] = src[2]; raw[3] = src[3];
            const bf16_t* rv = (const bf16_t*)raw;
            const int pos = (tk & ~15) | ((tk & 4) << 1) | ((tk & 8) >> 1) | (tk & 3);
#pragma unroll
            for (int i = 0; i < 32; ++i) sVt[(h * 64 + m * 32 + i) * 64 + pos] = rv[i];
        }
        __syncthreads();
        if (tid_ < 8) atomicMax(&p.kmax[(b * 4 + (tid_ >> 1)) * 2 + (tid_ & 1)], sMax[tid_]);
        for (int c = tid_; c < 2048; c += NTHR) {
            const int row = c >> 3, ch = c & 7, hq = row >> 6, dv = row & 63;
            *(uint4*)(p.Vt + ((((size_t)(b * 4 + hq) * 132 + kt) * 64 + dv) * 64 + ch * 8)) = *(const uint4*)(sVt + row * 64 + ch * 8);
        }
    }
}

#ifdef EMU
#define ATT_BAR() __syncthreads()
#define ATT_DMA(g, l) do { *(uint4*)((l) + (tid_ & 63) * 16) = *(const uint4*)(g); } while (0)
#define ATT_DMA_WAIT() do {} while (0)
#define ATT_PIN_P() do {} while (0)
#define ATT_LD_FENCE() do {} while (0)
#define ATT_PIN_S() do {} while (0)
#define ATT_PIN_O() do {} while (0)
#else
#define ATT_DMA(g, l) __builtin_amdgcn_global_load_lds((const unsigned*)(g), (LAS unsigned*)(l), 16, 0, 0)
#define ATT_DMA_WAIT() asm volatile("s_waitcnt vmcnt(0)" ::: "memory")
#define ATT_BAR() do { __builtin_amdgcn_sched_barrier(0); asm volatile("s_waitcnt lgkmcnt(0)" ::: "memory"); __builtin_amdgcn_s_barrier(); asm volatile("" ::: "memory"); __builtin_amdgcn_sched_barrier(0); } while (0)
#define ATT_LD_FENCE() __builtin_amdgcn_sched_barrier(0)
#define ATT_PIN_P() asm volatile("" : "+v"(pf[0][0]), "+v"(pf[0][1]), "+v"(pf[1][0]), "+v"(pf[1][1]), "+v"(l[0]), "+v"(l[1]))
#define ATT_PIN_S() asm volatile("" : "+v"(S[0]), "+v"(S[1]))
#define ATT_PIN_O() asm volatile("" : "+v"(O[0][0]), "+v"(O[0][1]), "+v"(O[1][0]), "+v"(O[1][1]))
#endif
__device__ __forceinline__ void ph_attn(const int wv_, unsigned char* smem, const Params& p, int layer) {
    PH_IDS();
    const int lane = tid_ & 63, w = tid_ >> 6, ql = lane & 31, hh = lane >> 5;
    const int grp = wv_ >> 2;
    unsigned char* sK0 = smem + 1024;
    constexpr int QB = (TJ - NCTX) / 256;
    const int nitem = 16 * QB + (layer < NLAYER - 1 ? 16 : 0);
    const float* lf = p.da_lambda + layer * 128;
    float d01 = 0.f, d23 = 0.f;
    for (int i = 0; i < 32; ++i) { d01 += lf[i] * lf[32 + i]; d23 += lf[64 + i] * lf[96 + i]; }
    const float lam_init = 0.8f - 0.6f * expf(-0.3f * (float)layer);
    const float lam = expf(d01) - expf(d23) + lam_init;
    int* qctr = p.cnt + 128;
    int* sitem = (int*)(smem + 64);
    for (;;) {
        __syncthreads();
        if (tid_ == 0) sitem[0] = atomicAdd(qctr, 1);
        __syncthreads();
        const int item = sitem[0];
        if (item >= nitem) break;
        const int is_ctx = item >= 16 * QB;
        const int bh = is_ctx ? item - 16 * QB : item / QB, b = bh >> 2, h = bh & 3;
        const int qtau = is_ctx ? w * 32 + ql : NCTX + (item % QB) * 256 + w * 32 + ql;
        const int ntile = is_ctx ? 4 : TJ / 64;
        bfx8 qf[2][2];
        const bf16_t* qp = p.Qr + ((size_t)bh * TJ + qtau) * 64 + hh * 8;
#pragma unroll
        for (int m = 0; m < 2; ++m)
#pragma unroll
            for (int ks = 0; ks < 2; ++ks) qf[m][ks] = *(const bfx8*)(qp + m * 32 + ks * 16);
        float negm[2];
#pragma unroll
        for (int m = 0; m < 2; ++m) negm[m] = -p.Qn[((size_t)bh * TJ + qtau) * 2 + m] * sqrtf(__uint_as_float(p.kmax[bh * 2 + m]));
        f32x16 O[2][2];
#pragma unroll
        for (int m = 0; m < 2; ++m)
#pragma unroll
            for (int t = 0; t < 2; ++t)
#pragma unroll
                for (int i = 0; i < 16; ++i) O[m][t][i] = 0.f;
        float l[2] = {0.f, 0.f};
        const int srow = tid_ >> 3, schk = (tid_ & 7) ^ ((tid_ >> 4) & 7);
        const char* kbase = (const char*)(p.Kr + (size_t)bh * TJ * 64) + srow * 128 + schk * 16;
        const char* vbase = (const char*)(p.Vt + (size_t)bh * 132 * 4096) + srow * 128 + schk * 16;
        __syncthreads();
        ATT_DMA(kbase, sK0 + wv_ * 1024); ATT_DMA(vbase, sK0 + 8192 + wv_ * 1024);
        if (ntile > 1) { ATT_DMA(kbase + 8192, sK0 + 16384 + wv_ * 1024); ATT_DMA(vbase + 8192, sK0 + 16384 + 8192 + wv_ * 1024); }
        if (ntile > 2) { ATT_DMA(kbase + 16384, sK0 + 32768 + wv_ * 1024); ATT_DMA(vbase + 16384, sK0 + 32768 + 8192 + wv_ * 1024); }
        ATT_DMA_WAIT();
        __syncthreads();
        if (grp) ATT_BAR();
        f32x16 S[2], NM[2];
        bfx8 pf[2][2];
#pragma unroll
        for (int m = 0; m < 2; ++m)
#pragma unroll
            for (int i = 0; i < 16; ++i) NM[m][i] = negm[m];
#ifndef EMU
        asm volatile("" : "+v"(NM[0]), "+v"(NM[1]));
#endif
#define ATT_LDK(sKp, sb) do { const int key = (sb) * 32 + ql; \
            _Pragma("unroll") for (int m = 0; m < 2; ++m) { _Pragma("unroll") for (int ks = 0; ks < 2; ++ks) { const int c = m * 4 + ks * 2 + hh; \
                kf[m][ks] = *(const bfx8*)((sKp) + key * 128 + ((c ^ ((key >> 1) & 7)) << 4)); } } } while (0)
#define ATT_LDV(sVp, sb) do { \
            _Pragma("unroll") for (int s2 = 0; s2 < 2; ++s2) { _Pragma("unroll") for (int t = 0; t < 2; ++t) { const int dv = t * 32 + ql, c = ((sb) * 2 + s2) * 2 + hh; \
                vf[s2][t] = *(const bfx8*)((sVp) + dv * 128 + ((c ^ ((dv >> 1) & 7)) << 4)); } } } while (0)
#define ATT_QK() do { \
            _Pragma("unroll") for (int m = 0; m < 2; ++m) { \
                S[m] = __builtin_amdgcn_mfma_f32_32x32x16_bf16(kf[m][0], qf[m][0], NM[m], 0, 0, 0); \
                S[m] = __builtin_amdgcn_mfma_f32_32x32x16_bf16(kf[m][1], qf[m][1], S[m], 0, 0, 0); } \
            ATT_PIN_S(); } while (0)
#define ATT_PV() do { \
            _Pragma("unroll") for (int s2 = 0; s2 < 2; ++s2) { _Pragma("unroll") for (int t = 0; t < 2; ++t) { \
                O[0][t] = __builtin_amdgcn_mfma_f32_32x32x16_bf16(vf[s2][t], pf[0][s2], O[0][t], 0, 0, 0); \
                O[1][t] = __builtin_amdgcn_mfma_f32_32x32x16_bf16(vf[s2][t], pf[1][s2], O[1][t], 0, 0, 0); } } \
            ATT_PIN_O(); } while (0)
#define ATT_SOFTMAX() do { \
            _Pragma("unroll") for (int m = 0; m < 2; ++m) { float ls = 0.f; \
                _Pragma("unroll") for (int i = 0; i < 16; ++i) { S[m][i] = __builtin_amdgcn_exp2f(S[m][i]); ls += S[m][i]; } \
                l[m] += ls; \
                _Pragma("unroll") for (int s2 = 0; s2 < 2; ++s2) { unsigned u[4]; \
                    _Pragma("unroll") for (int j = 0; j < 4; ++j) u[j] = cvt_pk_bf16_(S[m][8 * s2 + 2 * j], S[m][8 * s2 + 2 * j + 1]); \
                    pf[m][s2] = *(const bfx8*)u; } } \
            ATT_PIN_P(); } while (0)
        bfx8 kf[2][2], vf[2][2];
        ATT_LDK(sK0, 0);
        ATT_QK();
        ATT_BAR();
        ATT_LDK(sK0, 1); ATT_LDV(sK0 + 8192, 0);
        ATT_LD_FENCE();
        ATT_SOFTMAX();
        ATT_BAR();
        int r0 = 0, r1 = 16384, r2 = 32768;
#pragma unroll 1
        for (int j = 0; j + 1 < ntile; ++j) {
            ATT_QK();
            ATT_PV();
            ATT_BAR();
            ATT_LDK(sK0 + r1, 0); ATT_LDV(sK0 + r0 + 8192, 1);
            ATT_LD_FENCE();
            ATT_SOFTMAX();
            ATT_BAR();
            ATT_QK();
            ATT_PV();
            ATT_BAR();
            ATT_LDK(sK0 + r1, 1); ATT_LDV(sK0 + r1 + 8192, 0);
            ATT_LD_FENCE();
            ATT_SOFTMAX();
            ATT_DMA_WAIT();
            if (j + 3 < ntile) { ATT_DMA(kbase + (size_t)(j + 3) * 8192, sK0 + r0 + wv_ * 1024); ATT_DMA(vbase + (size_t)(j + 3) * 8192, sK0 + r0 + 8192 + wv_ * 1024); }
            ATT_BAR();
            { const int t = r0; r0 = r1; r1 = r2; r2 = t; }
        }
        {
            ATT_QK();
            ATT_PV();
            ATT_BAR();
            ATT_LDV(sK0 + r0 + 8192, 1);
            ATT_LD_FENCE();
            ATT_SOFTMAX();
            ATT_BAR();
            ATT_PV();
            ATT_BAR();
            ATT_BAR();
        }
        if (!grp) ATT_BAR();
#undef ATT_LDK
#undef ATT_LDV
#undef ATT_QK
#undef ATT_PV
#undef ATT_SOFTMAX
        const float l0 = l[0] + __shfl_xor(l[0], 32, 64), l1 = l[1] + __shfl_xor(l[1], 32, 64);
        const float i0 = 1.0f / l0, i1 = lam / l1;
        float ss = 0.f;
#pragma unroll
        for (int t = 0; t < 2; ++t)
#pragma unroll
            for (int i = 0; i < 16; ++i) { const float o = O[0][t][i] * i0 - O[1][t][i] * i1; O[0][t][i] = o; ss += o * o; }
        ss += __shfl_xor(ss, 32, 64);
        const float rs = rsqrtf(ss * (1.0f / 64.0f) + 1e-5f) * (1.0f - lam_init);
        const float* g = p.da_norm_g + layer * 64;
        bf16_t* yo = p.Y + ((size_t)b * TJ + qtau) * DM + 512 + h * 64;
#pragma unroll
        for (int t = 0; t < 2; ++t)
#pragma unroll
            for (int gq = 0; gq < 4; ++gq) {
                const int dv0 = 32 * t + 8 * gq + 4 * hh;
                uint2 w2;
                w2.x = cvt_pk_bf16_(O[0][t][4 * gq] * rs * g[dv0], O[0][t][4 * gq + 1] * rs * g[dv0 + 1]);
                w2.y = cvt_pk_bf16_(O[0][t][4 * gq + 2] * rs * g[dv0 + 2], O[0][t][4 * gq + 3] * rs * g[dv0 + 3]);
                *(uint2*)(yo + dv0) = w2;
            }
    }
}

__device__ __forceinline__ void ph_finish(const int wv_, unsigned char* smem, const Params& p, int layer) {
    PH_IDS();
    const int lane = tid_ & 63, c4 = lane * 4;
    const float4 g = *(const float4*)(p.dn_norm_g + layer * 64 + (c4 & 63));
    for (int r0 = WID * 2; r0 < NTOK; r0 += GWV * 2) {
        if (layer == NLAYER - 1 && (r0 % TJ) < NCTX) continue;
        uint2 ya[2], yb[2], zz[2];
#pragma unroll
        for (int u = 0; u < 2; ++u) { const size_t r = (size_t)(r0 + u);
            ya[u] = *(const uint2*)(p.Y + r * DM + c4); yb[u] = *(const uint2*)(p.ODN + r * 256 + c4); zz[u] = *(const uint2*)(p.P + r * DINP + C_DNZ + c4); }
#pragma unroll
        for (int u = 0; u < 2; ++u) {
            float o0 = __uint_as_float(ya[u].x << 16) + __uint_as_float(yb[u].x << 16), o1 = __uint_as_float(ya[u].x & 0xffff0000u) + __uint_as_float(yb[u].x & 0xffff0000u);
            float o2 = __uint_as_float(ya[u].y << 16) + __uint_as_float(yb[u].y << 16), o3 = __uint_as_float(ya[u].y & 0xffff0000u) + __uint_as_float(yb[u].y & 0xffff0000u);
            float ss = o0 * o0 + o1 * o1 + o2 * o2 + o3 * o3;
            ss += __shfl_xor(ss, 1, 64); ss += __shfl_xor(ss, 2, 64); ss += __shfl_xor(ss, 4, 64); ss += __shfl_xor(ss, 8, 64);
            const float rs = rsqrtf(ss * (1.f / 64.f) + 1e-6f);
            const float z0 = __uint_as_float(zz[u].x << 16), z1 = __uint_as_float(zz[u].x & 0xffff0000u), z2 = __uint_as_float(zz[u].y << 16), z3 = __uint_as_float(zz[u].y & 0xffff0000u);
            uint2 w; w.x = cvt_pk_bf16_(o0 * rs * g.x * siluf_(z0), o1 * rs * g.y * siluf_(z1)); w.y = cvt_pk_bf16_(o2 * rs * g.z * siluf_(z2), o3 * rs * g.w * siluf_(z3));
            *(uint2*)(p.Y + (size_t)(r0 + u) * DM + c4) = w;
        }
    }
}

__device__ __forceinline__ void ph_norm2_route(const int wv_, unsigned char* smem, const Params& p, int layer) {
    PH_IDS();
    int lane = tid_ & 63;
    float* swr = (float*)(smem + 1024);
    int* lcnt = (int*)(smem + 64);
    __syncthreads();
    for (int i = tid_; i < DM * 16; i += NTHR) { const int k = i >> 4, e = i & 15; swr[e * DM + k] = p.w_router[i]; }
    if (tid_ < 16) lcnt[tid_] = 0;
    __syncthreads();
    const int rpb = (NTOK + nblk_ - 1) / nblk_;
    for (int rr = (tid_ >> 6); rr < rpb; rr += NWV) {
        const int r = bid_ * rpb + rr;
        if (r >= NTOK) continue;
        if (layer == NLAYER - 1 && (r % TJ) < NCTX) continue;
        const float* h = hrow(p, r); const float* md = modrow(p, layer, r);
        float f[16]; float ss = 0.f;
#pragma unroll
        for (int i = 0; i < 4; ++i) { float4 v = *(const float4*)(h + i * 256 + lane * 4); f[i * 4] = v.x; f[i * 4 + 1] = v.y; f[i * 4 + 2] = v.z; f[i * 4 + 3] = v.w; ss += v.x * v.x + v.y * v.y + v.z * v.z + v.w * v.w; }
        ss = wave_sum(ss);
        float rs = rsqrtf(ss * (1.0f / DM) + 1e-6f);
        const float* g = p.norm2_g + layer * DM;
        float sc[16];
#pragma unroll
        for (int e = 0; e < 16; ++e) sc[e] = 0.f;
#pragma unroll
        for (int i = 0; i < 4; ++i) {
            int c0 = i * 256 + lane * 4; ushort4 ob; bf16_t* obp = (bf16_t*)&ob;
            float vq[4];
#pragma unroll
            for (int j = 0; j < 4; ++j) { vq[j] = f[i * 4 + j] * rs * g[c0 + j] * (1.f + md[4 * DM + c0 + j]) + md[3 * DM + c0 + j]; obp[j] = f2bf(vq[j]); }
#pragma unroll
            for (int e = 0; e < 16; ++e) { const float4 w = *(const float4*)(swr + e * DM + c0); sc[e] += vq[0] * w.x + vq[1] * w.y + vq[2] * w.z + vq[3] * w.w; }
            *(ushort4*)(p.A + (size_t)r * DM + c0) = ob;
        }
        {
            float t8[8], t4[4], t2[2], t1;
#pragma unroll
            for (int i = 0; i < 8; ++i) { const float keep = (lane & 1) ? sc[i + 8] : sc[i], send = (lane & 1) ? sc[i] : sc[i + 8]; t8[i] = keep + __shfl_xor(send, 1, 64); }
#pragma unroll
            for (int i = 0; i < 4; ++i) { const float keep = (lane & 2) ? t8[i + 4] : t8[i], send = (lane & 2) ? t8[i] : t8[i + 4]; t4[i] = keep + __shfl_xor(send, 2, 64); }
#pragma unroll
            for (int i = 0; i < 2; ++i) { const float keep = (lane & 4) ? t4[i + 2] : t4[i], send = (lane & 4) ? t4[i] : t4[i + 2]; t2[i] = keep + __shfl_xor(send, 4, 64); }
            { const float keep = (lane & 8) ? t2[1] : t2[0], send = (lane & 8) ? t2[0] : t2[1]; t1 = keep + __shfl_xor(send, 8, 64); }
            t1 += __shfl_xor(t1, 16, 64); t1 += __shfl_xor(t1, 32, 64);
#pragma unroll
            for (int e = 0; e < 16; ++e) sc[e] = rdlane(t1, ((e >> 3) & 1) | (((e >> 2) & 1) << 1) | (((e >> 1) & 1) << 2) | ((e & 1) << 3));
        }
        if (lane == 0) {
            float s[16], gb[16];
#pragma unroll
            for (int e = 0; e < 16; ++e) { s[e] = sigmoidf_(sc[e]); gb[e] = s[e] + p.b_router[e]; }
            int best = 0; float bestv = -1e30f;
#pragma unroll
            for (int gI = 0; gI < 4; ++gI) {
                float a0 = -1e30f, a1 = -1e30f;
#pragma unroll
                for (int j = 0; j < 4; ++j) { float v = gb[gI * 4 + j]; if (v > a0) { a1 = a0; a0 = v; } else if (v > a1) a1 = v; }
                float gs = a0 + a1; if (gs > bestv) { bestv = gs; best = gI; }
            }
            int i0 = 0, i1 = 0; float v0 = -1e30f, v1 = -1e30f;
#pragma unroll
            for (int j = 0; j < 4; ++j) {
                float v = 0.f;
#pragma unroll
                for (int gI = 0; gI < 4; ++gI) if (gI == best) v = gb[gI * 4 + j];
                if (v > v0) { v1 = v0; i1 = i0; v0 = v; i0 = j; } else if (v > v1) { v1 = v; i1 = j; }
            }
            int e0 = best * 4 + i0, e1 = best * 4 + i1;
            float w0 = 0.f, w1 = 0.f;
#pragma unroll
            for (int e = 0; e < 16; ++e) { if (e == e0) w0 = s[e]; if (e == e1) w1 = s[e]; }
            float inv = 1.f / (w0 + w1);
            p.tok_e[r * 2] = e0; p.tok_e[r * 2 + 1] = e1; p.tok_w[r * 2] = w0 * inv; p.tok_w[r * 2 + 1] = w1 * inv;
            p.tok_pos[r * 2] = atomicAdd(&lcnt[e0], 1); p.tok_pos[r * 2 + 1] = atomicAdd(&lcnt[e1], 1);
        }
    }
    __syncthreads();
    if (tid_ < 16) p.cnt[1024 + bid_ * 16 + tid_] = atomicAdd(&p.cnt[512 + tid_ * 16], lcnt[tid_]);
}

__device__ __forceinline__ void ph_moe_gather(const int wv_, unsigned char* smem, const Params& p, int layer) {
    PH_IDS();
    int* sstart = (int*)(smem + 64);
    __syncthreads();
    if (tid_ == 0) {
        int acc = 0;
        for (int e = 0; e < 16; ++e) { sstart[e] = acc; acc += (p.cnt[512 + e * 16] + 255) / 256 * 256; if (bid_ == 0) p.cnt[16 + e] = acc; }
        if (bid_ == 0) p.cnt[32] = acc;
    }
    __syncthreads();
    int lane = tid_ & 63;
    const int rpb = (NTOK + nblk_ - 1) / nblk_;
    for (int r0 = WID * 2; r0 < NTOK; r0 += GWV * 2) {
        if (layer == NLAYER - 1 && (r0 % TJ) < NCTX) continue;
        const int r1 = r0 + 1;
        const int e00 = p.tok_e[2 * r0] & 15, e01 = p.tok_e[2 * r0 + 1] & 15, e10 = p.tok_e[2 * r1] & 15, e11 = p.tok_e[2 * r1 + 1] & 15;
        const int q00 = p.tok_pos[2 * r0], q01 = p.tok_pos[2 * r0 + 1], q10 = p.tok_pos[2 * r1], q11 = p.tok_pos[2 * r1 + 1];
        const uint4* sa = (const uint4*)(p.A + (size_t)r0 * DM); const uint4* sb = (const uint4*)(p.A + (size_t)r1 * DM);
        const uint4 a0 = sa[lane], a1 = sa[lane + 64], b0 = sb[lane], b1 = sb[lane + 64];
        const int* wb0 = p.cnt + 1024 + (r0 / rpb) * 16; const int* wb1 = p.cnt + 1024 + (r1 / rpb) * 16;
        const int s00 = sstart[e00] + wb0[e00] + q00, s01 = sstart[e01] + wb0[e01] + q01, s10 = sstart[e10] + wb1[e10] + q10, s11 = sstart[e11] + wb1[e11] + q11;
        if (lane == 0) { p.tok_slot[2 * r0] = s00; p.tok_slot[2 * r0 + 1] = s01; p.tok_slot[2 * r1] = s10; p.tok_slot[2 * r1 + 1] = s11; }
        uint4* d00 = (uint4*)(p.BUF + (size_t)s00 * DM); uint4* d01 = (uint4*)(p.BUF + (size_t)s01 * DM); uint4* d10 = (uint4*)(p.BUF + (size_t)s10 * DM); uint4* d11 = (uint4*)(p.BUF + (size_t)s11 * DM);
        d00[lane] = a0; d00[lane + 64] = a1; d01[lane] = a0; d01[lane + 64] = a1;
        d10[lane] = b0; d10[lane + 64] = b1; d11[lane] = b0; d11[lane + 64] = b1;
    }
}

__device__ __forceinline__ void ph_moe_combine(const int wv_, const Params& p, int layer) {
    PH_IDS();
    int lane = tid_ & 63;
    int rn = WID;
    while (rn < NTOK && layer == NLAYER - 1 && (rn % TJ) < NCTX) rn += GWV;
    int s0n = 0, s1n = 0; float w0n = 0.f, w1n = 0.f;
    if (rn < NTOK) { s0n = p.tok_slot[rn * 2]; s1n = p.tok_slot[rn * 2 + 1]; w0n = p.tok_w[rn * 2]; w1n = p.tok_w[rn * 2 + 1]; }
    while (rn < NTOK) {
        const int r = rn; const int s0 = s0n, s1 = s1n; const float w0 = w0n, w1 = w1n;
        rn += GWV;
        while (rn < NTOK && layer == NLAYER - 1 && (rn % TJ) < NCTX) rn += GWV;
        if (rn < NTOK) { s0n = p.tok_slot[rn * 2]; s1n = p.tok_slot[rn * 2 + 1]; w0n = p.tok_w[rn * 2]; w1n = p.tok_w[rn * 2 + 1]; }
        float* h = hrow(p, r); const float* md = modrow(p, layer, r) + 5 * DM;
        const bf16_t* p0 = p.PO + (size_t)s0 * DM; const bf16_t* p1 = p.PO + (size_t)s1 * DM;
        float v[16]; float ss = 0.f;
#pragma unroll
        for (int i = 0; i < 4; ++i) {
            int c0 = i * 256 + lane * 4;
            float4 hv = *(const float4*)(h + c0); ushort4 a = *(const ushort4*)(p0 + c0), bq = *(const ushort4*)(p1 + c0); float4 m = *(const float4*)(md + c0);
            hv.x += m.x * (w0 * bf2f(a.x) + w1 * bf2f(bq.x)); hv.y += m.y * (w0 * bf2f(a.y) + w1 * bf2f(bq.y));
            hv.z += m.z * (w0 * bf2f(a.z) + w1 * bf2f(bq.z)); hv.w += m.w * (w0 * bf2f(a.w) + w1 * bf2f(bq.w));
            v[i * 4] = hv.x; v[i * 4 + 1] = hv.y; v[i * 4 + 2] = hv.z; v[i * 4 + 3] = hv.w;
            ss += hv.x * hv.x + hv.y * hv.y + hv.z * hv.z + hv.w * hv.w;
        }
        ss = wave_sum(ss); const float rs = rsqrtf(ss * (1.0f / DM) + 1e-6f);
        if (layer == NLAYER - 1) {
#pragma unroll
            for (int i = 0; i < 4; ++i) { int c0 = i * 256 + lane * 4; float4 g = *(const float4*)(p.final_g + c0);
                float4 o; o.x = v[i * 4] * rs * g.x; o.y = v[i * 4 + 1] * rs * g.y; o.z = v[i * 4 + 2] * rs * g.z; o.w = v[i * 4 + 3] * rs * g.w; *(float4*)(h + c0) = o; }
        } else {
            const float* g1 = p.norm1_g + (layer + 1) * DM; const float* mdn = modrow(p, layer + 1, r);
#pragma unroll
            for (int i = 0; i < 4; ++i) { int c0 = i * 256 + lane * 4; float4 o; o.x = v[i * 4]; o.y = v[i * 4 + 1]; o.z = v[i * 4 + 2]; o.w = v[i * 4 + 3]; *(float4*)(h + c0) = o;
                const float4 gg = *(const float4*)(g1 + c0), sh = *(const float4*)(mdn + c0), sc = *(const float4*)(mdn + DM + c0);
                ushort4 ob; ob.x = f2bf(o.x * rs * gg.x * (1.f + sc.x) + sh.x); ob.y = f2bf(o.y * rs * gg.y * (1.f + sc.y) + sh.y); ob.z = f2bf(o.z * rs * gg.z * (1.f + sc.z) + sh.z); ob.w = f2bf(o.w * rs * gg.w * (1.f + sc.w) + sh.w);
                *(ushort4*)(p.A + (size_t)r * DM + c0) = ob; }
        }
    }
}


#ifndef EMU
struct CvtTask { const float* src; bf16_t* dst; int lds, K, N, Nsrc, ldd; };
__device__ __forceinline__ void cvt_tiles(unsigned char* smem, const CvtTask& t, int& base, int tid_, int bid_, int nblk_) {
    float (*sT)[65] = (float (*)[65])(smem + 1024);
    const int nkt = t.K / 64, nnt = t.N / 64, ntile = nkt * nnt;
    int first = (bid_ - base % nblk_ + nblk_) % nblk_;
    for (int it = first; it < ntile; it += nblk_) {
        const int kt = it % nkt, ntl = it / nkt, k0 = kt * 64, n0 = ntl * 64;
        __syncthreads();
#pragma unroll
        for (int j = 0; j < 2; ++j) {
            int k = (tid_ >> 4) + 32 * j, n4 = (tid_ & 15) * 4;
            float4 v = make_float4(0.f, 0.f, 0.f, 0.f);
            if (n0 + n4 < t.Nsrc) v = *(const float4*)(t.src + (size_t)(k0 + k) * t.lds + n0 + n4);
            sT[k][n4] = v.x; sT[k][n4 + 1] = v.y; sT[k][n4 + 2] = v.z; sT[k][n4 + 3] = v.w;
        }
        __syncthreads();
        {
            int n = tid_ >> 3, k8 = (tid_ & 7) * 8;
            ushort4 a, b;
            a.x = f2bf(sT[k8 + 0][n]); a.y = f2bf(sT[k8 + 1][n]); a.z = f2bf(sT[k8 + 2][n]); a.w = f2bf(sT[k8 + 3][n]);
            b.x = f2bf(sT[k8 + 4][n]); b.y = f2bf(sT[k8 + 5][n]); b.z = f2bf(sT[k8 + 6][n]); b.w = f2bf(sT[k8 + 7][n]);
            bf16_t* d = t.dst + (size_t)(n0 + n) * t.ldd + k0 + k8;
            *(ushort4*)d = a; *(ushort4*)(d + 4) = b;
        }
    }
    base += ntile;
}
__device__ __forceinline__ void ph_convert(const int wv_, unsigned char* smem, const Params& p, int layer) {
    PH_IDS();
    int base = 0;
    cvt_tiles(smem, CvtTask{p.w_in + (size_t)layer * DM * DIN, p.WinT, DIN, DM, DINP, DIN, DM}, base, tid_, bid_, nblk_);
}
__device__ __forceinline__ void convert_merge_vb(unsigned char* smem, const Params& p, int layer, const int bid_, const int nblk_, const int tid_) {
    int base = 0;
    cvt_tiles(smem, CvtTask{p.w_gate + (size_t)layer * DM * 4096, p.WgT, 4096, DM, 4096, 4096, DM}, base, tid_, bid_, nblk_);
    for (int i = 0; i < 4; ++i)
        cvt_tiles(smem, CvtTask{p.w_branch + ((size_t)layer * 4 + i) * 256 * DM, p.WbrT + i * 256, DM, 256, DM, DM, DM}, base, tid_, bid_, nblk_);
    cvt_tiles(smem, CvtTask{p.w_out + (size_t)layer * DM * DM, p.WoT, DM, DM, DM, DM, DM}, base, tid_, bid_, nblk_);
}
__device__ __forceinline__ void ph_convert_experts(const int wv_, unsigned char* smem, const Params& p, int layer) {
    PH_IDS();
    int base = 0;
    for (int e = 0; e < NEXP; ++e) {
        for (int u = 0; u < 4; ++u) {
            cvt_tiles(smem, CvtTask{p.w_e_gate + ((size_t)layer * NEXP + e) * DM * DEXP + u * 128, p.WguT + ((size_t)e * 1024 + u * 256) * DM, DEXP, DM, 128, 128, DM}, base, tid_, bid_, nblk_);
            cvt_tiles(smem, CvtTask{p.w_e_up + ((size_t)layer * NEXP + e) * DM * DEXP + u * 128, p.WguT + ((size_t)e * 1024 + u * 256 + 128) * DM, DEXP, DM, 128, 128, DM}, base, tid_, bid_, nblk_);
        }
        cvt_tiles(smem, CvtTask{p.w_e_down + ((size_t)layer * NEXP + e) * DEXP * DM, p.WdT + (size_t)e * DM * DEXP, DM, DEXP, DM, DM, DEXP}, base, tid_, bid_, nblk_);
    }
}

namespace pg8 {
#define PG8_LAS __attribute__((address_space(3)))
typedef short bf16x8 __attribute__((ext_vector_type(8)));
typedef float f32x4 __attribute__((ext_vector_type(4)));
typedef unsigned u32x4 __attribute__((ext_vector_type(4)));
constexpr int BM = 256, BK = 64, HALF = 128, HTB = HALF * BK * 2, STAGE_BYTES = 8 * HTB, NXCD = 8, WGM = 8;
__host__ __device__ __forceinline__ int lds_byte(int r, int c) { const int st = (r >> 4) * 2 + (c >> 5), rr = r & 15, cc = c & 31, ob = rr * 64 + cc * 2; return st * 1024 + (ob ^ (((ob >> 9) & 1) << 5)); }
__host__ __device__ __forceinline__ void stage_rc(int b, int& R, int& C) { const int st = b / 1024, sb = b % 1024, swz = sb ^ (((sb >> 9) & 1) << 5); R = (st >> 1) * 16 + swz / 64; C = (st & 1) * 32 + (swz % 64) / 2; }
__host__ __device__ __forceinline__ int perm32(int rho) { const int n = rho >> 4, i = rho & 15; return 8 * (i >> 2) + 4 * n + (i & 3); }
struct Unit { int pm, pn, nt, kind; const char* a; const char* b; };
__device__ __forceinline__ void static_map(int L, int nM, int nN, int& pm, int& pn) {
    const int nwg = nM * nN; int wgid = L; { const int q = nwg / NXCD, r = nwg % NXCD, xcd = wgid % NXCD, off = wgid / NXCD; wgid = (xcd < r ? xcd * (q + 1) : r * (q + 1) + (xcd - r) * q) + off; }
    const int nig = WGM * nN, gid = wgid / nig, fm = gid * WGM, gsz = (nM - fm) < WGM ? (nM - fm) : WGM;
    pm = fm + ((wgid % nig) % gsz); pn = (wgid % nig) / gsz;
}
__device__ __forceinline__ unsigned cvt_pk_bf16(float lo, float hi) { return cvt_pk_bf16_(lo, hi); }

template <class Epi, class Sched>
__device__ __forceinline__ void gemm_phase(PG8_LAS unsigned char* lds, const int lda, const int ldb, const Sched& S, const Epi& E, int tid) {
    asm volatile("" : "+v"(tid));
    const int wid = __builtin_amdgcn_readfirstlane(tid >> 6), lane = tid & 63, wr = wid >> 2, wc = wid & 3, fr = lane & 15, fq = lane >> 4;
    unsigned voffA[2], voffB[2];
#pragma unroll
    for (int i = 0; i < 2; ++i) { int R, C; stage_rc(tid * 16 + i * 8192, R, C); const int Rb = Epi::PERM ? ((R & ~31) + perm32(R & 31)) : R;
        voffA[i] = (unsigned)(R * lda + C) * 2u; voffB[i] = (unsigned)(Rb * ldb + C) * 2u; }
    const size_t kstep = (size_t)(BK * 2);
    const size_t hstepA = (size_t)HALF * lda * 2, hstepB = (size_t)HALF * ldb * 2;
    const unsigned ldsw = (unsigned)wid * 1024u;
    const int aoff = lds_byte(wr * 64 + fr, fq * 8), boff = lds_byte(wc * 32 + fr, fq * 8);
#define PG8_SA(b, h) (((b) * 2 + (h)) * HTB)
#define PG8_SB(b, h) ((4 + (b) * 2 + (h)) * HTB)
#define PG8_STAGE(bufoff, gbase, voff) do { _Pragma("unroll") for (int _i = 0; _i < 2; ++_i) \
        __builtin_amdgcn_global_load_lds((const unsigned*)((const char*)(gbase) + (voff)[_i]), (PG8_LAS unsigned*)(lds + (bufoff) + ldsw + _i * 8192), 16, 0, 0); } while (0)
#define PG8_LDA(dst, b, h) do { _Pragma("unroll") for (int m = 0; m < 4; ++m) _Pragma("unroll") for (int k = 0; k < 2; ++k) dst[m][k] = *(const PG8_LAS bf16x8*)(lds + PG8_SA(b, h) + aoff + m * 2048 + k * 1024); } while (0)
#define PG8_LDB(dst, b, h) do { _Pragma("unroll") for (int n = 0; n < 2; ++n) _Pragma("unroll") for (int k = 0; k < 2; ++k) dst[n][k] = *(const PG8_LAS bf16x8*)(lds + PG8_SB(b, h) + boff + n * 2048 + k * 1024); } while (0)
#define PG8_MMA(ai, bj, At, Bt) do { __builtin_amdgcn_s_setprio(1); _Pragma("unroll") for (int m = 0; m < 4; ++m) _Pragma("unroll") for (int n = 0; n < 2; ++n) _Pragma("unroll") for (int k = 0; k < 2; ++k) \
        acc[ai][bj][m][n] = __builtin_amdgcn_mfma_f32_16x16x32_bf16(Bt[n][k], At[m][k], acc[ai][bj][m][n], 0, 0, 0); __builtin_amdgcn_s_setprio(0); } while (0)
#define PG8_WAIT_V(n) asm volatile("s_waitcnt vmcnt(" #n ")" ::: "memory")
#define PG8_WAIT_L(n) asm volatile("s_waitcnt lgkmcnt(" #n ")" ::: "memory")
#define PG8_BAR __builtin_amdgcn_s_barrier()
#define PG8_SCHED __builtin_amdgcn_sched_barrier(0)
    Unit cur, nxt; int ui = 0;
    if (!S.next(0, cur)) return;
    f32x4 acc[2][2][4][2];
#pragma unroll
    for (int a = 0; a < 2; ++a)
#pragma unroll
        for (int b = 0; b < 2; ++b)
#pragma unroll
            for (int m = 0; m < 4; ++m)
#pragma unroll
                for (int n = 0; n < 2; ++n) acc[a][b][m][n] = (f32x4){0.f, 0.f, 0.f, 0.f};
    bf16x8 At[4][2], B0[2][2], B1[2][2];
    const char* cA = cur.a; const char* cB = cur.b;
    PG8_STAGE(PG8_SB(0, 0), cB, voffB); PG8_STAGE(PG8_SA(0, 0), cA, voffA); PG8_STAGE(PG8_SB(0, 1), cB + hstepB, voffB); PG8_STAGE(PG8_SA(0, 1), cA + hstepA, voffA);
    if (wr == 1) PG8_BAR;
    PG8_WAIT_V(4); PG8_BAR;
    PG8_STAGE(PG8_SB(1, 0), cB + kstep, voffB); PG8_STAGE(PG8_SA(1, 0), cA + kstep, voffA); PG8_STAGE(PG8_SB(1, 1), cB + hstepB + kstep, voffB);
    PG8_WAIT_V(6); PG8_BAR;
    for (;;) {
        const bool has_next = S.next(ui + 1, nxt);
        const char* nA = has_next ? nxt.a : cA; const char* nB = has_next ? nxt.b : cB;
        const int nt = cur.nt;
        for (int t = 0; t < nt; t += 2) {
            const bool last = (t == nt - 2);
            const char* a1 = cA + (size_t)(t + 1) * kstep;
            const char* a2 = last ? nA : cA + (size_t)(t + 2) * kstep; const char* b2 = last ? nB : cB + (size_t)(t + 2) * kstep;
            const char* a3 = a2 + kstep; const char* b3 = b2 + kstep;
            PG8_LDB(B0, 0, 0); PG8_SCHED; PG8_LDA(At, 0, 0); PG8_STAGE(PG8_SA(1, 1), a1 + hstepA, voffA);
            PG8_WAIT_L(8); PG8_BAR; PG8_WAIT_L(0); PG8_MMA(0, 0, At, B0); PG8_BAR; PG8_SCHED;
            PG8_LDB(B1, 0, 1); PG8_STAGE(PG8_SB(0, 0), b2, voffB);
            PG8_BAR; PG8_WAIT_L(0); PG8_MMA(0, 1, At, B1); PG8_BAR;
            PG8_LDA(At, 0, 1); PG8_STAGE(PG8_SA(0, 0), a2, voffA);
            PG8_BAR; PG8_WAIT_L(0); PG8_MMA(1, 0, At, B0); PG8_BAR; PG8_SCHED;
            PG8_STAGE(PG8_SB(0, 1), b2 + hstepB, voffB);
            PG8_WAIT_V(6); PG8_BAR; PG8_MMA(1, 1, At, B1); PG8_BAR;
            PG8_LDB(B0, 1, 0); PG8_SCHED; PG8_LDA(At, 1, 0); PG8_STAGE(PG8_SA(0, 1), a2 + hstepA, voffA);
            PG8_WAIT_L(8); PG8_BAR; PG8_WAIT_L(0); PG8_MMA(0, 0, At, B0); PG8_BAR; PG8_SCHED;
            PG8_LDB(B1, 1, 1); PG8_STAGE(PG8_SB(1, 0), b3, voffB);
            PG8_BAR; PG8_WAIT_L(0); PG8_MMA(0, 1, At, B1); PG8_BAR;
            PG8_LDA(At, 1, 1); PG8_STAGE(PG8_SA(1, 0), a3, voffA);
            PG8_BAR; PG8_WAIT_L(0); PG8_MMA(1, 0, At, B0); PG8_BAR; PG8_SCHED;
            PG8_STAGE(PG8_SB(1, 1), b3 + hstepB, voffB);
            PG8_WAIT_V(6); PG8_BAR; PG8_MMA(1, 1, At, B1); PG8_BAR;
        }
        E(acc, cur, wr, wc, fr, fq, tid);
        if (!has_next) break;
#pragma unroll
        for (int a = 0; a < 2; ++a)
#pragma unroll
            for (int b = 0; b < 2; ++b)
#pragma unroll
                for (int m = 0; m < 4; ++m)
#pragma unroll
                    for (int n = 0; n < 2; ++n) acc[a][b][m][n] = (f32x4){0.f, 0.f, 0.f, 0.f};
        cur = nxt; cA = nA; cB = nB; ++ui;
    }
    PG8_WAIT_V(0);
    if (wr == 0) PG8_BAR;
    PG8_BAR;
#undef PG8_SA
#undef PG8_SB
#undef PG8_STAGE
#undef PG8_LDA
#undef PG8_LDB
#undef PG8_MMA
#undef PG8_WAIT_V
#undef PG8_WAIT_L
#undef PG8_BAR
#undef PG8_SCHED
}

struct SchedRows {
    const char* A; const char* Bt; int lda, ldb, nt, nN, nM, skip_ctx, G, c;
    __device__ __forceinline__ bool next(int i, Unit& u) const {
        const int L = i * G + c; if (L >= nM * nN) return false;
        int pmi, pn; static_map(L, nM, nN, pmi, pn);
        const int pm = skip_ctx ? (pmi >> 5) * 33 + 1 + (pmi & 31) : pmi;
        u.pm = pm; u.pn = pn; u.nt = nt; u.kind = 0;
        u.a = A + (size_t)pm * 256 * lda * 2; u.b = Bt + (size_t)pn * 256 * ldb * 2; return true;
    }
};
struct SchedMerge {
    const char* A; const char* Y; const char* WgT; const char* WbrT; int with_ctx, G, c;
    __device__ __forceinline__ bool next(int i, Unit& u) const {
        const int nlat = (NB * 32 * 4) / G;
        if (i < nlat * 8) {
            const int ch = (i >> 3) * G + c, sub = i & 7;
            int pmi, pn; static_map(ch, NB * 32, 4, pmi, pn);
            const int pm = (pmi >> 5) * 33 + 1 + (pmi & 31), br = sub >> 1;
            u.pm = pm; u.pn = pn; u.kind = sub;
            if (sub & 1) { u.nt = 4;  u.a = Y + ((size_t)pm * 256 * DM + br * 256) * 2; u.b = WbrT + ((size_t)pn * 256 * DM + br * 256) * 2; }
            else         { u.nt = 16; u.a = A + (size_t)pm * 256 * DM * 2;              u.b = WgT + ((size_t)br * DM + pn * 256) * DM * 2; }
            return true;
        }
        const int j = i - nlat * 8;
        if (!with_ctx || c >= 64 || j >= 2) return false;
        const int tile = c >> 2, br = c & 3, pm = (tile >> 2) * 33, pn = tile & 3;
        u.pm = pm; u.pn = pn; u.kind = 16 + (br << 1) + j;
        if (j) { u.nt = 4;  u.a = Y + ((size_t)pm * 256 * DM + br * 256) * 2; u.b = WbrT + ((size_t)pn * 256 * DM + br * 256) * 2; }
        else   { u.nt = 16; u.a = A + (size_t)pm * 256 * DM * 2;              u.b = WgT + ((size_t)br * DM + pn * 256) * DM * 2; }
        return true;
    }
};
struct SchedMoe {
    const char* A; const char* Bt; const int* pe  ; int lda, ldb, nt, nN, G, c;
    __device__ __forceinline__ bool next(int i, Unit& u) const {
        const int nM = pe[16] >> 8; const int L = i * G + c; if (L >= nM * nN) return false;
        int pm, pn; static_map(L, nM, nN, pm, pn);
        int e = 0;
#pragma unroll
        for (int j = 0; j < 16; ++j) e += (pe[j] <= pm * 256) ? 1 : 0;
        if (e > 15) e = 15;
        u.pm = pm; u.pn = pn; u.nt = nt; u.kind = e;
        u.a = A + (size_t)pm * 256 * lda * 2; u.b = Bt + ((size_t)e * nN + pn) * 256 * ldb * 2; return true;
    }
};

struct EpiBf16 {
    static constexpr bool PERM = true;
    bf16_t* O; int ldc;
    __device__ __forceinline__ void operator()(const f32x4 (&acc)[2][2][4][2], const Unit& u, int wr, int wc, int fr, int fq, int tid) const {
        const int row0 = u.pm * BM + wr * 64 + fr, col0 = u.pn * BM + wc * 32 + 8 * fq;
#pragma unroll
        for (int ai = 0; ai < 2; ++ai)
#pragma unroll
            for (int m = 0; m < 4; ++m) { bf16_t* rowp = O + (size_t)(row0 + ai * HALF + m * 16) * ldc + col0;
#pragma unroll
                for (int bj = 0; bj < 2; ++bj) { const f32x4 v0 = acc[ai][bj][m][0], v1 = acc[ai][bj][m][1];
                    u32x4 w; w.x = cvt_pk_bf16(v0[0], v0[1]); w.y = cvt_pk_bf16(v0[2], v0[3]); w.z = cvt_pk_bf16(v1[0], v1[1]); w.w = cvt_pk_bf16(v1[2], v1[3]);
                    *(u32x4*)(rowp + bj * HALF) = w; } }
    }
};
struct EpiResidual {
    static constexpr bool PERM = false;
    float* hctx; float* out; const float* mod; int layer, modoff; const float* sctx; const float* slat;
    __device__ __forceinline__ void operator()(const f32x4 (&acc)[2][2][4][2], const Unit& u, int wr, int wc, int fr, int fq, int tid) const {
        const int row0 = u.pm * BM + wr * 64 + fr, col0 = u.pn * BM + wc * 32 + 4 * fq;
        const int b = (u.pm * BM) / TJ; const bool isctx = (u.pm * BM - b * TJ) < NCTX;
        const float* md = mod + ((size_t)layer * 5 + (isctx ? 4 : b)) * (6 * DM) + modoff * DM + col0;
        f32x4 mv[2][2];
#pragma unroll
        for (int bj = 0; bj < 2; ++bj)
#pragma unroll
            for (int n = 0; n < 2; ++n) mv[bj][n] = *(const f32x4*)(md + bj * HALF + n * 16);
        const size_t roff = isctx ? ((size_t)b * NCTX + (row0 - b * TJ)) * DM + col0 : ((size_t)b * SEQ + (row0 - b * TJ - NCTX)) * DM + col0;
        float* const base = (isctx ? hctx : out) + roff; const float* const sbase = (isctx ? sctx : slat) + roff;
#pragma unroll
        for (int ai = 0; ai < 2; ++ai) {
            f32x4 hv[4][2][2];
#pragma unroll
            for (int m = 0; m < 4; ++m)
#pragma unroll
                for (int bj = 0; bj < 2; ++bj)
#pragma unroll
                    for (int n = 0; n < 2; ++n) hv[m][bj][n] = *(const f32x4*)(sbase + (size_t)(ai * HALF + m * 16) * DM + bj * HALF + n * 16);
#pragma unroll
            for (int m = 0; m < 4; ++m)
#pragma unroll
                for (int bj = 0; bj < 2; ++bj)
#pragma unroll
                    for (int n = 0; n < 2; ++n) *(f32x4*)(base + (size_t)(ai * HALF + m * 16) * DM + bj * HALF + n * 16) = hv[m][bj][n] + mv[bj][n] * acc[ai][bj][m][n];
        }
    }
};
struct EpiMerge {
    static constexpr bool PERM = true;
    bf16_t* T; bf16_t* stash  ; const float* bgate; bf16_t* TP;
    __device__ __forceinline__ void operator()(const f32x4 (&acc)[2][2][4][2], const Unit& u, int wr, int wc, int fr, int fq, int tid) const {
        const bool part = u.kind >= 16;
        const int br = (u.kind & 15) >> 1;
        asm volatile("" : "+v"(tid));
        const unsigned soff = (unsigned)tid * 16u;
        if ((u.kind & 1) == 0) {
            const float* bg = bgate + br * DM + u.pn * BM + wc * 32 + 8 * fq;
            f32x4 bv[2][2];
#pragma unroll
            for (int bj = 0; bj < 2; ++bj)
#pragma unroll
                for (int n = 0; n < 2; ++n) bv[bj][n] = *(const f32x4*)(bg + bj * HALF + 4 * n);
#pragma unroll
            for (int ai = 0; ai < 2; ++ai)
#pragma unroll
                for (int m = 0; m < 4; ++m)
#pragma unroll
                    for (int bj = 0; bj < 2; ++bj) { f32x4 v0 = acc[ai][bj][m][0] + bv[bj][0], v1 = acc[ai][bj][m][1] + bv[bj][1];
#pragma unroll
                        for (int j = 0; j < 4; ++j) { v0[j] = sigmoidf_(v0[j]); v1[j] = sigmoidf_(v1[j]); }
                        u32x4 w; w.x = cvt_pk_bf16(v0[0], v0[1]); w.y = cvt_pk_bf16(v0[2], v0[3]); w.z = cvt_pk_bf16(v1[0], v1[1]); w.w = cvt_pk_bf16(v1[2], v1[3]);
                        *(u32x4*)((char*)stash + (soff + (unsigned)(((ai * 4 + m) * 2 + bj) * NTHR * 16))) = w; }
        } else {
            const int row0 = (part ? (u.pm / 33) * BM : u.pm * BM) + wr * 64 + fr, col0 = u.pn * BM + wc * 32 + 8 * fq;
            bf16_t* Tb = (part ? TP + (size_t)br * (NB * NCTX) * DM : T) + (size_t)row0 * DM + col0;
            const bool rmw = br > 0 && !part;
#pragma unroll
            for (int ai = 0; ai < 2; ++ai) {
                u32x4 g[4][2], o[4][2];
#pragma unroll
                for (int m = 0; m < 4; ++m)
#pragma unroll
                    for (int bj = 0; bj < 2; ++bj) g[m][bj] = *(const u32x4*)((const char*)stash + (soff + (unsigned)(((ai * 4 + m) * 2 + bj) * NTHR * 16)));
                if (rmw) {
#pragma unroll
                    for (int m = 0; m < 4; ++m)
#pragma unroll
                        for (int bj = 0; bj < 2; ++bj) o[m][bj] = *(const u32x4*)(Tb + (size_t)(ai * HALF + m * 16) * DM + bj * HALF);
                } else {
#pragma unroll
                    for (int m = 0; m < 4; ++m)
#pragma unroll
                        for (int bj = 0; bj < 2; ++bj) o[m][bj] = (u32x4){0u, 0u, 0u, 0u};
                }
#pragma unroll
                for (int m = 0; m < 4; ++m)
#pragma unroll
                    for (int bj = 0; bj < 2; ++bj) {
                        const u32x4 gg = g[m][bj], oo = o[m][bj];
                        f32x4 v0 = acc[ai][bj][m][0], v1 = acc[ai][bj][m][1];
                        v0[0] = v0[0] * __uint_as_float(gg.x << 16) + __uint_as_float(oo.x << 16); v0[1] = v0[1] * __uint_as_float(gg.x & 0xffff0000u) + __uint_as_float(oo.x & 0xffff0000u);
                        v0[2] = v0[2] * __uint_as_float(gg.y << 16) + __uint_as_float(oo.y << 16); v0[3] = v0[3] * __uint_as_float(gg.y & 0xffff0000u) + __uint_as_float(oo.y & 0xffff0000u);
                        v1[0] = v1[0] * __uint_as_float(gg.z << 16) + __uint_as_float(oo.z << 16); v1[1] = v1[1] * __uint_as_float(gg.z & 0xffff0000u) + __uint_as_float(oo.z & 0xffff0000u);
                        v1[2] = v1[2] * __uint_as_float(gg.w << 16) + __uint_as_float(oo.w << 16); v1[3] = v1[3] * __uint_as_float(gg.w & 0xffff0000u) + __uint_as_float(oo.w & 0xffff0000u);
                        u32x4 w; w.x = cvt_pk_bf16(v0[0], v0[1]); w.y = cvt_pk_bf16(v0[2], v0[3]); w.z = cvt_pk_bf16(v1[0], v1[1]); w.w = cvt_pk_bf16(v1[2], v1[3]);
                        *(u32x4*)(Tb + (size_t)(ai * HALF + m * 16) * DM + bj * HALF) = w; }
            }
        }
    }
};
struct EpiSwiGlu {
    static constexpr bool PERM = true;
    bf16_t* H;
    __device__ __forceinline__ void operator()(const f32x4 (&acc)[2][2][4][2], const Unit& u, int wr, int wc, int fr, int fq, int tid) const {
        const int row0 = u.pm * BM + wr * 64 + fr, col0 = u.pn * HALF + wc * 32 + 8 * fq;
#pragma unroll
        for (int ai = 0; ai < 2; ++ai)
#pragma unroll
            for (int m = 0; m < 4; ++m) {
                f32x4 v0 = acc[ai][0][m][0], v1 = acc[ai][0][m][1]; const f32x4 u0 = acc[ai][1][m][0], u1 = acc[ai][1][m][1];
#pragma unroll
                for (int j = 0; j < 4; ++j) { v0[j] = siluf_(v0[j]) * u0[j]; v1[j] = siluf_(v1[j]) * u1[j]; }
                u32x4 w; w.x = cvt_pk_bf16(v0[0], v0[1]); w.y = cvt_pk_bf16(v0[2], v0[3]); w.z = cvt_pk_bf16(v1[0], v1[1]); w.w = cvt_pk_bf16(v1[2], v1[3]);
                *(u32x4*)(H + (size_t)(row0 + ai * HALF + m * 16) * DEXP + col0) = w;
            }
    }
};
}

#define STAGE_OFF 1024
__device__ __forceinline__ void ph_gemm_inproj(const int wv_, unsigned char* smem, const Params& p) {
    PH_IDS();
    pg8::SchedRows S{(const char*)p.A, (const char*)p.WinT, DM, DM, DM / 64, DINP / 256, NTOK / 256, 0, nblk_, bid_};
    pg8::gemm_phase((PG8_LAS unsigned char*)(smem + STAGE_OFF), DM, DM, S, pg8::EpiBf16{p.P, DINP}, tid_);
}
__device__ __forceinline__ void ph_gemm_merge(const int wv_, unsigned char* smem, const Params& p, int layer, int last) {
    PH_IDS();
    pg8::SchedMerge S{(const char*)p.A, (const char*)p.Y, (const char*)p.WgT, (const char*)p.WbrT, !last, nblk_, bid_};
    pg8::gemm_phase((PG8_LAS unsigned char*)(smem + STAGE_OFF), DM, DM, S, pg8::EpiMerge{p.T, p.STASH + (size_t)bid_ * 65536, p.b_gate + layer * 4096, p.TP}, tid_);
}
__device__ __forceinline__ void ph_ctx_sum(const int wv_, const Params& p) {
    PH_IDS();
    for (int idx = bid_ * NTHR + tid_; idx < NB * NCTX * DM / 8; idx += nblk_ * NTHR) {
        const int row = idx / (DM / 8), c8 = (idx - row * (DM / 8)) * 8, b = row / NCTX, t = row - b * NCTX;
        float a[8];
#pragma unroll
        for (int e = 0; e < 8; ++e) a[e] = 0.f;
#pragma unroll
        for (int br = 0; br < 4; ++br) {
            const uint4 v = *(const uint4*)(p.TP + ((size_t)br * (NB * NCTX) + row) * DM + c8); const unsigned vv[4] = {v.x, v.y, v.z, v.w};
#pragma unroll
            for (int e = 0; e < 4; ++e) { a[2 * e] += __uint_as_float(vv[e] << 16); a[2 * e + 1] += __uint_as_float(vv[e] & 0xffff0000u); }
        }
        uint4 o; o.x = cvt_pk_bf16_(a[0], a[1]); o.y = cvt_pk_bf16_(a[2], a[3]); o.z = cvt_pk_bf16_(a[4], a[5]); o.w = cvt_pk_bf16_(a[6], a[7]);
        *(uint4*)(p.T + ((size_t)b * TJ + t) * DM + c8) = o;
    }
}
__device__ __forceinline__ void ph_gemm_wout(const int wv_, unsigned char* smem, const Params& p, int layer, int last) {
    PH_IDS();
    pg8::SchedRows S{(const char*)p.T, (const char*)p.WoT, DM, DM, DM / 64, DM / 256, last ? NB * 32 : NTOK / 256, last, nblk_, bid_};
    pg8::gemm_phase((PG8_LAS unsigned char*)(smem + STAGE_OFF), DM, DM, S, pg8::EpiResidual{p.hctx, p.out, p.mod, layer, 2, layer == 0 ? p.ctx : p.hctx, layer == 0 ? p.x : p.out}, tid_);
}
__device__ __forceinline__ void moe_pad_to_lds(unsigned char* smem, const Params& p, int tid_) {
    __syncthreads();
    if (tid_ < 17) ((int*)(smem + 64))[tid_] = p.cnt[16 + tid_];
    __syncthreads();
}
__device__ __forceinline__ void ph_gemm_moe_up(const int wv_, unsigned char* smem, const Params& p) {
    PH_IDS();
    moe_pad_to_lds(smem, p, tid_);
    pg8::SchedMoe S{(const char*)p.BUF, (const char*)p.WguT, (const int*)(smem + 64), DM, DM, DM / 64, 4, nblk_, bid_};
    pg8::gemm_phase((PG8_LAS unsigned char*)(smem + STAGE_OFF), DM, DM, S, pg8::EpiSwiGlu{p.HID}, tid_);
}
__device__ __forceinline__ void ph_gemm_moe_down(const int wv_, unsigned char* smem, const Params& p) {
    PH_IDS();
    moe_pad_to_lds(smem, p, tid_);
    pg8::SchedMoe S{(const char*)p.HID, (const char*)p.WdT, (const int*)(smem + 64), DEXP, DEXP, DEXP / 64, 4, nblk_, bid_};
    pg8::gemm_phase((PG8_LAS unsigned char*)(smem + STAGE_OFF), DEXP, DEXP, S, pg8::EpiBf16{p.PO, DM}, tid_);
}

__device__ __forceinline__ void ph_tail_work(const int wv_, unsigned char* smem, const Params& p, int layer) {
    PH_IDS();
    int* sitem = (int*)(smem + 64);
    for (;;) {
        __syncthreads();
        if (tid_ == 0) sitem[0] = atomicAdd(p.cnt + 133, 1);
        __syncthreads();
        const int item = sitem[0];
        if (item >= 80 + 256) break;
        if (item < 80) s5_prep_item(smem, p, layer, item, tid_);
        else convert_merge_vb(smem, p, layer, item - 80, 256, tid_);
    }
}

#define LDS_BYTES (152 * 1024)
typedef const __attribute__((address_space(4))) unsigned long long* KArgPtr;
__device__ __forceinline__ Params ldparams() {
    KArgPtr q = (KArgPtr)__builtin_amdgcn_kernarg_segment_ptr(); asm volatile("" : "+s"(q));
    Params r; unsigned long long* d = (unsigned long long*)&r;
#pragma unroll
    for (int i = 0; i < (int)(sizeof(Params) / 8); ++i) d[i] = q[i];
    return r;
}
#define PHASE(call) do { const Params p = ldparams(); call; } while (0)
#ifndef PROBE_T
#define PROBE_T 0
#endif
#if PROBE_T
#define TMARK(id) do { if ((id) == PROBE_T && blockIdx.x == 0 && threadIdx.x == 0) *(unsigned long long*)(smem + 96) = __builtin_amdgcn_s_memrealtime(); } while (0)
#define TSTOP(id) do { if ((id) == PROBE_T && blockIdx.x == 0 && threadIdx.x == 0) *(unsigned long long*)(smem + 104) += __builtin_amdgcn_s_memrealtime() - *(unsigned long long*)(smem + 96); } while (0)
#else
#define TMARK(id) do {} while (0)
#define TSTOP(id) do {} while (0)
#endif

#define GRID_SYNC() do { int t0_ = wv * 64 + (int)__builtin_amdgcn_mbcnt_hi(~0u, __builtin_amdgcn_mbcnt_lo(~0u, 0u)); asm volatile("" : "+v"(t0_)); \
    XcdBarrier b_; b_.bar = ldparams().bar; b_.x = xb_xcc_id(); b_.st = (volatile LAS unsigned*)smem; xcd_barrier_(b_, t0_); } while (0)
__device__ __forceinline__ void layer_body(const int l, const int wv, unsigned char* smem) {
    const int last = (l == NLAYER - 1);
    if (l == 0) {
        TMARK(2);
        PHASE(ph_norm1(wv, p, l));
        GRID_SYNC(); TSTOP(2);
    }
    TMARK(3);
    PHASE(ph_gemm_inproj(wv, smem, p));
    PHASE(ph_tail_work(wv, smem, p, l));
    GRID_SYNC(); TSTOP(3);
    TMARK(4);
    PHASE(ph_dn_prep(wv, smem, p, l, 0));
    GRID_SYNC(); TSTOP(4);
    TMARK(5);
    PHASE(ph_dn_prep(wv, smem, p, l, 1));
    PHASE(ph_dn_defer_publish(wv, p));
    PHASE(ph_attn_prep(wv, smem, p, l));
    PHASE(ph_gla1(wv, smem, p, l));
    PHASE(ph_s5_1(wv, smem, p, l));
    if (blockIdx.x >= 32) { PHASE(ph_sub_barrier(wv, p)); }
    PHASE(ph_scans(wv, smem, p, l));
    if (blockIdx.x < 32) { PHASE(ph_sub_barrier(wv, p)); }
    PHASE(ph_attn(wv, smem, p, l));
    PHASE(ph_wait_scans(wv, p));
    PHASE(ph_s5_3(wv, smem, p, l));
    PHASE(ph_gla3(wv, smem, p, l));
    GRID_SYNC(); TSTOP(5);
    TMARK(6);
    PHASE(ph_finish(wv, smem, p, l));
    GRID_SYNC(); TSTOP(6);
    TMARK(7);
    PHASE(ph_gemm_merge(wv, smem, p, l, last));
    GRID_SYNC();
    if (!last) { PHASE(ph_ctx_sum(wv, p)); GRID_SYNC(); }
    TSTOP(7);
    TMARK(8);
    PHASE(ph_gemm_wout(wv, smem, p, l, last));
    GRID_SYNC(); TSTOP(8);
    TMARK(9);
    PHASE(ph_convert_experts(wv, smem, p, l));
    PHASE(ph_norm2_route(wv, smem, p, l));
    GRID_SYNC(); TSTOP(9);
    TMARK(10);
    PHASE(ph_moe_gather(wv, smem, p, l));
    GRID_SYNC(); TSTOP(10);
    TMARK(11);
    PHASE(ph_gemm_moe_up(wv, smem, p));
    GRID_SYNC(); TSTOP(11);
    TMARK(12);
    PHASE(ph_gemm_moe_down(wv, smem, p));
    GRID_SYNC(); TSTOP(12);
    TMARK(13);
    PHASE(ph_moe_combine(wv, p, l));
    if (!last) { PHASE(ph_zero_counters(wv, p)); PHASE(ph_convert(wv, smem, p, l + 1)); }
    GRID_SYNC(); TSTOP(13);
}
__global__ __launch_bounds__(NTHR, 2) void k_mega(Params p_unused) {
    extern __shared__ __attribute__((aligned(16))) unsigned char smem[];
    int wv = __builtin_amdgcn_readfirstlane(threadIdx.x >> 6); asm volatile("" : "+s"(wv));
    if (threadIdx.x == 0) *(uint4*)smem = make_uint4(0u, 0u, 0u, 0u);
    __syncthreads();
    (void)xcd_barrier_post(ldparams().bar, (volatile LAS unsigned*)smem);
#if PROBE_T
    if (threadIdx.x == 0) *(unsigned long long*)(smem + 104) = 0ull;
#endif
    TMARK(1);
    PHASE(ph_mod(wv, smem, p));
    PHASE(ph_convert(wv, smem, p, 0));
    GRID_SYNC(); TSTOP(1);
    static_assert(NLAYER == 2, "layers are instantiated explicitly");
    layer_body(0, wv, smem);
    layer_body(1, wv, smem);
#if PROBE_T
    if (blockIdx.x == 0 && threadIdx.x == 0) {
        const unsigned long long acc = *(unsigned long long*)(smem + 104), t0 = __builtin_amdgcn_s_memrealtime();
        while (__builtin_amdgcn_s_memrealtime() - t0 < 4ull * acc) __builtin_amdgcn_s_sleep(8);
    }
#endif
}

static inline size_t al(size_t x) { return (x + 255) & ~(size_t)255; }

extern "C" void kernel_launch(void* const* d_in, const int* in_sizes, int n_in, void* d_out, int out_size, void* d_ws, size_t ws_size, hipStream_t stream) {
    Params p{};
    const float** ins = (const float**)d_in;
    p.x = ins[0]; p.c = ins[1]; p.ctx = ins[2]; p.c_ctx = ins[3]; p.w_mod = ins[4]; p.b_mod = ins[5]; p.norm1_g = ins[6]; p.norm2_g = ins[7]; p.w_in = ins[8];
    p.dn_conv = ins[9]; p.dn_a_log = ins[10]; p.dn_dt_bias = ins[11]; p.dn_norm_g = ins[12];
    p.s5_a_re = ins[13]; p.s5_a_im = ins[14]; p.s5_log_dt = ins[15]; p.s5_b_re = ins[16]; p.s5_b_im = ins[17]; p.s5_c_re = ins[18]; p.s5_c_im = ins[19]; p.s5_d = ins[20]; p.s5_glu_w = ins[21]; p.s5_glu_b = ins[22];
    p.da_lambda = ins[23]; p.da_norm_g = ins[24]; p.gla_w_gate = ins[25]; p.gla_b_gate = ins[26]; p.gla_norm_g = ins[27];
    p.w_branch = ins[28]; p.w_gate = ins[29]; p.b_gate = ins[30]; p.w_out = ins[31]; p.w_router = ins[32]; p.b_router = ins[33];
    p.w_e_gate = ins[34]; p.w_e_up = ins[35]; p.w_e_down = ins[36]; p.final_g = ins[37];
    p.out = (float*)d_out;
    char* ws = (char*)d_ws; size_t off = 0;
    auto take = [&](size_t bytes) { char* q = ws + off; off += al(bytes); return q; };
    p.bar = (unsigned*)take((size_t)XCD_BAR_WORDS * 4);
    p.cnt = (int*)take(8192 * 4);
    p.kmax = (unsigned*)take(256);
    p.mod = (float*)take((size_t)NLAYER * 5 * 6 * DM * 4);
    p.hctx = (float*)take((size_t)NB * NCTX * DM * 4);
    p.tok_e = (int*)take((size_t)NTOK * 2 * 4); p.tok_w = (float*)take((size_t)NTOK * 2 * 4); p.tok_pos = (int*)take((size_t)NTOK * 2 * 4); p.tok_slot = (int*)take((size_t)NTOK * 2 * 4);
    p.WinT = (bf16_t*)take((size_t)DINP * DM * 2); p.WgT = (bf16_t*)take((size_t)4096 * DM * 2); p.WbrT = (bf16_t*)take((size_t)DM * DM * 2); p.WoT = (bf16_t*)take((size_t)DM * DM * 2);
    p.SB = (bf16_t*)take((size_t)16 * 256 * 512 * 2); p.SE = (bf16_t*)take((size_t)16 * 256 * 256 * 2); p.GLUt = (bf16_t*)take((size_t)65536 * 2); p.A16 = (float*)take((size_t)2 * 16 * 64 * 2 * 4);
    p.A = (bf16_t*)take((size_t)NTOK * DM * 2);
    p.Y = (bf16_t*)take((size_t)NTOK * DM * 2);
    char* big = ws + off;
    p.P = (bf16_t*)take((size_t)NTOK * DINP * 2);
    char* ms = ws + off;
    p.WguT = (bf16_t*)(ms + ((size_t)16 << 20)); p.WdT = (bf16_t*)(ms + ((size_t)16 << 20) + (size_t)NEXP * 1024 * DM * 2);
    p.Qr = (bf16_t*)take((size_t)16 * TJ * 64 * 2); p.Kr = (bf16_t*)take((size_t)16 * TJ * 64 * 2); p.Vt = (bf16_t*)take((size_t)16 * 132 * 4096 * 2); p.Qn = (float*)take((size_t)16 * TJ * 2 * 4);
    p.ODN = (bf16_t*)take((size_t)NTOK * 256 * 2);
    p.QKVN = (bf16_t*)take((size_t)NTOK * 768 * 2);
    p.XS = (bf16_t*)take((size_t)NB * S5NS * 16 * 256 * 2);
    p.GST = (bf16_t*)take((size_t)32 * (TJ / 64) * 2048 * 2); p.DCY = (float*)take((size_t)32 * (TJ / 64) * 32 * 4);
    p.T = (bf16_t*)big;
    p.STASH = (bf16_t*)(big + al((size_t)NTOK * DM * 2));
    p.TP = (bf16_t*)(big + al((size_t)NTOK * DM * 2) + al((size_t)256 * 65536 * 2));
    p.BUF = (bf16_t*)big; p.PO = (bf16_t*)big;
    p.HID = (bf16_t*)(big + al((size_t)MAXSLOT * DM * 2));
    if (off > ws_size) return;

    static int grid = 0;
    if (!grid) {
        int dev = 0, cus = 0, per_cu = 0;
        (void)hipGetDevice(&dev);
        (void)hipDeviceGetAttribute(&cus, hipDeviceAttributeMultiprocessorCount, dev);
        (void)hipFuncSetAttribute((const void*)k_mega, hipFuncAttributeMaxDynamicSharedMemorySize, LDS_BYTES);
        (void)hipOccupancyMaxActiveBlocksPerMultiprocessor(&per_cu, (const void*)k_mega, NTHR, LDS_BYTES);
        grid = per_cu >= 1 ? cus : 0;
    }
    if (!grid) return;
    (void)hipMemsetAsync(p.bar, 0, (size_t)XCD_BAR_WORDS * 4, stream);
    k_mega<<<grid, NTHR, LDS_BYTES, stream>>>(p);
}

#endif
```
